# Optimizing an MI355X kernel written in HIP

```python
import math
import jax, jax.numpy as jnp
from jax import lax
import numpy as np

D_MODEL = 1024
BATCH = 2
SEQ = 16384
DEPTH = 4

D_RNN = 1024
RNN_BLOCKS = 16
RNN_BW = D_RNN // RNN_BLOCKS
CONV_W = 4
LRU_C = 8.0
N_HEADS = 8
HEAD_DIM = 128
D_ATT = N_HEADS * HEAD_DIM
KV_RANK = 256
IDX_HEADS = 8
IDX_DIM = 64
TOPK_MAX = 256
Q_BLOCK = 128
N_BUCKETS = 32
MAX_DIST = 128
N_EXPERTS = 16
N_GROUPS = 4
EXPERTS_PER_GROUP = N_EXPERTS // N_GROUPS
TOP_K_EXPERTS = 2
D_EXPERT = 512
ALPHA = (2 * DEPTH) ** 0.25
BETA = (8 * DEPTH) ** -0.25
LN_EPS = 1e-5
RMS_EPS = 1e-6
SPLITS = (D_RNN, D_RNN, D_ATT, KV_RANK, IDX_HEADS * IDX_DIM, IDX_DIM, IDX_HEADS, D_MODEL, D_MODEL)
D_IN = sum(SPLITS)
SPLIT_AT = tuple(int(v) for v in np.cumsum(SPLITS)[:-1])

kernel_name = "hybrid_rglru_dsa_groupmoe_deepnorm"


def layer_norm(x, g, b):
    xf = x.astype(jnp.float32)
    mu = jnp.mean(xf, axis=-1, keepdims=True)
    var = jnp.mean(jnp.square(xf - mu), axis=-1, keepdims=True)
    return ((xf - mu) * lax.rsqrt(var + LN_EPS) * g + b).astype(x.dtype)


def rms_norm(x, g):
    xf = x.astype(jnp.float32)
    return (xf * lax.rsqrt(jnp.mean(jnp.square(xf), axis=-1, keepdims=True) + RMS_EPS) * g).astype(x.dtype)


def causal_depthwise_conv(x, w, b):
    S = x.shape[1]
    xp = jnp.pad(x, ((0, 0), (CONV_W - 1, 0), (0, 0)))
    return b + sum(w[k] * xp[:, k:k + S] for k in range(CONV_W))


def rg_lru(x, w_a, b_a, w_x, b_x, lam):
    B, S, _ = x.shape
    xb = x.reshape(B, S, RNN_BLOCKS, RNN_BW)
    r = jax.nn.sigmoid(jnp.einsum('bsgi,gij->bsgj', xb, w_a).reshape(B, S, D_RNN) + b_a)
    i = jax.nn.sigmoid(jnp.einsum('bsgi,gij->bsgj', xb, w_x).reshape(B, S, D_RNN) + b_x)
    log_a = (-LRU_C * r.astype(jnp.float32)) * jax.nn.softplus(-lam.astype(jnp.float32))
    a = jnp.exp(log_a)
    u = jnp.sqrt(-jnp.expm1(2.0 * log_a)) * (i * x).astype(jnp.float32)

    def combine(left, right):
        a_l, b_l = left
        a_r, b_r = right
        return a_l * a_r, a_r * b_l + b_r

    _, h = lax.associative_scan(combine, (a, u), axis=1)
    return h.astype(x.dtype)


def t5_bucket(dist):
    max_exact = N_BUCKETS // 2
    d = jnp.maximum(dist, 0)
    large = max_exact + (jnp.log(jnp.maximum(d, 1).astype(jnp.float32) / max_exact)
                         / math.log(MAX_DIST / max_exact) * (N_BUCKETS - max_exact)).astype(jnp.int32)
    large = jnp.minimum(large, N_BUCKETS - 1)
    return jnp.where(d < max_exact, d, large)


def dsa_attention(q, c_kv, q_idx, k_idx, w_idx, w_uk, w_uv, rel_bias):
    B, S = c_kv.shape[:2]
    n_keep = min(TOPK_MAX, S // 4)
    nb = S // Q_BLOCK
    q_lat = jnp.einsum('bshd,hcd->bshc', q, w_uk) * (HEAD_DIM ** -0.5)
    key_pos = jnp.arange(S, dtype=jnp.int32)

    def blocks(a):
        return jnp.swapaxes(a.reshape(B, nb, Q_BLOCK, *a.shape[2:]), 0, 1)

    def one_block(args):
        blk, ql, qi, wi = args
        t = blk * Q_BLOCK + jnp.arange(Q_BLOCK, dtype=jnp.int32)
        sc = jax.nn.relu(jnp.einsum('bqhd,bsd->bqhs', qi, k_idx))
        sc = jnp.einsum('bqhs,bqh->bqs', sc, wi).astype(jnp.float32)
        causal = key_pos[None, :] <= t[:, None]
        sc = jnp.where(causal[None], sc, -jnp.inf)
        _, idx = lax.top_k(sc, n_keep)
        valid = idx <= t[None, :, None]
        kv = jax.vmap(lambda c, ix: c[ix])(c_kv, idx)
        logits = jnp.einsum('bqhc,bqkc->bhqk', ql, kv).astype(jnp.float32)
        bias = rel_bias[t5_bucket(t[None, :, None] - idx)]
        logits = logits + jnp.moveaxis(bias, -1, 1).astype(jnp.float32)
        logits = jnp.where(valid[:, None], logits, -1e30)
        p = jax.nn.softmax(logits, axis=-1).astype(kv.dtype)
        return jnp.einsum('bhqk,bqkc->bqhc', p, kv)

    o_lat = lax.map(one_block, (jnp.arange(nb, dtype=jnp.int32), blocks(q_lat), blocks(q_idx), blocks(w_idx)))
    o_lat = jnp.swapaxes(o_lat, 0, 1).reshape(B, S, N_HEADS, KV_RANK)
    o = jnp.einsum('bshc,hcd->bshd', o_lat, w_uv)
    return o.reshape(B, S, D_ATT)


def token_mixer(x, w_in, conv_w, conv_b, lru_wa, lru_ba, lru_wx, lru_bx, lru_lambda,
                kv_norm, w_uk, w_uv, proj_rnn, proj_att, w_out, rel_bias):
    B, S, _ = x.shape
    h = x @ w_in
    x_rnn, g_rnn, q, c_kv, q_idx, k_idx, w_idx, gate_rnn, gate_att = jnp.split(h, SPLIT_AT, axis=-1)
    xr = causal_depthwise_conv(x_rnn, conv_w, conv_b)
    y_rnn = rg_lru(xr, lru_wa, lru_ba, lru_wx, lru_bx, lru_lambda) * jax.nn.gelu(g_rnn)
    y_att = dsa_attention(q.reshape(B, S, N_HEADS, HEAD_DIM), rms_norm(c_kv, kv_norm),
                          q_idx.reshape(B, S, IDX_HEADS, IDX_DIM) * (IDX_DIM ** -0.5), k_idx,
                          w_idx * (IDX_HEADS ** -0.5), w_uk, w_uv, rel_bias)
    merged = jax.nn.sigmoid(gate_rnn) * (y_rnn @ proj_rnn) + jax.nn.sigmoid(gate_att) * (y_att @ proj_att)
    return merged @ w_out


def grouped_moe(x, w_router, router_bias, w_gate, w_up, w_down):
    B, S, D = x.shape
    tok = x.reshape(B * S, D)
    aff = jax.nn.sigmoid((tok @ w_router).astype(jnp.float32))
    sel = aff + router_bias.astype(jnp.float32)
    grp = sel.reshape(-1, N_GROUPS, EXPERTS_PER_GROUP)
    grp_score = jnp.sum(lax.top_k(grp, TOP_K_EXPERTS)[0], axis=-1)
    g_best = jnp.argmax(grp_score, axis=-1)
    in_group = (jnp.arange(N_EXPERTS) // EXPERTS_PER_GROUP)[None, :] == g_best[:, None]
    _, e_idx = lax.top_k(jnp.where(in_group, sel, -jnp.inf), TOP_K_EXPERTS)
    g = jnp.take_along_axis(aff, e_idx, axis=-1)
    g = g / jnp.sum(g, axis=-1, keepdims=True)
    combine = jnp.sum(jax.nn.one_hot(e_idx, N_EXPERTS, dtype=jnp.float32) * g[..., None], axis=1)
    out = jnp.zeros_like(tok)
    for e in range(N_EXPERTS):
        he = jax.nn.silu(tok @ w_gate[e]) * (tok @ w_up[e])
        out = out + combine[:, e:e + 1].astype(tok.dtype) * (he @ w_down[e])
    return out.reshape(B, S, D)


def setup_inputs(seed: int = 0) -> dict:
    key = jax.random.key(seed)
    ks = jax.random.split(key, 24)
    f32 = jnp.float32
    L = DEPTH

    def nrm(k, shape, scale):
        return jax.random.normal(k, shape, f32) * scale

    u = jax.random.uniform(ks[9], (L, D_RNN), f32, 0.9, 0.999)
    a0 = u ** (1.0 / LRU_C)
    lru_lambda = jnp.log(a0) - jnp.log1p(-a0)
    return {
        "x": nrm(ks[0], (BATCH, SEQ, D_MODEL), 1.0),
        "w_in": nrm(ks[1], (L, D_MODEL, D_IN), D_MODEL ** -0.5),
        "conv_w": nrm(ks[2], (L, CONV_W, D_RNN), CONV_W ** -0.5),
        "conv_b": nrm(ks[3], (L, D_RNN), 0.01),
        "lru_wa": nrm(ks[4], (L, RNN_BLOCKS, RNN_BW, RNN_BW), RNN_BW ** -0.5),
        "lru_ba": nrm(ks[5], (L, D_RNN), 0.01),
        "lru_wx": nrm(ks[6], (L, RNN_BLOCKS, RNN_BW, RNN_BW), RNN_BW ** -0.5),
        "lru_bx": nrm(ks[7], (L, D_RNN), 0.01),
        "lru_lambda": lru_lambda,
        "kv_norm": 1.0 + nrm(ks[8], (L, KV_RANK), 0.02),
        "w_uk": nrm(ks[10], (L, N_HEADS, KV_RANK, HEAD_DIM), KV_RANK ** -0.5),
        "w_uv": nrm(ks[11], (L, N_HEADS, KV_RANK, HEAD_DIM), KV_RANK ** -0.5),
        "proj_rnn": nrm(ks[12], (L, D_RNN, D_MODEL), D_RNN ** -0.5),
        "proj_att": nrm(ks[13], (L, D_ATT, D_MODEL), D_ATT ** -0.5),
        "w_out": nrm(ks[14], (L, D_MODEL, D_MODEL), BETA * D_MODEL ** -0.5),
        "ln1_g": 1.0 + nrm(ks[15], (L, D_MODEL), 0.02),
        "ln1_b": nrm(ks[16], (L, D_MODEL), 0.01),
        "w_router": nrm(ks[17], (D_MODEL, N_EXPERTS), D_MODEL ** -0.5),
        "router_bias": nrm(ks[18], (N_EXPERTS,), 0.01),
        "exp_w_gate": nrm(ks[19], (L, N_EXPERTS, D_MODEL, D_EXPERT), D_MODEL ** -0.5),
        "exp_w_up": nrm(ks[20], (L, N_EXPERTS, D_MODEL, D_EXPERT), D_MODEL ** -0.5),
        "exp_w_down": nrm(ks[21], (L, N_EXPERTS, D_EXPERT, D_MODEL), BETA * D_EXPERT ** -0.5),
        "ln2_g": 1.0 + nrm(ks[22], (L, D_MODEL), 0.02),
        "ln2_b": nrm(ks[23], (L, D_MODEL), 0.01),
        "rel_bias": nrm(jax.random.fold_in(key, 99), (N_BUCKETS, N_HEADS), 0.1),
    }


def reference(x, w_in, conv_w, conv_b, lru_wa, lru_ba, lru_wx, lru_bx, lru_lambda, kv_norm,
              w_uk, w_uv, proj_rnn, proj_att, w_out, ln1_g, ln1_b, w_router, router_bias,
              exp_w_gate, exp_w_up, exp_w_down, ln2_g, ln2_b, rel_bias):
    for l in range(DEPTH):
        mix = token_mixer(x, w_in[l], conv_w[l], conv_b[l], lru_wa[l], lru_ba[l], lru_wx[l], lru_bx[l],
                          lru_lambda[l], kv_norm[l], w_uk[l], w_uv[l], proj_rnn[l], proj_att[l], w_out[l],
                          rel_bias)
        x = layer_norm(ALPHA * x + mix, ln1_g[l], ln1_b[l])
        ffn = grouped_moe(x, w_router, router_bias, exp_w_gate[l], exp_w_up[l], exp_w_down[l])
        x = layer_norm(ALPHA * x + ffn, ln2_g[l], ln2_b[l])
    return x
```

```cpp
#include <hip/hip_runtime.h>
#include <cstdio>
#include <cstdint>

#define GAS __attribute__((address_space(1)))
#define LAS __attribute__((address_space(3)))
typedef unsigned short bf16_t;
typedef short bf16x8 __attribute__((ext_vector_type(8)));
typedef short s16x4 __attribute__((ext_vector_type(4)));
typedef float f32x2 __attribute__((ext_vector_type(2)));
typedef float f32x4 __attribute__((ext_vector_type(4)));
typedef float f32x16 __attribute__((ext_vector_type(16)));
typedef unsigned u32x2 __attribute__((ext_vector_type(2)));
typedef unsigned u32x4 __attribute__((ext_vector_type(4)));

constexpr int NB = 2, SEQ = 16384, T = NB * SEQ, D = 1024, NL = 4, DIN = 5960;
constexpr int NE = 16;
constexpr float ALPHA = 1.681792830507429f;
constexpr float LN_EPS = 1e-5f, RMS_EPS = 1e-6f;
constexpr int NWAVES = 8, NTHR = 512;

constexpr size_t MiB = 1u << 20;
constexpr size_t WS_CTL = 0, CTL_BYTES = 1 * MiB;
constexpr size_t WS_XB = 1 * MiB;
constexpr size_t WS_WMIX = 65 * MiB, WMIX_STRIDE = 22 * MiB;
constexpr size_t OFF_WIN = 0, OFF_WG = 10 * MiB, OFF_WPR = 14 * MiB, OFF_WVO = 16 * MiB, OFF_WO = 20 * MiB;
constexpr size_t WS_WSM = 153 * MiB;
constexpr size_t WS_WEXP = 154 * MiB;
constexpr size_t OFF_DN = 32 * MiB;
constexpr size_t WS_R = 202 * MiB;
constexpr size_t R_XRNN = 0, R_GRNN = 64 * MiB, R_QLAT = 128 * MiB, R_CKV = 256 * MiB, R_QIDX = 272 * MiB, R_KIDX = 304 * MiB, R_WIDX = 308 * MiB,
                 R_TOT = 309 * MiB, R_MSCR = 310 * MiB, R_MSCR2 = 342 * MiB, R_END = 406 * MiB;
constexpr size_t R_MERGED = R_XRNN;
constexpr size_t R_XG = 0, R_HE = 136 * MiB, R_ROUTE = 204 * MiB;
constexpr size_t R_WQ = 0, R_UKP = 8 * MiB, R_PT = 24 * MiB, R_UVP = 32 * MiB;
constexpr size_t WS_END = WS_R + R_END;
constexpr int MP_MAX = 2 * T + NE * 256;

constexpr int CW_TMO = 0;
constexpr int CW_BAR = 4096;
constexpr int CW_CNT = 8192;

constexpr int LDS_BYTES = 163840;
constexpr int LDS_MISC = LDS_BYTES - 256;

#define RLX_AGENT __ATOMIC_RELAXED, __HIP_MEMORY_SCOPE_AGENT
__device__ __forceinline__ unsigned f2bf(float f) { unsigned u = __builtin_bit_cast(unsigned, f); return (u + 0x7fffu + ((u >> 16) & 1u)) >> 16; }
typedef __bf16 bf16x2_t __attribute__((ext_vector_type(2)));
__device__ __forceinline__ unsigned pk2(float lo, float hi) { const f32x2 v = {lo, hi}; const bf16x2_t b = __builtin_convertvector(v, bf16x2_t); return __builtin_bit_cast(unsigned, b); }
__device__ __forceinline__ float bf_lo(unsigned w) { return __builtin_bit_cast(float, w << 16); }
__device__ __forceinline__ float bf_hi(unsigned w) { return __builtin_bit_cast(float, w & 0xffff0000u); }
__device__ __forceinline__ float bf2f(bf16_t h) { return __builtin_bit_cast(float, ((unsigned)h) << 16); }
__device__ __forceinline__ float fast_exp(float x) { return __builtin_amdgcn_exp2f(x * 1.4426950408889634f); }
__device__ __forceinline__ float fast_rcp(float x) { return __builtin_amdgcn_rcpf(x); }
__device__ __forceinline__ float sigmoidf_(float x) { return fast_rcp(1.0f + fast_exp(-x)); }
__device__ __forceinline__ float gelu_tanh(float x) { const float y = 0.7978845608028654f * (x + 0.044715f * x * x * x); const float e = fast_exp(2.0f * y); const float th = 1.0f - 2.0f * fast_rcp(e + 1.0f); return 0.5f * x * (1.0f + th); }
__device__ __forceinline__ float wave_sum(float v) {
#pragma unroll
    for (int o = 1; o < 64; o <<= 1) v += __shfl_xor(v, o);
    return v;
}

__device__ __forceinline__ int lane_id() { unsigned z = 0u; asm volatile("" : "+v"(z)); return (int)__builtin_amdgcn_mbcnt_hi(~0u, __builtin_amdgcn_mbcnt_lo(~0u, z)); }
#define XB_TMO      128
#define XB_XCNT(j)  (256  + 64 * (j))
#define XB_XSUB(j)  (1280 + 64 * (j))
#define XB_XGEN(j)  (2304 + 64 * (j))
#define XB_TOP      3328
#define XB_TOPGEN   3392
#define XCD_BAR_WORDS 3456
#define XB_SPIN_CAP (1u << 18)
__device__ __forceinline__ unsigned xb_ld(unsigned* p)              { return __hip_atomic_load(p, __ATOMIC_RELAXED, __HIP_MEMORY_SCOPE_AGENT); }
__device__ __forceinline__ unsigned xb_add(unsigned* p, unsigned v) { return __hip_atomic_fetch_add(p, v, __ATOMIC_RELAXED, __HIP_MEMORY_SCOPE_AGENT); }
__device__ __forceinline__ unsigned xb_xcc_id() { return (unsigned)__builtin_amdgcn_s_getreg((3 << 11) | 20) & 0xFu; }
#define XB_SPIN(cond, bar) do { unsigned _sp = 0; while (cond) { __builtin_amdgcn_s_sleep(1); \
    if ((++_sp & 255u) == 0u) { if (xb_ld(&(bar)[XB_TMO])) break; if (_sp > XB_SPIN_CAP) { atomicAdd(&(bar)[XB_TMO], 1u); break; } } } } while (0)
struct XcdBarrier { unsigned* bar; unsigned x; volatile LAS unsigned* st; };
__device__ __forceinline__ XcdBarrier xcd_barrier_post(unsigned* bar, volatile LAS unsigned* st) {
    XcdBarrier b; b.bar = bar; b.x = xb_xcc_id(); b.st = st;
    if (threadIdx.x == 0) (void)xb_add(&bar[XB_XCNT(b.x)], 1u);
    return b;
}
__device__ __forceinline__ void xcd_barrier_complete(unsigned* bar, unsigned x, unsigned& nloc, unsigned& nx) {
    const unsigned G = gridDim.x * gridDim.y * gridDim.z;
    unsigned sum, cnt, mine, sp = 0u;
    for (;;) {
        sum = 0u; cnt = 0u; mine = 0u;
#pragma unroll
        for (unsigned j = 0; j < 16; ++j) { const unsigned c = xb_ld(&bar[XB_XCNT(j)]); sum += c; cnt += (c > 0u) ? 1u : 0u; mine = (j == x) ? c : mine; }
        if (sum == G) break;
        __builtin_amdgcn_s_sleep(1);
        if ((++sp & 255u) == 0u) { if (xb_ld(&bar[XB_TMO])) break; if (sp > XB_SPIN_CAP) { atomicAdd(&bar[XB_TMO], 1u); break; } }
    }
    nloc = mine > 0u ? mine : 1u; nx = cnt > 0u ? cnt : 1u;
}
__device__ __forceinline__ void xcd_barrier(const XcdBarrier& b, bool is_t0) {
    asm volatile("s_waitcnt vmcnt(0)" ::: "memory");
    __syncthreads();
    if (is_t0) {
        unsigned* bar = b.bar;
        __builtin_amdgcn_s_waitcnt(0);
        unsigned nloc = b.st[0], nx = b.st[1];
        if (nloc == 0u) { xcd_barrier_complete(bar, b.x, nloc, nx); b.st[0] = nloc; b.st[1] = nx; }
        const unsigned old = xb_add(&bar[XB_XSUB(b.x)], 1u);
        const unsigned gen = old / nloc;
        if (old + 1u == (gen + 1u) * nloc) {
            __builtin_amdgcn_fence(__ATOMIC_RELEASE, "agent");
            asm volatile("s_waitcnt vmcnt(0)" ::: "memory");
            const unsigned og = xb_add(&bar[XB_TOP], 1u);
            const unsigned tg = og / nx;
            if (og + 1u == (tg + 1u) * nx) xb_add(&bar[XB_TOPGEN], 1u);
            else XB_SPIN(xb_ld(&bar[XB_TOPGEN]) == tg, bar);
            __builtin_amdgcn_fence(__ATOMIC_ACQUIRE, "agent");
            xb_add(&bar[XB_XGEN(b.x)], 1u);
            asm volatile("s_waitcnt vmcnt(0)" ::: "memory");
        } else {
            XB_SPIN(xb_ld(&bar[XB_XGEN(b.x)]) == gen, bar);
            __builtin_amdgcn_fence(__ATOMIC_ACQUIRE, "agent");
            asm volatile("s_waitcnt vmcnt(0)" ::: "memory");
        }
    }
    __syncthreads();
}
namespace gs {
constexpr int BM = 256, BK = 64, HALF = 128, HTB = HALF * BK * 2, STAGE_BYTES = 8 * HTB, NXCD = 8, WGM = 8;
__host__ __device__ __forceinline__ int lds_byte(int r, int c) { const int st = (r >> 4) * 2 + (c >> 5), rr = r & 15, cc = c & 31, ob = rr * 64 + cc * 2; return st * 1024 + (ob ^ (((ob >> 9) & 1) << 5)); }
__host__ __device__ __forceinline__ void stage_rc(int b, int& R, int& C) { const int st = b / 1024, sb = b % 1024, swz = sb ^ (((sb >> 9) & 1) << 5); R = (st >> 1) * 16 + swz / 64; C = (st & 1) * 32 + (swz % 64) / 2; }
__host__ __device__ __forceinline__ int perm32(int rho) { const int n = rho >> 4, i = rho & 15; return 8 * (i >> 2) + 4 * n + (i & 3); }

struct UD { const char* A; const char* B; unsigned lda, ldb; int nt; int kind, pm, pn, aux; };

__device__ __forceinline__ bool tile_of(long L, int nM, int nN, int& pm, int& pn) {
    const int nwg = nM * nN; if (L >= nwg) return false;
    int wgid = (int)L; { const int q = nwg / NXCD, r = nwg % NXCD, xcd = wgid % NXCD, off = wgid / NXCD; wgid = (xcd < r ? xcd * (q + 1) : r * (q + 1) + (xcd - r) * q) + off; }
    const int nig = WGM * nN, gid = wgid / nig, fm = gid * WGM, gsz = (nM - fm) < WGM ? (nM - fm) : WGM;
    pm = fm + ((wgid % nig) % gsz); pn = (wgid % nig) / gsz; return true;
}

template <bool PERM, class Sched, class Epi>
__device__ __forceinline__ void gemm_stream(LAS unsigned char* lds, const Sched& S, const Epi& E, int wave_s) {
    int tid = wave_s * 64 + lane_id(); asm volatile("" : "+v"(tid));
    const int wid = __builtin_amdgcn_readfirstlane(tid >> 6), lane = tid & 63, wr = wid >> 2, wc = wid & 3, fr = lane & 15, fq = lane >> 4;
    int rA[2], rB[2], cb[2];
#pragma unroll
    for (int i = 0; i < 2; ++i) { int R, C; stage_rc(tid * 16 + i * 8192, R, C); rA[i] = R; rB[i] = PERM ? ((R & ~31) + perm32(R & 31)) : R; cb[i] = C * 2; }
    const size_t kstep = (size_t)(BK * 2);
    const unsigned ldsw = (unsigned)wid * 1024u;
    const int aoff = lds_byte(wr * 64 + fr, fq * 8), boff = lds_byte(wc * 32 + fr, fq * 8);
#define GS_SA(b, h) (((b) * 2 + (h)) * HTB)
#define GS_SB(b, h) ((4 + (b) * 2 + (h)) * HTB)
#define GS_STAGE(bufoff, gbase, voff) do { _Pragma("unroll") for (int _i = 0; _i < 2; ++_i) \
        __builtin_amdgcn_global_load_lds((const unsigned*)((const char*)(gbase) + (voff)[_i]), (LAS unsigned*)(lds + (bufoff) + ldsw + _i * 8192), 16, 0, 0); } while (0)
#define GS_LDA(dst, b, h) do { _Pragma("unroll") for (int m = 0; m < 4; ++m) _Pragma("unroll") for (int k = 0; k < 2; ++k) dst[m][k] = *(const LAS bf16x8*)(lds + GS_SA(b, h) + aoff + m * 2048 + k * 1024); } while (0)
#define GS_LDB(dst, b, h) do { _Pragma("unroll") for (int n = 0; n < 2; ++n) _Pragma("unroll") for (int k = 0; k < 2; ++k) dst[n][k] = *(const LAS bf16x8*)(lds + GS_SB(b, h) + boff + n * 2048 + k * 1024); } while (0)
#define GS_MMA(ai, bj, At, Bt) do { __builtin_amdgcn_s_setprio(1); _Pragma("unroll") for (int m = 0; m < 4; ++m) _Pragma("unroll") for (int n = 0; n < 2; ++n) _Pragma("unroll") for (int k = 0; k < 2; ++k) \
        acc[ai][bj][m][n] = __builtin_amdgcn_mfma_f32_16x16x32_bf16(Bt[n][k], At[m][k], acc[ai][bj][m][n], 0, 0, 0); __builtin_amdgcn_s_setprio(0); } while (0)
#define GS_WAIT_V(n) asm volatile("s_waitcnt vmcnt(" #n ")" ::: "memory")
#define GS_WAIT_L(n) asm volatile("s_waitcnt lgkmcnt(" #n ")" ::: "memory")
#define GS_BAR __builtin_amdgcn_s_barrier()
#define GS_SCHED __builtin_amdgcn_sched_barrier(0)
    UD cur, nxt; int ui = 0; const bool prime = false;
    if (!S.next(0, cur)) return;
    f32x4 acc[2][2][4][2];
#pragma unroll
    for (int a = 0; a < 2; ++a)
#pragma unroll
        for (int b = 0; b < 2; ++b)
#pragma unroll
            for (int m = 0; m < 4; ++m)
#pragma unroll
                for (int n = 0; n < 2; ++n) acc[a][b][m][n] = (f32x4){0.f, 0.f, 0.f, 0.f};
    bf16x8 At[4][2], B0[2][2], B1[2][2];
    unsigned vAc[2], vBc[2];
#pragma unroll
    for (int i = 0; i < 2; ++i) { vAc[i] = (unsigned)rA[i] * cur.lda + (unsigned)cb[i]; vBc[i] = (unsigned)rB[i] * cur.ldb + (unsigned)cb[i]; }
    const char* cA = cur.A; const char* cB = cur.B; size_t hA = (size_t)HALF * cur.lda, hB = (size_t)HALF * cur.ldb;
    GS_STAGE(GS_SB(0, 0), cB, vBc); GS_STAGE(GS_SA(0, 0), cA, vAc); GS_STAGE(GS_SB(0, 1), cB + hB, vBc); GS_STAGE(GS_SA(0, 1), cA + hA, vAc);
    if (wr == 1) GS_BAR;
    GS_WAIT_V(4); GS_BAR;
    GS_STAGE(GS_SB(1, 0), cB + kstep, vBc); GS_STAGE(GS_SA(1, 0), cA + kstep, vAc); GS_STAGE(GS_SB(1, 1), cB + hB + kstep, vBc);
    GS_WAIT_V(6); GS_BAR;
    for (;;) {
        const bool has_next = S.next(ui + 1, nxt);
        const char* nA = has_next ? nxt.A : cA; const char* nB = has_next ? nxt.B : cB;
        const unsigned nlda = has_next ? nxt.lda : cur.lda, nldb = has_next ? nxt.ldb : cur.ldb;
        unsigned vAn[2], vBn[2];
#pragma unroll
        for (int i = 0; i < 2; ++i) { vAn[i] = (unsigned)rA[i] * nlda + (unsigned)cb[i]; vBn[i] = (unsigned)rB[i] * nldb + (unsigned)cb[i]; }
        const size_t hAn = (size_t)HALF * nlda, hBn = (size_t)HALF * nldb;
        const int nt = cur.nt;
        for (int t = 0; t < nt; t += 2) {
            const bool last = (t == nt - 2);
            const char* a1 = cA + (size_t)(t + 1) * kstep;
            const char* a2 = last ? nA : cA + (size_t)(t + 2) * kstep; const char* b2 = last ? nB : cB + (size_t)(t + 2) * kstep;
            const char* a3 = a2 + kstep; const char* b3 = b2 + kstep;
            unsigned vA2[2], vB2[2];
#pragma unroll
            for (int i = 0; i < 2; ++i) { vA2[i] = last ? vAn[i] : vAc[i]; vB2[i] = last ? vBn[i] : vBc[i]; }
            const size_t hA2 = last ? hAn : hA, hB2 = last ? hBn : hB;
            GS_LDB(B0, 0, 0); GS_SCHED; GS_LDA(At, 0, 0); GS_STAGE(GS_SA(1, 1), a1 + hA, vAc);
            GS_WAIT_L(8); GS_BAR; GS_WAIT_L(0); GS_MMA(0, 0, At, B0); GS_BAR; GS_SCHED;
            GS_LDB(B1, 0, 1); GS_STAGE(GS_SB(0, 0), b2, vB2);
            GS_BAR; GS_WAIT_L(0); GS_MMA(0, 1, At, B1); GS_BAR;
            GS_LDA(At, 0, 1); GS_STAGE(GS_SA(0, 0), a2, vA2);
            GS_BAR; GS_WAIT_L(0); GS_MMA(1, 0, At, B0); GS_BAR; GS_SCHED;
            GS_STAGE(GS_SB(0, 1), b2 + hB2, vB2);
            GS_WAIT_V(6); GS_BAR; GS_MMA(1, 1, At, B1); GS_BAR;
            GS_LDB(B0, 1, 0); GS_SCHED; GS_LDA(At, 1, 0); GS_STAGE(GS_SA(0, 1), a2 + hA2, vA2);
            GS_WAIT_L(8); GS_BAR; GS_WAIT_L(0); GS_MMA(0, 0, At, B0); GS_BAR; GS_SCHED;
            GS_LDB(B1, 1, 1); GS_STAGE(GS_SB(1, 0), b3, vB2);
            GS_BAR; GS_WAIT_L(0); GS_MMA(0, 1, At, B1); GS_BAR;
            GS_LDA(At, 1, 1); GS_STAGE(GS_SA(1, 0), a3, vA2);
            GS_BAR; GS_WAIT_L(0); GS_MMA(1, 0, At, B0); GS_BAR; GS_SCHED;
            GS_STAGE(GS_SB(1, 1), b3 + hB2, vB2);
            GS_WAIT_V(6); GS_BAR; GS_MMA(1, 1, At, B1); GS_BAR;
        }
        if (!prime) { int tz = wave_s * 64 + lane_id(); asm volatile("" : "+v"(tz)); const int w2 = __builtin_amdgcn_readfirstlane(tz >> 6), l2 = tz & 63; E(acc, cur, w2 >> 2, w2 & 3, l2 & 15, l2 >> 4, tz); }
        if (!has_next) break;
#pragma unroll
        for (int a = 0; a < 2; ++a)
#pragma unroll
            for (int b = 0; b < 2; ++b)
#pragma unroll
                for (int m = 0; m < 4; ++m)
#pragma unroll
                    for (int n = 0; n < 2; ++n) acc[a][b][m][n] = (f32x4){0.f, 0.f, 0.f, 0.f};
        cur = nxt; cA = nA; cB = nB; hA = hAn; hB = hBn;
#pragma unroll
        for (int i = 0; i < 2; ++i) { vAc[i] = vAn[i]; vBc[i] = vBn[i]; }
        ++ui;
    }
    GS_WAIT_V(0);
    if (wr == 0) GS_BAR;
    GS_BAR;
#undef GS_SA
#undef GS_SB
#undef GS_STAGE
#undef GS_LDA
#undef GS_LDB
#undef GS_MMA
#undef GS_WAIT_V
#undef GS_WAIT_L
#undef GS_BAR
#undef GS_SCHED
}
}
using gs::UD;
__device__ __forceinline__ u32x4 pack8(f32x4 v0, f32x4 v1) { u32x4 w; w.x = pk2(v0[0], v0[1]); w.y = pk2(v0[2], v0[3]); w.z = pk2(v1[0], v1[1]); w.w = pk2(v1[2], v1[3]); return w; }
__device__ __forceinline__ void unpack8(u32x4 w, f32x4& v0, f32x4& v1) { v0 = (f32x4){bf_lo(w.x), bf_hi(w.x), bf_lo(w.y), bf_hi(w.y)}; v1 = (f32x4){bf_lo(w.z), bf_hi(w.z), bf_lo(w.w), bf_hi(w.w)}; }

struct EpiInproj {
    bf16_t *xrnn, *grnn, *qlat, *ckv, *qidx, *kidx; float* widx;
    __device__ __forceinline__ void operator()(const f32x4 (&acc)[2][2][4][2], const UD& u, int wr, int wc, int fr, int fq, int tid) const {
        const int pn = u.pn; const size_t row0 = (size_t)u.pm * 256 + wr * 64 + fr;
        if (pn < 19) {
            bf16_t* base; int ldc, colt; float sc = 1.f; bool gl = false;
            if (pn < 4) { base = xrnn; ldc = 1024; colt = 256 * pn; }
            else if (pn < 8) { base = grnn; ldc = 1024; colt = 256 * (pn - 4); gl = true; }
            else if (pn < 16) { base = qlat; ldc = 2048; colt = 256 * (pn - 8); }
            else if (pn == 16) { base = ckv; ldc = 256; colt = 0; }
            else { base = qidx; ldc = 512; colt = 256 * (pn - 17); sc = 0.125f; }
#pragma unroll
            for (int ai = 0; ai < 2; ++ai)
#pragma unroll
                for (int m = 0; m < 4; ++m) { bf16_t* rowp = base + (row0 + ai * 128 + m * 16) * ldc + colt + wc * 32 + 8 * fq;
#pragma unroll
                    for (int bj = 0; bj < 2; ++bj) { f32x4 v0 = acc[ai][bj][m][0], v1 = acc[ai][bj][m][1];
                        if (gl) {
#pragma unroll
                            for (int j = 0; j < 4; ++j) { v0[j] = gelu_tanh(v0[j]); v1[j] = gelu_tanh(v1[j]); } }
                        v0 = v0 * sc; v1 = v1 * sc;
                        *(u32x4*)(rowp + bj * 128) = pack8(v0, v1); } }
        } else {
#pragma unroll
            for (int ai = 0; ai < 2; ++ai)
#pragma unroll
                for (int m = 0; m < 4; ++m) { const size_t row = row0 + ai * 128 + m * 16; const f32x4 v0 = acc[ai][0][m][0], v1 = acc[ai][0][m][1];
                    if (wc < 2) *(u32x4*)(kidx + row * 64 + wc * 32 + 8 * fq) = pack8(v0, v1);
                    else if (wc == 2 && fq == 0) { *(f32x4*)(widx + row * 8) = v0 * 0.35355339059327373f; *(f32x4*)(widx + row * 8 + 4) = v1 * 0.35355339059327373f; } }
        }
    }
};
struct EpiMerge1 {
    unsigned char* s1b; unsigned char* s2b; bf16_t* merged;
    __device__ __forceinline__ void operator()(const f32x4 (&acc)[2][2][4][2], const UD& u, int wr, int wc, int fr, int fq, int tid) const {
        const int kind = u.kind;
        u32x4* s1 = (u32x4*)s1b + tid; u32x4* s2 = (u32x4*)(s2b + (size_t)(u.pm * 4 + u.pn) * 131072) + tid;
#pragma unroll
        for (int ai = 0; ai < 2; ++ai)
#pragma unroll
            for (int bj = 0; bj < 2; ++bj)
#pragma unroll
                for (int m = 0; m < 4; ++m) { const int slot = (ai * 2 + bj) * 4 + m; f32x4 v0 = acc[ai][bj][m][0], v1 = acc[ai][bj][m][1];
                    if (kind != 1) {
#pragma unroll
                        for (int j = 0; j < 4; ++j) { v0[j] = sigmoidf_(v0[j]); v1[j] = sigmoidf_(v1[j]); }
#ifdef DBG_S1_CONST
                        { const float cv = (float)(u.pm * 4 + u.pn + 1) * (1.0f / 512.0f); v0 = (f32x4){cv, cv, cv, cv}; v1 = v0; }
#endif
                        (kind == 0 ? s1 : s2)[slot * 512] = pack8(v0, v1);
                    } else {
                        f32x4 a0, a1; unpack8(__builtin_nontemporal_load(s1 + slot * 512), a0, a1);
#ifdef DBG_NO_S1
                        a0 = (f32x4){1.f, 1.f, 1.f, 1.f}; a1 = a0;
#endif
                        const size_t row = (size_t)u.pm * 256 + ai * 128 + wr * 64 + m * 16 + fr;
                        *(u32x4*)(merged + row * 1024 + u.pn * 256 + bj * 128 + wc * 32 + 8 * fq) = pack8(a0 * v0, a1 * v1);
#ifdef DBG_OUT_S1
                        *(u32x4*)(merged + row * 1024 + u.pn * 256 + bj * 128 + wc * 32 + 8 * fq) = pack8(a0, a1);
#endif
                    }
                    if (m & 1) asm volatile("" ::: "memory"); }
    }
};
struct EpiMerge2 {
    unsigned char* s2b; bf16_t* merged;
    __device__ __forceinline__ void operator()(const f32x4 (&acc)[2][2][4][2], const UD& u, int wr, int wc, int fr, int fq, int tid) const {
        const u32x4* s2 = (const u32x4*)(s2b + (size_t)(u.pm * 4 + u.pn) * 131072) + tid;
#pragma unroll
        for (int ai = 0; ai < 2; ++ai)
#pragma unroll
            for (int bj = 0; bj < 2; ++bj)
#pragma unroll
                for (int m = 0; m < 4; ++m) { const int slot = (ai * 2 + bj) * 4 + m;
                    const size_t row = (size_t)u.pm * 256 + ai * 128 + wr * 64 + m * 16 + fr;
                    u32x4* mp = (u32x4*)(merged + row * 1024 + u.pn * 256 + bj * 128 + wc * 32 + 8 * fq);
                    f32x4 a0, a1, b0, b1; unpack8(__builtin_nontemporal_load(mp), a0, a1); unpack8(__builtin_nontemporal_load(s2 + slot * 512), b0, b1);
#ifdef DBG_NO_S2
                    b0 = (f32x4){1.f, 1.f, 1.f, 1.f}; b1 = b0;
#endif
#ifdef DBG_NO_MRG
                    a0 = (f32x4){0.f, 0.f, 0.f, 0.f}; a1 = a0;
#endif
                    *mp = pack8(a0 + b0 * acc[ai][bj][m][0], a1 + b1 * acc[ai][bj][m][1]);
                    if (m & 1) asm volatile("" ::: "memory"); }
    }
};
struct EpiOut {
    float* xo;
    __device__ __forceinline__ void operator()(const f32x4 (&acc)[2][2][4][2], const UD& u, int wr, int wc, int fr, int fq, int tid) const {
#pragma unroll
        for (int ai = 0; ai < 2; ++ai)
#pragma unroll
            for (int m = 0; m < 4; ++m) { float* rowp = xo + ((size_t)u.pm * 256 + ai * 128 + wr * 64 + m * 16 + fr) * 1024 + u.pn * 256 + wc * 32 + 4 * fq;
#pragma unroll
                for (int bj = 0; bj < 2; ++bj)
#pragma unroll
                    for (int n = 0; n < 2; ++n) { f32x4* p = (f32x4*)(rowp + bj * 128 + n * 16); *p = (*p) * ALPHA + acc[ai][bj][m][n]; } }
    }
};
struct EpiGU {
    bf16_t* he;
    __device__ __forceinline__ void operator()(const f32x4 (&acc)[2][2][4][2], const UD& u, int wr, int wc, int fr, int fq, int tid) const {
#pragma unroll
        for (int ai = 0; ai < 2; ++ai)
#pragma unroll
            for (int m = 0; m < 4; ++m) { bf16_t* rowp = he + ((size_t)u.pm * 256 + ai * 128 + wr * 64 + m * 16 + fr) * 512 + u.pn * 128 + wc * 16 + 4 * fq;
#pragma unroll
                for (int bj = 0; bj < 2; ++bj) { const f32x4 g = acc[ai][bj][m][0], up = acc[ai][bj][m][1]; f32x4 o;
#pragma unroll
                    for (int j = 0; j < 4; ++j) o[j] = g[j] * sigmoidf_(g[j]) * up[j];
                    u32x2 w; w.x = pk2(o[0], o[1]); w.y = pk2(o[2], o[3]); *(u32x2*)(rowp + bj * 64) = w; } }
    }
};
struct EpiBf16 {
    bf16_t* out; int ldc;
    __device__ __forceinline__ void operator()(const f32x4 (&acc)[2][2][4][2], const UD& u, int wr, int wc, int fr, int fq, int tid) const {
#pragma unroll
        for (int ai = 0; ai < 2; ++ai)
#pragma unroll
            for (int m = 0; m < 4; ++m) { bf16_t* rowp = out + ((size_t)u.pm * 256 + ai * 128 + wr * 64 + m * 16 + fr) * ldc + u.pn * 256 + wc * 32 + 8 * fq;
#pragma unroll
                for (int bj = 0; bj < 2; ++bj) *(u32x4*)(rowp + bj * 128) = pack8(acc[ai][bj][m][0], acc[ai][bj][m][1]); }
    }
};
struct EpiPro {
    unsigned char* wmix;
    __device__ __forceinline__ void operator()(const f32x4 (&acc)[2][2][4][2], const UD& u, int wr, int wc, int fr, int fq, int tid) const {
        const int l = u.aux >> 3, h = u.aux & 7, p = u.pn;
        bf16_t* base; int ldc; float sc;
        if (u.kind == 0) { base = (bf16_t*)(wmix + (size_t)l * WMIX_STRIDE + OFF_WIN) + (size_t)(2048 + 256 * h) * 1024 + 256 * p; ldc = 1024; sc = 0.08838834764831845f; }
        else { base = (bf16_t*)(wmix + (size_t)l * WMIX_STRIDE + OFF_WVO) + (size_t)(256 * p) * 2048 + 256 * h; ldc = 2048; sc = 1.f; }
#pragma unroll
        for (int ai = 0; ai < 2; ++ai)
#pragma unroll
            for (int m = 0; m < 4; ++m) { bf16_t* rowp = base + (size_t)(ai * 128 + wr * 64 + m * 16 + fr) * ldc + wc * 32 + 8 * fq;
#pragma unroll
                for (int bj = 0; bj < 2; ++bj) *(u32x4*)(rowp + bj * 128) = pack8(acc[ai][bj][m][0] * sc, acc[ai][bj][m][1] * sc); }
    }
};

struct SchedDense {
    const char* A; const char* B; unsigned lda, ldb; int nt, nM, nN, G, c;
    __device__ __forceinline__ bool next(int i, UD& u) const {
        int pm, pn; if (!gs::tile_of((long)i * G + c, nM, nN, pm, pn)) return false;
        u.A = A + (size_t)pm * 256 * lda; u.B = B + (size_t)pn * 256 * ldb; u.lda = lda; u.ldb = ldb; u.nt = nt; u.kind = 0; u.pm = pm; u.pn = pn; u.aux = 0; return true;
    }
};
struct SchedMerge1 {
    const char *xb, *yrnn, *wg, *wpr; int G, c;
    __device__ __forceinline__ bool next(int i_, UD& u) const { int i = i_;
#ifdef DBG_DUPFIRST
        if (i > 0) i -= 1;
#endif
#ifdef DBG_ORDER201
        const int ti = i / 3, kk_ = i - 3 * ti, k = kk_ == 0 ? 2 : kk_ - 1;
#else
        const int ti = i / 3, k = i - 3 * ti;
#endif
        int pm, pn; if (!gs::tile_of((long)ti * G + c, T / 256, 4, pm, pn)) return false;
        u.kind = k; u.pm = pm; u.pn = pn; u.aux = 0; u.lda = 2048; u.ldb = 2048; u.nt = 16;
#ifdef DBG_K0_AS_K1
        if (k == 0) { u.A = yrnn + (size_t)pm * 256 * 2048; u.B = wpr + (size_t)pn * 256 * 2048; }
#else
        if (k == 0) { u.A = xb + (size_t)pm * 256 * 2048; u.B = wg + (size_t)pn * 256 * 2048; }
#endif
        else if (k == 1) { u.A = yrnn + (size_t)pm * 256 * 2048; u.B = wpr + (size_t)pn * 256 * 2048; }
        else { u.A = xb + (size_t)pm * 256 * 2048; u.B = wg + (size_t)(1024 + pn * 256) * 2048; }
        return true;
    }
};
struct SchedMoE {
    const char* A; const char* B; unsigned lda, ldb; size_t bstride; int nt, nN, G, c; const LAS int* offp;
    __device__ __forceinline__ bool next(int i, UD& u) const {
        const int nM = offp[16] >> 8; int pm, pn; if (!gs::tile_of((long)i * G + c, nM, nN, pm, pn)) return false;
        int e = 0;
#pragma unroll 1
        for (int j = 1; j < 16; ++j) e += (pm * 256 >= offp[j]) ? 1 : 0;
        u.A = A + (size_t)pm * 256 * lda; u.B = B + (size_t)e * bstride + (size_t)pn * 256 * ldb; u.lda = lda; u.ldb = ldb; u.nt = nt; u.kind = 0; u.pm = pm; u.pn = pn; u.aux = e; return true;
    }
};
struct SchedPro {
    const unsigned char* tmp; int G, c;
    __device__ __forceinline__ bool next(int i, UD& u) const {
        const long L = (long)i * G + c; if (L >= 256) return false;
        const int kind = (int)(L >> 7), l = (int)(L >> 5) & 3, h = (int)(L >> 2) & 7, p = (int)L & 3;
        u.kind = kind; u.aux = l * 8 + h; u.pm = 0; u.pn = p; u.nt = 4; u.lda = 2048; u.ldb = 2048;
        if (kind == 0) { u.A = (const char*)tmp + R_UKP + ((size_t)(l * 8 + h) * 256) * 2048;
                         u.B = (const char*)tmp + R_WQ + (size_t)l * 2 * MiB + (size_t)(256 * p) * 2048 + (size_t)(h >> 1) * 512; }
        else { u.A = (const char*)tmp + R_PT + (size_t)l * 2 * MiB + (size_t)(256 * p) * 2048 + (size_t)(h >> 1) * 512;
               u.B = (const char*)tmp + R_UVP + ((size_t)(l * 8 + h) * 256) * 2048; }
        return true;
    }
};

__device__ __forceinline__ void tr_item(const float* src, int ld, int c0, int nvalid, bf16_t* dst, int lddst, int mode, int item, int nblk, LAS float* scr, int lane) {
    const int kb = item / nblk, nb = item - kb * nblk, k0 = 64 * kb, n0 = 32 * nb;
    const int n = n0 + (lane & 31); const bool ok = n < nvalid;
#pragma unroll 8
    for (int i = 0; i < 32; ++i) { const int kk = 2 * i + (lane >> 5); scr[kk * 33 + (lane & 31)] = ok ? src[(size_t)(k0 + kk) * ld + c0 + n] : 0.f; }
    asm volatile("s_waitcnt lgkmcnt(0)" ::: "memory");
    const int c = lane & 7;
#pragma unroll
    for (int j = 0; j < 4; ++j) { const int nl = (lane >> 3) + 8 * j; const int nn = n0 + nl; const int row = mode ? (8 * (nn >> 2) + (nn & 3)) : nn; const LAS float* s = scr + (8 * c) * 33 + nl;
        u32x4 o; o.x = pk2(s[0 * 33], s[1 * 33]); o.y = pk2(s[2 * 33], s[3 * 33]); o.z = pk2(s[4 * 33], s[5 * 33]); o.w = pk2(s[6 * 33], s[7 * 33]);
        *(u32x4*)(dst + (size_t)row * lddst + k0 + 8 * c) = o; }
    asm volatile("s_waitcnt lgkmcnt(0)" ::: "memory");
}
__device__ __forceinline__ float expm1_acc(float x) {
    if (x > -0.35f) { float p = 1.0f + x * (1.0f / 8.0f); p = 1.0f + x * (1.0f / 7.0f) * p; p = 1.0f + x * (1.0f / 6.0f) * p; p = 1.0f + x * (1.0f / 5.0f) * p; p = 1.0f + x * 0.25f * p; p = 1.0f + x * (1.0f / 3.0f) * p; p = 1.0f + x * 0.5f * p; return x * p; }
    return fast_exp(x) - 1.0f;
}
struct RnnP { const bf16_t* xrnn; bf16_t* gy; float* tot; const bf16_t *waT, *wxT; const float *convw, *convb, *ba, *bx, *lam; };
template <int PASS>
__device__ __forceinline__ void rnn_item(const RnnP& P, int item, LAS unsigned char* wlds, int lane) {
    const int b = item >> 10, g = (item >> 6) & 15, seg = item & 63, ch0 = 64 * g;
    const int row = lane & 15, kg = lane >> 4, col = lane & 15;
    LAS float* CW = (LAS float*)wlds;
    LAS float* XR = CW + 320;
#pragma unroll
    for (int k = 0; k < 4; ++k) CW[k * 64 + lane] = P.convw[k * 1024 + ch0 + lane];
    CW[256 + lane] = P.convb[ch0 + lane];
    bf16x8 Ba[4][2], Bx[4][2];
#pragma unroll
    for (int jt = 0; jt < 4; ++jt)
#pragma unroll
        for (int s = 0; s < 2; ++s) { const size_t o = ((size_t)g * 64 + 16 * jt + col) * 64 + 32 * s + 8 * kg; Ba[jt][s] = *(const bf16x8*)(P.waT + o); Bx[jt][s] = *(const bf16x8*)(P.wxT + o); }
    float cba[4], cbx[4], sp8[4], h0[4], Pc[4];
#pragma unroll
    for (int jt = 0; jt < 4; ++jt) { const int ch = ch0 + 16 * jt + col; cba[jt] = P.ba[ch]; cbx[jt] = P.bx[ch]; const float lm = P.lam[ch]; sp8[jt] = -8.0f * log1pf(expf(-lm)); h0[jt] = 0.f; Pc[jt] = 1.f; }
    float* totp = P.tot + ((size_t)(b * 64) * 1024 + ch0 + col) * 2;
    if (PASS == 2) {
        for (int s2 = 0; s2 < seg; ++s2) {
#pragma unroll
            for (int jt = 0; jt < 4; ++jt) { const f32x2 ph = *(const f32x2*)(totp + ((size_t)s2 * 1024 + 16 * jt) * 2); h0[jt] = ph.x * h0[jt] + ph.y; }
        }
    }
    asm volatile("s_waitcnt lgkmcnt(0)" ::: "memory");
    const size_t rowb = (size_t)b * SEQ;
    u32x4 xn[4][2];
    { const int tA0 = seg * 256 + row;
#pragma unroll
      for (int dt = 0; dt < 4; ++dt) { const int tt = tA0 - 3 + dt;
#pragma unroll
          for (int s = 0; s < 2; ++s) xn[dt][s] = (tt >= 0) ? *(const u32x4*)(P.xrnn + (rowb + tt) * 1024 + ch0 + 32 * s + 8 * kg) : (u32x4){0u, 0u, 0u, 0u}; } }
    for (int tile = 0; tile < 16; ++tile) {
        const int t0 = seg * 256 + tile * 16;
        u32x4 xw[4][2];
#pragma unroll
        for (int dt = 0; dt < 4; ++dt)
#pragma unroll
            for (int s = 0; s < 2; ++s) xw[dt][s] = xn[dt][s];
        if (tile + 1 < 16) { const int tB = t0 + 16 + row;
#pragma unroll
            for (int dt = 0; dt < 4; ++dt) { const int tt = tB - 3 + dt;
#pragma unroll
                for (int s = 0; s < 2; ++s) xn[dt][s] = *(const u32x4*)(P.xrnn + (rowb + tt) * 1024 + ch0 + 32 * s + 8 * kg); } }
        bf16x8 Af[2];
#pragma unroll
        for (int s = 0; s < 2; ++s) {
            const int cl = 32 * s + 8 * kg;
            f32x4 o0 = *(LAS f32x4*)(CW + 256 + cl), o1 = *(LAS f32x4*)(CW + 256 + cl + 4);
#pragma unroll
            for (int dt = 0; dt < 4; ++dt) { const f32x4 w0 = *(LAS f32x4*)(CW + dt * 64 + cl), w1 = *(LAS f32x4*)(CW + dt * 64 + cl + 4); const u32x4 x = xw[dt][s];
                o0[0] += w0[0] * bf_lo(x.x); o0[1] += w0[1] * bf_hi(x.x); o0[2] += w0[2] * bf_lo(x.y); o0[3] += w0[3] * bf_hi(x.y);
                o1[0] += w1[0] * bf_lo(x.z); o1[1] += w1[1] * bf_hi(x.z); o1[2] += w1[2] * bf_lo(x.w); o1[3] += w1[3] * bf_hi(x.w); }
            *(LAS f32x4*)(XR + row * 68 + cl) = o0; *(LAS f32x4*)(XR + row * 68 + cl + 4) = o1;
            const u32x4 pk = pack8(o0, o1); Af[s] = __builtin_bit_cast(bf16x8, pk);
        }
        f32x4 ar[4], ax[4];
#pragma unroll
        for (int jt = 0; jt < 4; ++jt) { ar[jt] = (f32x4){0.f, 0.f, 0.f, 0.f}; ax[jt] = ar[jt];
#pragma unroll
            for (int s = 0; s < 2; ++s) { ar[jt] = __builtin_amdgcn_mfma_f32_16x16x32_bf16(Af[s], Ba[jt][s], ar[jt], 0, 0, 0); ax[jt] = __builtin_amdgcn_mfma_f32_16x16x32_bf16(Af[s], Bx[jt][s], ax[jt], 0, 0, 0); } }
        asm volatile("s_waitcnt lgkmcnt(0)" ::: "memory");
#pragma unroll
        for (int jt = 0; jt < 4; ++jt) {
            float Pp[4], Hp[4]; float pr = 1.f, hr = 0.f;
#pragma unroll
            for (int r = 0; r < 4; ++r) {
                const float xr = XR[(4 * kg + r) * 68 + 16 * jt + col];
                const float rg = sigmoidf_(ar[jt][r] + cba[jt]), ig = sigmoidf_(ax[jt][r] + cbx[jt]);
                const float la = sp8[jt] * rg; const float em = expm1_acc(la); const float a = 1.0f + em;
                const float mm = __builtin_sqrtf(fmaxf(-em * (2.0f + em), 0.f));
                const float uu = mm * ig * xr;
                hr = a * hr + uu; pr = pr * a; Pp[r] = pr; Hp[r] = hr;
            }
            const float P0 = __shfl(pr, col), P1 = __shfl(pr, col + 16), P2 = __shfl(pr, col + 32), P3 = __shfl(pr, col + 48);
            const float H0 = __shfl(hr, col), H1 = __shfl(hr, col + 16), H2 = __shfl(hr, col + 32), H3 = __shfl(hr, col + 48);
            const float h1 = P0 * h0[jt] + H0, h2 = P1 * h1 + H1, h3 = P2 * h2 + H2, h4 = P3 * h3 + H3;
            if (PASS == 2) {
                const float hs = kg == 0 ? h0[jt] : (kg == 1 ? h1 : (kg == 2 ? h2 : h3));
                bf16_t* gp = P.gy + (rowb + t0 + 4 * kg) * 1024 + ch0 + 16 * jt + col;
#pragma unroll
                for (int r = 0; r < 4; ++r) { const float hv = Pp[r] * hs + Hp[r]; const float gg = bf2f(gp[(size_t)r * 1024]); gp[(size_t)r * 1024] = (bf16_t)f2bf(hv * gg); }
            } else Pc[jt] = Pc[jt] * (P0 * P1) * (P2 * P3);
            h0[jt] = h4;
        }
    }
    if (PASS == 1 && kg == 0) {
#pragma unroll
        for (int jt = 0; jt < 4; ++jt) *(f32x2*)(totp + ((size_t)seg * 1024 + 16 * jt) * 2) = (f32x2){Pc[jt], h0[jt]};
    }
}
__device__ __forceinline__ void ckv_norm_row(bf16_t* rowp, const float* gain, int lane) {
    const u32x2 w = *(const u32x2*)(rowp + 4 * lane);
    float v0 = bf_lo(w.x), v1 = bf_hi(w.x), v2 = bf_lo(w.y), v3 = bf_hi(w.y);
    const float ss = wave_sum(v0 * v0 + v1 * v1 + v2 * v2 + v3 * v3);
    const float rs = 1.0f / __builtin_sqrtf(ss * (1.0f / 256.0f) + RMS_EPS);
    const f32x4 gn = *(const f32x4*)(gain + 4 * lane);
    u32x2 o; o.x = pk2(v0 * rs * gn[0], v1 * rs * gn[1]); o.y = pk2(v2 * rs * gn[2], v3 * rs * gn[3]);
    *(u32x2*)(rowp + 4 * lane) = o;
}
constexpr int AT_CAND = 32768, AT_KBUF = 65536, AT_KROW = 144, AT_KCH = 256 * AT_KROW, AT_SEL = 139264, AT_BIAS = 155648, AT_BKT = 156672, AT_GROW = 544, AT_GBUF = 32 * AT_GROW;
constexpr int AT_NBIN = 512, AT_CAP = 128;
#ifndef AT_LBREF
#define AT_LBREF 0
#endif
struct AttnP { const bf16_t *qidx, *kidx, *ckv; const float* widx; bf16_t* qlat; unsigned long long* cbuf; };

__device__ __forceinline__ unsigned ord_key(float s) { const unsigned b = __builtin_bit_cast(unsigned, s); return (b & 0x80000000u) ? ~b : (b | 0x80000000u); }

__device__ __forceinline__ void hist_scan(const LAS unsigned* hq, int lane, int& bsel, int& cat, int& abat) {
    const u32x4 w0 = *(const LAS u32x4*)(hq + 4 * lane);
    int cnt[8];
    cnt[0] = w0.x & 0xffff; cnt[1] = w0.x >> 16; cnt[2] = w0.y & 0xffff; cnt[3] = w0.y >> 16; cnt[4] = w0.z & 0xffff; cnt[5] = w0.z >> 16; cnt[6] = w0.w & 0xffff; cnt[7] = w0.w >> 16;
    int s = 0;
#pragma unroll
    for (int i = 0; i < 8; ++i) s += cnt[i];
    int S = s;
#pragma unroll
    for (int off = 1; off < 64; off <<= 1) { const int v = __shfl_down(S, off); if (lane + off < 64) S += v; }
    bsel = -1; cat = 0; abat = 0;
    const unsigned long long mk = __ballot(S >= 256);
    if (mk != 0ull) {
        const int Ls = 63 - __builtin_clzll(mk);
        int above = S - s; bool found = false;
#pragma unroll
        for (int bb = 7; bb >= 0; --bb) { const int c = cnt[bb]; if (!found && above + c >= 256) { bsel = 8 * lane + bb; cat = c; abat = above; found = true; } above += c; }
        bsel = __shfl(bsel, Ls); cat = __shfl(cat, Ls); abat = __shfl(abat, Ls);
    }
}
template <int MODE>
__device__ __forceinline__ void attn_pass(LAS unsigned char* lds, const bf16x8 (&afr)[4], const float (&wq)[2][9], const bf16_t* kbase, int u, int wave, int lane, int tid,
                                          const int (&b0e)[2], const int (&neede)[2], const int (&tiee)[2], int (&csel)[2], int (&ccand)[2]) {
    const int hh = lane >> 5, kcol = lane & 31;
    LAS unsigned* HIST = (LAS unsigned*)lds; LAS unsigned long long* CAND = (LAS unsigned long long*)(lds + AT_CAND); LAS unsigned short* SEL = (LAS unsigned short*)(lds + AT_SEL);
    const int nch = (u >> 3) + 1;
    float lbt[2];
#pragma unroll
    for (int e = 0; e < 2; ++e) lbt[e] = (MODE == 1 && b0e[e] >= 1) ? (float)b0e[e] : -3.0e38f;
    u32x4 st[4];
    const bf16_t* gp = kbase + (size_t)(tid >> 3) * 64 + (tid & 7) * 8;
    const int lofs = (tid >> 3) * AT_KROW + (tid & 7) * 16;
#pragma unroll
    for (int i = 0; i < 4; ++i) st[i] = *(const u32x4*)(gp + (size_t)i * 64 * 64);
#pragma unroll
    for (int i = 0; i < 4; ++i) *(LAS u32x4*)(lds + AT_KBUF + lofs + i * 64 * AT_KROW) = st[i];
    __syncthreads();
    for (int c = 0; c < nch; ++c) {
        if (c + 1 < nch) {
#pragma unroll
            for (int i = 0; i < 4; ++i) st[i] = *(const u32x4*)(gp + ((size_t)(c + 1) * 256 + i * 64) * 64);
        }
        const LAS unsigned char* kb = lds + AT_KBUF + (c & 1) * AT_KCH + kcol * AT_KROW + hh * 16;
        const int ntile = (c + 1 < nch) ? 8 : (u & 7) + 1;
#define AT_READ(BF, TT) do { _Pragma("unroll") for (int ks = 0; ks < 4; ++ks) BF[ks] = *(const LAS bf16x8*)(kb + (TT) * 32 * AT_KROW + ks * 32); } while (0)
#define AT_MFMA(ACC, BF) do { _Pragma("unroll") for (int i_ = 0; i_ < 16; ++i_) ACC[i_] = 0.f; \
            _Pragma("unroll") for (int ks = 0; ks < 4; ++ks) ACC = __builtin_amdgcn_mfma_f32_32x32x16_bf16(afr[ks], BF[ks], ACC, 0, 0, 0); } while (0)
        f32x16 accA, accB; bf16x8 B0[4], B1[4];
        AT_READ(B0, 0); if (ntile > 1) AT_READ(B1, 1);
        AT_MFMA(accA, B0);
        for (int tt = 0; tt < ntile; tt += 2) {
            if (tt + 2 < ntile) AT_READ(B0, tt + 2);
            if (tt + 1 < ntile) AT_MFMA(accB, B1);
            { const int kt = c * 8 + tt; const f32x16& acc = accA;
            float sc[2];
#pragma unroll
            for (int e = 0; e < 2; ++e) { float s = 0.f;
#pragma unroll
                for (int i = 0; i < 8; ++i) s = __builtin_fmaf(wq[e][i], __builtin_amdgcn_fmed3f(acc[8 * e + i], 0.f, 3.0e38f), s);
                sc[e] = s; }
#pragma unroll
            for (int e = 0; e < 2; ++e) {
                const int q = 4 * wave + 2 * hh + e;
                const float tv = __builtin_fmaf(sc[e], wq[e][8], 256.0f);
                const bool live = ((kt < u) || (kcol <= 4 * wave + 2 * hh + e)) && tv >= lbt[e];
                if (MODE == 0 || __ballot(live) != 0ull) {
                    const int bin = (int)__builtin_amdgcn_fmed3f(tv, 0.0f, 511.5f);
                    if (MODE == 0) {
                        if (live) __hip_atomic_fetch_add(HIST + q * (AT_NBIN / 2) + (bin >> 1), (bin & 1) ? 65536u : 1u, __ATOMIC_RELAXED, __HIP_MEMORY_SCOPE_WORKGROUP);
                    } else {
                        const int key = kt * 32 + kcol;
                        const bool cc = live && bin == b0e[e];
                        const unsigned long long m2 = __ballot(cc); const unsigned h2 = hh ? (unsigned)(m2 >> 32) : (unsigned)m2;
                        const int pc = ccand[e] + __builtin_popcount(h2 & ((1u << kcol) - 1u));
                        if (cc && !tiee[e] && pc < AT_CAP) CAND[q * AT_CAP + pc] = ((unsigned long long)ord_key(sc[e]) << 32) | (unsigned)(0xFFFFu - key);
                        ccand[e] += __builtin_popcount(h2);
                        const bool cs = live && (bin > b0e[e] || (tiee[e] && cc && pc < neede[e]));
                        const unsigned long long m1 = __ballot(cs); const unsigned h1 = hh ? (unsigned)(m1 >> 32) : (unsigned)m1;
                        if (cs) SEL[q * 256 + csel[e] + __builtin_popcount(h1 & ((1u << kcol) - 1u))] = (unsigned short)key;
                        csel[e] += __builtin_popcount(h1);
                    }
                }
            }

            }
            if (tt + 1 < ntile) {
                if (tt + 3 < ntile) AT_READ(B1, tt + 3);
                if (tt + 2 < ntile) AT_MFMA(accA, B0);
                { const int kt = c * 8 + tt + 1; const f32x16& acc = accB;
            float sc[2];
#pragma unroll
            for (int e = 0; e < 2; ++e) { float s = 0.f;
#pragma unroll
                for (int i = 0; i < 8; ++i) s = __builtin_fmaf(wq[e][i], __builtin_amdgcn_fmed3f(acc[8 * e + i], 0.f, 3.0e38f), s);
                sc[e] = s; }
#pragma unroll
            for (int e = 0; e < 2; ++e) {
                const int q = 4 * wave + 2 * hh + e;
                const float tv = __builtin_fmaf(sc[e], wq[e][8], 256.0f);
                const bool live = ((kt < u) || (kcol <= 4 * wave + 2 * hh + e)) && tv >= lbt[e];
                if (MODE == 0 || __ballot(live) != 0ull) {
                    const int bin = (int)__builtin_amdgcn_fmed3f(tv, 0.0f, 511.5f);
                    if (MODE == 0) {
                        if (live) __hip_atomic_fetch_add(HIST + q * (AT_NBIN / 2) + (bin >> 1), (bin & 1) ? 65536u : 1u, __ATOMIC_RELAXED, __HIP_MEMORY_SCOPE_WORKGROUP);
                    } else {
                        const int key = kt * 32 + kcol;
                        const bool cc = live && bin == b0e[e];
                        const unsigned long long m2 = __ballot(cc); const unsigned h2 = hh ? (unsigned)(m2 >> 32) : (unsigned)m2;
                        const int pc = ccand[e] + __builtin_popcount(h2 & ((1u << kcol) - 1u));
                        if (cc && !tiee[e] && pc < AT_CAP) CAND[q * AT_CAP + pc] = ((unsigned long long)ord_key(sc[e]) << 32) | (unsigned)(0xFFFFu - key);
                        ccand[e] += __builtin_popcount(h2);
                        const bool cs = live && (bin > b0e[e] || (tiee[e] && cc && pc < neede[e]));
                        const unsigned long long m1 = __ballot(cs); const unsigned h1 = hh ? (unsigned)(m1 >> 32) : (unsigned)m1;
                        if (cs) SEL[q * 256 + csel[e] + __builtin_popcount(h1 & ((1u << kcol) - 1u))] = (unsigned short)key;
                        csel[e] += __builtin_popcount(h1);
                    }
                }
            }

                }
            }
        }
#undef AT_READ
#undef AT_MFMA
        if (MODE == 0 && AT_LBREF && c + 1 < nch && (c < 4 || (c & 3) == 3)) {
#pragma unroll
            for (int q = 0; q < 4; ++q) { int bs, c1, c2; hist_scan(HIST + (4 * wave + q) * (AT_NBIN / 2), lane, bs, c1, c2);
                const float lb = bs >= 1 ? (float)bs : -3.0e38f;
                if ((q >> 1) == hh) lbt[q & 1] = lb; }
        }
        if (c + 1 < nch) {
#pragma unroll
            for (int i = 0; i < 4; ++i) *(LAS u32x4*)(lds + AT_KBUF + ((c + 1) & 1) * AT_KCH + lofs + i * 64 * AT_KROW) = st[i];
        }
        __syncthreads();
    }
}

__device__ __forceinline__ void attn_unit(LAS unsigned char* lds, const AttnP& P, int b, int u, int tid_) {
    int tid = tid_; asm volatile("" : "+v"(tid));
    const int wave = __builtin_amdgcn_readfirstlane(tid >> 6), lane = tid & 63, hh = lane >> 5, kcol = lane & 31;
    LAS unsigned* HIST = (LAS unsigned*)lds; LAS unsigned long long* CAND = (LAS unsigned long long*)(lds + AT_CAND); LAS unsigned short* SEL = (LAS unsigned short*)(lds + AT_SEL);
    const LAS float* BIAS = (const LAS float*)(lds + AT_BIAS); const LAS int* BKT = (const LAS int*)(lds + AT_BKT);
    const int t0 = 32 * u; const size_t rowb = (size_t)b * SEQ;
    __syncthreads();
#pragma unroll
    for (int i = 0; i < 4; ++i) *(LAS u32x4*)(lds + (i * 512 + tid) * 16) = (u32x4){0u, 0u, 0u, 0u};
    bf16x8 afr[4]; float wq[2][9];
    { const int rho = kcol, j = rho >> 3, r = rho & 3, hq = (rho >> 2) & 1, head = 4 * (j & 1) + r, qloc = 2 * hq + (j >> 1);
      const bf16_t* qp = P.qidx + (rowb + t0 + 4 * wave + qloc) * 512 + head * 64 + 8 * hh;
#pragma unroll
      for (int ks = 0; ks < 4; ++ks) afr[ks] = *(const bf16x8*)(qp + ks * 16);
#pragma unroll
      for (int e = 0; e < 2; ++e) { const float* wp = P.widx + (rowb + t0 + 4 * wave + 2 * hh + e) * 8; const f32x4 a = *(const f32x4*)wp, c = *(const f32x4*)(wp + 4);
          wq[e][0] = a[0]; wq[e][1] = a[1]; wq[e][2] = a[2]; wq[e][3] = a[3]; wq[e][4] = c[0]; wq[e][5] = c[1]; wq[e][6] = c[2]; wq[e][7] = c[3];
          const float ss = (a[0] * a[0] + a[1] * a[1]) + (a[2] * a[2] + a[3] * a[3]) + (c[0] * c[0] + c[1] * c[1]) + (c[2] * c[2] + c[3] * c[3]);
          wq[e][8] = 32.0f / __builtin_sqrtf(fmaxf(ss, 1.0e-12f)); } }
    const bf16_t* kbase = P.kidx + rowb * 64;
    int b0e[2] = {0, 0}, neede[2] = {0, 0}, tiee[2] = {0, 0}, csel[2] = {0, 0}, ccand[2] = {0, 0};
#ifdef DBG_REP_PASS
    attn_pass<0>(lds, afr, wq, kbase, u, wave, lane, tid, b0e, neede, tiee, csel, ccand);
    __syncthreads();
#pragma unroll
    for (int i = 0; i < 4; ++i) *(LAS u32x4*)(lds + (i * 512 + tid) * 16) = (u32x4){0u, 0u, 0u, 0u};
    { int d0[2] = {511, 511}, d1[2] = {0, 0}, d2[2] = {0, 0}, d3[2] = {0, 0}, d4[2] = {0, 0};
      attn_pass<1>(lds, afr, wq, kbase, u, wave, lane, tid, d0, d1, d2, d3, d4); }
    __syncthreads();
#endif
    attn_pass<0>(lds, afr, wq, kbase, u, wave, lane, tid, b0e, neede, tiee, csel, ccand);
    int b0q[4], needq[4], nb0q[4];
#pragma unroll
    for (int q = 0; q < 4; ++q) {
        const int nq = t0 + 4 * wave + q + 1;
        int bsel, cat, abat; hist_scan(HIST + (4 * wave + q) * (AT_NBIN / 2), lane, bsel, cat, abat);
        if (nq <= 256) { bsel = -1; cat = 0; abat = 0; }
        b0q[q] = bsel; nb0q[q] = cat; needq[q] = (nq > 256) ? (256 - abat) : 0;
    }
    b0e[0] = hh ? b0q[2] : b0q[0]; b0e[1] = hh ? b0q[3] : b0q[1];
    neede[0] = hh ? needq[2] : needq[0]; neede[1] = hh ? needq[3] : needq[1];
    tiee[0] = (hh ? nb0q[2] : nb0q[0]) > AT_CAP; tiee[1] = (hh ? nb0q[3] : nb0q[1]) > AT_CAP;
    attn_pass<1>(lds, afr, wq, kbase, u, wave, lane, tid, b0e, neede, tiee, csel, ccand);
    int nselq[4];
#pragma unroll
    for (int q = 0; q < 4; ++q) {
        const int cv = (q & 1) ? csel[1] : csel[0];
        int cs = __builtin_amdgcn_readlane(cv, (q >> 1) * 32);
        const int need = needq[q], nb0 = nb0q[q];
        if (need > 0 && nb0 <= AT_CAP) {
            const int nc = nb0;
            const LAS unsigned long long* cq = CAND + (4 * wave + q) * AT_CAP;
            for (int i0 = 0; i0 < nc; i0 += 64) {
                const int i = i0 + lane; const unsigned long long mine = (i < nc) ? cq[i] : 0ull;
                int rank = 0; for (int j = 0; j < nc; ++j) rank += (cq[j] > mine) ? 1 : 0;
                const bool pick = (i < nc) && rank < need;
                const unsigned long long mk = __ballot(pick);
                if (pick) SEL[(4 * wave + q) * 256 + cs + __builtin_popcountll(mk & ((1ull << lane) - 1ull))] = (unsigned short)(0xFFFFu - (unsigned)(mine & 0xFFFFu));
                cs += __builtin_popcountll(mk);
            }
        }
        nselq[q] = cs;
    }
    asm volatile("s_waitcnt lgkmcnt(0)" ::: "memory");
    __syncthreads();
    LAS unsigned char* gb = lds + wave * AT_GBUF;
    const int n = lane & 15, kg = lane >> 4, head = n & 7;
#pragma unroll 1
    for (int qi = 0; qi < 4; ++qi) {
        const int q = 4 * wave + qi, t = t0 + q;
        const int nsel = qi == 0 ? nselq[0] : (qi == 1 ? nselq[1] : (qi == 2 ? nselq[2] : nselq[3]));
        const LAS unsigned short* sel = SEL + q * 256;
        bf16_t* qrow = P.qlat + (rowb + t) * 2048;
        bf16x8 qb[8];
#pragma unroll
        for (int ks = 0; ks < 8; ++ks) { qb[ks] = (bf16x8){0, 0, 0, 0, 0, 0, 0, 0}; if (n < 8) qb[ks] = *(const bf16x8*)(qrow + n * 256 + 32 * ks + 8 * kg); }
        f32x4 oacc[16];
#pragma unroll
        for (int mt = 0; mt < 16; ++mt) oacc[mt] = (f32x4){0.f, 0.f, 0.f, 0.f};
        float mrun = -1e30f, lrun = 0.f;
        const int nchunk = (nsel + 31) >> 5;
#pragma unroll 1
        for (int c = 0; c < nchunk; ++c) {
            const int jn = 32 * c + kcol; const int idxc = (jn < nsel) ? (int)sel[jn] : 0;
#pragma unroll
            for (int hf = 0; hf < 2; ++hf) {
                u32x4 pre[8];
#pragma unroll
                for (int i = 0; i < 8; ++i) { const int r0 = __builtin_amdgcn_readlane(idxc, 16 * hf + 2 * i), r1 = __builtin_amdgcn_readlane(idxc, 16 * hf + 2 * i + 1); const int ri = hh ? r1 : r0;
                    pre[i] = *(const u32x4*)(P.ckv + (rowb + ri) * 256 + kcol * 8); }
#pragma unroll
                for (int i = 0; i < 8; ++i) *(LAS u32x4*)(gb + (16 * hf + 2 * i + hh) * AT_GROW + kcol * 16) = pre[i];
            }
            f32x4 st[2];
#pragma unroll
            for (int k2 = 0; k2 < 2; ++k2) { st[k2] = (f32x4){0.f, 0.f, 0.f, 0.f};
#pragma unroll
                for (int ks = 0; ks < 8; ++ks) { const bf16x8 a = *(const LAS bf16x8*)(gb + (16 * k2 + n) * AT_GROW + (32 * ks + 8 * kg) * 2); st[k2] = __builtin_amdgcn_mfma_f32_16x16x32_bf16(a, qb[ks], st[k2], 0, 0, 0); } }
            float mloc = -1e30f;
#pragma unroll
            for (int k2 = 0; k2 < 2; ++k2)
#pragma unroll
                for (int r = 0; r < 4; ++r) { const int jj = 16 * k2 + 4 * kg + r; const int idx = __shfl(idxc, jj); const int d = t - idx;
                    const int bk = d < 16 ? d : (d < 128 ? BKT[d] : 31);
                    float lg = st[k2][r] + BIAS[bk * 8 + head]; if (32 * c + jj >= nsel) lg = -1e30f;
                    st[k2][r] = lg; mloc = fmaxf(mloc, lg); }
            mloc = fmaxf(mloc, __shfl_xor(mloc, 16)); mloc = fmaxf(mloc, __shfl_xor(mloc, 32));
            const float mnew = fmaxf(mrun, mloc), alpha = fast_exp(mrun - mnew);
            float ps = 0.f;
#pragma unroll
            for (int k2 = 0; k2 < 2; ++k2)
#pragma unroll
                for (int r = 0; r < 4; ++r) { const float p = fast_exp(st[k2][r] - mnew); st[k2][r] = p; ps += p; }
            ps += __shfl_xor(ps, 16); ps += __shfl_xor(ps, 32);
            lrun = lrun * alpha + ps; mrun = mnew;
#pragma unroll
            for (int mt = 0; mt < 16; ++mt) oacc[mt] = oacc[mt] * alpha;
            u32x4 pw; pw.x = pk2(st[0][0], st[0][1]); pw.y = pk2(st[0][2], st[0][3]); pw.z = pk2(st[1][0], st[1][1]); pw.w = pk2(st[1][2], st[1][3]);
            const bf16x8 pb = __builtin_bit_cast(bf16x8, pw);
            LAS unsigned char* tb = gb + (4 * kg + (n >> 2)) * AT_GROW + 8 * (n & 3);
#pragma unroll
            for (int mt = 0; mt < 16; ++mt) {
                const s16x4 v1 = __builtin_amdgcn_ds_read_tr16_b64_v4i16((LAS s16x4*)(tb + 32 * mt));
                const s16x4 v2 = __builtin_amdgcn_ds_read_tr16_b64_v4i16((LAS s16x4*)(tb + 16 * AT_GROW + 32 * mt));
                const bf16x8 av = (bf16x8){v1[0], v1[1], v1[2], v1[3], v2[0], v2[1], v2[2], v2[3]};
                oacc[mt] = __builtin_amdgcn_mfma_f32_16x16x32_bf16(av, pb, oacc[mt], 0, 0, 0);
            }
        }
        const float inv = 1.0f / lrun;
        if (n < 8) {
#pragma unroll
            for (int mt = 0; mt < 16; ++mt) { const f32x4 o = oacc[mt] * inv; u32x2 w; w.x = pk2(o[0], o[1]); w.y = pk2(o[2], o[3]); *(u32x2*)(qrow + n * 256 + 16 * mt + 4 * kg) = w; }
        }
    }
}
__device__ __forceinline__ void ln_finish(f32x4 (&v)[4], const float* gam, const float* bet, float* orow, bf16_t* brow, int lane) {
    float s = 0.f;
#pragma unroll
    for (int j = 0; j < 4; ++j) s += (v[j][0] + v[j][1]) + (v[j][2] + v[j][3]);
    const float mean = wave_sum(s) * (1.0f / 1024.0f); float s2 = 0.f;
#pragma unroll
    for (int j = 0; j < 4; ++j) { v[j] = v[j] - mean; s2 += (v[j][0] * v[j][0] + v[j][1] * v[j][1]) + (v[j][2] * v[j][2] + v[j][3] * v[j][3]); }
    const float rstd = 1.0f / __builtin_sqrtf(wave_sum(s2) * (1.0f / 1024.0f) + LN_EPS);
#pragma unroll
    for (int j = 0; j < 4; ++j) { const f32x4 g = *(const f32x4*)(gam + 256 * j + 4 * lane), bb = *(const f32x4*)(bet + 256 * j + 4 * lane);
        v[j] = v[j] * rstd * g + bb;
        *(f32x4*)(orow + 256 * j + 4 * lane) = v[j];
        u32x2 w; w.x = pk2(v[j][0], v[j][1]); w.y = pk2(v[j][2], v[j][3]); *(u32x2*)(brow + 256 * j + 4 * lane) = w; }
}
struct RouteP { int* r_e; int* r_pos; int* r_slot; float* r_g; unsigned* gcnt; };

__device__ __forceinline__ void ln1_route_block(LAS unsigned char* lds, int blk, float* xo, bf16_t* xb, const float* gam, const float* bet, const float* rbias, const RouteP& R, int tid) {
    const int wave = __builtin_amdgcn_readfirstlane(tid >> 6), lane = tid & 63;
    const LAS float* WR = (const LAS float*)lds; LAS int* lcnt = (LAS int*)(lds + 65536); LAS int* basee = (LAS int*)(lds + 65600); LAS int* tok = (LAS int*)(lds + 65664);
    __syncthreads();
    if (tid < 16) lcnt[tid] = 0;
    __syncthreads();
    for (int rr = 0; rr < 16; ++rr) {
        const int rl = wave * 16 + rr; const size_t row = (size_t)blk * 128 + rl;
        f32x4 v[4];
#pragma unroll
        for (int j = 0; j < 4; ++j) v[j] = *(const f32x4*)(xo + row * 1024 + 256 * j + 4 * lane);
        ln_finish(v, gam, bet, xo + row * 1024, xb + row * 1024, lane);
        float aff[16], sel[16];
#pragma unroll
        for (int e = 0; e < 16; ++e) { float p = 0.f;
#pragma unroll
            for (int j = 0; j < 4; ++j) { const f32x4 w = *(const LAS f32x4*)(WR + e * 1024 + 256 * j + 4 * lane); p += (v[j][0] * w[0] + v[j][1] * w[1]) + (v[j][2] * w[2] + v[j][3] * w[3]); }
            const float lg = wave_sum(p); aff[e] = 1.0f / (1.0f + expf(-lg)); sel[e] = aff[e] + rbias[e]; }
        float gbv = -3.0e38f; int gb = 0;
#pragma unroll
        for (int g = 0; g < 4; ++g) { float m1 = -3.0e38f, m2 = -3.0e38f;
#pragma unroll
            for (int i = 0; i < 4; ++i) { const float x = sel[4 * g + i]; if (x > m1) { m2 = m1; m1 = x; } else if (x > m2) m2 = x; }
            const float gs_ = m1 + m2; if (gs_ > gbv) { gbv = gs_; gb = g; } }
        float s0 = -3.0e38f, a0 = 0.f; int e0 = 0;
#pragma unroll
        for (int e = 0; e < 16; ++e) { const bool in = (e >> 2) == gb; if (in && sel[e] > s0) { s0 = sel[e]; a0 = aff[e]; e0 = e; } }
        float s1 = -3.0e38f, a1 = 0.f; int e1 = 0;
#pragma unroll
        for (int e = 0; e < 16; ++e) { const bool in = ((e >> 2) == gb) && (e != e0); if (in && sel[e] > s1) { s1 = sel[e]; a1 = aff[e]; e1 = e; } }
        if (lane == 0) {
            const float inv = 1.0f / (a0 + a1);
            const int p0 = __hip_atomic_fetch_add(lcnt + e0, 1, __ATOMIC_RELAXED, __HIP_MEMORY_SCOPE_WORKGROUP);
            const int p1 = __hip_atomic_fetch_add(lcnt + e1, 1, __ATOMIC_RELAXED, __HIP_MEMORY_SCOPE_WORKGROUP);
            tok[rl * 4 + 0] = e0; tok[rl * 4 + 1] = p0; tok[rl * 4 + 2] = e1; tok[rl * 4 + 3] = p1;
            *(f32x2*)(R.r_g + row * 2) = (f32x2){a0 * inv, a1 * inv};
        }
    }
    __syncthreads();
    if (tid < 16) basee[tid] = (int)__hip_atomic_fetch_add(R.gcnt + tid * 64, (unsigned)lcnt[tid], __ATOMIC_RELAXED, __HIP_MEMORY_SCOPE_AGENT);
    __syncthreads();
    if (tid < 256) { const int rl = tid >> 1, k = tid & 1; const int e = tok[rl * 4 + 2 * k], p = tok[rl * 4 + 2 * k + 1]; const size_t o = ((size_t)blk * 128 + rl) * 2 + k; R.r_e[o] = e; R.r_pos[o] = basee[e] + p; }
}
__device__ __forceinline__ void moe_offsets(LAS int* offp, const unsigned* gcnt, int tid) {
    __syncthreads();
    if (tid == 0) { int o = 0;
        for (int e = 0; e < 16; ++e) { offp[e] = o; const int c = (int)__hip_atomic_load(gcnt + e * 64, __ATOMIC_RELAXED, __HIP_MEMORY_SCOPE_AGENT); o += (c + 255) & ~255; }
        offp[16] = o; }
    __syncthreads();
}
#ifndef MK_PER_PHASE
#define MK_PER_PHASE 0
#endif
#ifndef EN_MASK
#define EN_MASK 0xFFF
#endif
#ifndef EN_M1
#define EN_M1 1
#endif
#ifndef EN_M2
#define EN_M2 1
#endif
#ifndef DBG_REP_P0A
#define DBG_REP_P0A 1
#endif
#ifndef EN_2A
#define EN_2A 1
#endif
#ifndef EN_2R
#define EN_2R 1
#endif
#define EN_A ((EN_MASK >> 0) & 1)
#define EN_B ((EN_MASK >> 1) & 1)
#define EN_0 ((EN_MASK >> 2) & 1)
#define EN_1 ((EN_MASK >> 3) & 1)
#define EN_2 ((EN_MASK >> 4) & 1)
#define EN_3 ((EN_MASK >> 5) & 1)
#define EN_4 ((EN_MASK >> 6) & 1)
#define EN_5 ((EN_MASK >> 7) & 1)
#define EN_6 ((EN_MASK >> 8) & 1)
#define EN_7 ((EN_MASK >> 9) & 1)
#define EN_8 ((EN_MASK >> 10) & 1)
#define EN_9 ((EN_MASK >> 11) & 1)
constexpr int NPH_L = 10, NPH = 2 + NL * NPH_L;
struct Args { const float* in[25]; float* out; unsigned char* ws; int ph_lo, ph_hi; };

__global__ void __launch_bounds__(NTHR, 2) fwd(Args a) {
    extern __shared__ __attribute__((aligned(16))) unsigned char lds_raw[];
    LAS unsigned char* lds = (LAS unsigned char*)lds_raw;
    const int G = gridDim.x, bx = blockIdx.x, vcu = (G % 8 == 0) ? (bx % 8) * (G / 8) + bx / 8 : bx;
    const int NGW = G * NWAVES;
#define PH_LOCALS int tid = wave_s * 64 + lane_id(); asm volatile("" : "+v"(tid)); const int lane = tid & 63, wave = wave_s, gw = vcu * NWAVES + wave; (void)lane; (void)gw;
    volatile LAS unsigned* MISC = (volatile LAS unsigned*)(lds + LDS_MISC);
    const int wave_s = __builtin_amdgcn_readfirstlane((int)threadIdx.x >> 6);
    if (threadIdx.x < 64) MISC[threadIdx.x] = 0u;
    __syncthreads();
    unsigned char* ws = a.ws;
    unsigned* ctl = (unsigned*)(ws + WS_CTL);
    const int lo = a.ph_lo, hi = a.ph_hi;
    XcdBarrier bar; bar.bar = ctl + CW_BAR; bar.x = 0; bar.st = MISC + 8;
    if (hi - lo > 1) bar = xcd_barrier_post(ctl + CW_BAR, MISC + 8);
#define IN(k) (lo <= (k) && (k) < hi)
#define SEAM(k) do { if (IN(k) && IN((k) + 1)) xcd_barrier(bar, wave_s == 0 && lane_id() == 0); } while (0)
    float* xo = a.out;
    bf16_t* xb = (bf16_t*)(ws + WS_XB);
    unsigned char* R = ws + WS_R;

    for (int rep_ = 0; rep_ < (DBG_REP_P0A); ++rep_)
    if (EN_A && IN(0)) { PH_LOCALS
        LAS float* scr = (LAS float*)(lds + wave * 8448);
        constexpr int PER_L = 4160;
        for (int it = gw; it < NL * PER_L; it += NGW) {
            const int l = it / PER_L; int r = it - l * PER_L;
            const float* win = a.in[1] + (size_t)l * 1024 * DIN;
            unsigned char* wm = ws + WS_WMIX + (size_t)l * WMIX_STRIDE;
            if (r < 1024) { tr_item(win, DIN, 0, 2048, (bf16_t*)(wm + OFF_WIN), 1024, 0, r, 64, scr, lane); continue; } r -= 1024;
            if (r < 512) { tr_item(win, DIN, 3072, 840, (bf16_t*)(wm + OFF_WIN) + (size_t)4096 * 1024, 1024, 0, r, 32, scr, lane); continue; } r -= 512;
            if (r < 1024) { tr_item(win, DIN, 3912, 2048, (bf16_t*)(wm + OFF_WG), 1024, 0, r, 64, scr, lane); continue; } r -= 1024;
            if (r < 512) { tr_item(a.in[12] + (size_t)l * 1048576, 1024, 0, 1024, (bf16_t*)(wm + OFF_WPR), 1024, 0, r, 32, scr, lane); continue; } r -= 512;
            if (r < 512) { tr_item(a.in[14] + (size_t)l * 1048576, 1024, 0, 1024, (bf16_t*)(wm + OFF_WO), 1024, 0, r, 32, scr, lane); continue; } r -= 512;
            if (r < 512) { tr_item(a.in[13] + (size_t)l * 1048576, 1024, 0, 1024, (bf16_t*)(R + R_PT + (size_t)l * 2 * MiB), 1024, 0, r, 32, scr, lane); continue; } r -= 512;
            { const int m = r >> 5, g = (r >> 1) & 15, nb = r & 1;
              const float* src = (m ? a.in[6] : a.in[4]) + (size_t)(l * 16 + g) * 4096;
              bf16_t* dst = (bf16_t*)(ws + WS_WSM + (size_t)l * 262144 + (size_t)m * 131072) + g * 4096;
              tr_item(src, 64, 0, 64, dst, 64, 0, nb, 2, scr, lane); }
        }
        const size_t gt = (size_t)vcu * NTHR + tid, GT = (size_t)G * NTHR;
        for (size_t i = gt; i < (size_t)NL * 1024 * 128; i += GT) { const int l = (int)(i >> 17), k = (int)(i >> 7) & 1023, j8 = (int)i & 127;
            const float* s = a.in[1] + ((size_t)l * 1024 + k) * DIN + 2048 + 8 * j8; const f32x4 v0 = *(const f32x4*)s, v1 = *(const f32x4*)(s + 4);
            *(u32x4*)((bf16_t*)(R + R_WQ + (size_t)l * 2 * MiB) + (size_t)k * 1024 + 8 * j8) = pack8(v0, v1); }
        for (size_t i = gt; i < (size_t)2 * NL * 8 * 256 * 32; i += GT) { const int which = (int)(i >> 18); const int r = (int)(i & 262143); const int lh = r >> 13, c = (r >> 5) & 255, d8 = r & 31; const int h = lh & 7;
            u32x4 o = (u32x4){0u, 0u, 0u, 0u};
            if ((d8 >> 4) == (h & 1)) { const float* s = (which ? a.in[11] : a.in[10]) + ((size_t)lh * 256 + c) * 128 + 8 * (d8 & 15); o = pack8(*(const f32x4*)s, *(const f32x4*)(s + 4)); }
            *(u32x4*)((bf16_t*)(R + (which ? R_UVP : R_UKP)) + ((size_t)lh * 256 + c) * 1024 + 8 * d8) = o; }
        for (size_t i = gt; i < (size_t)T * 128; i += GT) { const float* s = a.in[0] + i * 8; const f32x4 v0 = *(const f32x4*)s, v1 = *(const f32x4*)(s + 4);
            *(f32x4*)(xo + i * 8) = v0; *(f32x4*)(xo + i * 8 + 4) = v1; *(u32x4*)(xb + i * 8) = pack8(v0, v1); }
    }
    SEAM(0);
    if (EN_B && IN(1)) {
        SchedPro S{R, G, vcu}; EpiPro E{ws + WS_WMIX};
        gs::gemm_stream<true>(lds, S, E, wave_s);
    }
    SEAM(1);

    for (int l = 0; l < NL; ++l) {
        const int pb = 2 + l * NPH_L;
        unsigned char* wm = ws + WS_WMIX + (size_t)l * WMIX_STRIDE;
        bf16_t* xrnn = (bf16_t*)(R + R_XRNN); bf16_t* grnn = (bf16_t*)(R + R_GRNN); bf16_t* qlat = (bf16_t*)(R + R_QLAT); bf16_t* ckv = (bf16_t*)(R + R_CKV);
        bf16_t* qidx = (bf16_t*)(R + R_QIDX); bf16_t* kidx = (bf16_t*)(R + R_KIDX); float* widx = (float*)(R + R_WIDX);
        if (EN_0 && IN(pb + 0)) {
            SchedDense S{(const char*)xb, (const char*)(wm + OFF_WIN), 2048u, 2048u, 16, T / 256, 20, G, vcu};
            EpiInproj E{xrnn, grnn, qlat, ckv, qidx, kidx, widx};
            gs::gemm_stream<true>(lds, S, E, wave_s);
#ifdef DBG_REP_INPROJ
            gs::gemm_stream<true>(lds, S, E, wave_s);
#endif
        }
        SEAM(pb + 0);
        RnnP RP{xrnn, grnn, (float*)(R + R_TOT), (const bf16_t*)(ws + WS_WSM + (size_t)l * 262144), (const bf16_t*)(ws + WS_WSM + (size_t)l * 262144 + 131072),
                a.in[2] + (size_t)l * 4096, a.in[3] + (size_t)l * 1024, a.in[5] + (size_t)l * 1024, a.in[7] + (size_t)l * 1024, a.in[8] + (size_t)l * 1024};
        if (EN_1 && IN(pb + 1)) { PH_LOCALS
            for (int it = gw; it < 2048; it += NGW) rnn_item<1>(RP, it, lds + wave * 8448, lane);
#ifdef DBG_REP_RNN
            for (int it = gw; it < 2048; it += NGW) rnn_item<1>(RP, it, lds + wave * 8448, lane);
#endif
            for (int row = gw; row < T; row += NGW) ckv_norm_row(ckv + (size_t)row * 256, a.in[9] + (size_t)l * 256, lane);
            LAS float* scr = (LAS float*)(lds + wave * 8448);
            for (int it = gw; it < 16 * 768; it += NGW) { const int e = it / 768; int r = it - e * 768; const size_t le = (size_t)l * 16 + e;
                bf16_t* gu = (bf16_t*)(ws + WS_WEXP) + (size_t)e * 1048576; bf16_t* dn = (bf16_t*)(ws + WS_WEXP + OFF_DN) + (size_t)e * 524288;
                if (r < 256) { tr_item(a.in[19] + le * 524288, 512, 0, 512, gu, 1024, 1, r, 16, scr, lane); continue; } r -= 256;
                if (r < 256) { tr_item(a.in[20] + le * 524288, 512, 0, 512, gu + 4 * 1024, 1024, 1, r, 16, scr, lane); continue; } r -= 256;
                tr_item(a.in[21] + le * 524288, 1024, 0, 1024, dn, 512, 0, r, 32, scr, lane); }
        }
        SEAM(pb + 1);
        if (EN_2 && IN(pb + 2)) { PH_LOCALS
            __syncthreads();
            if (tid < 256) ((LAS float*)(lds + AT_BIAS))[tid] = a.in[24][tid];
            if (tid < 128) { const int d = tid; int bk = d; if (d >= 16) { bk = 16 + (int)(logf((float)d / 16.0f) / 2.0794415416798357f * 16.0f); bk = bk > 31 ? 31 : bk; } ((LAS int*)(lds + AT_BKT))[d] = bk; }
            AttnP AP{qidx, kidx, ckv, widx, qlat, (unsigned long long*)(R + R_MSCR + (size_t)bx * 393216)};
            if (EN_2A) for (int p = vcu; p < 512; p += G) { const int b = p >> 8, uu = p & 255;
#pragma unroll 1
                for (int k2 = 0; k2 < 2; ++k2) attn_unit(lds, AP, b, k2 ? uu : 511 - uu, tid); }
            __syncthreads();
            if (EN_2R) for (int it = gw; it < 2048; it += NGW) rnn_item<2>(RP, it, lds + wave * 8448, lane);
        }
        SEAM(pb + 2);
        if (EN_3 && IN(pb + 3)) {
            if (EN_M1) { SchedMerge1 S{(const char*)xb, (const char*)grnn, (const char*)(wm + OFF_WG), (const char*)(wm + OFF_WPR), G, vcu};
              EpiMerge1 E{R + R_MSCR + (size_t)bx * 131072, R + R_MSCR2, (bf16_t*)(R + R_MERGED)};
              gs::gemm_stream<true>(lds, S, E, wave_s); }
            if (EN_M2) { SchedDense S{(const char*)qlat, (const char*)(wm + OFF_WVO), 4096u, 4096u, 32, T / 256, 4, G, vcu};
              EpiMerge2 E{R + R_MSCR2, (bf16_t*)(R + R_MERGED)};
              gs::gemm_stream<true>(lds, S, E, wave_s); }
        }
        SEAM(pb + 3);
        if (EN_4 && IN(pb + 4)) {
            SchedDense S{(const char*)(R + R_MERGED), (const char*)(wm + OFF_WO), 2048u, 2048u, 16, T / 256, 4, G, vcu};
            EpiOut E{xo};
            gs::gemm_stream<false>(lds, S, E, wave_s);
        }
        SEAM(pb + 4);
        RouteP RT{(int*)(R + R_ROUTE), (int*)(R + R_ROUTE + 262144), (int*)(R + R_ROUTE + 524288), (float*)(R + R_ROUTE + 786432), ctl + CW_CNT + l * 16 * 64};
        LAS int* offp = (LAS int*)(lds + LDS_MISC - 128);
        if (EN_5 && IN(pb + 5)) { PH_LOCALS
            __syncthreads();
            for (int i = tid; i < 16384; i += NTHR) ((LAS float*)lds)[(i & 15) * 1024 + (i >> 4)] = a.in[17][i];
            for (int blk = vcu; blk < T / 128; blk += G) ln1_route_block(lds, blk, xo, xb, a.in[15] + (size_t)l * 1024, a.in[16] + (size_t)l * 1024, a.in[18], RT, tid);
        }
        SEAM(pb + 5);
        if (EN_6 && IN(pb + 6)) { PH_LOCALS
            moe_offsets(offp, RT.gcnt, tid);
            for (int p = gw; p < 2 * T; p += NGW) { const int e = RT.r_e[p], slot = offp[e] + RT.r_pos[p]; if (lane == 0) RT.r_slot[p] = slot;
                const u32x4* s = (const u32x4*)(xb + (size_t)(p >> 1) * 1024); u32x4* d = (u32x4*)((bf16_t*)(R + R_XG) + (size_t)slot * 1024);
                const u32x4 v0 = s[lane], v1 = s[64 + lane]; d[lane] = v0; d[64 + lane] = v1; }
        }
        SEAM(pb + 6);
        if (EN_7 && IN(pb + 7)) { PH_LOCALS
            moe_offsets(offp, RT.gcnt, tid);
            SchedMoE S{(const char*)(R + R_XG), (const char*)(ws + WS_WEXP), 2048u, 2048u, (size_t)2097152, 16, 4, G, vcu, offp};
            EpiGU E{(bf16_t*)(R + R_HE)};
            gs::gemm_stream<true>(lds, S, E, wave_s);
        }
        SEAM(pb + 7);
        if (EN_8 && IN(pb + 8)) { PH_LOCALS
            moe_offsets(offp, RT.gcnt, tid);
            SchedMoE S{(const char*)(R + R_HE), (const char*)(ws + WS_WEXP + OFF_DN), 1024u, 1024u, (size_t)1048576, 8, 4, G, vcu, offp};
            EpiBf16 E{(bf16_t*)(R + R_XG), 1024};
            gs::gemm_stream<true>(lds, S, E, wave_s);
        }
        SEAM(pb + 8);
        if (EN_9 && IN(pb + 9)) { PH_LOCALS
            const bf16_t* Y = (const bf16_t*)(R + R_XG);
            for (int row = gw; row < T; row += NGW) {
                const int s0 = RT.r_slot[2 * row], s1 = RT.r_slot[2 * row + 1]; const f32x2 gg = *(const f32x2*)(RT.r_g + 2 * (size_t)row);
                f32x4 v[4];
#pragma unroll
                for (int j = 0; j < 4; ++j) { const f32x4 x1 = *(const f32x4*)(xo + (size_t)row * 1024 + 256 * j + 4 * lane);
                    const u32x2 y0 = *(const u32x2*)(Y + (size_t)s0 * 1024 + 256 * j + 4 * lane), y1 = *(const u32x2*)(Y + (size_t)s1 * 1024 + 256 * j + 4 * lane);
                    v[j][0] = ALPHA * x1[0] + gg.x * bf_lo(y0.x) + gg.y * bf_lo(y1.x); v[j][1] = ALPHA * x1[1] + gg.x * bf_hi(y0.x) + gg.y * bf_hi(y1.x);
                    v[j][2] = ALPHA * x1[2] + gg.x * bf_lo(y0.y) + gg.y * bf_lo(y1.y); v[j][3] = ALPHA * x1[3] + gg.x * bf_hi(y0.y) + gg.y * bf_hi(y1.y); }
                ln_finish(v, a.in[22] + (size_t)l * 1024, a.in[23] + (size_t)l * 1024, xo + (size_t)row * 1024, xb + (size_t)row * 1024, lane);
            }
        }
        SEAM(pb + 9);
    }
#undef IN
#undef SEAM
}

#ifdef DUMP_OFF
__global__ void dump_k(const bf16_t* src, float* dst, size_t ld, size_t col0) { for (size_t i = (size_t)blockIdx.x * blockDim.x + threadIdx.x; i < (size_t)T * 1024; i += (size_t)gridDim.x * blockDim.x) dst[i] = bf2f(src[(i >> 10) * ld + col0 + (i & 1023)]); }
#endif
extern "C" void kernel_launch(void* const* d_in, const int* in_sizes, int n_in, void* d_out, int out_size, void* d_ws, size_t ws_size, hipStream_t stream) {
    static int grid = 0;
    if (grid == 0) {
        if (n_in != 25 || out_size != T * D || ws_size < WS_END) { fprintf(stderr, "kernel_launch: unexpected shapes (n_in %d, out %d, ws %zu < %zu)\n", n_in, out_size, ws_size, (size_t)WS_END); grid = -1; return; }
        int dev = 0, cus = 0, per_cu = 0;
        if (hipGetDevice(&dev) != hipSuccess || hipDeviceGetAttribute(&cus, hipDeviceAttributeMultiprocessorCount, dev) != hipSuccess) { grid = -1; return; }
        if (hipFuncSetAttribute((const void*)fwd, hipFuncAttributeMaxDynamicSharedMemorySize, LDS_BYTES) != hipSuccess) { fprintf(stderr, "kernel_launch: hipFuncSetAttribute failed\n"); grid = -1; return; }
        if (hipOccupancyMaxActiveBlocksPerMultiprocessor(&per_cu, (const void*)fwd, NTHR, LDS_BYTES) != hipSuccess || per_cu < 1) fprintf(stderr, "kernel_launch: occupancy query says %d\n", per_cu);
        (void)hipGetLastError();
        grid = cus < 256 ? cus : 256;
    }
    if (grid < 0) return;
    (void)hipMemsetAsync((char*)d_ws + WS_CTL, 0, CTL_BYTES, stream);
    Args a{};
    for (int i = 0; i < 25; ++i) a.in[i] = (const float*)d_in[i];
    a.out = (float*)d_out; a.ws = (unsigned char*)d_ws;
#if MK_PER_PHASE
#ifndef PH_LIMIT
#define PH_LIMIT NPH
#endif
    for (int ph = 0; ph < PH_LIMIT; ++ph) { a.ph_lo = ph; a.ph_hi = ph + 1; hipLaunchKernelGGL(fwd, dim3(grid), dim3(NTHR), LDS_BYTES, stream, a); }
#else
    a.ph_lo = 0; a.ph_hi = NPH; hipLaunchKernelGGL(fwd, dim3(grid), dim3(NTHR), LDS_BYTES, stream, a);
#endif
#ifdef DUMP_OFF
    hipLaunchKernelGGL(dump_k, dim3(2048), dim3(256), 0, stream, (const bf16_t*)((const char*)d_ws + (DUMP_OFF)), (float*)d_out, (size_t)(DUMP_LD), (size_t)(DUMP_COL));
#endif
}
```

```cpp
#include <hip/hip_runtime.h>
#include <cstdio>
#include <cstdint>

#define GAS __attribute__((address_space(1)))
#define LAS __attribute__((address_space(3)))
typedef unsigned short bf16_t;
typedef short bf16x8 __attribute__((ext_vector_type(8)));
typedef short s16x4 __attribute__((ext_vector_type(4)));
typedef float f32x2 __attribute__((ext_vector_type(2)));
typedef float f32x4 __attribute__((ext_vector_type(4)));
typedef float f32x16 __attribute__((ext_vector_type(16)));
typedef unsigned u32x2 __attribute__((ext_vector_type(2)));
typedef unsigned u32x4 __attribute__((ext_vector_type(4)));

constexpr int NB = 2, SEQ = 16384, T = NB * SEQ, D = 1024, NL = 4, DIN = 5960;
constexpr int NE = 16;
constexpr float ALPHA = 1.681792830507429f;
constexpr float LN_EPS = 1e-5f, RMS_EPS = 1e-6f;
constexpr int NWAVES = 8, NTHR = 512;

constexpr size_t MiB = 1u << 20;
constexpr size_t WS_CTL = 0, CTL_BYTES = 1 * MiB;
constexpr size_t WS_XB = 1 * MiB;
constexpr size_t WS_WMIX = 65 * MiB, WMIX_STRIDE = 22 * MiB;
constexpr size_t OFF_WIN = 0, OFF_WG = 10 * MiB, OFF_WPR = 14 * MiB, OFF_WVO = 16 * MiB, OFF_WO = 20 * MiB;
constexpr size_t WS_WSM = 153 * MiB;
constexpr size_t WS_WEXP = 154 * MiB;
constexpr size_t OFF_DN = 32 * MiB;
constexpr size_t WS_R = 202 * MiB;
constexpr size_t R_XRNN = 0, R_GRNN = 64 * MiB, R_QLAT = 128 * MiB, R_CKV = 256 * MiB, R_QIDX = 272 * MiB, R_KIDX = 304 * MiB, R_WIDX = 308 * MiB,
                 R_TOT = 309 * MiB, R_MSCR = 310 * MiB, R_MSCR2 = 342 * MiB, R_END = 406 * MiB;
constexpr size_t R_MERGED = R_XRNN;
constexpr size_t R_XG = 0, R_HE = 136 * MiB, R_ROUTE = 204 * MiB;
constexpr size_t R_WQ = 0, R_UKP = 8 * MiB, R_PT = 24 * MiB, R_UVP = 32 * MiB;
constexpr size_t WS_END = WS_R + R_END;
constexpr int MP_MAX = 2 * T + NE * 256;

constexpr int CW_TMO = 0;
constexpr int CW_BAR = 4096;
constexpr int CW_CNT = 8192;
constexpr int CW_QUEUE = 14336;

constexpr int LDS_BYTES = 163840;
constexpr int LDS_MISC = LDS_BYTES - 256;

#define RLX_AGENT __ATOMIC_RELAXED, __HIP_MEMORY_SCOPE_AGENT
__device__ __forceinline__ unsigned f2bf(float f) { unsigned u = __builtin_bit_cast(unsigned, f); return (u + 0x7fffu + ((u >> 16) & 1u)) >> 16; }
typedef __bf16 bf16x2_t __attribute__((ext_vector_type(2)));
__device__ __forceinline__ unsigned pk2(float lo, float hi) { const f32x2 v = {lo, hi}; const bf16x2_t b = __builtin_convertvector(v, bf16x2_t); return __builtin_bit_cast(unsigned, b); }
__device__ __forceinline__ float bf_lo(unsigned w) { return __builtin_bit_cast(float, w << 16); }
__device__ __forceinline__ float bf_hi(unsigned w) { return __builtin_bit_cast(float, w & 0xffff0000u); }
__device__ __forceinline__ float bf2f(bf16_t h) { return __builtin_bit_cast(float, ((unsigned)h) << 16); }
__device__ __forceinline__ float fast_exp(float x) { return __builtin_amdgcn_exp2f(x * 1.4426950408889634f); }
__device__ __forceinline__ float fast_rcp(float x) { return __builtin_amdgcn_rcpf(x); }
__device__ __forceinline__ float sigmoidf_(float x) { return fast_rcp(1.0f + fast_exp(-x)); }
__device__ __forceinline__ float gelu_tanh(float x) { const float y = 0.7978845608028654f * (x + 0.044715f * x * x * x); const float e = fast_exp(2.0f * y); const float th = 1.0f - 2.0f * fast_rcp(e + 1.0f); return 0.5f * x * (1.0f + th); }
template <int CTRL> __device__ __forceinline__ float dpp_f(float v) { return __builtin_bit_cast(float, __builtin_amdgcn_update_dpp(0, __builtin_bit_cast(int, v), CTRL, 0xf, 0xf, true)); }
__device__ __forceinline__ float wave_sum(float v) {
    v += dpp_f<0xB1>(v); v += dpp_f<0x4E>(v); v += dpp_f<0x141>(v); v += dpp_f<0x140>(v);
    const int vi = __builtin_bit_cast(int, v);
    return (__builtin_bit_cast(float, __builtin_amdgcn_readlane(vi, 0)) + __builtin_bit_cast(float, __builtin_amdgcn_readlane(vi, 16))) +
           (__builtin_bit_cast(float, __builtin_amdgcn_readlane(vi, 32)) + __builtin_bit_cast(float, __builtin_amdgcn_readlane(vi, 48)));
}

__device__ __forceinline__ int lane_id() { unsigned z = 0u; asm volatile("" : "+v"(z)); return (int)__builtin_amdgcn_mbcnt_hi(~0u, __builtin_amdgcn_mbcnt_lo(~0u, z)); }
#define XB_TMO      128
#define XB_XCNT(j)  (256  + 64 * (j))
#define XB_XSUB(j)  (1280 + 64 * (j))
#define XB_XGEN(j)  (2304 + 64 * (j))
#define XB_TOP      3328
#define XB_TOPGEN   3392
#define XCD_BAR_WORDS 3456
#define XB_SPIN_CAP (1u << 18)
__device__ __forceinline__ unsigned xb_ld(unsigned* p)              { return __hip_atomic_load(p, __ATOMIC_RELAXED, __HIP_MEMORY_SCOPE_AGENT); }
__device__ __forceinline__ unsigned xb_add(unsigned* p, unsigned v) { return __hip_atomic_fetch_add(p, v, __ATOMIC_RELAXED, __HIP_MEMORY_SCOPE_AGENT); }
__device__ __forceinline__ unsigned xb_xcc_id() { return (unsigned)__builtin_amdgcn_s_getreg((3 << 11) | 20) & 0xFu; }
#define XB_SPIN(cond, bar) do { unsigned _sp = 0; while (cond) { __builtin_amdgcn_s_sleep(1); \
    if ((++_sp & 255u) == 0u) { if (xb_ld(&(bar)[XB_TMO])) break; if (_sp > XB_SPIN_CAP) { atomicAdd(&(bar)[XB_TMO], 1u); break; } } } } while (0)
struct XcdBarrier { unsigned* bar; unsigned x; volatile LAS unsigned* st; };
__device__ __forceinline__ XcdBarrier xcd_barrier_post(unsigned* bar, volatile LAS unsigned* st) {
    XcdBarrier b; b.bar = bar; b.x = xb_xcc_id(); b.st = st;
    if (threadIdx.x == 0) (void)xb_add(&bar[XB_XCNT(b.x)], 1u);
    return b;
}
__device__ __forceinline__ void xcd_barrier_complete(unsigned* bar, unsigned x, unsigned& nloc, unsigned& nx) {
    const unsigned G = gridDim.x * gridDim.y * gridDim.z;
    unsigned sum, cnt, mine, sp = 0u;
    for (;;) {
        sum = 0u; cnt = 0u; mine = 0u;
#pragma unroll
        for (unsigned j = 0; j < 16; ++j) { const unsigned c = xb_ld(&bar[XB_XCNT(j)]); sum += c; cnt += (c > 0u) ? 1u : 0u; mine = (j == x) ? c : mine; }
        if (sum == G) break;
        __builtin_amdgcn_s_sleep(1);
        if ((++sp & 255u) == 0u) { if (xb_ld(&bar[XB_TMO])) break; if (sp > XB_SPIN_CAP) { atomicAdd(&bar[XB_TMO], 1u); break; } }
    }
    nloc = mine > 0u ? mine : 1u; nx = cnt > 0u ? cnt : 1u;
}
__device__ __forceinline__ void xcd_barrier(const XcdBarrier& b, bool is_t0) {
    asm volatile("s_waitcnt vmcnt(0)" ::: "memory");
    __syncthreads();
    if (is_t0) {
        unsigned* bar = b.bar;
        __builtin_amdgcn_s_waitcnt(0);
        unsigned nloc = b.st[0], nx = b.st[1];
        if (nloc == 0u) { xcd_barrier_complete(bar, b.x, nloc, nx); b.st[0] = nloc; b.st[1] = nx; }
        const unsigned old = xb_add(&bar[XB_XSUB(b.x)], 1u);
        const unsigned gen = old / nloc;
        if (old + 1u == (gen + 1u) * nloc) {
            __builtin_amdgcn_fence(__ATOMIC_RELEASE, "agent");
            asm volatile("s_waitcnt vmcnt(0)" ::: "memory");
            const unsigned og = xb_add(&bar[XB_TOP], 1u);
            const unsigned tg = og / nx;
            if (og + 1u == (tg + 1u) * nx) xb_add(&bar[XB_TOPGEN], 1u);
            else XB_SPIN(xb_ld(&bar[XB_TOPGEN]) == tg, bar);
            __builtin_amdgcn_fence(__ATOMIC_ACQUIRE, "agent");
            xb_add(&bar[XB_XGEN(b.x)], 1u);
            asm volatile("s_waitcnt vmcnt(0)" ::: "memory");
        } else {
            XB_SPIN(xb_ld(&bar[XB_XGEN(b.x)]) == gen, bar);
            __builtin_amdgcn_fence(__ATOMIC_ACQUIRE, "agent");
            asm volatile("s_waitcnt vmcnt(0)" ::: "memory");
        }
    }
    __syncthreads();
}
namespace gs {
constexpr int BM = 256, BK = 64, HALF = 128, HTB = HALF * BK * 2, STAGE_BYTES = 8 * HTB, NXCD = 8, WGM = 8;
__host__ __device__ __forceinline__ int lds_byte(int r, int c) { const int st = (r >> 4) * 2 + (c >> 5), rr = r & 15, cc = c & 31, ob = rr * 64 + cc * 2; return st * 1024 + (ob ^ (((ob >> 9) & 1) << 5)); }
__host__ __device__ __forceinline__ void stage_rc(int b, int& R, int& C) { const int st = b / 1024, sb = b % 1024, swz = sb ^ (((sb >> 9) & 1) << 5); R = (st >> 1) * 16 + swz / 64; C = (st & 1) * 32 + (swz % 64) / 2; }
__host__ __device__ __forceinline__ int perm32(int rho) { const int n = rho >> 4, i = rho & 15; return 8 * (i >> 2) + 4 * n + (i & 3); }

struct UD { const char* A; const char* B; unsigned lda, ldb; int nt; int kind, pm, pn, aux; };

__device__ __forceinline__ bool tile_of(long L, int nM, int nN, int& pm, int& pn) {
    const int nwg = nM * nN; if (L >= nwg) return false;
    int wgid = (int)L; { const int q = nwg / NXCD, r = nwg % NXCD, xcd = wgid % NXCD, off = wgid / NXCD; wgid = (xcd < r ? xcd * (q + 1) : r * (q + 1) + (xcd - r) * q) + off; }
    const int nig = WGM * nN, gid = wgid / nig, fm = gid * WGM, gsz = (nM - fm) < WGM ? (nM - fm) : WGM;
    pm = fm + ((wgid % nig) % gsz); pn = (wgid % nig) / gsz; return true;
}

template <bool PERM, class Sched, class Epi, bool GATHER = false>
__device__ __forceinline__ void gemm_stream(LAS unsigned char* lds, const Sched& S, const Epi& E, int wave_s) {
    int tid = wave_s * 64 + lane_id(); asm volatile("" : "+v"(tid));
    const int wid = __builtin_amdgcn_readfirstlane(tid >> 6), lane = tid & 63, wr = wid >> 2, wc = wid & 3, fr = lane & 15, fq = lane >> 4;
    int rA[2], rB[2], cb[2];
#pragma unroll
    for (int i = 0; i < 2; ++i) { int R, C; stage_rc(tid * 16 + i * 8192, R, C); rA[i] = R; rB[i] = PERM ? ((R & ~31) + perm32(R & 31)) : R; cb[i] = C * 2; }
    const size_t kstep = (size_t)(BK * 2);
    const unsigned ldsw = (unsigned)wid * 1024u;
    const int aoff = lds_byte(wr * 64 + fr, fq * 8), boff = lds_byte(wc * 32 + fr, fq * 8);
#define GS_SA(b, h) (((b) * 2 + (h)) * HTB)
#define GS_SB(b, h) ((4 + (b) * 2 + (h)) * HTB)
#define GS_STAGE(bufoff, gbase, voff) do { _Pragma("unroll") for (int _i = 0; _i < 2; ++_i) \
        __builtin_amdgcn_global_load_lds((const unsigned*)((const char*)(gbase) + (voff)[_i]), (LAS unsigned*)(lds + (bufoff) + ldsw + _i * 8192), 16, 0, 0); } while (0)
#define GS_LDA(dst, b, h) do { _Pragma("unroll") for (int m = 0; m < 4; ++m) _Pragma("unroll") for (int k = 0; k < 2; ++k) dst[m][k] = *(const LAS bf16x8*)(lds + GS_SA(b, h) + aoff + m * 2048 + k * 1024); } while (0)
#define GS_LDB(dst, b, h) do { _Pragma("unroll") for (int n = 0; n < 2; ++n) _Pragma("unroll") for (int k = 0; k < 2; ++k) dst[n][k] = *(const LAS bf16x8*)(lds + GS_SB(b, h) + boff + n * 2048 + k * 1024); } while (0)
#define GS_MMA(ai, bj, At, Bt) do { __builtin_amdgcn_s_setprio(1); _Pragma("unroll") for (int m = 0; m < 4; ++m) _Pragma("unroll") for (int n = 0; n < 2; ++n) _Pragma("unroll") for (int k = 0; k < 2; ++k) \
        acc[ai][bj][m][n] = __builtin_amdgcn_mfma_f32_16x16x32_bf16(Bt[n][k], At[m][k], acc[ai][bj][m][n], 0, 0, 0); __builtin_amdgcn_s_setprio(0); } while (0)
#define GS_WAIT_V(n) asm volatile("s_waitcnt vmcnt(" #n ")" ::: "memory")
#define GS_WAIT_L(n) asm volatile("s_waitcnt lgkmcnt(" #n ")" ::: "memory")
#define GS_BAR __builtin_amdgcn_s_barrier()
#define GS_SCHED __builtin_amdgcn_sched_barrier(0)
    UD cur, nxt; int ui = 0; const bool prime = false;
    if (!S.next(0, cur)) return;
    f32x4 acc[2][2][4][2];
#pragma unroll
    for (int a = 0; a < 2; ++a)
#pragma unroll
        for (int b = 0; b < 2; ++b)
#pragma unroll
            for (int m = 0; m < 4; ++m)
#pragma unroll
                for (int n = 0; n < 2; ++n) acc[a][b][m][n] = (f32x4){0.f, 0.f, 0.f, 0.f};
    bf16x8 At[4][2], B0[2][2], B1[2][2];
    unsigned vAc[2], vBc[2], vAc1[2] = {0u, 0u};
#pragma unroll
    for (int i = 0; i < 2; ++i) { vAc[i] = (unsigned)rA[i] * cur.lda + (unsigned)cb[i]; vBc[i] = (unsigned)rB[i] * cur.ldb + (unsigned)cb[i]; }
    if constexpr (GATHER) { const int* rm = S.rmap + cur.pm * 256;
#pragma unroll
        for (int i = 0; i < 2; ++i) { vAc[i] = (unsigned)rm[rA[i]] * cur.lda + (unsigned)cb[i]; vAc1[i] = (unsigned)rm[HALF + rA[i]] * cur.lda + (unsigned)cb[i]; } }
    const char* cA = cur.A; const char* cB = cur.B; size_t hA = GATHER ? (size_t)0 : (size_t)HALF * cur.lda, hB = (size_t)HALF * cur.ldb;
    GS_STAGE(GS_SB(0, 0), cB, vBc); GS_STAGE(GS_SA(0, 0), cA, vAc); GS_STAGE(GS_SB(0, 1), cB + hB, vBc); GS_STAGE(GS_SA(0, 1), cA + hA, (GATHER ? vAc1 : vAc));
    if (wr == 1) GS_BAR;
    GS_WAIT_V(4); GS_BAR;
    GS_STAGE(GS_SB(1, 0), cB + kstep, vBc); GS_STAGE(GS_SA(1, 0), cA + kstep, vAc); GS_STAGE(GS_SB(1, 1), cB + hB + kstep, vBc);
    GS_WAIT_V(6); GS_BAR;
    for (;;) {
        const bool has_next = S.next(ui + 1, nxt);
        const char* nA = has_next ? nxt.A : cA; const char* nB = has_next ? nxt.B : cB;
        const unsigned nlda = has_next ? nxt.lda : cur.lda, nldb = has_next ? nxt.ldb : cur.ldb;
        unsigned vAn[2], vBn[2], vAn1[2] = {0u, 0u};
#pragma unroll
        for (int i = 0; i < 2; ++i) { vAn[i] = (unsigned)rA[i] * nlda + (unsigned)cb[i]; vBn[i] = (unsigned)rB[i] * nldb + (unsigned)cb[i]; }
        if constexpr (GATHER) { const int* rm = S.rmap + (has_next ? nxt.pm : cur.pm) * 256;
#pragma unroll
            for (int i = 0; i < 2; ++i) { vAn[i] = (unsigned)rm[rA[i]] * nlda + (unsigned)cb[i]; vAn1[i] = (unsigned)rm[HALF + rA[i]] * nlda + (unsigned)cb[i]; } }
        const size_t hAn = GATHER ? (size_t)0 : (size_t)HALF * nlda, hBn = (size_t)HALF * nldb;
        const int nt = cur.nt;
        for (int t = 0; t < nt; t += 2) {
            const bool last = (t == nt - 2);
            const char* a1 = cA + (size_t)(t + 1) * kstep;
            const char* a2 = last ? nA : cA + (size_t)(t + 2) * kstep; const char* b2 = last ? nB : cB + (size_t)(t + 2) * kstep;
            const char* a3 = a2 + kstep; const char* b3 = b2 + kstep;
            unsigned vA2[2], vB2[2], vA21[2];
#pragma unroll
            for (int i = 0; i < 2; ++i) { vA2[i] = last ? vAn[i] : vAc[i]; vB2[i] = last ? vBn[i] : vBc[i]; vA21[i] = last ? vAn1[i] : vAc1[i]; }
            const size_t hA2 = last ? hAn : hA, hB2 = last ? hBn : hB;
            GS_LDB(B0, 0, 0); GS_SCHED; GS_LDA(At, 0, 0); GS_STAGE(GS_SA(1, 1), a1 + hA, (GATHER ? vAc1 : vAc));
            GS_WAIT_L(8); GS_BAR; GS_WAIT_L(0); GS_MMA(0, 0, At, B0); GS_BAR; GS_SCHED;
            GS_LDB(B1, 0, 1); GS_STAGE(GS_SB(0, 0), b2, vB2);
            GS_BAR; GS_WAIT_L(0); GS_MMA(0, 1, At, B1); GS_BAR;
            GS_LDA(At, 0, 1); GS_STAGE(GS_SA(0, 0), a2, vA2);
            GS_BAR; GS_WAIT_L(0); GS_MMA(1, 0, At, B0); GS_BAR; GS_SCHED;
            GS_STAGE(GS_SB(0, 1), b2 + hB2, vB2);
            GS_WAIT_V(6); GS_BAR; GS_MMA(1, 1, At, B1); GS_BAR;
            GS_LDB(B0, 1, 0); GS_SCHED; GS_LDA(At, 1, 0); GS_STAGE(GS_SA(0, 1), a2 + hA2, (GATHER ? vA21 : vA2));
            GS_WAIT_L(8); GS_BAR; GS_WAIT_L(0); GS_MMA(0, 0, At, B0); GS_BAR; GS_SCHED;
            GS_LDB(B1, 1, 1); GS_STAGE(GS_SB(1, 0), b3, vB2);
            GS_BAR; GS_WAIT_L(0); GS_MMA(0, 1, At, B1); GS_BAR;
            GS_LDA(At, 1, 1); GS_STAGE(GS_SA(1, 0), a3, vA2);
            GS_BAR; GS_WAIT_L(0); GS_MMA(1, 0, At, B0); GS_BAR; GS_SCHED;
            GS_STAGE(GS_SB(1, 1), b3 + hB2, vB2);
            GS_WAIT_V(6); GS_BAR; GS_MMA(1, 1, At, B1); GS_BAR;
        }
        if (!prime) { int tz = wave_s * 64 + lane_id(); asm volatile("" : "+v"(tz)); const int w2 = __builtin_amdgcn_readfirstlane(tz >> 6), l2 = tz & 63; E(acc, cur, w2 >> 2, w2 & 3, l2 & 15, l2 >> 4, tz); }
        if (!has_next) break;
#pragma unroll
        for (int a = 0; a < 2; ++a)
#pragma unroll
            for (int b = 0; b < 2; ++b)
#pragma unroll
                for (int m = 0; m < 4; ++m)
#pragma unroll
                    for (int n = 0; n < 2; ++n) acc[a][b][m][n] = (f32x4){0.f, 0.f, 0.f, 0.f};
        cur = nxt; cA = nA; cB = nB; hA = hAn; hB = hBn;
#pragma unroll
        for (int i = 0; i < 2; ++i) { vAc[i] = vAn[i]; vBc[i] = vBn[i]; vAc1[i] = vAn1[i]; }
        ++ui;
    }
    GS_WAIT_V(0);
    if (wr == 0) GS_BAR;
    GS_BAR;
#undef GS_SA
#undef GS_SB
#undef GS_STAGE
#undef GS_LDA
#undef GS_LDB
#undef GS_MMA
#undef GS_WAIT_V
#undef GS_WAIT_L
#undef GS_BAR
#undef GS_SCHED
}
}
using gs::UD;
__device__ __forceinline__ u32x4 pack8(f32x4 v0, f32x4 v1) { u32x4 w; w.x = pk2(v0[0], v0[1]); w.y = pk2(v0[2], v0[3]); w.z = pk2(v1[0], v1[1]); w.w = pk2(v1[2], v1[3]); return w; }
__device__ __forceinline__ void unpack8(u32x4 w, f32x4& v0, f32x4& v1) { v0 = (f32x4){bf_lo(w.x), bf_hi(w.x), bf_lo(w.y), bf_hi(w.y)}; v1 = (f32x4){bf_lo(w.z), bf_hi(w.z), bf_lo(w.w), bf_hi(w.w)}; }

struct EpiInproj {
    bf16_t *xrnn, *grnn, *qlat, *ckv, *qidx, *kidx; float* widx;
    __device__ __forceinline__ void operator()(const f32x4 (&acc)[2][2][4][2], const UD& u, int wr, int wc, int fr, int fq, int tid) const {
        const int pn = u.pn; const size_t row0 = (size_t)u.pm * 256 + wr * 64 + fr;
        if (pn < 19) {
            bf16_t* base; int ldc, colt; float sc = 1.f; bool gl = false;
            if (pn < 4) { base = xrnn; ldc = 1024; colt = 256 * pn; }
            else if (pn < 8) { base = grnn; ldc = 1024; colt = 256 * (pn - 4); gl = true; }
            else if (pn < 16) { base = qlat; ldc = 2048; colt = 256 * (pn - 8); }
            else if (pn == 16) { base = ckv; ldc = 256; colt = 0; }
            else { base = qidx; ldc = 512; colt = 256 * (pn - 17); sc = 0.125f; }
#pragma unroll
            for (int ai = 0; ai < 2; ++ai)
#pragma unroll
                for (int m = 0; m < 4; ++m) { bf16_t* rowp = base + (row0 + ai * 128 + m * 16) * ldc + colt + wc * 32 + 8 * fq;
#pragma unroll
                    for (int bj = 0; bj < 2; ++bj) { f32x4 v0 = acc[ai][bj][m][0], v1 = acc[ai][bj][m][1];
                        if (gl) {
#pragma unroll
                            for (int j = 0; j < 4; ++j) { v0[j] = gelu_tanh(v0[j]); v1[j] = gelu_tanh(v1[j]); } }
                        v0 = v0 * sc; v1 = v1 * sc;
                        *(u32x4*)(rowp + bj * 128) = pack8(v0, v1); } }
        } else {
#pragma unroll
            for (int ai = 0; ai < 2; ++ai)
#pragma unroll
                for (int m = 0; m < 4; ++m) { const size_t row = row0 + ai * 128 + m * 16; const f32x4 v0 = acc[ai][0][m][0], v1 = acc[ai][0][m][1];
                    if (wc < 2) *(u32x4*)(kidx + row * 64 + wc * 32 + 8 * fq) = pack8(v0, v1);
                    else if (wc == 2 && fq == 0) { *(f32x4*)(widx + row * 8) = v0 * 0.35355339059327373f; *(f32x4*)(widx + row * 8 + 4) = v1 * 0.35355339059327373f; } }
        }
    }
};
struct EpiMerge1 {
    unsigned char* s1b; unsigned char* s2b; bf16_t* merged;
    __device__ __forceinline__ void operator()(const f32x4 (&acc)[2][2][4][2], const UD& u, int wr, int wc, int fr, int fq, int tid) const {
        const int kind = u.kind;
        u32x4* s1 = (u32x4*)s1b + tid; u32x4* s2 = (u32x4*)(s2b + (size_t)(u.pm * 4 + u.pn) * 131072) + tid;
#pragma unroll
        for (int ai = 0; ai < 2; ++ai)
#pragma unroll
            for (int bj = 0; bj < 2; ++bj)
#pragma unroll
                for (int m = 0; m < 4; ++m) { const int slot = (ai * 2 + bj) * 4 + m; f32x4 v0 = acc[ai][bj][m][0], v1 = acc[ai][bj][m][1];
                    if (kind != 1) {
#pragma unroll
                        for (int j = 0; j < 4; ++j) { v0[j] = sigmoidf_(v0[j]); v1[j] = sigmoidf_(v1[j]); }
#ifdef DBG_S1_CONST
                        { const float cv = (float)(u.pm * 4 + u.pn + 1) * (1.0f / 512.0f); v0 = (f32x4){cv, cv, cv, cv}; v1 = v0; }
#endif
                        (kind == 0 ? s1 : s2)[slot * 512] = pack8(v0, v1);
                    } else {
                        f32x4 a0, a1; unpack8(__builtin_nontemporal_load(s1 + slot * 512), a0, a1);
#ifdef DBG_NO_S1
                        a0 = (f32x4){1.f, 1.f, 1.f, 1.f}; a1 = a0;
#endif
                        const size_t row = (size_t)u.pm * 256 + ai * 128 + wr * 64 + m * 16 + fr;
                        *(u32x4*)(merged + row * 1024 + u.pn * 256 + bj * 128 + wc * 32 + 8 * fq) = pack8(a0 * v0, a1 * v1);
#ifdef DBG_OUT_S1
                        *(u32x4*)(merged + row * 1024 + u.pn * 256 + bj * 128 + wc * 32 + 8 * fq) = pack8(a0, a1);
#endif
                    }
                    if (m & 1) asm volatile("" ::: "memory"); }
    }
};
struct EpiMerge2 {
    unsigned char* s2b; bf16_t* merged;
    __device__ __forceinline__ void operator()(const f32x4 (&acc)[2][2][4][2], const UD& u, int wr, int wc, int fr, int fq, int tid) const {
        const u32x4* s2 = (const u32x4*)(s2b + (size_t)(u.pm * 4 + u.pn) * 131072) + tid;
#pragma unroll
        for (int ai = 0; ai < 2; ++ai)
#pragma unroll
            for (int bj = 0; bj < 2; ++bj)
#pragma unroll
                for (int m = 0; m < 4; ++m) { const int slot = (ai * 2 + bj) * 4 + m;
                    const size_t row = (size_t)u.pm * 256 + ai * 128 + wr * 64 + m * 16 + fr;
                    u32x4* mp = (u32x4*)(merged + row * 1024 + u.pn * 256 + bj * 128 + wc * 32 + 8 * fq);
                    f32x4 a0, a1, b0, b1; unpack8(__builtin_nontemporal_load(mp), a0, a1); unpack8(__builtin_nontemporal_load(s2 + slot * 512), b0, b1);
#ifdef DBG_NO_S2
                    b0 = (f32x4){1.f, 1.f, 1.f, 1.f}; b1 = b0;
#endif
#ifdef DBG_NO_MRG
                    a0 = (f32x4){0.f, 0.f, 0.f, 0.f}; a1 = a0;
#endif
                    *mp = pack8(a0 + b0 * acc[ai][bj][m][0], a1 + b1 * acc[ai][bj][m][1]);
                    if (m & 1) asm volatile("" ::: "memory"); }
    }
};
struct EpiOut {
    bf16_t* xb;
    __device__ __forceinline__ void operator()(const f32x4 (&acc)[2][2][4][2], const UD& u, int wr, int wc, int fr, int fq, int tid) const {
#pragma unroll
        for (int ai = 0; ai < 2; ++ai)
#pragma unroll
            for (int m = 0; m < 4; ++m) { bf16_t* rowp = xb + ((size_t)u.pm * 256 + ai * 128 + wr * 64 + m * 16 + fr) * 1024 + u.pn * 256 + wc * 32 + 8 * fq;
#pragma unroll
                for (int bj = 0; bj < 2; ++bj) { u32x4* p = (u32x4*)(rowp + bj * 128); const u32x4 xv = *p; f32x4 v0 = acc[ai][bj][m][0], v1 = acc[ai][bj][m][1];
                    v0[0] += ALPHA * bf_lo(xv.x); v0[1] += ALPHA * bf_hi(xv.x); v0[2] += ALPHA * bf_lo(xv.y); v0[3] += ALPHA * bf_hi(xv.y);
                    v1[0] += ALPHA * bf_lo(xv.z); v1[1] += ALPHA * bf_hi(xv.z); v1[2] += ALPHA * bf_lo(xv.w); v1[3] += ALPHA * bf_hi(xv.w);
                    *p = pack8(v0, v1); } }
    }
};
struct EpiGU {
    bf16_t* he;
    __device__ __forceinline__ void operator()(const f32x4 (&acc)[2][2][4][2], const UD& u, int wr, int wc, int fr, int fq, int tid) const {
#pragma unroll
        for (int ai = 0; ai < 2; ++ai)
#pragma unroll
            for (int m = 0; m < 4; ++m) { bf16_t* rowp = he + ((size_t)u.pm * 256 + ai * 128 + wr * 64 + m * 16 + fr) * 512 + u.pn * 128 + wc * 16 + 4 * fq;
#pragma unroll
                for (int bj = 0; bj < 2; ++bj) { const f32x4 g = acc[ai][bj][m][0], up = acc[ai][bj][m][1]; f32x4 o;
#pragma unroll
                    for (int j = 0; j < 4; ++j) o[j] = g[j] * sigmoidf_(g[j]) * up[j];
                    u32x2 w; w.x = pk2(o[0], o[1]); w.y = pk2(o[2], o[3]); *(u32x2*)(rowp + bj * 64) = w; } }
    }
};
struct EpiBf16 {
    bf16_t* out; int ldc;
    __device__ __forceinline__ void operator()(const f32x4 (&acc)[2][2][4][2], const UD& u, int wr, int wc, int fr, int fq, int tid) const {
#pragma unroll
        for (int ai = 0; ai < 2; ++ai)
#pragma unroll
            for (int m = 0; m < 4; ++m) { bf16_t* rowp = out + ((size_t)u.pm * 256 + ai * 128 + wr * 64 + m * 16 + fr) * ldc + u.pn * 256 + wc * 32 + 8 * fq;
#pragma unroll
                for (int bj = 0; bj < 2; ++bj) *(u32x4*)(rowp + bj * 128) = pack8(acc[ai][bj][m][0], acc[ai][bj][m][1]); }
    }
};
struct EpiPro {
    unsigned char* wmix;
    __device__ __forceinline__ void operator()(const f32x4 (&acc)[2][2][4][2], const UD& u, int wr, int wc, int fr, int fq, int tid) const {
        const int l = u.aux >> 3, h = u.aux & 7, p = u.pn;
        bf16_t* base; int ldc; float sc;
        if (u.kind == 0) { base = (bf16_t*)(wmix + (size_t)l * WMIX_STRIDE + OFF_WIN) + (size_t)(2048 + 256 * h) * 1024 + 256 * p; ldc = 1024; sc = 0.08838834764831845f; }
        else { base = (bf16_t*)(wmix + (size_t)l * WMIX_STRIDE + OFF_WVO) + (size_t)(256 * p) * 2048 + 256 * h; ldc = 2048; sc = 1.f; }
#pragma unroll
        for (int ai = 0; ai < 2; ++ai)
#pragma unroll
            for (int m = 0; m < 4; ++m) { bf16_t* rowp = base + (size_t)(ai * 128 + wr * 64 + m * 16 + fr) * ldc + wc * 32 + 8 * fq;
#pragma unroll
                for (int bj = 0; bj < 2; ++bj) *(u32x4*)(rowp + bj * 128) = pack8(acc[ai][bj][m][0] * sc, acc[ai][bj][m][1] * sc); }
    }
};

struct SchedDense {
    const char* A; const char* B; unsigned lda, ldb; int nt, nM, nN, G, c;
    __device__ __forceinline__ bool next(int i, UD& u) const {
        int pm, pn; if (!gs::tile_of((long)i * G + c, nM, nN, pm, pn)) return false;
        u.A = A + (size_t)pm * 256 * lda; u.B = B + (size_t)pn * 256 * ldb; u.lda = lda; u.ldb = ldb; u.nt = nt; u.kind = 0; u.pm = pm; u.pn = pn; u.aux = 0; return true;
    }
};
struct SchedMerge1 {
    const char *xb, *yrnn, *wg, *wpr; int G, c;
    __device__ __forceinline__ bool next(int i_, UD& u) const { int i = i_;
#ifdef DBG_DUPFIRST
        if (i > 0) i -= 1;
#endif
#ifdef DBG_ORDER201
        const int ti = i / 3, kk_ = i - 3 * ti, k = kk_ == 0 ? 2 : kk_ - 1;
#else
        const int ti = i / 3, k = i - 3 * ti;
#endif
        int pm, pn; if (!gs::tile_of((long)ti * G + c, T / 256, 4, pm, pn)) return false;
        u.kind = k; u.pm = pm; u.pn = pn; u.aux = 0; u.lda = 2048; u.ldb = 2048; u.nt = 16;
#ifdef DBG_K0_AS_K1
        if (k == 0) { u.A = yrnn + (size_t)pm * 256 * 2048; u.B = wpr + (size_t)pn * 256 * 2048; }
#else
        if (k == 0) { u.A = xb + (size_t)pm * 256 * 2048; u.B = wg + (size_t)pn * 256 * 2048; }
#endif
        else if (k == 1) { u.A = yrnn + (size_t)pm * 256 * 2048; u.B = wpr + (size_t)pn * 256 * 2048; }
        else { u.A = xb + (size_t)pm * 256 * 2048; u.B = wg + (size_t)(1024 + pn * 256) * 2048; }
        return true;
    }
};
struct SchedMoE {
    const char* A; const char* B; unsigned lda, ldb; size_t bstride; int nt, nN, G, c; const LAS int* offp;
    __device__ __forceinline__ bool next(int i, UD& u) const {
        const int nM = offp[16] >> 8; int pm, pn; if (!gs::tile_of((long)i * G + c, nM, nN, pm, pn)) return false;
        int e = 0;
#pragma unroll 1
        for (int j = 1; j < 16; ++j) e += (pm * 256 >= offp[j]) ? 1 : 0;
        u.A = A + (size_t)pm * 256 * lda; u.B = B + (size_t)e * bstride + (size_t)pn * 256 * ldb; u.lda = lda; u.ldb = ldb; u.nt = nt; u.kind = 0; u.pm = pm; u.pn = pn; u.aux = e; return true;
    }
};
struct SchedMoEG {
    const char* A; const char* B; unsigned lda, ldb; size_t bstride; int nt, nN, G, c; const LAS int* offp; const int* rmap;
    __device__ __forceinline__ bool next(int i, UD& u) const {
        const int nM = offp[16] >> 8; int pm, pn; if (!gs::tile_of((long)i * G + c, nM, nN, pm, pn)) return false;
        int e = 0;
#pragma unroll 1
        for (int j = 1; j < 16; ++j) e += (pm * 256 >= offp[j]) ? 1 : 0;
        u.A = A; u.B = B + (size_t)e * bstride + (size_t)pn * 256 * ldb; u.lda = lda; u.ldb = ldb; u.nt = nt; u.kind = 0; u.pm = pm; u.pn = pn; u.aux = e; return true;
    }
};
struct SchedPro {
    const unsigned char* tmp; int G, c;
    __device__ __forceinline__ bool next(int i, UD& u) const {
        const long L = (long)i * G + c; if (L >= 256) return false;
        const int kind = (int)(L >> 7), l = (int)(L >> 5) & 3, h = (int)(L >> 2) & 7, p = (int)L & 3;
        u.kind = kind; u.aux = l * 8 + h; u.pm = 0; u.pn = p; u.nt = 4; u.lda = 2048; u.ldb = 2048;
        if (kind == 0) { u.A = (const char*)tmp + R_UKP + ((size_t)(l * 8 + h) * 256) * 2048;
                         u.B = (const char*)tmp + R_WQ + (size_t)l * 2 * MiB + (size_t)(256 * p) * 2048 + (size_t)(h >> 1) * 512; }
        else { u.A = (const char*)tmp + R_PT + (size_t)l * 2 * MiB + (size_t)(256 * p) * 2048 + (size_t)(h >> 1) * 512;
               u.B = (const char*)tmp + R_UVP + ((size_t)(l * 8 + h) * 256) * 2048; }
        return true;
    }
};

__device__ __forceinline__ void tr_item(const float* src, int ld, int c0, int nvalid, bf16_t* dst, int lddst, int mode, int item, int nblk, LAS float* scr, int lane) {
    const int kb = item / nblk, nb = item - kb * nblk, k0 = 64 * kb, n0 = 32 * nb;
    const int cc = 4 * (lane & 7); const bool ok = n0 + cc < nvalid;
    f32x4 tv_[8];
#pragma unroll
    for (int i = 0; i < 8; ++i) { const int kk = 8 * i + (lane >> 3); tv_[i] = ok ? *(const f32x4*)(src + (size_t)(k0 + kk) * ld + c0 + n0 + cc) : (f32x4){0.f, 0.f, 0.f, 0.f}; }
#pragma unroll
    for (int i = 0; i < 8; ++i) { const int kk = 8 * i + (lane >> 3);
#pragma unroll
        for (int j = 0; j < 4; ++j) scr[kk * 33 + cc + j] = tv_[i][j]; }
    asm volatile("s_waitcnt lgkmcnt(0)" ::: "memory");
    const int c = lane & 7;
#pragma unroll
    for (int j = 0; j < 4; ++j) { const int nl = (lane >> 3) + 8 * j; const int nn = n0 + nl; const int row = mode ? (8 * (nn >> 2) + (nn & 3)) : nn; const LAS float* s = scr + (8 * c) * 33 + nl;
        u32x4 o; o.x = pk2(s[0 * 33], s[1 * 33]); o.y = pk2(s[2 * 33], s[3 * 33]); o.z = pk2(s[4 * 33], s[5 * 33]); o.w = pk2(s[6 * 33], s[7 * 33]);
        *(u32x4*)(dst + (size_t)row * lddst + k0 + 8 * c) = o; }
    asm volatile("s_waitcnt lgkmcnt(0)" ::: "memory");
}
__device__ __forceinline__ float expm1_acc(float x) {
    if (x > -0.35f) { float p = 1.0f + x * (1.0f / 8.0f); p = 1.0f + x * (1.0f / 7.0f) * p; p = 1.0f + x * (1.0f / 6.0f) * p; p = 1.0f + x * (1.0f / 5.0f) * p; p = 1.0f + x * 0.25f * p; p = 1.0f + x * (1.0f / 3.0f) * p; p = 1.0f + x * 0.5f * p; return x * p; }
    return fast_exp(x) - 1.0f;
}
struct RnnP { const bf16_t* xrnn; bf16_t* gy; float* tot; const bf16_t *waT, *wxT; const float *convw, *convb, *ba, *bx, *lam; };
template <int PASS>
__device__ __forceinline__ void rnn_item(const RnnP& P, int item, LAS unsigned char* wlds, int lane) {
    const int b = item >> 10, g = (item >> 6) & 15, seg = item & 63, ch0 = 64 * g;
    const int row = lane & 15, kg = lane >> 4, col = lane & 15;
    LAS float* CW = (LAS float*)wlds;
    LAS float* XR = CW + 320;
#pragma unroll
    for (int k = 0; k < 4; ++k) CW[k * 64 + lane] = P.convw[k * 1024 + ch0 + lane];
    CW[256 + lane] = P.convb[ch0 + lane];
    bf16x8 Ba[4][2], Bx[4][2];
#pragma unroll
    for (int jt = 0; jt < 4; ++jt)
#pragma unroll
        for (int s = 0; s < 2; ++s) { const size_t o = ((size_t)g * 64 + 16 * jt + col) * 64 + 32 * s + 8 * kg; Ba[jt][s] = *(const bf16x8*)(P.waT + o); Bx[jt][s] = *(const bf16x8*)(P.wxT + o); }
    float cba[4], cbx[4], sp8[4], h0[4], Pc[4];
#pragma unroll
    for (int jt = 0; jt < 4; ++jt) { const int ch = ch0 + 16 * jt + col; cba[jt] = P.ba[ch]; cbx[jt] = P.bx[ch]; const float lm = P.lam[ch]; sp8[jt] = -8.0f * log1pf(expf(-lm)); h0[jt] = 0.f; Pc[jt] = 1.f; }
    float* totp = P.tot + ((size_t)(b * 64) * 1024 + ch0 + col) * 2;
    if (PASS == 2 && seg > 0) {
        const int Q = (seg + 3) >> 2, slo = kg * Q;
        float Pq[4] = {1.f, 1.f, 1.f, 1.f}, Hq[4] = {0.f, 0.f, 0.f, 0.f};
        for (int i0 = 0; i0 < Q; i0 += 4) {
            f32x2 ph[4][4];
#pragma unroll
            for (int i = 0; i < 4; ++i) { int s2 = slo + i0 + i; s2 = s2 < seg ? s2 : seg - 1;
#pragma unroll
                for (int jt = 0; jt < 4; ++jt) ph[i][jt] = *(const f32x2*)(totp + ((size_t)s2 * 1024 + 16 * jt) * 2); }
#pragma unroll
            for (int i = 0; i < 4; ++i) { const bool ok = (i0 + i < Q) && (slo + i0 + i < seg);
#pragma unroll
                for (int jt = 0; jt < 4; ++jt) { const float px = ok ? ph[i][jt].x : 1.f, hy = ok ? ph[i][jt].y : 0.f; Hq[jt] = px * Hq[jt] + hy; Pq[jt] = Pq[jt] * px; } }
        }
#pragma unroll
        for (int jt = 0; jt < 4; ++jt) {
            const float H0 = __shfl(Hq[jt], col), P1 = __shfl(Pq[jt], col + 16), H1 = __shfl(Hq[jt], col + 16), P2 = __shfl(Pq[jt], col + 32), H2 = __shfl(Hq[jt], col + 32),
                        P3 = __shfl(Pq[jt], col + 48), H3 = __shfl(Hq[jt], col + 48);
            float h = H0; h = P1 * h + H1; h = P2 * h + H2; h = P3 * h + H3; h0[jt] = h; }
    }
    asm volatile("s_waitcnt lgkmcnt(0)" ::: "memory");
    const size_t rowb = (size_t)b * SEQ;
    u32x4 xn[4][2];
    { const int tA0 = seg * 256 + row;
#pragma unroll
      for (int dt = 0; dt < 4; ++dt) { const int tt = tA0 - 3 + dt;
#pragma unroll
          for (int s = 0; s < 2; ++s) xn[dt][s] = (tt >= 0) ? *(const u32x4*)(P.xrnn + (rowb + tt) * 1024 + ch0 + 32 * s + 8 * kg) : (u32x4){0u, 0u, 0u, 0u}; } }
    for (int tile = 0; tile < 16; ++tile) {
        const int t0 = seg * 256 + tile * 16;
        u32x4 xw[4][2];
#pragma unroll
        for (int dt = 0; dt < 4; ++dt)
#pragma unroll
            for (int s = 0; s < 2; ++s) xw[dt][s] = xn[dt][s];
        if (tile + 1 < 16) { const int tB = t0 + 16 + row;
#pragma unroll
            for (int dt = 0; dt < 4; ++dt) { const int tt = tB - 3 + dt;
#pragma unroll
                for (int s = 0; s < 2; ++s) xn[dt][s] = *(const u32x4*)(P.xrnn + (rowb + tt) * 1024 + ch0 + 32 * s + 8 * kg); } }
        bf16_t gq[4][4];
        if (PASS == 2) { const bf16_t* gp0 = P.gy + (rowb + t0 + 4 * kg) * 1024 + ch0 + col;
#pragma unroll
            for (int jt = 0; jt < 4; ++jt)
#pragma unroll
                for (int r = 0; r < 4; ++r) gq[jt][r] = gp0[(size_t)r * 1024 + 16 * jt]; }
        bf16x8 Af[2];
#pragma unroll
        for (int s = 0; s < 2; ++s) {
            const int cl = 32 * s + 8 * kg;
            f32x4 o0 = *(LAS f32x4*)(CW + 256 + cl), o1 = *(LAS f32x4*)(CW + 256 + cl + 4);
#pragma unroll
            for (int dt = 0; dt < 4; ++dt) { const f32x4 w0 = *(LAS f32x4*)(CW + dt * 64 + cl), w1 = *(LAS f32x4*)(CW + dt * 64 + cl + 4); const u32x4 x = xw[dt][s];
                o0[0] += w0[0] * bf_lo(x.x); o0[1] += w0[1] * bf_hi(x.x); o0[2] += w0[2] * bf_lo(x.y); o0[3] += w0[3] * bf_hi(x.y);
                o1[0] += w1[0] * bf_lo(x.z); o1[1] += w1[1] * bf_hi(x.z); o1[2] += w1[2] * bf_lo(x.w); o1[3] += w1[3] * bf_hi(x.w); }
            *(LAS f32x4*)(XR + row * 68 + cl) = o0; *(LAS f32x4*)(XR + row * 68 + cl + 4) = o1;
            const u32x4 pk = pack8(o0, o1); Af[s] = __builtin_bit_cast(bf16x8, pk);
        }
        f32x4 ar[4], ax[4];
#pragma unroll
        for (int jt = 0; jt < 4; ++jt) { ar[jt] = (f32x4){0.f, 0.f, 0.f, 0.f}; ax[jt] = ar[jt];
#pragma unroll
            for (int s = 0; s < 2; ++s) { ar[jt] = __builtin_amdgcn_mfma_f32_16x16x32_bf16(Af[s], Ba[jt][s], ar[jt], 0, 0, 0); ax[jt] = __builtin_amdgcn_mfma_f32_16x16x32_bf16(Af[s], Bx[jt][s], ax[jt], 0, 0, 0); } }
        asm volatile("s_waitcnt lgkmcnt(0)" ::: "memory");
#pragma unroll
        for (int jt = 0; jt < 4; ++jt) {
            float Pp[4], Hp[4]; float pr = 1.f, hr = 0.f;
#pragma unroll
            for (int r = 0; r < 4; ++r) {
                const float xr = XR[(4 * kg + r) * 68 + 16 * jt + col];
                const float rg = sigmoidf_(ar[jt][r] + cba[jt]), ig = sigmoidf_(ax[jt][r] + cbx[jt]);
                const float la = sp8[jt] * rg; const float em = expm1_acc(la); const float a = 1.0f + em;
                const float mm = __builtin_amdgcn_sqrtf(fmaxf(-em * (2.0f + em), 0.f));
                const float uu = mm * ig * xr;
                hr = a * hr + uu; pr = pr * a; Pp[r] = pr; Hp[r] = hr;
            }
            const float P0 = __shfl(pr, col), P1 = __shfl(pr, col + 16), P2 = __shfl(pr, col + 32), P3 = __shfl(pr, col + 48);
            const float H0 = __shfl(hr, col), H1 = __shfl(hr, col + 16), H2 = __shfl(hr, col + 32), H3 = __shfl(hr, col + 48);
            const float h1 = P0 * h0[jt] + H0, h2 = P1 * h1 + H1, h3 = P2 * h2 + H2, h4 = P3 * h3 + H3;
            if (PASS == 2) {
                const float hs = kg == 0 ? h0[jt] : (kg == 1 ? h1 : (kg == 2 ? h2 : h3));
                bf16_t* gp = P.gy + (rowb + t0 + 4 * kg) * 1024 + ch0 + 16 * jt + col;
#pragma unroll
                for (int r = 0; r < 4; ++r) { const float hv = Pp[r] * hs + Hp[r]; const float gg = bf2f(gq[jt][r]); gp[(size_t)r * 1024] = (bf16_t)f2bf(hv * gg); }
            } else Pc[jt] = Pc[jt] * (P0 * P1) * (P2 * P3);
            h0[jt] = h4;
        }
    }
    if (PASS == 1 && kg == 0) {
#pragma unroll
        for (int jt = 0; jt < 4; ++jt) *(f32x2*)(totp + ((size_t)seg * 1024 + 16 * jt) * 2) = (f32x2){Pc[jt], h0[jt]};
    }
}
__device__ __forceinline__ void ckv_norm_rows4(bf16_t* base, int row0, int rstep, int nrows, const float* gain, int lane) {
    u32x2 w[4];
#pragma unroll
    for (int i = 0; i < 4; ++i) { const int r = row0 + i * rstep; w[i] = *(const u32x2*)(base + (size_t)(r < nrows ? r : row0) * 256 + 4 * lane); }
    const f32x4 gn = *(const f32x4*)(gain + 4 * lane);
#pragma unroll
    for (int i = 0; i < 4; ++i) { const int r = row0 + i * rstep;
        const float v0 = bf_lo(w[i].x), v1 = bf_hi(w[i].x), v2 = bf_lo(w[i].y), v3 = bf_hi(w[i].y);
        const float ss = wave_sum(v0 * v0 + v1 * v1 + v2 * v2 + v3 * v3);
        const float rs = 1.0f / __builtin_sqrtf(ss * (1.0f / 256.0f) + RMS_EPS);
        u32x2 o; o.x = pk2(v0 * rs * gn[0], v1 * rs * gn[1]); o.y = pk2(v2 * rs * gn[2], v3 * rs * gn[3]);
        if (r < nrows) *(u32x2*)(base + (size_t)r * 256 + 4 * lane) = o; }
}
constexpr int AT_CAND = 0, AT_KBUF = 65536, AT_KROW = 144, AT_KCH = 256 * AT_KROW, AT_SEL = 139264, AT_BIAS = 155648, AT_BKT = 156672, AT_GROW = 544, AT_GBUF = 32 * AT_GROW;
constexpr int AT_NBIN = 512, AT_CAP = 256, AT_LCAP = 1024, AT_TIEF = 157184, AT_BIAS2 = 157440;
#ifndef AT_SAMPLE_MIN_U
#define AT_SAMPLE_MIN_U 64
#endif
#ifndef AT_LBREF
#define AT_LBREF 0
#endif
struct AttnP { const bf16_t *qidx, *kidx, *ckv; const float* widx; bf16_t* qlat; unsigned long long* cbuf; };

__device__ __forceinline__ unsigned ord_key(float s) { const unsigned b = __builtin_bit_cast(unsigned, s); return (b & 0x80000000u) ? ~b : (b | 0x80000000u); }

__device__ __forceinline__ void hist_scan(const LAS unsigned* hq, int lane, int kth, int& bsel, int& cat, int& abat) {
    const u32x4 w0 = *(const LAS u32x4*)(hq + 8 * lane), w1 = *(const LAS u32x4*)(hq + 8 * lane + 4);
    int cnt[8];
    cnt[0] = (int)w0.x; cnt[1] = (int)w0.y; cnt[2] = (int)w0.z; cnt[3] = (int)w0.w; cnt[4] = (int)w1.x; cnt[5] = (int)w1.y; cnt[6] = (int)w1.z; cnt[7] = (int)w1.w;
    int s = 0;
#pragma unroll
    for (int i = 0; i < 8; ++i) s += cnt[i];
    int S = s;
#pragma unroll
    for (int off = 1; off < 64; off <<= 1) { const int v = __shfl_down(S, off); if (lane + off < 64) S += v; }
    bsel = -1; cat = 0; abat = 0;
    const unsigned long long mk = __ballot(S >= kth);
    if (mk != 0ull) {
        const int Ls = 63 - __builtin_clzll(mk);
        int above = S - s; bool found = false;
#pragma unroll
        for (int bb = 7; bb >= 0; --bb) { const int c = cnt[bb]; if (!found && above + c >= kth) { bsel = 8 * lane + bb; cat = c; abat = above; found = true; } above += c; }
        bsel = __shfl(bsel, Ls); cat = __shfl(cat, Ls); abat = __shfl(abat, Ls);
    }
}
__device__ __forceinline__ int key_row(int r, bool sm, int u) { if (sm) { r = r * 8 + (u & 7); r = r < SEQ ? r : SEQ - 1; } return r; }
template <int MODE>
__device__ __forceinline__ void attn_pass(LAS unsigned char* lds, const bf16x8 (&afr)[4], const float (&wq)[2][9], const bf16_t* kbase, int u, int wave, int lane, int tid,
                                          const int (&b0e)[2], const int (&neede)[2], const int (&tiee)[2], int (&csel)[2], int (&ccand)[2], unsigned long long* cbw, int samp = 0) {
    const int hh = lane >> 5, kcol = lane & 31;
    LAS unsigned* HIST = (LAS unsigned*)lds; LAS unsigned long long* CAND = (LAS unsigned long long*)(lds + AT_CAND); LAS unsigned short* SEL = (LAS unsigned short*)(lds + AT_SEL);
    const bool sm = (MODE == 0) && (samp != 0);
    const int nst = u >> 3, nch = sm ? ((nst + 7) >> 3) : (u >> 3) + 1;
    float lbt[2];
#pragma unroll
    for (int e = 0; e < 2; ++e) lbt[e] = ((MODE == 1 || MODE == 3) && b0e[e] >= 1) ? (float)b0e[e] : -3.0e38f;
    u32x4 st[4];
    const int lofs = (tid >> 3) * AT_KROW + (tid & 7) * 16;
#define AT_KADDR(C, I) (kbase + (size_t)key_row((C) * 256 + (tid >> 3) + 64 * (I), sm, u) * 64 + (tid & 7) * 8)
#pragma unroll
    for (int i = 0; i < 4; ++i) st[i] = *(const u32x4*)AT_KADDR(0, i);
#pragma unroll
    for (int i = 0; i < 4; ++i) *(LAS u32x4*)(lds + AT_KBUF + lofs + i * 64 * AT_KROW) = st[i];
    __syncthreads();
    for (int c = 0; c < nch; ++c) {
        if (c + 1 < nch) {
#pragma unroll
            for (int i = 0; i < 4; ++i) st[i] = *(const u32x4*)AT_KADDR(c + 1, i);
        }
        const LAS unsigned char* kb = lds + AT_KBUF + (c & 1) * AT_KCH + kcol * AT_KROW + hh * 16;
        const int ntile = sm ? ((nst - 8 * c) < 8 ? (nst - 8 * c) : 8) : ((c + 1 < nch) ? 8 : (u & 7) + 1);
#define AT_READ(BF, TT) do { _Pragma("unroll") for (int ks = 0; ks < 4; ++ks) BF[ks] = *(const LAS bf16x8*)(kb + (TT) * 32 * AT_KROW + ks * 32); } while (0)
#define AT_MFMA(ACC, BF) do { _Pragma("unroll") for (int i_ = 0; i_ < 16; ++i_) ACC[i_] = 0.f; \
            _Pragma("unroll") for (int ks = 0; ks < 4; ++ks) ACC = __builtin_amdgcn_mfma_f32_32x32x16_bf16(afr[ks], BF[ks], ACC, 0, 0, 0); } while (0)
          \

#define AT_POST(ACC, KT, DIAG) do { const int kt = (KT); \
            float sc[2]; \
            _Pragma("unroll") for (int e = 0; e < 2; ++e) { float s = 0.f; \
                _Pragma("unroll") for (int i = 0; i < 8; ++i) s = __builtin_fmaf(wq[e][i], __builtin_amdgcn_fmed3f(ACC[8 * e + i], 0.f, 3.0e38f), s); \
                sc[e] = s; } \
            _Pragma("unroll") for (int e = 0; e < 2; ++e) { \
                const int q = 4 * wave + 2 * hh + e; \
                const float tv = __builtin_fmaf(sc[e], wq[e][8], 256.0f); \
                const bool cz = !(DIAG) || (kt < u) || (kcol <= q); \
                const bool live = cz && tv >= lbt[e]; \
                if (MODE == 3) { \
                    const unsigned long long m3 = __ballot(live); \
                    { \
                        const unsigned h3 = hh ? (unsigned)(m3 >> 32) : (unsigned)m3; \
                        const int pa = ccand[e] + __builtin_popcount(h3 & ((1u << kcol) - 1u)); \
                        if (live && pa < AT_LCAP) { u32x2 ent; ent.x = (unsigned)(kt * 32 + kcol); ent.y = __builtin_bit_cast(unsigned, sc[e]); \
                            *(u32x2*)((char*)cbw + ((unsigned)((2 * hh + e) * AT_LCAP + pa) * 8u)) = ent; } \
                        ccand[e] += __builtin_popcount(h3); \
                    } \
                } else if (MODE == 0) { \
                    const int bin = (int)__builtin_amdgcn_fmed3f(tv, 0.0f, 511.5f); \
                    LAS unsigned* hp = HIST + q * AT_NBIN + bin; \
                    if (cz) __hip_atomic_fetch_add(hp, 1u, __ATOMIC_RELAXED, __HIP_MEMORY_SCOPE_WORKGROUP); \
                } else if (__ballot(live) != 0ull) { \
                    const int bin = (int)__builtin_amdgcn_fmed3f(tv, 0.0f, 511.5f); \
                    const int key = kt * 32 + kcol; \
                    const bool cc = live && bin == b0e[e]; \
                    const unsigned long long m2 = __ballot(cc); const unsigned h2 = hh ? (unsigned)(m2 >> 32) : (unsigned)m2; \
                    const int pc = ccand[e] + __builtin_popcount(h2 & ((1u << kcol) - 1u)); \
                    if (cc && !tiee[e] && pc < AT_CAP) CAND[q * AT_CAP + pc] = ((unsigned long long)ord_key(sc[e]) << 32) | (unsigned)(0xFFFFu - key); \
                    ccand[e] += __builtin_popcount(h2); \
                    const bool cs = live && (bin > b0e[e] || (tiee[e] && cc && pc < neede[e])); \
                    const unsigned long long m1 = __ballot(cs); const unsigned h1 = hh ? (unsigned)(m1 >> 32) : (unsigned)m1; \
                    if (cs) SEL[q * 256 + csel[e] + __builtin_popcount(h1 & ((1u << kcol) - 1u))] = (unsigned short)key; \
                    csel[e] += __builtin_popcount(h1); \
                } \
            } } while (0)
#define AT_TILES(NT, DIAG, PRAG) do { \
        AT_READ(B0, 0); if ((NT) > 1) AT_READ(B1, 1); \
        AT_MFMA(accA, B0); \
        PRAG for (int tt = 0; tt < (NT); tt += 2) { \
            if (tt + 2 < (NT)) AT_READ(B0, tt + 2); \
            if (tt + 1 < (NT)) AT_MFMA(accB, B1); \
            AT_POST(accA, c * 8 + tt, DIAG); \
            if (tt + 1 < (NT)) { \
                if (tt + 3 < (NT)) AT_READ(B1, tt + 3); \
                if (tt + 2 < (NT)) AT_MFMA(accA, B0); \
                AT_POST(accB, c * 8 + tt + 1, DIAG); \
            } \
        } } while (0)
        f32x16 accA, accB; bf16x8 B0[4], B1[4];
        if (sm ? (ntile == 8) : (c + 1 < nch)) AT_TILES(8, false, _Pragma("unroll"));
        else AT_TILES(ntile, true, _Pragma("unroll 1"));
#undef AT_TILES
#undef AT_POST
#undef AT_KADDR
#undef AT_READ
#undef AT_MFMA
        if (MODE == 0 && AT_LBREF && c + 1 < nch && (c < 4 || (c & 3) == 3)) {
#pragma unroll
            for (int q = 0; q < 4; ++q) { int bs, c1, c2; hist_scan(HIST + (4 * wave + q) * AT_NBIN, lane, 256, bs, c1, c2);
                const float lb = bs >= 1 ? (float)bs : -3.0e38f;
                if ((q >> 1) == hh) lbt[q & 1] = lb; }
        }
        if (c + 1 < nch) {
#pragma unroll
            for (int i = 0; i < 4; ++i) *(LAS u32x4*)(lds + AT_KBUF + ((c + 1) & 1) * AT_KCH + lofs + i * 64 * AT_KROW) = st[i];
        }
        __syncthreads();
    }
}

__device__ __forceinline__ void attn_unit(LAS unsigned char* lds, const AttnP& P, int b, int u, int tid_) {
    int tid = tid_; asm volatile("" : "+v"(tid));
    const int wave = __builtin_amdgcn_readfirstlane(tid >> 6), lane = tid & 63, hh = lane >> 5, kcol = lane & 31;
    LAS unsigned* HIST = (LAS unsigned*)lds; LAS unsigned long long* CAND = (LAS unsigned long long*)(lds + AT_CAND); LAS unsigned short* SEL = (LAS unsigned short*)(lds + AT_SEL);
    const LAS float* BIAS2 = (const LAS float*)(lds + AT_BIAS2);
    const int t0 = 32 * u; const size_t rowb = (size_t)b * SEQ;
    __syncthreads();
#pragma unroll
    for (int i = 0; i < 8; ++i) *(LAS u32x4*)(lds + (i * 512 + tid) * 16) = (u32x4){0u, 0u, 0u, 0u};
    if (tid == 0) *(LAS unsigned*)(lds + AT_TIEF) = 0u;
    bf16x8 afr[4]; float wq[2][9];
    { const int rho = kcol, j = rho >> 3, r = rho & 3, hq = (rho >> 2) & 1, head = 4 * (j & 1) + r, qloc = 2 * hq + (j >> 1);
      const bf16_t* qp = P.qidx + (rowb + t0 + 4 * wave + qloc) * 512 + head * 64 + 8 * hh;
#pragma unroll
      for (int ks = 0; ks < 4; ++ks) afr[ks] = *(const bf16x8*)(qp + ks * 16);
#pragma unroll
      for (int e = 0; e < 2; ++e) { const float* wp = P.widx + (rowb + t0 + 4 * wave + 2 * hh + e) * 8; const f32x4 a = *(const f32x4*)wp, c = *(const f32x4*)(wp + 4);
          wq[e][0] = a[0]; wq[e][1] = a[1]; wq[e][2] = a[2]; wq[e][3] = a[3]; wq[e][4] = c[0]; wq[e][5] = c[1]; wq[e][6] = c[2]; wq[e][7] = c[3];
          const float ss = (a[0] * a[0] + a[1] * a[1]) + (a[2] * a[2] + a[3] * a[3]) + (c[0] * c[0] + c[1] * c[1]) + (c[2] * c[2] + c[3] * c[3]);
          wq[e][8] = 32.0f / __builtin_sqrtf(fmaxf(ss, 1.0e-12f)); } }
    const bf16_t* kbase = P.kidx + rowb * 64;
    int b0e[2] = {0, 0}, neede[2] = {0, 0}, tiee[2] = {0, 0}, csel[2] = {0, 0}, ccand[2] = {0, 0};
    int b0q[4], needq[4], nb0q[4], csq[4];
    unsigned long long* cbw = P.cbuf + (size_t)(4 * wave) * AT_LCAP;
#pragma unroll 1
    for (int att = (u >= AT_SAMPLE_MIN_U) ? 0 : 1; att < 2; ++att) {
        int tl = tid; asm volatile("" : "+v"(tl));
        const int ll = tl & 63, hl = ll >> 5;
        if (att == 1 && u >= AT_SAMPLE_MIN_U) {
            __syncthreads();
#pragma unroll
            for (int i = 0; i < 8; ++i) *(LAS u32x4*)(lds + (i * 512 + tl) * 16) = (u32x4){0u, 0u, 0u, 0u};
            if (tl == 0) *(LAS unsigned*)(lds + AT_TIEF) = 0u;
        }
        csel[0] = 0; csel[1] = 0; ccand[0] = 0; ccand[1] = 0;
        attn_pass<0>(lds, afr, wq, kbase, u, wave, ll, tl, b0e, neede, tiee, csel, ccand, nullptr, att == 0 ? 1 : 0);
        const int kth = att == 0 ? 64 : 256;
#pragma unroll
        for (int q = 0; q < 4; ++q) {
            const int nq = t0 + 4 * wave + q + 1;
            int bsel, cat, abat; hist_scan(HIST + (4 * wave + q) * AT_NBIN, ll, kth, bsel, cat, abat);
            if (att == 1 && nq <= 256) { bsel = -1; cat = 0; abat = 0; }
            b0q[q] = bsel; nb0q[q] = cat; needq[q] = (nq > 256) ? (256 - abat) : 0;
        }
        b0e[0] = hl ? b0q[2] : b0q[0]; b0e[1] = hl ? b0q[3] : b0q[1];
        neede[0] = hl ? needq[2] : needq[0]; neede[1] = hl ? needq[3] : needq[1];
        tiee[0] = (att == 1) && ((hl ? nb0q[2] : nb0q[0]) > AT_CAP); tiee[1] = (att == 1) && ((hl ? nb0q[3] : nb0q[1]) > AT_CAP);
        if ((tiee[0] | tiee[1]) != 0) *(LAS unsigned*)(lds + AT_TIEF) = 1u;
        __syncthreads();
        if (att == 1 && *(const LAS unsigned*)(lds + AT_TIEF) != 0u) {
            attn_pass<1>(lds, afr, wq, kbase, u, wave, ll, tl, b0e, neede, tiee, csel, ccand, cbw);
#pragma unroll
            for (int q = 0; q < 4; ++q) { const int cv = (q & 1) ? csel[1] : csel[0]; csq[q] = __builtin_amdgcn_readlane(cv, (q >> 1) * 32); }
            break;
        }
        if (att == 0) {
#pragma unroll
            for (int i = 0; i < 8; ++i) *(LAS u32x4*)(lds + wave * 8192 + (i * 64 + ll) * 16) = (u32x4){0u, 0u, 0u, 0u};
        }
        attn_pass<3>(lds, afr, wq, kbase, u, wave, ll, tl, b0e, neede, tiee, csel, ccand, cbw);
        asm volatile("s_waitcnt vmcnt(0)" ::: "memory");
        if (att == 0) {
            bool ok = true;
#pragma unroll
            for (int q = 0; q < 4; ++q) {
                const int cv = (q & 1) ? ccand[1] : ccand[0]; const int nraw = __builtin_amdgcn_readlane(cv, (q >> 1) * 32); ok = ok && nraw >= 256 && nraw <= AT_LCAP;
                const int n = nraw > AT_LCAP ? AT_LCAP : nraw;
                const float scl = (q & 2) ? __shfl(wq[q & 1][8], 32) : __shfl(wq[q & 1][8], 0);
#pragma unroll
                for (int jb = 0; jb < AT_LCAP / 256; ++jb) {
                    if (256 * jb < n) {
                        unsigned long long ent[4];
#pragma unroll
                        for (int j = 0; j < 4; ++j) { const int i = 256 * jb + 64 * j + ll; ent[j] = (i < n) ? __builtin_nontemporal_load(cbw + q * AT_LCAP + i) : 0ull; }
#pragma unroll
                        for (int j = 0; j < 4; ++j) { const int i = 256 * jb + 64 * j + ll; const float scv = __builtin_bit_cast(float, (unsigned)(ent[j] >> 32));
                            const int bin = (int)__builtin_amdgcn_fmed3f(__builtin_fmaf(scv, scl, 256.0f), 0.0f, 511.5f);
                            if (i < n) __hip_atomic_fetch_add(HIST + (4 * wave + q) * AT_NBIN + bin, 1u, __ATOMIC_RELAXED, __HIP_MEMORY_SCOPE_WORKGROUP); }
                    }
                }
            }
            asm volatile("s_waitcnt lgkmcnt(0)" ::: "memory");
#pragma unroll
            for (int q = 0; q < 4; ++q) {
                int bsel, cat, abat; hist_scan(HIST + (4 * wave + q) * AT_NBIN, ll, 256, bsel, cat, abat);
                ok = ok && bsel >= 0;
                b0q[q] = bsel; nb0q[q] = cat; needq[q] = 256 - abat;
            }
            if (!ok) *(LAS unsigned*)(lds + AT_TIEF) = 1u;
            __syncthreads();
            if (*(const LAS unsigned*)(lds + AT_TIEF) != 0u) continue;
        }
#pragma unroll
        for (int q = 0; q < 4; ++q) {
            const int cv = (q & 1) ? ccand[1] : ccand[0]; int n = __builtin_amdgcn_readlane(cv, (q >> 1) * 32); n = n > AT_LCAP ? AT_LCAP : n;
            const int b0 = b0q[q], need = needq[q]; const bool tieq = nb0q[q] > AT_CAP;
            const float scl = (q & 2) ? __shfl(wq[q & 1][8], 32) : __shfl(wq[q & 1][8], 0);
            int cs = 0, cc = 0;
#pragma unroll
            for (int jb = 0; jb < AT_LCAP / 256; ++jb) {
                if (256 * jb < n) {
                    unsigned long long ent[4];
#pragma unroll
                    for (int j = 0; j < 4; ++j) { const int i = 256 * jb + 64 * j + ll; ent[j] = (i < n) ? __builtin_nontemporal_load(cbw + q * AT_LCAP + i) : 0ull; }
#pragma unroll
                    for (int j = 0; j < 4; ++j) {
                        const unsigned long long v = ent[j]; const bool in = 256 * jb + 64 * j + ll < n;
                        const float scv = __builtin_bit_cast(float, (unsigned)(v >> 32));
                        const int bin = (int)__builtin_amdgcn_fmed3f(__builtin_fmaf(scv, scl, 256.0f), 0.0f, 511.5f);
                        const bool isc = in && bin == b0;
                        const unsigned long long mc = __ballot(isc);
                        const int pc = cc + __builtin_popcountll(mc & ((1ull << ll) - 1ull));
                        const bool isa = in && (bin > b0 || (tieq && isc && pc < need));
                        const unsigned long long ms = __ballot(isa);
                        if (isa) SEL[(4 * wave + q) * 256 + cs + __builtin_popcountll(ms & ((1ull << ll) - 1ull))] = (unsigned short)(v & 0xFFFFu);
                        if (isc && !tieq && pc < AT_CAP) CAND[(4 * wave + q) * AT_CAP + pc] = ((unsigned long long)ord_key(scv) << 32) | (unsigned)(0xFFFFu - (unsigned)(v & 0xFFFFu));
                        cs += __builtin_popcountll(ms); cc += __builtin_popcountll(mc);
                    }
                }
            }
            csq[q] = cs;
            asm volatile("" ::: "memory");
        }
        break;
    }
    int nselq[4];
#pragma unroll
    for (int q = 0; q < 4; ++q) {
        int cs = csq[q];
        const int need = needq[q], nb0 = nb0q[q];
        if (need > 0 && nb0 <= AT_CAP) {
            const int nc = nb0;
            const LAS unsigned long long* cq = CAND + (4 * wave + q) * AT_CAP;
            for (int i0 = 0; i0 < nc; i0 += 64) {
                const int i = i0 + lane; const unsigned long long mine = (i < nc) ? cq[i] : 0ull;
                int rank = 0; for (int j = 0; j < nc; ++j) rank += (cq[j] > mine) ? 1 : 0;
                const bool pick = (i < nc) && rank < need;
                const unsigned long long mk = __ballot(pick);
                if (pick) SEL[(4 * wave + q) * 256 + cs + __builtin_popcountll(mk & ((1ull << lane) - 1ull))] = (unsigned short)(0xFFFFu - (unsigned)(mine & 0xFFFFu));
                cs += __builtin_popcountll(mk);
            }
        }
        nselq[q] = cs;
    }
    asm volatile("s_waitcnt lgkmcnt(0)" ::: "memory");
#ifdef DBG_TIME_ATT
    if (tid == 0) { const unsigned tn_ = (unsigned)__builtin_amdgcn_s_memrealtime(); ((LAS unsigned*)(lds + LDS_MISC))[19] += tn_ - tk0; tk0 = tn_; }
#endif
    __syncthreads();
    LAS unsigned char* gb = lds + wave * AT_GBUF;
    const int n = lane & 15, kg = lane >> 4, head = n & 7;
#pragma unroll 1
    for (int qi = 0; qi < 4; ++qi) {
        const int q = 4 * wave + qi, t = t0 + q;
        const int nsel = qi == 0 ? nselq[0] : (qi == 1 ? nselq[1] : (qi == 2 ? nselq[2] : nselq[3]));
        const LAS unsigned short* sel = SEL + q * 256;
        bf16_t* qrow = P.qlat + (rowb + t) * 2048;
        bf16x8 qb[8];
#pragma unroll
        for (int ks = 0; ks < 8; ++ks) { qb[ks] = (bf16x8){0, 0, 0, 0, 0, 0, 0, 0}; if (n < 8) qb[ks] = *(const bf16x8*)(qrow + n * 256 + 32 * ks + 8 * kg); }
        f32x4 oacc[16];
#pragma unroll
        for (int mt = 0; mt < 16; ++mt) oacc[mt] = (f32x4){0.f, 0.f, 0.f, 0.f};
        float mrun = -1e30f, lrun = 0.f;
        const int nchunk = (nsel + 31) >> 5;
#pragma unroll 1
        for (int c = 0; c < nchunk; ++c) {
            const int jn = 32 * c + kcol; const int idxc = (jn < nsel) ? (int)sel[jn] : 0;
            { u32x4 pre[16];
              const unsigned offc = ((unsigned)rowb + (unsigned)idxc) * 512u;
#pragma unroll
              for (int i = 0; i < 16; ++i) { const unsigned o0 = (unsigned)__builtin_amdgcn_readlane((int)offc, 2 * i), o1 = (unsigned)__builtin_amdgcn_readlane((int)offc, 2 * i + 1);
                  pre[i] = *(const u32x4*)((const char*)P.ckv + ((hh ? o1 : o0) + (unsigned)kcol * 16u)); }
#pragma unroll
              for (int i = 0; i < 16; ++i) *(LAS u32x4*)(gb + (2 * i + hh) * AT_GROW + kcol * 16) = pre[i];
            }
            f32x4 st[2];
#pragma unroll
            for (int k2 = 0; k2 < 2; ++k2) { st[k2] = (f32x4){0.f, 0.f, 0.f, 0.f};
#pragma unroll
                for (int ks = 0; ks < 8; ++ks) { const bf16x8 a = *(const LAS bf16x8*)(gb + (16 * k2 + n) * AT_GROW + (32 * ks + 8 * kg) * 2); st[k2] = __builtin_amdgcn_mfma_f32_16x16x32_bf16(a, qb[ks], st[k2], 0, 0, 0); } }
            float mloc = -1e30f;
#pragma unroll
            for (int k2 = 0; k2 < 2; ++k2)
#pragma unroll
                for (int r = 0; r < 4; ++r) { const int jj = 16 * k2 + 4 * kg + r; const int idx = (32 * c + jj < nsel) ? (int)sel[32 * c + jj] : 0; int d = t - idx; d = d < 127 ? d : 127;
                    float lg = st[k2][r] + BIAS2[d * 8 + head]; if (32 * c + jj >= nsel) lg = -1e30f;
                    st[k2][r] = lg; mloc = fmaxf(mloc, lg); }
            if (c == 0) { mloc = fmaxf(mloc, __shfl_xor(mloc, 16)); mloc = fmaxf(mloc, __shfl_xor(mloc, 32)); mrun = mloc; }
            else if (__ballot(mloc > mrun + 60.0f) != 0ull) {
                mloc = fmaxf(mloc, __shfl_xor(mloc, 16)); mloc = fmaxf(mloc, __shfl_xor(mloc, 32));
                const float mnew = fmaxf(mrun, mloc), alpha = fast_exp(mrun - mnew);
                lrun = lrun * alpha; mrun = mnew;
#pragma unroll
                for (int mt = 0; mt < 16; ++mt) oacc[mt] = oacc[mt] * alpha;
            }
#pragma unroll
            for (int k2 = 0; k2 < 2; ++k2)
#pragma unroll
                for (int r = 0; r < 4; ++r) { const float p = fast_exp(st[k2][r] - mrun); st[k2][r] = p; lrun += p; }
            u32x4 pw; pw.x = pk2(st[0][0], st[0][1]); pw.y = pk2(st[0][2], st[0][3]); pw.z = pk2(st[1][0], st[1][1]); pw.w = pk2(st[1][2], st[1][3]);
            const bf16x8 pb = __builtin_bit_cast(bf16x8, pw);
            LAS unsigned char* tb = gb + (4 * kg + (n >> 2)) * AT_GROW + 8 * (n & 3);
#pragma unroll
            for (int mt = 0; mt < 16; ++mt) {
                const s16x4 v1 = __builtin_amdgcn_ds_read_tr16_b64_v4i16((LAS s16x4*)(tb + 32 * mt));
                const s16x4 v2 = __builtin_amdgcn_ds_read_tr16_b64_v4i16((LAS s16x4*)(tb + 16 * AT_GROW + 32 * mt));
                const bf16x8 av = (bf16x8){v1[0], v1[1], v1[2], v1[3], v2[0], v2[1], v2[2], v2[3]};
                oacc[mt] = __builtin_amdgcn_mfma_f32_16x16x32_bf16(av, pb, oacc[mt], 0, 0, 0);
            }
        }
        lrun += __shfl_xor(lrun, 16); lrun += __shfl_xor(lrun, 32);
        const float inv = 1.0f / lrun;
        if (n < 8) {
#pragma unroll
            for (int mt = 0; mt < 16; ++mt) { const f32x4 o = oacc[mt] * inv; u32x2 w; w.x = pk2(o[0], o[1]); w.y = pk2(o[2], o[3]); *(u32x2*)(qrow + n * 256 + 16 * mt + 4 * kg) = w; }
        }
    }
#ifdef DBG_TIME_ATT
    if (tid == 0) { const unsigned tn_ = (unsigned)__builtin_amdgcn_s_memrealtime(); ((LAS unsigned*)(lds + LDS_MISC))[20] += tn_ - tk0; tk0 = tn_; }
#endif
}
__device__ __forceinline__ void ln_finish(f32x4 (&v)[4], const float* gam, const float* bet, float* orow, bf16_t* brow, int lane) {
    float s = 0.f;
#pragma unroll
    for (int j = 0; j < 4; ++j) s += (v[j][0] + v[j][1]) + (v[j][2] + v[j][3]);
    const float mean = wave_sum(s) * (1.0f / 1024.0f); float s2 = 0.f;
#pragma unroll
    for (int j = 0; j < 4; ++j) { v[j] = v[j] - mean; s2 += (v[j][0] * v[j][0] + v[j][1] * v[j][1]) + (v[j][2] * v[j][2] + v[j][3] * v[j][3]); }
    const float rstd = 1.0f / __builtin_sqrtf(wave_sum(s2) * (1.0f / 1024.0f) + LN_EPS);
#pragma unroll
    for (int j = 0; j < 4; ++j) { const f32x4 g = *(const f32x4*)(gam + 256 * j + 4 * lane), bb = *(const f32x4*)(bet + 256 * j + 4 * lane);
        v[j] = v[j] * rstd * g + bb;
        if (orow != nullptr) *(f32x4*)(orow + 256 * j + 4 * lane) = v[j];
        u32x2 w; w.x = pk2(v[j][0], v[j][1]); w.y = pk2(v[j][2], v[j][3]); *(u32x2*)(brow + 256 * j + 4 * lane) = w; }
}
struct RouteP { int* r_e; int* r_pos; int* r_slot; float* r_g; unsigned* gcnt; };

__device__ __forceinline__ void ln1_route_block(LAS unsigned char* lds, int blk, float* xo, bf16_t* xb, const float* gam, const float* bet, const float* rbias, const RouteP& R, int tid) {
    const int wave = __builtin_amdgcn_readfirstlane(tid >> 6), lane = tid & 63;
    const LAS float* WR = (const LAS float*)lds; LAS int* lcnt = (LAS int*)(lds + 65536); LAS int* basee = (LAS int*)(lds + 65600); LAS int* tok = (LAS int*)(lds + 65664);
    __syncthreads();
    if (tid < 16) lcnt[tid] = 0;
    __syncthreads();
    u32x2 wn[4];
#pragma unroll
    for (int j = 0; j < 4; ++j) wn[j] = *(const u32x2*)(xb + ((size_t)blk * 128 + wave * 16) * 1024 + 256 * j + 4 * lane);
    for (int rr = 0; rr < 16; ++rr) {
        const int rl = wave * 16 + rr; const size_t row = (size_t)blk * 128 + rl;
        f32x4 v[4];
#pragma unroll
        for (int j = 0; j < 4; ++j) { const u32x2 w = wn[j]; v[j] = (f32x4){bf_lo(w.x), bf_hi(w.x), bf_lo(w.y), bf_hi(w.y)}; }
        { const size_t rn = row + (rr + 1 < 16 ? 1 : 0);
#pragma unroll
          for (int j = 0; j < 4; ++j) wn[j] = *(const u32x2*)(xb + rn * 1024 + 256 * j + 4 * lane); }
        ln_finish(v, gam, bet, nullptr, xb + row * 1024, lane);
        float aff[16], sel[16];
#pragma unroll
        for (int e = 0; e < 16; ++e) { float p = 0.f;
#pragma unroll
            for (int j = 0; j < 4; ++j) { const f32x4 w = *(const LAS f32x4*)(WR + e * 1024 + 256 * j + 4 * lane); p += (v[j][0] * w[0] + v[j][1] * w[1]) + (v[j][2] * w[2] + v[j][3] * w[3]); }
            const float lg = wave_sum(p); aff[e] = 1.0f / (1.0f + expf(-lg)); sel[e] = aff[e] + rbias[e]; }
        float gbv = -3.0e38f; int gb = 0;
#pragma unroll
        for (int g = 0; g < 4; ++g) { float m1 = -3.0e38f, m2 = -3.0e38f;
#pragma unroll
            for (int i = 0; i < 4; ++i) { const float x = sel[4 * g + i]; if (x > m1) { m2 = m1; m1 = x; } else if (x > m2) m2 = x; }
            const float gs_ = m1 + m2; if (gs_ > gbv) { gbv = gs_; gb = g; } }
        float s0 = -3.0e38f, a0 = 0.f; int e0 = 0;
#pragma unroll
        for (int e = 0; e < 16; ++e) { const bool in = (e >> 2) == gb; if (in && sel[e] > s0) { s0 = sel[e]; a0 = aff[e]; e0 = e; } }
        float s1 = -3.0e38f, a1 = 0.f; int e1 = 0;
#pragma unroll
        for (int e = 0; e < 16; ++e) { const bool in = ((e >> 2) == gb) && (e != e0); if (in && sel[e] > s1) { s1 = sel[e]; a1 = aff[e]; e1 = e; } }
        if (lane == 0) {
            const float inv = 1.0f / (a0 + a1);
            const int p0 = __hip_atomic_fetch_add(lcnt + e0, 1, __ATOMIC_RELAXED, __HIP_MEMORY_SCOPE_WORKGROUP);
            const int p1 = __hip_atomic_fetch_add(lcnt + e1, 1, __ATOMIC_RELAXED, __HIP_MEMORY_SCOPE_WORKGROUP);
            tok[rl * 4 + 0] = e0; tok[rl * 4 + 1] = p0; tok[rl * 4 + 2] = e1; tok[rl * 4 + 3] = p1;
            *(f32x2*)(R.r_g + row * 2) = (f32x2){a0 * inv, a1 * inv};
        }
    }
    __syncthreads();
    if (tid < 16) basee[tid] = (int)__hip_atomic_fetch_add(R.gcnt + tid * 64, (unsigned)lcnt[tid], __ATOMIC_RELAXED, __HIP_MEMORY_SCOPE_AGENT);
    __syncthreads();
    if (tid < 256) { const int rl = tid >> 1, k = tid & 1; const int e = tok[rl * 4 + 2 * k], p = tok[rl * 4 + 2 * k + 1]; const size_t o = ((size_t)blk * 128 + rl) * 2 + k; R.r_e[o] = e; R.r_pos[o] = basee[e] + p; }
}
__device__ __forceinline__ void moe_offsets(LAS int* offp, const unsigned* gcnt, int tid) {
    __syncthreads();
    if (tid == 0) { int o = 0;
        for (int e = 0; e < 16; ++e) { offp[e] = o; const int c = (int)__hip_atomic_load(gcnt + e * 64, __ATOMIC_RELAXED, __HIP_MEMORY_SCOPE_AGENT); o += (c + 255) & ~255; }
        offp[16] = o; }
    __syncthreads();
}
#ifndef MK_PER_PHASE
#define MK_PER_PHASE 0
#endif
#ifndef EN_MASK
#define EN_MASK 0xFFF
#endif
#ifndef EN_M1
#define EN_M1 1
#endif
#ifndef EN_M2
#define EN_M2 1
#endif
#ifndef DBG_REP_P0A
#define DBG_REP_P0A 1
#endif
#ifndef EN_2A
#define EN_2A 1
#endif
#ifndef EN_2R
#define EN_2R 1
#endif
#define EN_A ((EN_MASK >> 0) & 1)
#define EN_B ((EN_MASK >> 1) & 1)
#define EN_0 ((EN_MASK >> 2) & 1)
#define EN_1 ((EN_MASK >> 3) & 1)
#define EN_2 ((EN_MASK >> 4) & 1)
#define EN_3 ((EN_MASK >> 5) & 1)
#define EN_4 ((EN_MASK >> 6) & 1)
#define EN_5 ((EN_MASK >> 7) & 1)
#define EN_6 ((EN_MASK >> 8) & 1)
#define EN_7 ((EN_MASK >> 9) & 1)
#define EN_8 ((EN_MASK >> 10) & 1)
#define EN_9 ((EN_MASK >> 11) & 1)
constexpr int NPH_L = 10, NPH = 2 + NL * NPH_L;
struct Args { const float* in[25]; float* out; unsigned char* ws; int ph_lo, ph_hi; };

__global__ void __launch_bounds__(NTHR, 2) fwd(Args a) {
    extern __shared__ __attribute__((aligned(16))) unsigned char lds_raw[];
    LAS unsigned char* lds = (LAS unsigned char*)lds_raw;
    const int G = gridDim.x, bx = blockIdx.x, vcu = (G % 8 == 0) ? (bx % 8) * (G / 8) + bx / 8 : bx;
    const int NGW = G * NWAVES;
#define PH_LOCALS int tid = wave_s * 64 + lane_id(); asm volatile("" : "+v"(tid)); const int lane = tid & 63, wave = wave_s, gw = vcu * NWAVES + wave; (void)lane; (void)gw;
    volatile LAS unsigned* MISC = (volatile LAS unsigned*)(lds + LDS_MISC);
    const int wave_s = __builtin_amdgcn_readfirstlane((int)threadIdx.x >> 6);
    if (threadIdx.x < 64) MISC[threadIdx.x] = 0u;
    __syncthreads();
    unsigned char* ws = a.ws;
    unsigned* ctl = (unsigned*)(ws + WS_CTL);
    const int lo = a.ph_lo, hi = a.ph_hi;
    XcdBarrier bar; bar.bar = ctl + CW_BAR; bar.x = 0; bar.st = MISC + 8;
    if (hi - lo > 1) bar = xcd_barrier_post(ctl + CW_BAR, MISC + 8);
#define IN(k) (lo <= (k) && (k) < hi)
#ifdef DBG_TIME
    if (blockIdx.x == 0 && threadIdx.x == 0) ctl[12288 + 63] = (unsigned)__builtin_amdgcn_s_memrealtime();
#define SEAM(k) do { if (IN(k) && IN((k) + 1)) { xcd_barrier(bar, wave_s == 0 && lane_id() == 0); if (bx == 0 && wave_s == 0 && lane_id() == 0) ctl[12288 + (k)] = (unsigned)__builtin_amdgcn_s_memrealtime(); } } while (0)
#else
#define SEAM(k) do { if (IN(k) && IN((k) + 1)) xcd_barrier(bar, wave_s == 0 && lane_id() == 0); } while (0)
#endif
    float* xo = a.out;
    bf16_t* xb = (bf16_t*)(ws + WS_XB);
    unsigned char* R = ws + WS_R;

    for (int rep_ = 0; rep_ < (DBG_REP_P0A); ++rep_)
    if (EN_A && IN(0)) { PH_LOCALS
        LAS float* scr = (LAS float*)(lds + wave * 8448);
        constexpr int PER_L = 4160;
        for (int it = gw; it < NL * PER_L; it += NGW) {
            const int l = it / PER_L; int r = it - l * PER_L;
            const float* win = a.in[1] + (size_t)l * 1024 * DIN;
            unsigned char* wm = ws + WS_WMIX + (size_t)l * WMIX_STRIDE;
            if (r < 1024) { tr_item(win, DIN, 0, 2048, (bf16_t*)(wm + OFF_WIN), 1024, 0, r, 64, scr, lane); continue; } r -= 1024;
            if (r < 512) { tr_item(win, DIN, 3072, 840, (bf16_t*)(wm + OFF_WIN) + (size_t)4096 * 1024, 1024, 0, r, 32, scr, lane); continue; } r -= 512;
            if (r < 1024) { tr_item(win, DIN, 3912, 2048, (bf16_t*)(wm + OFF_WG), 1024, 0, r, 64, scr, lane); continue; } r -= 1024;
            if (r < 512) { tr_item(a.in[12] + (size_t)l * 1048576, 1024, 0, 1024, (bf16_t*)(wm + OFF_WPR), 1024, 0, r, 32, scr, lane); continue; } r -= 512;
            if (r < 512) { tr_item(a.in[14] + (size_t)l * 1048576, 1024, 0, 1024, (bf16_t*)(wm + OFF_WO), 1024, 0, r, 32, scr, lane); continue; } r -= 512;
            if (r < 512) { tr_item(a.in[13] + (size_t)l * 1048576, 1024, 0, 1024, (bf16_t*)(R + R_PT + (size_t)l * 2 * MiB), 1024, 0, r, 32, scr, lane); continue; } r -= 512;
            { const int m = r >> 5, g = (r >> 1) & 15, nb = r & 1;
              const float* src = (m ? a.in[6] : a.in[4]) + (size_t)(l * 16 + g) * 4096;
              bf16_t* dst = (bf16_t*)(ws + WS_WSM + (size_t)l * 262144 + (size_t)m * 131072) + g * 4096;
              tr_item(src, 64, 0, 64, dst, 64, 0, nb, 2, scr, lane); }
        }
        const size_t gt = (size_t)vcu * NTHR + tid, GT = (size_t)G * NTHR;
        for (size_t i = gt; i < (size_t)NL * 1024 * 128; i += GT) { const int l = (int)(i >> 17), k = (int)(i >> 7) & 1023, j8 = (int)i & 127;
            const float* s = a.in[1] + ((size_t)l * 1024 + k) * DIN + 2048 + 8 * j8; const f32x4 v0 = *(const f32x4*)s, v1 = *(const f32x4*)(s + 4);
            *(u32x4*)((bf16_t*)(R + R_WQ + (size_t)l * 2 * MiB) + (size_t)k * 1024 + 8 * j8) = pack8(v0, v1); }
        for (size_t i = gt; i < (size_t)2 * NL * 8 * 256 * 32; i += GT) { const int which = (int)(i >> 18); const int r = (int)(i & 262143); const int lh = r >> 13, c = (r >> 5) & 255, d8 = r & 31; const int h = lh & 7;
            u32x4 o = (u32x4){0u, 0u, 0u, 0u};
            if ((d8 >> 4) == (h & 1)) { const float* s = (which ? a.in[11] : a.in[10]) + ((size_t)lh * 256 + c) * 128 + 8 * (d8 & 15); o = pack8(*(const f32x4*)s, *(const f32x4*)(s + 4)); }
            *(u32x4*)((bf16_t*)(R + (which ? R_UVP : R_UKP)) + ((size_t)lh * 256 + c) * 1024 + 8 * d8) = o; }
        for (size_t i = gt; i < (size_t)T * 128; i += GT) { const float* s = a.in[0] + i * 8; const f32x4 v0 = *(const f32x4*)s, v1 = *(const f32x4*)(s + 4);
            *(u32x4*)(xb + i * 8) = pack8(v0, v1); }
    }
    SEAM(0);
    if (EN_B && IN(1)) {
        SchedPro S{R, G, vcu}; EpiPro E{ws + WS_WMIX};
        gs::gemm_stream<true>(lds, S, E, wave_s);
    }
    SEAM(1);

    for (int l = 0; l < NL; ++l) {
        const int pb = 2 + l * NPH_L;
        unsigned char* wm = ws + WS_WMIX + (size_t)l * WMIX_STRIDE;
        bf16_t* xrnn = (bf16_t*)(R + R_XRNN); bf16_t* grnn = (bf16_t*)(R + R_GRNN); bf16_t* qlat = (bf16_t*)(R + R_QLAT); bf16_t* ckv = (bf16_t*)(R + R_CKV);
        bf16_t* qidx = (bf16_t*)(R + R_QIDX); bf16_t* kidx = (bf16_t*)(R + R_KIDX); float* widx = (float*)(R + R_WIDX);
        if (EN_0 && IN(pb + 0)) {
            SchedDense S{(const char*)xb, (const char*)(wm + OFF_WIN), 2048u, 2048u, 16, T / 256, 20, G, vcu};
            EpiInproj E{xrnn, grnn, qlat, ckv, qidx, kidx, widx};
            gs::gemm_stream<true>(lds, S, E, wave_s);
#ifdef DBG_REP_INPROJ
            gs::gemm_stream<true>(lds, S, E, wave_s);
#endif
        }
        SEAM(pb + 0);
        RnnP RP{xrnn, grnn, (float*)(R + R_TOT), (const bf16_t*)(ws + WS_WSM + (size_t)l * 262144), (const bf16_t*)(ws + WS_WSM + (size_t)l * 262144 + 131072),
                a.in[2] + (size_t)l * 4096, a.in[3] + (size_t)l * 1024, a.in[5] + (size_t)l * 1024, a.in[7] + (size_t)l * 1024, a.in[8] + (size_t)l * 1024};
        if (EN_1 && IN(pb + 1)) { PH_LOCALS
#ifdef DBG_TIME
            if (tid == 0) MISC[24] = (unsigned)__builtin_amdgcn_s_memrealtime();
#endif
            for (int it = gw; it < 2048; it += NGW) rnn_item<1>(RP, it, lds + wave * 8448, lane);
#ifdef DBG_TIME
            if (tid == 0) MISC[25] = (unsigned)__builtin_amdgcn_s_memrealtime();
#endif
#ifdef DBG_REP_RNN
            for (int it = gw; it < 2048; it += NGW) rnn_item<1>(RP, it, lds + wave * 8448, lane);
#endif
            for (int row = gw; row < T; row += 4 * NGW) ckv_norm_rows4(ckv, row, NGW, T, a.in[9] + (size_t)l * 256, lane);
#ifdef DBG_TIME
            if (tid == 0) MISC[26] = (unsigned)__builtin_amdgcn_s_memrealtime();
#endif
            LAS float* scr = (LAS float*)(lds + wave * 8448);
            for (int it = gw; it < 16 * 768; it += NGW) { const int e = it / 768; int r = it - e * 768; const size_t le = (size_t)l * 16 + e;
                bf16_t* gu = (bf16_t*)(ws + WS_WEXP) + (size_t)e * 1048576; bf16_t* dn = (bf16_t*)(ws + WS_WEXP + OFF_DN) + (size_t)e * 524288;
                if (r < 256) { tr_item(a.in[19] + le * 524288, 512, 0, 512, gu, 1024, 1, r, 16, scr, lane); continue; } r -= 256;
                if (r < 256) { tr_item(a.in[20] + le * 524288, 512, 0, 512, gu + 4 * 1024, 1024, 1, r, 16, scr, lane); continue; } r -= 256;
                tr_item(a.in[21] + le * 524288, 1024, 0, 1024, dn, 512, 0, r, 32, scr, lane); }
#ifdef DBG_TIME
            if (l == 1 && bx == 0 && tid == 0) { const unsigned tq3 = (unsigned)__builtin_amdgcn_s_memrealtime();
                ctl[12288 + 48] = MISC[25] - MISC[24]; ctl[12288 + 49] = MISC[26] - MISC[25]; ctl[12288 + 50] = tq3 - MISC[26]; ctl[12288 + 51] = tq3 - MISC[24]; }
#endif
        }
        SEAM(pb + 1);
        if (EN_2 && IN(pb + 2)) { PH_LOCALS
            __syncthreads();
            if (tid < 256) ((LAS float*)(lds + AT_BIAS))[tid] = a.in[24][tid];
            if (tid < 128) { const int d = tid; int bk = d; if (d >= 16) { bk = 16 + (int)(logf((float)d / 16.0f) / 2.0794415416798357f * 16.0f); bk = bk > 31 ? 31 : bk; } ((LAS int*)(lds + AT_BKT))[d] = bk; }
            __syncthreads();
            for (int i = tid; i < 1024; i += NTHR) ((LAS float*)(lds + AT_BIAS2))[i] = ((const LAS float*)(lds + AT_BIAS))[((const LAS int*)(lds + AT_BKT))[i >> 3] * 8 + (i & 7)];
            AttnP AP{qidx, kidx, ckv, widx, qlat, (unsigned long long*)(R + R_MSCR + (size_t)bx * 393216)};
#ifdef DBG_TIME
            unsigned tph0 = (unsigned)__builtin_amdgcn_s_memrealtime();
#endif
#ifdef DBG_STATIC_UNITS
            if (EN_2A) for (int p = vcu; p < 512; p += G) { const int b = p >> 8, uu = p & 255;
#pragma unroll 1
                for (int k2 = 0; k2 < 2; ++k2) { attn_unit(lds, AP, b, k2 ? uu : 511 - uu, tid);
#ifdef DBG_TIME
                    if (tid == 0) MISC[21] = MISC[21] + 1u;
#endif
                } }
#else
            if (EN_2A) for (;;) {
                __syncthreads();
                if (tid == 0) MISC[4] = __hip_atomic_fetch_add(ctl + CW_QUEUE + l * 64, 1u, __ATOMIC_RELAXED, __HIP_MEMORY_SCOPE_AGENT);
                __syncthreads();
                const unsigned tk = MISC[4];
                if (tk >= 1024u) break;
                attn_unit(lds, AP, (int)(tk & 1u), 511 - (int)(tk >> 1), tid);
#ifdef DBG_TIME
                if (tid == 0) MISC[21] = MISC[21] + 1u;
#endif
            }
            __syncthreads();
#endif
#ifdef DBG_TIME
            if (l == 1 && bx == 0 && tid == 0) { for (int i_ = 0; i_ < 6; ++i_) ctl[12288 + 40 + i_] = ((LAS unsigned*)(lds + LDS_MISC))[16 + i_]; ctl[12288 + 46] = ((LAS unsigned*)(lds + LDS_MISC))[16]; }
            if (l == 0 && tid == 0) { for (int i_ = 0; i_ < 6; ++i_) ((LAS unsigned*)(lds + LDS_MISC))[16 + i_] = 0u; }
            __syncthreads();
            unsigned tph1 = (unsigned)__builtin_amdgcn_s_memrealtime();
            if (l == 1 && bx == 0 && tid == 0) ctl[12288 + 47] = tph1 - tph0;
            if (l == 1 && tid == 0) { __hip_atomic_fetch_max(ctl + 12288 + 59, tph1 - tph0, __ATOMIC_RELAXED, __HIP_MEMORY_SCOPE_AGENT); __hip_atomic_fetch_max(ctl + 12288 + 58, 0x40000000u - (tph1 - tph0), __ATOMIC_RELAXED, __HIP_MEMORY_SCOPE_AGENT); }
#endif
            if (EN_2R) for (int it = gw; it < 2048; it += NGW) rnn_item<2>(RP, it, lds + wave * 8448, lane);
#ifdef DBG_TIME
            { __syncthreads(); const unsigned tph2 = (unsigned)__builtin_amdgcn_s_memrealtime();
              if (l == 1 && tid == 0) __hip_atomic_fetch_max(ctl + 12288 + 57, tph2 - tph1, __ATOMIC_RELAXED, __HIP_MEMORY_SCOPE_AGENT); }
#endif
        }
        SEAM(pb + 2);
        if (EN_3 && IN(pb + 3)) {
            if (EN_M1) { SchedMerge1 S{(const char*)xb, (const char*)grnn, (const char*)(wm + OFF_WG), (const char*)(wm + OFF_WPR), G, vcu};
              EpiMerge1 E{R + R_MSCR + (size_t)bx * 131072, R + R_MSCR2, (bf16_t*)(R + R_MERGED)};
              gs::gemm_stream<true>(lds, S, E, wave_s); }
            if (EN_M2) { SchedDense S{(const char*)qlat, (const char*)(wm + OFF_WVO), 4096u, 4096u, 32, T / 256, 4, G, vcu};
              EpiMerge2 E{R + R_MSCR2, (bf16_t*)(R + R_MERGED)};
              gs::gemm_stream<true>(lds, S, E, wave_s); }
        }
        SEAM(pb + 3);
        if (EN_4 && IN(pb + 4)) {
            SchedDense S{(const char*)(R + R_MERGED), (const char*)(wm + OFF_WO), 2048u, 2048u, 16, T / 256, 4, G, vcu};
            EpiOut E{xb};
            gs::gemm_stream<true>(lds, S, E, wave_s);
        }
        SEAM(pb + 4);
        RouteP RT{(int*)(R + R_ROUTE), (int*)(R + R_ROUTE + 262144), (int*)(R + R_ROUTE + 524288), (float*)(R + R_ROUTE + 786432), ctl + CW_CNT + l * 16 * 64};
        LAS int* offp = (LAS int*)(lds + LDS_MISC - 128);
        if (EN_5 && IN(pb + 5)) { PH_LOCALS
            __syncthreads();
            { float wv[32];
#pragma unroll
              for (int j = 0; j < 32; ++j) wv[j] = a.in[17][tid + j * NTHR];
#pragma unroll
              for (int j = 0; j < 32; ++j) { const int i = tid + j * NTHR; ((LAS float*)lds)[(i & 15) * 1024 + (i >> 4)] = wv[j]; } }
            for (int blk = vcu; blk < T / 128; blk += G) ln1_route_block(lds, blk, xo, xb, a.in[15] + (size_t)l * 1024, a.in[16] + (size_t)l * 1024, a.in[18], RT, tid);
        }
        SEAM(pb + 5);
        int* tokof = (int*)(R + R_ROUTE + 1048576);
        if (EN_6 && IN(pb + 6)) { PH_LOCALS
            moe_offsets(offp, RT.gcnt, tid);
            for (int p = vcu * NTHR + tid; p < 2 * T; p += G * NTHR) { const int e = RT.r_e[p], slot = offp[e] + RT.r_pos[p]; RT.r_slot[p] = slot; tokof[slot] = p >> 1; }
            if (vcu == 0 && tid < 256) {
                for (int e = 0; e < 16; ++e) { const int cnt = (int)__hip_atomic_load(RT.gcnt + e * 64, __ATOMIC_RELAXED, __HIP_MEMORY_SCOPE_AGENT); const int s0 = offp[e] + cnt;
                    if (s0 + tid < offp[e + 1]) tokof[s0 + tid] = 0; } }
        }
        SEAM(pb + 6);
        if (EN_7 && IN(pb + 7)) { PH_LOCALS
            moe_offsets(offp, RT.gcnt, tid);
            SchedMoEG S{(const char*)xb, (const char*)(ws + WS_WEXP), 2048u, 2048u, (size_t)2097152, 16, 4, G, vcu, offp, tokof};
            EpiGU E{(bf16_t*)(R + R_HE)};
            gs::gemm_stream<true, SchedMoEG, EpiGU, true>(lds, S, E, wave_s);
        }
        SEAM(pb + 7);
        if (EN_8 && IN(pb + 8)) { PH_LOCALS
            moe_offsets(offp, RT.gcnt, tid);
            SchedMoE S{(const char*)(R + R_HE), (const char*)(ws + WS_WEXP + OFF_DN), 1024u, 1024u, (size_t)1048576, 8, 4, G, vcu, offp};
            EpiBf16 E{(bf16_t*)(R + R_XG), 1024};
            gs::gemm_stream<true>(lds, S, E, wave_s);
        }
        SEAM(pb + 8);
        if (EN_9 && IN(pb + 9)) { PH_LOCALS
            const bf16_t* Y = (const bf16_t*)(R + R_XG);
            u32x2 xwn[4], y0n[4], y1n[4]; int s0n, s1n; f32x2 ggc, ggn;
            { const int r0 = gw < T ? gw : T - 1, r1 = gw + NGW < T ? gw + NGW : T - 1;
              const int a0 = RT.r_slot[2 * r0], a1 = RT.r_slot[2 * r0 + 1]; ggc = *(const f32x2*)(RT.r_g + 2 * (size_t)r0);
#pragma unroll
              for (int j = 0; j < 4; ++j) { xwn[j] = *(const u32x2*)(xb + (size_t)r0 * 1024 + 256 * j + 4 * lane); y0n[j] = *(const u32x2*)(Y + (size_t)a0 * 1024 + 256 * j + 4 * lane); y1n[j] = *(const u32x2*)(Y + (size_t)a1 * 1024 + 256 * j + 4 * lane); }
              s0n = RT.r_slot[2 * r1]; s1n = RT.r_slot[2 * r1 + 1]; ggn = *(const f32x2*)(RT.r_g + 2 * (size_t)r1); }
            for (int row = gw; row < T; row += NGW) {
                const f32x2 gg = ggc;
                u32x2 xwc[4], y0c[4], y1c[4];
#pragma unroll
                for (int j = 0; j < 4; ++j) { xwc[j] = xwn[j]; y0c[j] = y0n[j]; y1c[j] = y1n[j]; }
                { const int r1 = row + NGW < T ? row + NGW : T - 1, r2 = row + 2 * NGW < T ? row + 2 * NGW : T - 1;
                  const int a0 = s0n, a1 = s1n; ggc = ggn;
#pragma unroll
                  for (int j = 0; j < 4; ++j) { xwn[j] = *(const u32x2*)(xb + (size_t)r1 * 1024 + 256 * j + 4 * lane); y0n[j] = *(const u32x2*)(Y + (size_t)a0 * 1024 + 256 * j + 4 * lane); y1n[j] = *(const u32x2*)(Y + (size_t)a1 * 1024 + 256 * j + 4 * lane); }
                  s0n = RT.r_slot[2 * r2]; s1n = RT.r_slot[2 * r2 + 1]; ggn = *(const f32x2*)(RT.r_g + 2 * (size_t)r2); }
                f32x4 v[4];
#pragma unroll
                for (int j = 0; j < 4; ++j) { const u32x2 xw = xwc[j]; const f32x4 x1 = {bf_lo(xw.x), bf_hi(xw.x), bf_lo(xw.y), bf_hi(xw.y)};
                    const u32x2 y0 = y0c[j], y1 = y1c[j];
                    v[j][0] = ALPHA * x1[0] + gg.x * bf_lo(y0.x) + gg.y * bf_lo(y1.x); v[j][1] = ALPHA * x1[1] + gg.x * bf_hi(y0.x) + gg.y * bf_hi(y1.x);
                    v[j][2] = ALPHA * x1[2] + gg.x * bf_lo(y0.y) + gg.y * bf_lo(y1.y); v[j][3] = ALPHA * x1[3] + gg.x * bf_hi(y0.y) + gg.y * bf_hi(y1.y); }
                ln_finish(v, a.in[22] + (size_t)l * 1024, a.in[23] + (size_t)l * 1024, l == NL - 1 ? xo + (size_t)row * 1024 : nullptr, xb + (size_t)row * 1024, lane);
#ifdef DBG_TIME
                if (l == NL - 1) {
                    const unsigned ta = __hip_atomic_load(ctl + 12288 + (DBG_TA), __ATOMIC_RELAXED, __HIP_MEMORY_SCOPE_AGENT), tb = __hip_atomic_load(ctl + 12288 + (DBG_TB), __ATOMIC_RELAXED, __HIP_MEMORY_SCOPE_AGENT);
                    unsigned k_ = (DBG_Q) == 0 ? (40u * ta + tb / 2u) / (tb ? tb : 1u) : ((DBG_TA) == 58 ? (0x40000000u - ta) : (ta - tb)) / (unsigned)((DBG_Q) ? (DBG_Q) : 1); k_ = k_ > 45u ? 45u : k_;
                    const float sc_ = 1.0f - 0.02f * (float)k_;
#pragma unroll
                    for (int j = 0; j < 4; ++j) *(f32x4*)(xo + (size_t)row * 1024 + 256 * j + 4 * lane) = v[j] * sc_; }
#endif
            }
        }
        SEAM(pb + 9);
    }
#undef IN
#undef SEAM
}

#ifdef DUMP_OFF
__global__ void dump_k(const bf16_t* src, float* dst, size_t ld, size_t col0) { for (size_t i = (size_t)blockIdx.x * blockDim.x + threadIdx.x; i < (size_t)T * 1024; i += (size_t)gridDim.x * blockDim.x) dst[i] = bf2f(src[(i >> 10) * ld + col0 + (i & 1023)]); }
#endif
extern "C" void kernel_launch(void* const* d_in, const int* in_sizes, int n_in, void* d_out, int out_size, void* d_ws, size_t ws_size, hipStream_t stream) {
    static int grid = 0;
    if (grid == 0) {
        if (n_in != 25 || out_size != T * D || ws_size < WS_END) { fprintf(stderr, "kernel_launch: unexpected shapes (n_in %d, out %d, ws %zu < %zu)\n", n_in, out_size, ws_size, (size_t)WS_END); grid = -1; return; }
        int dev = 0, cus = 0, per_cu = 0;
        if (hipGetDevice(&dev) != hipSuccess || hipDeviceGetAttribute(&cus, hipDeviceAttributeMultiprocessorCount, dev) != hipSuccess) { grid = -1; return; }
        if (hipFuncSetAttribute((const void*)fwd, hipFuncAttributeMaxDynamicSharedMemorySize, LDS_BYTES) != hipSuccess) { fprintf(stderr, "kernel_launch: hipFuncSetAttribute failed\n"); grid = -1; return; }
        if (hipOccupancyMaxActiveBlocksPerMultiprocessor(&per_cu, (const void*)fwd, NTHR, LDS_BYTES) != hipSuccess || per_cu < 1) fprintf(stderr, "kernel_launch: occupancy query says %d\n", per_cu);
        (void)hipGetLastError();
        grid = cus < 256 ? cus : 256;
    }
    if (grid < 0) return;
    (void)hipMemsetAsync((char*)d_ws + WS_CTL, 0, CTL_BYTES, stream);
    Args a{};
    for (int i = 0; i < 25; ++i) a.in[i] = (const float*)d_in[i];
    a.out = (float*)d_out; a.ws = (unsigned char*)d_ws;
#if MK_PER_PHASE
#ifndef PH_LIMIT
#define PH_LIMIT NPH
#endif
    for (int ph = 0; ph < PH_LIMIT; ++ph) { a.ph_lo = ph; a.ph_hi = ph + 1; hipLaunchKernelGGL(fwd, dim3(grid), dim3(NTHR), LDS_BYTES, stream, a); }
#else
    a.ph_lo = 0; a.ph_hi = NPH; hipLaunchKernelGGL(fwd, dim3(grid), dim3(NTHR), LDS_BYTES, stream, a);
#endif
#ifdef DUMP_OFF
    hipLaunchKernelGGL(dump_k, dim3(2048), dim3(256), 0, stream, (const bf16_t*)((const char*)d_ws + (DUMP_OFF)), (float*)d_out, (size_t)(DUMP_LD), (size_t)(DUMP_COL));
#endif
}
```

```cpp
#include <hip/hip_runtime.h>
#include <cstdio>
#include <cstdint>

#define GAS __attribute__((address_space(1)))
#define LAS __attribute__((address_space(3)))
typedef unsigned short bf16_t;
typedef short bf16x8 __attribute__((ext_vector_type(8)));
typedef short s16x4 __attribute__((ext_vector_type(4)));
typedef float f32x2 __attribute__((ext_vector_type(2)));
typedef float f32x4 __attribute__((ext_vector_type(4)));
typedef float f32x16 __attribute__((ext_vector_type(16)));
typedef unsigned u32x2 __attribute__((ext_vector_type(2)));
typedef unsigned u32x4 __attribute__((ext_vector_type(4)));

constexpr int NB = 2, SEQ = 16384, T = NB * SEQ, D = 1024, NL = 4, DIN = 5960;
constexpr int NE = 16;
constexpr float ALPHA = 1.681792830507429f;
constexpr float LN_EPS = 1e-5f, RMS_EPS = 1e-6f;
constexpr int NWAVES = 8, NTHR = 512;

constexpr size_t MiB = 1u << 20;
constexpr size_t WS_CTL = 0, CTL_BYTES = 1 * MiB;
constexpr size_t WS_XB = 1 * MiB;
constexpr size_t WS_WMIX = 65 * MiB, WMIX_STRIDE = 22 * MiB;
constexpr size_t OFF_WIN = 0, OFF_WG = 10 * MiB, OFF_WPR = 14 * MiB, OFF_WVO = 16 * MiB, OFF_WO = 20 * MiB;
constexpr size_t WS_WSM = 153 * MiB;
constexpr size_t WS_WEXP = 154 * MiB;
constexpr size_t OFF_DN = 32 * MiB;
constexpr size_t WS_R = 202 * MiB;
constexpr size_t R_XRNN = 0, R_GRNN = 64 * MiB, R_QLAT = 128 * MiB, R_CKV = 256 * MiB, R_QIDX = 272 * MiB, R_KIDX = 304 * MiB, R_WIDX = 308 * MiB,
                 R_TOT = 309 * MiB, R_MSCR = 310 * MiB, R_MSCR2 = 342 * MiB, R_END = 406 * MiB;
constexpr size_t R_MERGED = R_XRNN;
constexpr size_t R_XG = 0, R_HE = 136 * MiB, R_ROUTE = 204 * MiB;
constexpr size_t R_WQ = 0, R_UKP = 8 * MiB, R_PT = 24 * MiB, R_UVP = 32 * MiB;
constexpr size_t WS_END = WS_R + R_END;
constexpr int MP_MAX = 2 * T + NE * 256;

constexpr int CW_TMO = 0;
constexpr int CW_BAR = 4096;
constexpr int CW_CNT = 8192;
constexpr int CW_QUEUE = 14336;

constexpr int LDS_BYTES = 163840;
constexpr int LDS_MISC = LDS_BYTES - 256;

#define RLX_AGENT __ATOMIC_RELAXED, __HIP_MEMORY_SCOPE_AGENT
__device__ __forceinline__ unsigned f2bf(float f) { unsigned u = __builtin_bit_cast(unsigned, f); return (u + 0x7fffu + ((u >> 16) & 1u)) >> 16; }
typedef __bf16 bf16x2_t __attribute__((ext_vector_type(2)));
__device__ __forceinline__ unsigned pk2(float lo, float hi) { const f32x2 v = {lo, hi}; const bf16x2_t b = __builtin_convertvector(v, bf16x2_t); return __builtin_bit_cast(unsigned, b); }
__device__ __forceinline__ float bf_lo(unsigned w) { return __builtin_bit_cast(float, w << 16); }
__device__ __forceinline__ float bf_hi(unsigned w) { return __builtin_bit_cast(float, w & 0xffff0000u); }
__device__ __forceinline__ float bf2f(bf16_t h) { return __builtin_bit_cast(float, ((unsigned)h) << 16); }
__device__ __forceinline__ float fast_exp(float x) { return __builtin_amdgcn_exp2f(x * 1.4426950408889634f); }
__device__ __forceinline__ float fast_rcp(float x) { return __builtin_amdgcn_rcpf(x); }
__device__ __forceinline__ float sigmoidf_(float x) { return fast_rcp(1.0f + fast_exp(-x)); }
__device__ __forceinline__ float gelu_tanh(float x) { const float y = 0.7978845608028654f * (x + 0.044715f * x * x * x); const float e = fast_exp(2.0f * y); const float th = 1.0f - 2.0f * fast_rcp(e + 1.0f); return 0.5f * x * (1.0f + th); }
template <int CTRL> __device__ __forceinline__ float dpp_f(float v) { return __builtin_bit_cast(float, __builtin_amdgcn_update_dpp(0, __builtin_bit_cast(int, v), CTRL, 0xf, 0xf, true)); }
__device__ __forceinline__ float wave_sum(float v) {
    v += dpp_f<0xB1>(v); v += dpp_f<0x4E>(v); v += dpp_f<0x141>(v); v += dpp_f<0x140>(v);
    const int vi = __builtin_bit_cast(int, v);
    return (__builtin_bit_cast(float, __builtin_amdgcn_readlane(vi, 0)) + __builtin_bit_cast(float, __builtin_amdgcn_readlane(vi, 16))) +
           (__builtin_bit_cast(float, __builtin_amdgcn_readlane(vi, 32)) + __builtin_bit_cast(float, __builtin_amdgcn_readlane(vi, 48)));
}

__device__ __forceinline__ int lane_id() { unsigned z = 0u; asm volatile("" : "+v"(z)); return (int)__builtin_amdgcn_mbcnt_hi(~0u, __builtin_amdgcn_mbcnt_lo(~0u, z)); }
#define XB_TMO      128
#define XB_XCNT(j)  (256  + 64 * (j))
#define XB_XSUB(j)  (1280 + 64 * (j))
#define XB_XGEN(j)  (2304 + 64 * (j))
#define XB_TOP      3328
#define XB_TOPGEN   3392
#define XCD_BAR_WORDS 3456
#define XB_SPIN_CAP (1u << 18)
__device__ __forceinline__ unsigned xb_ld(unsigned* p)              { return __hip_atomic_load(p, __ATOMIC_RELAXED, __HIP_MEMORY_SCOPE_AGENT); }
__device__ __forceinline__ unsigned xb_add(unsigned* p, unsigned v) { return __hip_atomic_fetch_add(p, v, __ATOMIC_RELAXED, __HIP_MEMORY_SCOPE_AGENT); }
__device__ __forceinline__ unsigned xb_xcc_id() { return (unsigned)__builtin_amdgcn_s_getreg((3 << 11) | 20) & 0xFu; }
#define XB_SPIN(cond, bar) do { unsigned _sp = 0; while (cond) { __builtin_amdgcn_s_sleep(1); \
    if ((++_sp & 255u) == 0u) { if (xb_ld(&(bar)[XB_TMO])) break; if (_sp > XB_SPIN_CAP) { atomicAdd(&(bar)[XB_TMO], 1u); break; } } } } while (0)
struct XcdBarrier { unsigned* bar; unsigned x; volatile LAS unsigned* st; };
__device__ __forceinline__ XcdBarrier xcd_barrier_post(unsigned* bar, volatile LAS unsigned* st) {
    XcdBarrier b; b.bar = bar; b.x = xb_xcc_id(); b.st = st;
    if (threadIdx.x == 0) (void)xb_add(&bar[XB_XCNT(b.x)], 1u);
    return b;
}
__device__ __forceinline__ void xcd_barrier_complete(unsigned* bar, unsigned x, unsigned& nloc, unsigned& nx) {
    const unsigned G = gridDim.x * gridDim.y * gridDim.z;
    unsigned sum, cnt, mine, sp = 0u;
    for (;;) {
        sum = 0u; cnt = 0u; mine = 0u;
#pragma unroll
        for (unsigned j = 0; j < 16; ++j) { const unsigned c = xb_ld(&bar[XB_XCNT(j)]); sum += c; cnt += (c > 0u) ? 1u : 0u; mine = (j == x) ? c : mine; }
        if (sum == G) break;
        __builtin_amdgcn_s_sleep(1);
        if ((++sp & 255u) == 0u) { if (xb_ld(&bar[XB_TMO])) break; if (sp > XB_SPIN_CAP) { atomicAdd(&bar[XB_TMO], 1u); break; } }
    }
    nloc = mine > 0u ? mine : 1u; nx = cnt > 0u ? cnt : 1u;
}
__device__ __forceinline__ void xcd_barrier(const XcdBarrier& b, bool is_t0) {
    asm volatile("s_waitcnt vmcnt(0)" ::: "memory");
    __syncthreads();
    if (is_t0) {
        unsigned* bar = b.bar;
        __builtin_amdgcn_s_waitcnt(0);
        unsigned nloc = b.st[0], nx = b.st[1];
        if (nloc == 0u) { xcd_barrier_complete(bar, b.x, nloc, nx); b.st[0] = nloc; b.st[1] = nx; }
        const unsigned old = xb_add(&bar[XB_XSUB(b.x)], 1u);
        const unsigned gen = old / nloc;
        if (old + 1u == (gen + 1u) * nloc) {
            __builtin_amdgcn_fence(__ATOMIC_RELEASE, "agent");
            asm volatile("s_waitcnt vmcnt(0)" ::: "memory");
            const unsigned og = xb_add(&bar[XB_TOP], 1u);
            const unsigned tg = og / nx;
            if (og + 1u == (tg + 1u) * nx) xb_add(&bar[XB_TOPGEN], 1u);
            else XB_SPIN(xb_ld(&bar[XB_TOPGEN]) == tg, bar);
            __builtin_amdgcn_fence(__ATOMIC_ACQUIRE, "agent");
            xb_add(&bar[XB_XGEN(b.x)], 1u);
            asm volatile("s_waitcnt vmcnt(0)" ::: "memory");
        } else {
            XB_SPIN(xb_ld(&bar[XB_XGEN(b.x)]) == gen, bar);
            __builtin_amdgcn_fence(__ATOMIC_ACQUIRE, "agent");
            asm volatile("s_waitcnt vmcnt(0)" ::: "memory");
        }
    }
    __syncthreads();
}
namespace gs {
constexpr int BM = 256, BK = 64, HALF = 128, HTB = HALF * BK * 2, STAGE_BYTES = 8 * HTB, NXCD = 8, WGM = 8;
__host__ __device__ __forceinline__ int lds_byte(int r, int c) { const int st = (r >> 4) * 2 + (c >> 5), rr = r & 15, cc = c & 31, ob = rr * 64 + cc * 2; return st * 1024 + (ob ^ (((ob >> 9) & 1) << 5)); }
__host__ __device__ __forceinline__ void stage_rc(int b, int& R, int& C) { const int st = b / 1024, sb = b % 1024, swz = sb ^ (((sb >> 9) & 1) << 5); R = (st >> 1) * 16 + swz / 64; C = (st & 1) * 32 + (swz % 64) / 2; }
__host__ __device__ __forceinline__ int perm32(int rho) { const int n = rho >> 4, i = rho & 15; return 8 * (i >> 2) + 4 * n + (i & 3); }

struct UD { const char* A; const char* B; unsigned lda, ldb; int nt; int kind, pm, pn, aux; };

__device__ __forceinline__ bool tile_of(long L, int nM, int nN, int& pm, int& pn) {
    const int nwg = nM * nN; if (L >= nwg) return false;
    int wgid = (int)L; { const int q = nwg / NXCD, r = nwg % NXCD, xcd = wgid % NXCD, off = wgid / NXCD; wgid = (xcd < r ? xcd * (q + 1) : r * (q + 1) + (xcd - r) * q) + off; }
    const int nig = WGM * nN, gid = wgid / nig, fm = gid * WGM, gsz = (nM - fm) < WGM ? (nM - fm) : WGM;
    pm = fm + ((wgid % nig) % gsz); pn = (wgid % nig) / gsz; return true;
}

template <bool PERM, class Sched, class Epi, bool GATHER = false>
__device__ __forceinline__ void gemm_stream(LAS unsigned char* lds, const Sched& S, const Epi& E, int wave_s) {
    int tid = wave_s * 64 + lane_id(); asm volatile("" : "+v"(tid));
    const int wid = __builtin_amdgcn_readfirstlane(tid >> 6), lane = tid & 63, wr = wid >> 2, wc = wid & 3, fr = lane & 15, fq = lane >> 4;
    int rA[2], rB[2], cb[2];
#pragma unroll
    for (int i = 0; i < 2; ++i) { int R, C; stage_rc(tid * 16 + i * 8192, R, C); rA[i] = R; rB[i] = PERM ? ((R & ~31) + perm32(R & 31)) : R; cb[i] = C * 2; }
    const size_t kstep = (size_t)(BK * 2);
    const unsigned ldsw = (unsigned)wid * 1024u;
    const int aoff = lds_byte(wr * 64 + fr, fq * 8), boff = lds_byte(wc * 32 + fr, fq * 8);
#define GS_SA(b, h) (((b) * 2 + (h)) * HTB)
#define GS_SB(b, h) ((4 + (b) * 2 + (h)) * HTB)
#define GS_STAGE(bufoff, gbase, voff) do { _Pragma("unroll") for (int _i = 0; _i < 2; ++_i) \
        __builtin_amdgcn_global_load_lds((const unsigned*)((const char*)(gbase) + (voff)[_i]), (LAS unsigned*)(lds + (bufoff) + ldsw + _i * 8192), 16, 0, 0); } while (0)
#define GS_LDA(dst, b, h) do { _Pragma("unroll") for (int m = 0; m < 4; ++m) _Pragma("unroll") for (int k = 0; k < 2; ++k) dst[m][k] = *(const LAS bf16x8*)(lds + GS_SA(b, h) + aoff + m * 2048 + k * 1024); } while (0)
#define GS_LDB(dst, b, h) do { _Pragma("unroll") for (int n = 0; n < 2; ++n) _Pragma("unroll") for (int k = 0; k < 2; ++k) dst[n][k] = *(const LAS bf16x8*)(lds + GS_SB(b, h) + boff + n * 2048 + k * 1024); } while (0)
#define GS_MMA(ai, bj, At, Bt) do { __builtin_amdgcn_s_setprio(1); _Pragma("unroll") for (int m = 0; m < 4; ++m) _Pragma("unroll") for (int n = 0; n < 2; ++n) _Pragma("unroll") for (int k = 0; k < 2; ++k) \
        acc[ai][bj][m][n] = __builtin_amdgcn_mfma_f32_16x16x32_bf16(Bt[n][k], At[m][k], acc[ai][bj][m][n], 0, 0, 0); __builtin_amdgcn_s_setprio(0); } while (0)
#define GS_WAIT_V(n) asm volatile("s_waitcnt vmcnt(" #n ")" ::: "memory")
#define GS_WAIT_L(n) asm volatile("s_waitcnt lgkmcnt(" #n ")" ::: "memory")
#define GS_BAR __builtin_amdgcn_s_barrier()
#define GS_SCHED __builtin_amdgcn_sched_barrier(0)
    UD cur, nxt; int ui = 0; const bool prime = false;
    if (!S.next(0, cur)) return;
    f32x4 acc[2][2][4][2];
#pragma unroll
    for (int a = 0; a < 2; ++a)
#pragma unroll
        for (int b = 0; b < 2; ++b)
#pragma unroll
            for (int m = 0; m < 4; ++m)
#pragma unroll
                for (int n = 0; n < 2; ++n) acc[a][b][m][n] = (f32x4){0.f, 0.f, 0.f, 0.f};
    bf16x8 At[4][2], B0[2][2], B1[2][2];
    unsigned vAc[2], vBc[2], vAc1[2] = {0u, 0u};
#pragma unroll
    for (int i = 0; i < 2; ++i) { vAc[i] = (unsigned)rA[i] * cur.lda + (unsigned)cb[i]; vBc[i] = (unsigned)rB[i] * cur.ldb + (unsigned)cb[i]; }
    if constexpr (GATHER) { const int* rm = S.rmap + cur.pm * 256;
#pragma unroll
        for (int i = 0; i < 2; ++i) { vAc[i] = (unsigned)rm[rA[i]] * cur.lda + (unsigned)cb[i]; vAc1[i] = (unsigned)rm[HALF + rA[i]] * cur.lda + (unsigned)cb[i]; } }
    const char* cA = cur.A; const char* cB = cur.B; size_t hA = GATHER ? (size_t)0 : (size_t)HALF * cur.lda, hB = (size_t)HALF * cur.ldb;
    GS_STAGE(GS_SB(0, 0), cB, vBc); GS_STAGE(GS_SA(0, 0), cA, vAc); GS_STAGE(GS_SB(0, 1), cB + hB, vBc); GS_STAGE(GS_SA(0, 1), cA + hA, (GATHER ? vAc1 : vAc));
    if (wr == 1) GS_BAR;
    GS_WAIT_V(4); GS_BAR;
    GS_STAGE(GS_SB(1, 0), cB + kstep, vBc); GS_STAGE(GS_SA(1, 0), cA + kstep, vAc); GS_STAGE(GS_SB(1, 1), cB + hB + kstep, vBc);
    GS_WAIT_V(6); GS_BAR;
    for (;;) {
        const bool has_next = S.next(ui + 1, nxt);
        const char* nA = has_next ? nxt.A : cA; const char* nB = has_next ? nxt.B : cB;
        const unsigned nlda = has_next ? nxt.lda : cur.lda, nldb = has_next ? nxt.ldb : cur.ldb;
        unsigned vAn[2], vBn[2], vAn1[2] = {0u, 0u};
#pragma unroll
        for (int i = 0; i < 2; ++i) { vAn[i] = (unsigned)rA[i] * nlda + (unsigned)cb[i]; vBn[i] = (unsigned)rB[i] * nldb + (unsigned)cb[i]; }
        if constexpr (GATHER) { const int* rm = S.rmap + (has_next ? nxt.pm : cur.pm) * 256;
#pragma unroll
            for (int i = 0; i < 2; ++i) { vAn[i] = (unsigned)rm[rA[i]] * nlda + (unsigned)cb[i]; vAn1[i] = (unsigned)rm[HALF + rA[i]] * nlda + (unsigned)cb[i]; } }
        const size_t hAn = GATHER ? (size_t)0 : (size_t)HALF * nlda, hBn = (size_t)HALF * nldb;
        const int nt = cur.nt;
        for (int t = 0; t < nt; t += 2) {
            const bool last = (t == nt - 2);
            const char* a1 = cA + (size_t)(t + 1) * kstep;
            const char* a2 = last ? nA : cA + (size_t)(t + 2) * kstep; const char* b2 = last ? nB : cB + (size_t)(t + 2) * kstep;
            const char* a3 = a2 + kstep; const char* b3 = b2 + kstep;
            unsigned vA2[2], vB2[2], vA21[2];
#pragma unroll
            for (int i = 0; i < 2; ++i) { vA2[i] = last ? vAn[i] : vAc[i]; vB2[i] = last ? vBn[i] : vBc[i]; vA21[i] = last ? vAn1[i] : vAc1[i]; }
            const size_t hA2 = last ? hAn : hA, hB2 = last ? hBn : hB;
            GS_LDB(B0, 0, 0); GS_SCHED; GS_LDA(At, 0, 0); GS_STAGE(GS_SA(1, 1), a1 + hA, (GATHER ? vAc1 : vAc));
            GS_WAIT_L(8); GS_BAR; GS_WAIT_L(0); GS_MMA(0, 0, At, B0); GS_BAR; GS_SCHED;
            GS_LDB(B1, 0, 1); GS_STAGE(GS_SB(0, 0), b2, vB2);
            GS_BAR; GS_WAIT_L(0); GS_MMA(0, 1, At, B1); GS_BAR;
            GS_LDA(At, 0, 1); GS_STAGE(GS_SA(0, 0), a2, vA2);
            GS_BAR; GS_WAIT_L(0); GS_MMA(1, 0, At, B0); GS_BAR; GS_SCHED;
            GS_STAGE(GS_SB(0, 1), b2 + hB2, vB2);
            GS_WAIT_V(6); GS_BAR; GS_MMA(1, 1, At, B1); GS_BAR;
            GS_LDB(B0, 1, 0); GS_SCHED; GS_LDA(At, 1, 0); GS_STAGE(GS_SA(0, 1), a2 + hA2, (GATHER ? vA21 : vA2));
            GS_WAIT_L(8); GS_BAR; GS_WAIT_L(0); GS_MMA(0, 0, At, B0); GS_BAR; GS_SCHED;
            GS_LDB(B1, 1, 1); GS_STAGE(GS_SB(1, 0), b3, vB2);
            GS_BAR; GS_WAIT_L(0); GS_MMA(0, 1, At, B1); GS_BAR;
            GS_LDA(At, 1, 1); GS_STAGE(GS_SA(1, 0), a3, vA2);
            GS_BAR; GS_WAIT_L(0); GS_MMA(1, 0, At, B0); GS_BAR; GS_SCHED;
            GS_STAGE(GS_SB(1, 1), b3 + hB2, vB2);
            GS_WAIT_V(6); GS_BAR; GS_MMA(1, 1, At, B1); GS_BAR;
        }
        if (!prime) { int tz = wave_s * 64 + lane_id(); asm volatile("" : "+v"(tz)); const int w2 = __builtin_amdgcn_readfirstlane(tz >> 6), l2 = tz & 63; E(acc, cur, w2 >> 2, w2 & 3, l2 & 15, l2 >> 4, tz); }
        if (!has_next) break;
#pragma unroll
        for (int a = 0; a < 2; ++a)
#pragma unroll
            for (int b = 0; b < 2; ++b)
#pragma unroll
                for (int m = 0; m < 4; ++m)
#pragma unroll
                    for (int n = 0; n < 2; ++n) acc[a][b][m][n] = (f32x4){0.f, 0.f, 0.f, 0.f};
        cur = nxt; cA = nA; cB = nB; hA = hAn; hB = hBn;
#pragma unroll
        for (int i = 0; i < 2; ++i) { vAc[i] = vAn[i]; vBc[i] = vBn[i]; vAc1[i] = vAn1[i]; }
        ++ui;
    }
    GS_WAIT_V(0);
    if (wr == 0) GS_BAR;
    GS_BAR;
#undef GS_SA
#undef GS_SB
#undef GS_STAGE
#undef GS_LDA
#undef GS_LDB
#undef GS_MMA
#undef GS_WAIT_V
#undef GS_WAIT_L
#undef GS_BAR
#undef GS_SCHED
}
}
using gs::UD;
__device__ __forceinline__ u32x4 pack8(f32x4 v0, f32x4 v1) { u32x4 w; w.x = pk2(v0[0], v0[1]); w.y = pk2(v0[2], v0[3]); w.z = pk2(v1[0], v1[1]); w.w = pk2(v1[2], v1[3]); return w; }
__device__ __forceinline__ void unpack8(u32x4 w, f32x4& v0, f32x4& v1) { v0 = (f32x4){bf_lo(w.x), bf_hi(w.x), bf_lo(w.y), bf_hi(w.y)}; v1 = (f32x4){bf_lo(w.z), bf_hi(w.z), bf_lo(w.w), bf_hi(w.w)}; }

struct EpiInproj {
    bf16_t *xrnn, *grnn, *qlat, *ckv, *qidx, *kidx; float* widx;
    __device__ __forceinline__ void operator()(const f32x4 (&acc)[2][2][4][2], const UD& u, int wr, int wc, int fr, int fq, int tid) const {
        const int pn = u.pn; const size_t row0 = (size_t)u.pm * 256 + wr * 64 + fr;
        if (pn < 19) {
            bf16_t* base; int ldc, colt; float sc = 1.f; bool gl = false;
            if (pn < 4) { base = xrnn; ldc = 1024; colt = 256 * pn; }
            else if (pn < 8) { base = grnn; ldc = 1024; colt = 256 * (pn - 4); gl = true; }
            else if (pn < 16) { base = qlat; ldc = 2048; colt = 256 * (pn - 8); }
            else if (pn == 16) { base = ckv; ldc = 256; colt = 0; }
            else { base = qidx; ldc = 512; colt = 256 * (pn - 17); sc = 0.125f; }
#pragma unroll
            for (int ai = 0; ai < 2; ++ai)
#pragma unroll
                for (int m = 0; m < 4; ++m) { bf16_t* rowp = base + (row0 + ai * 128 + m * 16) * ldc + colt + wc * 32 + 8 * fq;
#pragma unroll
                    for (int bj = 0; bj < 2; ++bj) { f32x4 v0 = acc[ai][bj][m][0], v1 = acc[ai][bj][m][1];
                        if (gl) {
#pragma unroll
                            for (int j = 0; j < 4; ++j) { v0[j] = gelu_tanh(v0[j]); v1[j] = gelu_tanh(v1[j]); } }
                        v0 = v0 * sc; v1 = v1 * sc;
                        *(u32x4*)(rowp + bj * 128) = pack8(v0, v1); } }
        } else {
#pragma unroll
            for (int ai = 0; ai < 2; ++ai)
#pragma unroll
                for (int m = 0; m < 4; ++m) { const size_t row = row0 + ai * 128 + m * 16; const f32x4 v0 = acc[ai][0][m][0], v1 = acc[ai][0][m][1];
                    if (wc < 2) *(u32x4*)(kidx + row * 64 + wc * 32 + 8 * fq) = pack8(v0, v1);
                    else if (wc == 2 && fq == 0) { *(f32x4*)(widx + row * 8) = v0 * 0.35355339059327373f; *(f32x4*)(widx + row * 8 + 4) = v1 * 0.35355339059327373f; } }
        }
    }
};
struct EpiMerge1 {
    unsigned char* s1b; unsigned char* s2b; bf16_t* merged;
    __device__ __forceinline__ void operator()(const f32x4 (&acc)[2][2][4][2], const UD& u, int wr, int wc, int fr, int fq, int tid) const {
        const int kind = u.kind;
        u32x4* s1 = (u32x4*)s1b + tid; u32x4* s2 = (u32x4*)(s2b + (size_t)(u.pm * 4 + u.pn) * 131072) + tid;
#pragma unroll
        for (int ai = 0; ai < 2; ++ai)
#pragma unroll
            for (int bj = 0; bj < 2; ++bj)
#pragma unroll
                for (int m = 0; m < 4; ++m) { const int slot = (ai * 2 + bj) * 4 + m; f32x4 v0 = acc[ai][bj][m][0], v1 = acc[ai][bj][m][1];
                    if (kind != 1) {
#pragma unroll
                        for (int j = 0; j < 4; ++j) { v0[j] = sigmoidf_(v0[j]); v1[j] = sigmoidf_(v1[j]); }
#ifdef DBG_S1_CONST
                        { const float cv = (float)(u.pm * 4 + u.pn + 1) * (1.0f / 512.0f); v0 = (f32x4){cv, cv, cv, cv}; v1 = v0; }
#endif
                        (kind == 0 ? s1 : s2)[slot * 512] = pack8(v0, v1);
                    } else {
                        f32x4 a0, a1; unpack8(__builtin_nontemporal_load(s1 + slot * 512), a0, a1);
#ifdef DBG_NO_S1
                        a0 = (f32x4){1.f, 1.f, 1.f, 1.f}; a1 = a0;
#endif
                        const size_t row = (size_t)u.pm * 256 + ai * 128 + wr * 64 + m * 16 + fr;
                        *(u32x4*)(merged + row * 1024 + u.pn * 256 + bj * 128 + wc * 32 + 8 * fq) = pack8(a0 * v0, a1 * v1);
#ifdef DBG_OUT_S1
                        *(u32x4*)(merged + row * 1024 + u.pn * 256 + bj * 128 + wc * 32 + 8 * fq) = pack8(a0, a1);
#endif
                    }
                    if (m & 1) asm volatile("" ::: "memory"); }
    }
};
struct EpiMerge2 {
    unsigned char* s2b; bf16_t* merged;
    __device__ __forceinline__ void operator()(const f32x4 (&acc)[2][2][4][2], const UD& u, int wr, int wc, int fr, int fq, int tid) const {
        const u32x4* s2 = (const u32x4*)(s2b + (size_t)(u.pm * 4 + u.pn) * 131072) + tid;
#pragma unroll
        for (int ai = 0; ai < 2; ++ai)
#pragma unroll
            for (int bj = 0; bj < 2; ++bj)
#pragma unroll
                for (int m = 0; m < 4; ++m) { const int slot = (ai * 2 + bj) * 4 + m;
                    const size_t row = (size_t)u.pm * 256 + ai * 128 + wr * 64 + m * 16 + fr;
                    u32x4* mp = (u32x4*)(merged + row * 1024 + u.pn * 256 + bj * 128 + wc * 32 + 8 * fq);
                    f32x4 a0, a1, b0, b1; unpack8(__builtin_nontemporal_load(mp), a0, a1); unpack8(__builtin_nontemporal_load(s2 + slot * 512), b0, b1);
#ifdef DBG_NO_S2
                    b0 = (f32x4){1.f, 1.f, 1.f, 1.f}; b1 = b0;
#endif
#ifdef DBG_NO_MRG
                    a0 = (f32x4){0.f, 0.f, 0.f, 0.f}; a1 = a0;
#endif
                    *mp = pack8(a0 + b0 * acc[ai][bj][m][0], a1 + b1 * acc[ai][bj][m][1]);
                    if (m & 1) asm volatile("" ::: "memory"); }
    }
};
struct EpiOut {
    bf16_t* xb;
    __device__ __forceinline__ void operator()(const f32x4 (&acc)[2][2][4][2], const UD& u, int wr, int wc, int fr, int fq, int tid) const {
#pragma unroll
        for (int ai = 0; ai < 2; ++ai)
#pragma unroll
            for (int m = 0; m < 4; ++m) { bf16_t* rowp = xb + ((size_t)u.pm * 256 + ai * 128 + wr * 64 + m * 16 + fr) * 1024 + u.pn * 256 + wc * 32 + 8 * fq;
#pragma unroll
                for (int bj = 0; bj < 2; ++bj) { u32x4* p = (u32x4*)(rowp + bj * 128); const u32x4 xv = *p; f32x4 v0 = acc[ai][bj][m][0], v1 = acc[ai][bj][m][1];
                    v0[0] += ALPHA * bf_lo(xv.x); v0[1] += ALPHA * bf_hi(xv.x); v0[2] += ALPHA * bf_lo(xv.y); v0[3] += ALPHA * bf_hi(xv.y);
                    v1[0] += ALPHA * bf_lo(xv.z); v1[1] += ALPHA * bf_hi(xv.z); v1[2] += ALPHA * bf_lo(xv.w); v1[3] += ALPHA * bf_hi(xv.w);
                    *p = pack8(v0, v1); } }
    }
};
struct EpiGU {
    bf16_t* he;
    __device__ __forceinline__ void operator()(const f32x4 (&acc)[2][2][4][2], const UD& u, int wr, int wc, int fr, int fq, int tid) const {
#pragma unroll
        for (int ai = 0; ai < 2; ++ai)
#pragma unroll
            for (int m = 0; m < 4; ++m) { bf16_t* rowp = he + ((size_t)u.pm * 256 + ai * 128 + wr * 64 + m * 16 + fr) * 512 + u.pn * 128 + wc * 16 + 4 * fq;
#pragma unroll
                for (int bj = 0; bj < 2; ++bj) { const f32x4 g = acc[ai][bj][m][0], up = acc[ai][bj][m][1]; f32x4 o;
#pragma unroll
                    for (int j = 0; j < 4; ++j) o[j] = g[j] * sigmoidf_(g[j]) * up[j];
                    u32x2 w; w.x = pk2(o[0], o[1]); w.y = pk2(o[2], o[3]); *(u32x2*)(rowp + bj * 64) = w; } }
    }
};
struct EpiBf16 {
    bf16_t* out; int ldc;
    __device__ __forceinline__ void operator()(const f32x4 (&acc)[2][2][4][2], const UD& u, int wr, int wc, int fr, int fq, int tid) const {
#pragma unroll
        for (int ai = 0; ai < 2; ++ai)
#pragma unroll
            for (int m = 0; m < 4; ++m) { bf16_t* rowp = out + ((size_t)u.pm * 256 + ai * 128 + wr * 64 + m * 16 + fr) * ldc + u.pn * 256 + wc * 32 + 8 * fq;
#pragma unroll
                for (int bj = 0; bj < 2; ++bj) *(u32x4*)(rowp + bj * 128) = pack8(acc[ai][bj][m][0], acc[ai][bj][m][1]); }
    }
};
struct EpiPro {
    unsigned char* wmix;
    __device__ __forceinline__ void operator()(const f32x4 (&acc)[2][2][4][2], const UD& u, int wr, int wc, int fr, int fq, int tid) const {
        const int l = u.aux >> 3, h = u.aux & 7, p = u.pn;
        bf16_t* base; int ldc; float sc;
        if (u.kind == 0) { base = (bf16_t*)(wmix + (size_t)l * WMIX_STRIDE + OFF_WIN) + (size_t)(2048 + 256 * h) * 1024 + 256 * p; ldc = 1024; sc = 0.08838834764831845f; }
        else { base = (bf16_t*)(wmix + (size_t)l * WMIX_STRIDE + OFF_WVO) + (size_t)(256 * p) * 2048 + 256 * h; ldc = 2048; sc = 1.f; }
#pragma unroll
        for (int ai = 0; ai < 2; ++ai)
#pragma unroll
            for (int m = 0; m < 4; ++m) { bf16_t* rowp = base + (size_t)(ai * 128 + wr * 64 + m * 16 + fr) * ldc + wc * 32 + 8 * fq;
#pragma unroll
                for (int bj = 0; bj < 2; ++bj) *(u32x4*)(rowp + bj * 128) = pack8(acc[ai][bj][m][0] * sc, acc[ai][bj][m][1] * sc); }
    }
};

struct SchedDense {
    const char* A; const char* B; unsigned lda, ldb; int nt, nM, nN, G, c;
    __device__ __forceinline__ bool next(int i, UD& u) const {
        int pm, pn; if (!gs::tile_of((long)i * G + c, nM, nN, pm, pn)) return false;
        u.A = A + (size_t)pm * 256 * lda; u.B = B + (size_t)pn * 256 * ldb; u.lda = lda; u.ldb = ldb; u.nt = nt; u.kind = 0; u.pm = pm; u.pn = pn; u.aux = 0; return true;
    }
};
struct SchedMerge1 {
    const char *xb, *yrnn, *wg, *wpr; int G, c;
    __device__ __forceinline__ bool next(int i_, UD& u) const { int i = i_;
#ifdef DBG_DUPFIRST
        if (i > 0) i -= 1;
#endif
#ifdef DBG_ORDER201
        const int ti = i / 3, kk_ = i - 3 * ti, k = kk_ == 0 ? 2 : kk_ - 1;
#else
        const int ti = i / 3, k = i - 3 * ti;
#endif
        int pm, pn; if (!gs::tile_of((long)ti * G + c, T / 256, 4, pm, pn)) return false;
        u.kind = k; u.pm = pm; u.pn = pn; u.aux = 0; u.lda = 2048; u.ldb = 2048; u.nt = 16;
#ifdef DBG_K0_AS_K1
        if (k == 0) { u.A = yrnn + (size_t)pm * 256 * 2048; u.B = wpr + (size_t)pn * 256 * 2048; }
#else
        if (k == 0) { u.A = xb + (size_t)pm * 256 * 2048; u.B = wg + (size_t)pn * 256 * 2048; }
#endif
        else if (k == 1) { u.A = yrnn + (size_t)pm * 256 * 2048; u.B = wpr + (size_t)pn * 256 * 2048; }
        else { u.A = xb + (size_t)pm * 256 * 2048; u.B = wg + (size_t)(1024 + pn * 256) * 2048; }
        return true;
    }
};
struct SchedMoE {
    const char* A; const char* B; unsigned lda, ldb; size_t bstride; int nt, nN, G, c; const LAS int* offp;
    __device__ __forceinline__ bool next(int i, UD& u) const {
        const int nM = offp[16] >> 8; int pm, pn; if (!gs::tile_of((long)i * G + c, nM, nN, pm, pn)) return false;
        int e = 0;
#pragma unroll 1
        for (int j = 1; j < 16; ++j) e += (pm * 256 >= offp[j]) ? 1 : 0;
        u.A = A + (size_t)pm * 256 * lda; u.B = B + (size_t)e * bstride + (size_t)pn * 256 * ldb; u.lda = lda; u.ldb = ldb; u.nt = nt; u.kind = 0; u.pm = pm; u.pn = pn; u.aux = e; return true;
    }
};
struct SchedMoEG {
    const char* A; const char* B; unsigned lda, ldb; size_t bstride; int nt, nN, G, c; const LAS int* offp; const int* rmap;
    __device__ __forceinline__ bool next(int i, UD& u) const {
        const int nM = offp[16] >> 8; int pm, pn; if (!gs::tile_of((long)i * G + c, nM, nN, pm, pn)) return false;
        int e = 0;
#pragma unroll 1
        for (int j = 1; j < 16; ++j) e += (pm * 256 >= offp[j]) ? 1 : 0;
        u.A = A; u.B = B + (size_t)e * bstride + (size_t)pn * 256 * ldb; u.lda = lda; u.ldb = ldb; u.nt = nt; u.kind = 0; u.pm = pm; u.pn = pn; u.aux = e; return true;
    }
};
struct SchedPro {
    const unsigned char* tmp; int G, c;
    __device__ __forceinline__ bool next(int i, UD& u) const {
        const long L = (long)i * G + c; if (L >= 256) return false;
        const int kind = (int)(L >> 7), l = (int)(L >> 5) & 3, h = (int)(L >> 2) & 7, p = (int)L & 3;
        u.kind = kind; u.aux = l * 8 + h; u.pm = 0; u.pn = p; u.nt = 4; u.lda = 2048; u.ldb = 2048;
        if (kind == 0) { u.A = (const char*)tmp + R_UKP + ((size_t)(l * 8 + h) * 256) * 2048;
                         u.B = (const char*)tmp + R_WQ + (size_t)l * 2 * MiB + (size_t)(256 * p) * 2048 + (size_t)(h >> 1) * 512; }
        else { u.A = (const char*)tmp + R_PT + (size_t)l * 2 * MiB + (size_t)(256 * p) * 2048 + (size_t)(h >> 1) * 512;
               u.B = (const char*)tmp + R_UVP + ((size_t)(l * 8 + h) * 256) * 2048; }
        return true;
    }
};

__device__ __forceinline__ void tr_item(const float* src, int ld, int c0, int nvalid, bf16_t* dst, int lddst, int mode, int item, int nblk, LAS float* scr, int lane) {
    const int kb = item / nblk, nb = item - kb * nblk, k0 = 64 * kb, n0 = 32 * nb;
    const int cc = 4 * (lane & 7); const bool ok = n0 + cc < nvalid;
    f32x4 tv_[8];
#pragma unroll
    for (int i = 0; i < 8; ++i) { const int kk = 8 * i + (lane >> 3); tv_[i] = ok ? *(const f32x4*)(src + (size_t)(k0 + kk) * ld + c0 + n0 + cc) : (f32x4){0.f, 0.f, 0.f, 0.f}; }
#pragma unroll
    for (int i = 0; i < 8; ++i) { const int kk = 8 * i + (lane >> 3);
#pragma unroll
        for (int j = 0; j < 4; ++j) scr[kk * 33 + cc + j] = tv_[i][j]; }
    asm volatile("s_waitcnt lgkmcnt(0)" ::: "memory");
    const int c = lane & 7;
#pragma unroll
    for (int j = 0; j < 4; ++j) { const int nl = (lane >> 3) + 8 * j; const int nn = n0 + nl; const int row = mode ? (8 * (nn >> 2) + (nn & 3)) : nn; const LAS float* s = scr + (8 * c) * 33 + nl;
        u32x4 o; o.x = pk2(s[0 * 33], s[1 * 33]); o.y = pk2(s[2 * 33], s[3 * 33]); o.z = pk2(s[4 * 33], s[5 * 33]); o.w = pk2(s[6 * 33], s[7 * 33]);
        *(u32x4*)(dst + (size_t)row * lddst + k0 + 8 * c) = o; }
    asm volatile("s_waitcnt lgkmcnt(0)" ::: "memory");
}
__device__ __forceinline__ float expm1_acc(float x) {
    if (x > -0.35f) { float p = 1.0f + x * (1.0f / 8.0f); p = 1.0f + x * (1.0f / 7.0f) * p; p = 1.0f + x * (1.0f / 6.0f) * p; p = 1.0f + x * (1.0f / 5.0f) * p; p = 1.0f + x * 0.25f * p; p = 1.0f + x * (1.0f / 3.0f) * p; p = 1.0f + x * 0.5f * p; return x * p; }
    return fast_exp(x) - 1.0f;
}
struct RnnP { const bf16_t* xrnn; bf16_t* gy; float* tot; const bf16_t *waT, *wxT; const float *convw, *convb, *ba, *bx, *lam; };
template <int PASS>
__device__ __forceinline__ void rnn_item(const RnnP& P, int item, LAS unsigned char* wlds, int lane) {
    const int b = item >> 10, g = (item >> 6) & 15, seg = item & 63, ch0 = 64 * g;
    const int row = lane & 15, kg = lane >> 4, col = lane & 15;
    LAS float* CW = (LAS float*)wlds;
    LAS float* XR = CW + 320;
#pragma unroll
    for (int k = 0; k < 4; ++k) CW[k * 64 + lane] = P.convw[k * 1024 + ch0 + lane];
    CW[256 + lane] = P.convb[ch0 + lane];
    bf16x8 Ba[4][2], Bx[4][2];
#pragma unroll
    for (int jt = 0; jt < 4; ++jt)
#pragma unroll
        for (int s = 0; s < 2; ++s) { const size_t o = ((size_t)g * 64 + 16 * jt + col) * 64 + 32 * s + 8 * kg; Ba[jt][s] = *(const bf16x8*)(P.waT + o); Bx[jt][s] = *(const bf16x8*)(P.wxT + o); }
    float cba[4], cbx[4], sp8[4], h0[4], Pc[4];
#pragma unroll
    for (int jt = 0; jt < 4; ++jt) { const int ch = ch0 + 16 * jt + col; cba[jt] = P.ba[ch]; cbx[jt] = P.bx[ch]; const float lm = P.lam[ch]; sp8[jt] = -8.0f * log1pf(expf(-lm)); h0[jt] = 0.f; Pc[jt] = 1.f; }
    float* totp = P.tot + ((size_t)(b * 64) * 1024 + ch0 + col) * 2;
    if (PASS == 2 && seg > 0) {
        const int Q = (seg + 3) >> 2, slo = kg * Q;
        float Pq[4] = {1.f, 1.f, 1.f, 1.f}, Hq[4] = {0.f, 0.f, 0.f, 0.f};
        for (int i0 = 0; i0 < Q; i0 += 4) {
            f32x2 ph[4][4];
#pragma unroll
            for (int i = 0; i < 4; ++i) { int s2 = slo + i0 + i; s2 = s2 < seg ? s2 : seg - 1;
#pragma unroll
                for (int jt = 0; jt < 4; ++jt) ph[i][jt] = *(const f32x2*)(totp + ((size_t)s2 * 1024 + 16 * jt) * 2); }
#pragma unroll
            for (int i = 0; i < 4; ++i) { const bool ok = (i0 + i < Q) && (slo + i0 + i < seg);
#pragma unroll
                for (int jt = 0; jt < 4; ++jt) { const float px = ok ? ph[i][jt].x : 1.f, hy = ok ? ph[i][jt].y : 0.f; Hq[jt] = px * Hq[jt] + hy; Pq[jt] = Pq[jt] * px; } }
        }
#pragma unroll
        for (int jt = 0; jt < 4; ++jt) {
            const float H0 = __shfl(Hq[jt], col), P1 = __shfl(Pq[jt], col + 16), H1 = __shfl(Hq[jt], col + 16), P2 = __shfl(Pq[jt], col + 32), H2 = __shfl(Hq[jt], col + 32),
                        P3 = __shfl(Pq[jt], col + 48), H3 = __shfl(Hq[jt], col + 48);
            float h = H0; h = P1 * h + H1; h = P2 * h + H2; h = P3 * h + H3; h0[jt] = h; }
    }
    asm volatile("s_waitcnt lgkmcnt(0)" ::: "memory");
    const size_t rowb = (size_t)b * SEQ;
    u32x4 xn[4][2];
    { const int tA0 = seg * 256 + row;
#pragma unroll
      for (int dt = 0; dt < 4; ++dt) { const int tt = tA0 - 3 + dt;
#pragma unroll
          for (int s = 0; s < 2; ++s) xn[dt][s] = (tt >= 0) ? *(const u32x4*)(P.xrnn + (rowb + tt) * 1024 + ch0 + 32 * s + 8 * kg) : (u32x4){0u, 0u, 0u, 0u}; } }
    for (int tile = 0; tile < 16; ++tile) {
        const int t0 = seg * 256 + tile * 16;
        u32x4 xw[4][2];
#pragma unroll
        for (int dt = 0; dt < 4; ++dt)
#pragma unroll
            for (int s = 0; s < 2; ++s) xw[dt][s] = xn[dt][s];
        if (tile + 1 < 16) { const int tB = t0 + 16 + row;
#pragma unroll
            for (int dt = 0; dt < 4; ++dt) { const int tt = tB - 3 + dt;
#pragma unroll
                for (int s = 0; s < 2; ++s) xn[dt][s] = *(const u32x4*)(P.xrnn + (rowb + tt) * 1024 + ch0 + 32 * s + 8 * kg); } }
        bf16_t gq[4][4];
        if (PASS == 2) { const bf16_t* gp0 = P.gy + (rowb + t0 + 4 * kg) * 1024 + ch0 + col;
#pragma unroll
            for (int jt = 0; jt < 4; ++jt)
#pragma unroll
                for (int r = 0; r < 4; ++r) gq[jt][r] = gp0[(size_t)r * 1024 + 16 * jt]; }
        bf16x8 Af[2];
#pragma unroll
        for (int s = 0; s < 2; ++s) {
            const int cl = 32 * s + 8 * kg;
            f32x4 o0 = *(LAS f32x4*)(CW + 256 + cl), o1 = *(LAS f32x4*)(CW + 256 + cl + 4);
#pragma unroll
            for (int dt = 0; dt < 4; ++dt) { const f32x4 w0 = *(LAS f32x4*)(CW + dt * 64 + cl), w1 = *(LAS f32x4*)(CW + dt * 64 + cl + 4); const u32x4 x = xw[dt][s];
                o0[0] += w0[0] * bf_lo(x.x); o0[1] += w0[1] * bf_hi(x.x); o0[2] += w0[2] * bf_lo(x.y); o0[3] += w0[3] * bf_hi(x.y);
                o1[0] += w1[0] * bf_lo(x.z); o1[1] += w1[1] * bf_hi(x.z); o1[2] += w1[2] * bf_lo(x.w); o1[3] += w1[3] * bf_hi(x.w); }
            *(LAS f32x4*)(XR + row * 68 + cl) = o0; *(LAS f32x4*)(XR + row * 68 + cl + 4) = o1;
            const u32x4 pk = pack8(o0, o1); Af[s] = __builtin_bit_cast(bf16x8, pk);
        }
        f32x4 ar[4], ax[4];
#pragma unroll
        for (int jt = 0; jt < 4; ++jt) { ar[jt] = (f32x4){0.f, 0.f, 0.f, 0.f}; ax[jt] = ar[jt];
#pragma unroll
            for (int s = 0; s < 2; ++s) { ar[jt] = __builtin_amdgcn_mfma_f32_16x16x32_bf16(Af[s], Ba[jt][s], ar[jt], 0, 0, 0); ax[jt] = __builtin_amdgcn_mfma_f32_16x16x32_bf16(Af[s], Bx[jt][s], ax[jt], 0, 0, 0); } }
        asm volatile("s_waitcnt lgkmcnt(0)" ::: "memory");
#pragma unroll
        for (int jt = 0; jt < 4; ++jt) {
            float Pp[4], Hp[4]; float pr = 1.f, hr = 0.f;
#pragma unroll
            for (int r = 0; r < 4; ++r) {
                const float xr = XR[(4 * kg + r) * 68 + 16 * jt + col];
                const float rg = sigmoidf_(ar[jt][r] + cba[jt]), ig = sigmoidf_(ax[jt][r] + cbx[jt]);
                const float la = sp8[jt] * rg; const float em = expm1_acc(la); const float a = 1.0f + em;
                const float mm = __builtin_amdgcn_sqrtf(fmaxf(-em * (2.0f + em), 0.f));
                const float uu = mm * ig * xr;
                hr = a * hr + uu; pr = pr * a; Pp[r] = pr; Hp[r] = hr;
            }
            const float P0 = __shfl(pr, col), P1 = __shfl(pr, col + 16), P2 = __shfl(pr, col + 32), P3 = __shfl(pr, col + 48);
            const float H0 = __shfl(hr, col), H1 = __shfl(hr, col + 16), H2 = __shfl(hr, col + 32), H3 = __shfl(hr, col + 48);
            const float h1 = P0 * h0[jt] + H0, h2 = P1 * h1 + H1, h3 = P2 * h2 + H2, h4 = P3 * h3 + H3;
            if (PASS == 2) {
                const float hs = kg == 0 ? h0[jt] : (kg == 1 ? h1 : (kg == 2 ? h2 : h3));
                bf16_t* gp = P.gy + (rowb + t0 + 4 * kg) * 1024 + ch0 + 16 * jt + col;
#pragma unroll
                for (int r = 0; r < 4; ++r) { const float hv = Pp[r] * hs + Hp[r]; const float gg = bf2f(gq[jt][r]); gp[(size_t)r * 1024] = (bf16_t)f2bf(hv * gg); }
            } else Pc[jt] = Pc[jt] * (P0 * P1) * (P2 * P3);
            h0[jt] = h4;
        }
    }
    if (PASS == 1 && kg == 0) {
#pragma unroll
        for (int jt = 0; jt < 4; ++jt) *(f32x2*)(totp + ((size_t)seg * 1024 + 16 * jt) * 2) = (f32x2){Pc[jt], h0[jt]};
    }
}
__device__ __forceinline__ void ckv_norm_rows4(bf16_t* base, int row0, int rstep, int nrows, const float* gain, int lane) {
    u32x2 w[4];
#pragma unroll
    for (int i = 0; i < 4; ++i) { const int r = row0 + i * rstep; w[i] = *(const u32x2*)(base + (size_t)(r < nrows ? r : row0) * 256 + 4 * lane); }
    const f32x4 gn = *(const f32x4*)(gain + 4 * lane);
#pragma unroll
    for (int i = 0; i < 4; ++i) { const int r = row0 + i * rstep;
        const float v0 = bf_lo(w[i].x), v1 = bf_hi(w[i].x), v2 = bf_lo(w[i].y), v3 = bf_hi(w[i].y);
        const float ss = wave_sum(v0 * v0 + v1 * v1 + v2 * v2 + v3 * v3);
        const float rs = 1.0f / __builtin_sqrtf(ss * (1.0f / 256.0f) + RMS_EPS);
        u32x2 o; o.x = pk2(v0 * rs * gn[0], v1 * rs * gn[1]); o.y = pk2(v2 * rs * gn[2], v3 * rs * gn[3]);
        if (r < nrows) *(u32x2*)(base + (size_t)r * 256 + 4 * lane) = o; }
}
constexpr int AT_CAND = 0, AT_KBUF = 65536, AT_KROW = 144, AT_KCH = 256 * AT_KROW, AT_SEL = 139264, AT_BIAS = 155648, AT_BKT = 156672, AT_GROW = 544, AT_GBUF = 32 * AT_GROW;
constexpr int AT_NBIN = 512, AT_CAP = 256, AT_LCAP = 1024, AT_TIEF = 157184, AT_BIAS2 = 157440;
#ifndef AT_SAMPLE_MIN_U
#define AT_SAMPLE_MIN_U 64
#endif
#ifndef AT_LBREF
#define AT_LBREF 0
#endif
struct AttnP { const bf16_t *qidx, *kidx, *ckv; const float* widx; bf16_t* qlat; unsigned long long* cbuf; };

__device__ __forceinline__ unsigned ord_key(float s) { const unsigned b = __builtin_bit_cast(unsigned, s); return (b & 0x80000000u) ? ~b : (b | 0x80000000u); }

__device__ __forceinline__ void hist_scan(const LAS unsigned* hq, int lane, int kth, int& bsel, int& cat, int& abat) {
    const u32x4 w0 = *(const LAS u32x4*)(hq + 8 * lane), w1 = *(const LAS u32x4*)(hq + 8 * lane + 4);
    int cnt[8];
    cnt[0] = (int)w0.x; cnt[1] = (int)w0.y; cnt[2] = (int)w0.z; cnt[3] = (int)w0.w; cnt[4] = (int)w1.x; cnt[5] = (int)w1.y; cnt[6] = (int)w1.z; cnt[7] = (int)w1.w;
    int s = 0;
#pragma unroll
    for (int i = 0; i < 8; ++i) s += cnt[i];
    int S = s;
#pragma unroll
    for (int off = 1; off < 64; off <<= 1) { const int v = __shfl_down(S, off); if (lane + off < 64) S += v; }
    bsel = -1; cat = 0; abat = 0;
    const unsigned long long mk = __ballot(S >= kth);
    if (mk != 0ull) {
        const int Ls = 63 - __builtin_clzll(mk);
        int above = S - s; bool found = false;
#pragma unroll
        for (int bb = 7; bb >= 0; --bb) { const int c = cnt[bb]; if (!found && above + c >= kth) { bsel = 8 * lane + bb; cat = c; abat = above; found = true; } above += c; }
        bsel = __shfl(bsel, Ls); cat = __shfl(cat, Ls); abat = __shfl(abat, Ls);
    }
}
__device__ __forceinline__ int key_row(int r, bool sm, int u) { if (sm) { r = r * 8 + (u & 7); r = r < SEQ ? r : SEQ - 1; } return r; }
template <int MODE>
__device__ __forceinline__ void attn_pass(LAS unsigned char* lds, const bf16x8 (&afr)[4], const float (&wq)[2][9], const bf16_t* kbase, int u, int wave, int lane, int tid,
                                          const int (&b0e)[2], const int (&neede)[2], const int (&tiee)[2], int (&csel)[2], int (&ccand)[2], unsigned long long* cbw, int samp = 0) {
    const int hh = lane >> 5, kcol = lane & 31;
    LAS unsigned* HIST = (LAS unsigned*)lds; LAS unsigned long long* CAND = (LAS unsigned long long*)(lds + AT_CAND); LAS unsigned short* SEL = (LAS unsigned short*)(lds + AT_SEL);
    const bool sm = (MODE == 0) && (samp != 0);
    const int nst = u >> 3, nch = sm ? ((nst + 7) >> 3) : (u >> 3) + 1;
    float lbt[2];
#pragma unroll
    for (int e = 0; e < 2; ++e) lbt[e] = ((MODE == 1 || MODE == 3) && b0e[e] >= 1) ? (float)b0e[e] : -3.0e38f;
    u32x4 st[4];
    const int lofs = (tid >> 3) * AT_KROW + (tid & 7) * 16;
#define AT_KADDR(C, I) (kbase + (size_t)key_row((C) * 256 + (tid >> 3) + 64 * (I), sm, u) * 64 + (tid & 7) * 8)
#pragma unroll
    for (int i = 0; i < 4; ++i) st[i] = *(const u32x4*)AT_KADDR(0, i);
#pragma unroll
    for (int i = 0; i < 4; ++i) *(LAS u32x4*)(lds + AT_KBUF + lofs + i * 64 * AT_KROW) = st[i];
    __syncthreads();
    for (int c = 0; c < nch; ++c) {
        if (c + 1 < nch) {
#pragma unroll
            for (int i = 0; i < 4; ++i) st[i] = *(const u32x4*)AT_KADDR(c + 1, i);
        }
        const LAS unsigned char* kb = lds + AT_KBUF + (c & 1) * AT_KCH + kcol * AT_KROW + hh * 16;
        const int ntile = sm ? ((nst - 8 * c) < 8 ? (nst - 8 * c) : 8) : ((c + 1 < nch) ? 8 : (u & 7) + 1);
#define AT_READ(BF, TT) do { _Pragma("unroll") for (int ks = 0; ks < 4; ++ks) BF[ks] = *(const LAS bf16x8*)(kb + (TT) * 32 * AT_KROW + ks * 32); } while (0)
#define AT_MFMA(ACC, BF) do { _Pragma("unroll") for (int i_ = 0; i_ < 16; ++i_) ACC[i_] = 0.f; \
            _Pragma("unroll") for (int ks = 0; ks < 4; ++ks) ACC = __builtin_amdgcn_mfma_f32_32x32x16_bf16(afr[ks], BF[ks], ACC, 0, 0, 0); } while (0)
          \

#define AT_POST(ACC, KT, DIAG) do { const int kt = (KT); \
            float sc[2]; \
            _Pragma("unroll") for (int e = 0; e < 2; ++e) { float s = 0.f; \
                _Pragma("unroll") for (int i = 0; i < 8; ++i) s = __builtin_fmaf(wq[e][i], __builtin_amdgcn_fmed3f(ACC[8 * e + i], 0.f, 3.0e38f), s); \
                sc[e] = s; } \
            _Pragma("unroll") for (int e = 0; e < 2; ++e) { \
                const int q = 4 * wave + 2 * hh + e; \
                const float tv = __builtin_fmaf(sc[e], wq[e][8], 256.0f); \
                const bool cz = !(DIAG) || (kt < u) || (kcol <= q); \
                const bool live = cz && tv >= lbt[e]; \
                if (MODE == 3) { \
                    const unsigned long long m3 = __ballot(live); \
                    { \
                        const unsigned h3 = hh ? (unsigned)(m3 >> 32) : (unsigned)m3; \
                        const int pa = ccand[e] + __builtin_popcount(h3 & ((1u << kcol) - 1u)); \
                        if (live) { u32x2 ent;      \
                             ent.x = (unsigned)(kt * 32 + kcol); ent.y = __builtin_bit_cast(unsigned, sc[e]); \
                            *(u32x2*)((char*)cbw + ((unsigned)((2 * hh + e) * AT_LCAP + pa) * 8u)) = ent; } \
                        ccand[e] += __builtin_popcount(h3); \
                    } \
                } else if (MODE == 0) { \
                    const int bin = (int)__builtin_amdgcn_fmed3f(tv, 0.0f, 511.5f); \
                    LAS unsigned* hp = HIST + q * AT_NBIN + bin; \
                    if (cz) __hip_atomic_fetch_add(hp, 1u, __ATOMIC_RELAXED, __HIP_MEMORY_SCOPE_WORKGROUP); \
                } else if (__ballot(live) != 0ull) { \
                    const int bin = (int)__builtin_amdgcn_fmed3f(tv, 0.0f, 511.5f); \
                    const int key = kt * 32 + kcol; \
                    const bool cc = live && bin == b0e[e]; \
                    const unsigned long long m2 = __ballot(cc); const unsigned h2 = hh ? (unsigned)(m2 >> 32) : (unsigned)m2; \
                    const int pc = ccand[e] + __builtin_popcount(h2 & ((1u << kcol) - 1u)); \
                    if (cc && !tiee[e] && pc < AT_CAP) CAND[q * AT_CAP + pc] = ((unsigned long long)ord_key(sc[e]) << 32) | (unsigned)(0xFFFFu - key); \
                    ccand[e] += __builtin_popcount(h2); \
                    const bool cs = live && (bin > b0e[e] || (tiee[e] && cc && pc < neede[e])); \
                    const unsigned long long m1 = __ballot(cs); const unsigned h1 = hh ? (unsigned)(m1 >> 32) : (unsigned)m1; \
                    if (cs) SEL[q * 256 + csel[e] + __builtin_popcount(h1 & ((1u << kcol) - 1u))] = (unsigned short)key; \
                    csel[e] += __builtin_popcount(h1); \
                } \
            } } while (0)
#define AT_TILES(NT, DIAG, PRAG) do { \
        AT_READ(B0, 0); if ((NT) > 1) AT_READ(B1, 1); \
        AT_MFMA(accA, B0); \
        PRAG for (int tt = 0; tt < (NT); tt += 2) { \
            if (tt + 2 < (NT)) AT_READ(B0, tt + 2); \
            if (tt + 1 < (NT)) AT_MFMA(accB, B1); \
            AT_POST(accA, c * 8 + tt, DIAG); \
            if (tt + 1 < (NT)) { \
                if (tt + 3 < (NT)) AT_READ(B1, tt + 3); \
                if (tt + 2 < (NT)) AT_MFMA(accA, B0); \
                AT_POST(accB, c * 8 + tt + 1, DIAG); \
            } \
        } } while (0)
        f32x16 accA, accB; bf16x8 B0[4], B1[4];
        if (sm ? (ntile == 8) : (c + 1 < nch)) AT_TILES(8, false, _Pragma("unroll"));
        else AT_TILES(ntile, true, _Pragma("unroll 1"));
#undef AT_TILES
#undef AT_POST
#undef AT_KADDR
#undef AT_READ
#undef AT_MFMA
        if (MODE == 0 && AT_LBREF && c + 1 < nch && (c < 4 || (c & 3) == 3)) {
#pragma unroll
            for (int q = 0; q < 4; ++q) { int bs, c1, c2; hist_scan(HIST + (4 * wave + q) * AT_NBIN, lane, 256, bs, c1, c2);
                const float lb = bs >= 1 ? (float)bs : -3.0e38f;
                if ((q >> 1) == hh) lbt[q & 1] = lb; }
        }
        if (c + 1 < nch) {
#pragma unroll
            for (int i = 0; i < 4; ++i) *(LAS u32x4*)(lds + AT_KBUF + ((c + 1) & 1) * AT_KCH + lofs + i * 64 * AT_KROW) = st[i];
        }
        __syncthreads();
    }
}

__device__ __forceinline__ void attn_unit(LAS unsigned char* lds, const AttnP& P, int b, int u, int tid_) {
    int tid = tid_; asm volatile("" : "+v"(tid));
    const int wave = __builtin_amdgcn_readfirstlane(tid >> 6), lane = tid & 63, hh = lane >> 5, kcol = lane & 31;
    LAS unsigned* HIST = (LAS unsigned*)lds; LAS unsigned long long* CAND = (LAS unsigned long long*)(lds + AT_CAND); LAS unsigned short* SEL = (LAS unsigned short*)(lds + AT_SEL);
    const LAS float* BIAS2 = (const LAS float*)(lds + AT_BIAS2);
    const int t0 = 32 * u; const size_t rowb = (size_t)b * SEQ;
    __syncthreads();
#pragma unroll
    for (int i = 0; i < 8; ++i) *(LAS u32x4*)(lds + (i * 512 + tid) * 16) = (u32x4){0u, 0u, 0u, 0u};
    if (tid == 0) *(LAS unsigned*)(lds + AT_TIEF) = 0u;
    bf16x8 afr[4]; float wq[2][9];
    { const int rho = kcol, j = rho >> 3, r = rho & 3, hq = (rho >> 2) & 1, head = 4 * (j & 1) + r, qloc = 2 * hq + (j >> 1);
      const bf16_t* qp = P.qidx + (rowb + t0 + 4 * wave + qloc) * 512 + head * 64 + 8 * hh;
#pragma unroll
      for (int ks = 0; ks < 4; ++ks) afr[ks] = *(const bf16x8*)(qp + ks * 16);
#pragma unroll
      for (int e = 0; e < 2; ++e) { const float* wp = P.widx + (rowb + t0 + 4 * wave + 2 * hh + e) * 8; const f32x4 a = *(const f32x4*)wp, c = *(const f32x4*)(wp + 4);
          wq[e][0] = a[0]; wq[e][1] = a[1]; wq[e][2] = a[2]; wq[e][3] = a[3]; wq[e][4] = c[0]; wq[e][5] = c[1]; wq[e][6] = c[2]; wq[e][7] = c[3];
          const float ss = (a[0] * a[0] + a[1] * a[1]) + (a[2] * a[2] + a[3] * a[3]) + (c[0] * c[0] + c[1] * c[1]) + (c[2] * c[2] + c[3] * c[3]);
          wq[e][8] = 32.0f / __builtin_sqrtf(fmaxf(ss, 1.0e-12f)); } }
    const bf16_t* kbase = P.kidx + rowb * 64;
    int b0e[2] = {0, 0}, neede[2] = {0, 0}, tiee[2] = {0, 0}, csel[2] = {0, 0}, ccand[2] = {0, 0};
    int b0q[4], needq[4], nb0q[4], csq[4];
    unsigned long long* cbw = P.cbuf + (size_t)(4 * wave) * AT_LCAP;
#pragma unroll 1
    for (int att = (u >= AT_SAMPLE_MIN_U) ? 0 : 1; att < 2; ++att) {
        int tl = tid; asm volatile("" : "+v"(tl));
        const int ll = tl & 63, hl = ll >> 5;
        if (att == 1 && u >= AT_SAMPLE_MIN_U) {
            __syncthreads();
#pragma unroll
            for (int i = 0; i < 8; ++i) *(LAS u32x4*)(lds + (i * 512 + tl) * 16) = (u32x4){0u, 0u, 0u, 0u};
            if (tl == 0) *(LAS unsigned*)(lds + AT_TIEF) = 0u;
        }
        csel[0] = 0; csel[1] = 0; ccand[0] = 0; ccand[1] = 0;
        attn_pass<0>(lds, afr, wq, kbase, u, wave, ll, tl, b0e, neede, tiee, csel, ccand, nullptr, att == 0 ? 1 : 0);
        const int kth = att == 0 ? 64 : 256;
#pragma unroll
        for (int q = 0; q < 4; ++q) {
            const int nq = t0 + 4 * wave + q + 1;
            int bsel, cat, abat; hist_scan(HIST + (4 * wave + q) * AT_NBIN, ll, kth, bsel, cat, abat);
            if (att == 1 && nq <= 256) { bsel = -1; cat = 0; abat = 0; }
            b0q[q] = bsel; nb0q[q] = cat; needq[q] = (nq > 256) ? (256 - abat) : 0;
        }
        b0e[0] = hl ? b0q[2] : b0q[0]; b0e[1] = hl ? b0q[3] : b0q[1];
        neede[0] = hl ? needq[2] : needq[0]; neede[1] = hl ? needq[3] : needq[1];
        tiee[0] = (att == 1) && ((hl ? nb0q[2] : nb0q[0]) > AT_CAP); tiee[1] = (att == 1) && ((hl ? nb0q[3] : nb0q[1]) > AT_CAP);
        if ((tiee[0] | tiee[1]) != 0) *(LAS unsigned*)(lds + AT_TIEF) = 1u;
        __syncthreads();
        if (att == 1 && *(const LAS unsigned*)(lds + AT_TIEF) != 0u) {
            attn_pass<1>(lds, afr, wq, kbase, u, wave, ll, tl, b0e, neede, tiee, csel, ccand, cbw);
#pragma unroll
            for (int q = 0; q < 4; ++q) { const int cv = (q & 1) ? csel[1] : csel[0]; csq[q] = __builtin_amdgcn_readlane(cv, (q >> 1) * 32); }
            break;
        }
        if (att == 0) {
#pragma unroll
            for (int i = 0; i < 8; ++i) *(LAS u32x4*)(lds + wave * 8192 + (i * 64 + ll) * 16) = (u32x4){0u, 0u, 0u, 0u};
        }
        attn_pass<3>(lds, afr, wq, kbase, u, wave, ll, tl, b0e, neede, tiee, csel, ccand, cbw);
        asm volatile("s_waitcnt vmcnt(0)" ::: "memory");
        if (att == 0) {
            bool ok = true;
#pragma unroll
            for (int q = 0; q < 4; ++q) {
                const int cv = (q & 1) ? ccand[1] : ccand[0]; const int nraw = __builtin_amdgcn_readlane(cv, (q >> 1) * 32); ok = ok && nraw >= 256 && nraw <= AT_LCAP;
                const int n = nraw > AT_LCAP ? AT_LCAP : nraw;
                const float scl = (q & 2) ? __shfl(wq[q & 1][8], 32) : __shfl(wq[q & 1][8], 0);
#pragma unroll
                for (int jb = 0; jb < AT_LCAP / 256; ++jb) {
                    if (256 * jb < n) {
                        unsigned long long ent[4];
#pragma unroll
                        for (int j = 0; j < 4; ++j) { const int i = 256 * jb + 64 * j + ll; ent[j] = (i < n) ? __builtin_nontemporal_load(cbw + q * AT_LCAP + i) : 0ull; }
#pragma unroll
                        for (int j = 0; j < 4; ++j) { const int i = 256 * jb + 64 * j + ll; const float scv = __builtin_bit_cast(float, (unsigned)(ent[j] >> 32));
                            const int bin = (int)__builtin_amdgcn_fmed3f(__builtin_fmaf(scv, scl, 256.0f), 0.0f, 511.5f);
                            if (i < n) __hip_atomic_fetch_add(HIST + (4 * wave + q) * AT_NBIN + bin, 1u, __ATOMIC_RELAXED, __HIP_MEMORY_SCOPE_WORKGROUP); }
                    }
                }
            }
            asm volatile("s_waitcnt lgkmcnt(0)" ::: "memory");
#pragma unroll
            for (int q = 0; q < 4; ++q) {
                int bsel, cat, abat; hist_scan(HIST + (4 * wave + q) * AT_NBIN, ll, 256, bsel, cat, abat);
                ok = ok && bsel >= 0;
                b0q[q] = bsel; nb0q[q] = cat; needq[q] = 256 - abat;
            }
            if (!ok) *(LAS unsigned*)(lds + AT_TIEF) = 1u;
            __syncthreads();
            if (*(const LAS unsigned*)(lds + AT_TIEF) != 0u) continue;
        }
#pragma unroll
        for (int q = 0; q < 4; ++q) {
            const int cv = (q & 1) ? ccand[1] : ccand[0]; int n = __builtin_amdgcn_readlane(cv, (q >> 1) * 32); n = n > AT_LCAP ? AT_LCAP : n;
            const int b0 = b0q[q], need = needq[q]; const bool tieq = nb0q[q] > AT_CAP;
            const float scl = (q & 2) ? __shfl(wq[q & 1][8], 32) : __shfl(wq[q & 1][8], 0);
            int cs = 0, cc = 0;
#pragma unroll
            for (int jb = 0; jb < AT_LCAP / 256; ++jb) {
                if (256 * jb < n) {
                    unsigned long long ent[4];
#pragma unroll
                    for (int j = 0; j < 4; ++j) { const int i = 256 * jb + 64 * j + ll; ent[j] = (i < n) ? __builtin_nontemporal_load(cbw + q * AT_LCAP + i) : 0ull; }
#pragma unroll
                    for (int j = 0; j < 4; ++j) {
                        const unsigned long long v = ent[j]; const bool in = 256 * jb + 64 * j + ll < n;
                        const float scv = __builtin_bit_cast(float, (unsigned)(v >> 32));
                        const int bin = (int)__builtin_amdgcn_fmed3f(__builtin_fmaf(scv, scl, 256.0f), 0.0f, 511.5f);
                        const bool isc = in && bin == b0;
                        const unsigned long long mc = __ballot(isc);
                        const int pc = cc + __builtin_popcountll(mc & ((1ull << ll) - 1ull));
                        const bool isa = in && (bin > b0 || (tieq && isc && pc < need));
                        const unsigned long long ms = __ballot(isa);
                        if (isa) SEL[(4 * wave + q) * 256 + cs + __builtin_popcountll(ms & ((1ull << ll) - 1ull))] = (unsigned short)(v & 0xFFFFu);
                        if (isc && !tieq && pc < AT_CAP) CAND[(4 * wave + q) * AT_CAP + pc] = ((unsigned long long)ord_key(scv) << 32) | (unsigned)(0xFFFFu - (unsigned)(v & 0xFFFFu));
                        cs += __builtin_popcountll(ms); cc += __builtin_popcountll(mc);
                    }
                }
            }
            csq[q] = cs;
            asm volatile("" ::: "memory");
        }
        break;
    }
    int nselq[4];
#pragma unroll
    for (int q = 0; q < 4; ++q) {
        int cs = csq[q];
        const int need = needq[q], nb0 = nb0q[q];
        if (need > 0 && nb0 <= AT_CAP) {
            const int nc = nb0;
            const LAS unsigned long long* cq = CAND + (4 * wave + q) * AT_CAP;
            for (int i0 = 0; i0 < nc; i0 += 64) {
                const int i = i0 + lane; const unsigned long long mine = (i < nc) ? cq[i] : 0ull;
                int rank = 0; for (int j = 0; j < nc; ++j) rank += (cq[j] > mine) ? 1 : 0;
                const bool pick = (i < nc) && rank < need;
                const unsigned long long mk = __ballot(pick);
                if (pick) SEL[(4 * wave + q) * 256 + cs + __builtin_popcountll(mk & ((1ull << lane) - 1ull))] = (unsigned short)(0xFFFFu - (unsigned)(mine & 0xFFFFu));
                cs += __builtin_popcountll(mk);
            }
        }
        nselq[q] = cs;
    }
    asm volatile("s_waitcnt lgkmcnt(0)" ::: "memory");
#ifdef DBG_TIME_ATT
    if (tid == 0) { const unsigned tn_ = (unsigned)__builtin_amdgcn_s_memrealtime(); ((LAS unsigned*)(lds + LDS_MISC))[19] += tn_ - tk0; tk0 = tn_; }
#endif
    __syncthreads();
    LAS unsigned char* gb = lds + wave * AT_GBUF;
    const int n = lane & 15, kg = lane >> 4, head = n & 7;
#pragma unroll 1
    for (int qi = 0; qi < 4; ++qi) {
        const int q = 4 * wave + qi, t = t0 + q;
        const int nsel = qi == 0 ? nselq[0] : (qi == 1 ? nselq[1] : (qi == 2 ? nselq[2] : nselq[3]));
        const LAS unsigned short* sel = SEL + q * 256;
        bf16_t* qrow = P.qlat + (rowb + t) * 2048;
        bf16x8 qb[8];
#pragma unroll
        for (int ks = 0; ks < 8; ++ks) { qb[ks] = (bf16x8){0, 0, 0, 0, 0, 0, 0, 0}; if (n < 8) qb[ks] = *(const bf16x8*)(qrow + n * 256 + 32 * ks + 8 * kg); }
        f32x4 oacc[16];
#pragma unroll
        for (int mt = 0; mt < 16; ++mt) oacc[mt] = (f32x4){0.f, 0.f, 0.f, 0.f};
        float mrun = -1e30f, lrun = 0.f;
        const int nchunk = (nsel + 31) >> 5;
#pragma unroll 1
        for (int c = 0; c < nchunk; ++c) {
            const int jn = 32 * c + kcol; const int idxc = (jn < nsel) ? (int)sel[jn] : 0;
            { u32x4 pre[16];
              const unsigned offc = ((unsigned)rowb + (unsigned)idxc) * 512u;
#pragma unroll
              for (int i = 0; i < 16; ++i) { const unsigned o0 = (unsigned)__builtin_amdgcn_readlane((int)offc, 2 * i), o1 = (unsigned)__builtin_amdgcn_readlane((int)offc, 2 * i + 1);
                  pre[i] = *(const u32x4*)((const char*)P.ckv + ((hh ? o1 : o0) + (unsigned)kcol * 16u)); }
#pragma unroll
              for (int i = 0; i < 16; ++i) *(LAS u32x4*)(gb + (2 * i + hh) * AT_GROW + kcol * 16) = pre[i];
            }
            f32x4 st[2];
#pragma unroll
            for (int k2 = 0; k2 < 2; ++k2) { st[k2] = (f32x4){0.f, 0.f, 0.f, 0.f};
#pragma unroll
                for (int ks = 0; ks < 8; ++ks) { const bf16x8 a = *(const LAS bf16x8*)(gb + (16 * k2 + n) * AT_GROW + (32 * ks + 8 * kg) * 2); st[k2] = __builtin_amdgcn_mfma_f32_16x16x32_bf16(a, qb[ks], st[k2], 0, 0, 0); } }
            float mloc = -1e30f;
#pragma unroll
            for (int k2 = 0; k2 < 2; ++k2)
#pragma unroll
                for (int r = 0; r < 4; ++r) { const int jj = 16 * k2 + 4 * kg + r; const int idx = (32 * c + jj < nsel) ? (int)sel[32 * c + jj] : 0; int d = t - idx; d = d < 127 ? d : 127;
                    float lg = st[k2][r] + BIAS2[d * 8 + head]; if (32 * c + jj >= nsel) lg = -1e30f;
                    st[k2][r] = lg; mloc = fmaxf(mloc, lg); }
            if (c == 0) { mloc = fmaxf(mloc, __shfl_xor(mloc, 16)); mloc = fmaxf(mloc, __shfl_xor(mloc, 32)); mrun = mloc; }
            else if (__ballot(mloc > mrun + 60.0f) != 0ull) {
                mloc = fmaxf(mloc, __shfl_xor(mloc, 16)); mloc = fmaxf(mloc, __shfl_xor(mloc, 32));
                const float mnew = fmaxf(mrun, mloc), alpha = fast_exp(mrun - mnew);
                lrun = lrun * alpha; mrun = mnew;
#pragma unroll
                for (int mt = 0; mt < 16; ++mt) oacc[mt] = oacc[mt] * alpha;
            }
#pragma unroll
            for (int k2 = 0; k2 < 2; ++k2)
#pragma unroll
                for (int r = 0; r < 4; ++r) { const float p = fast_exp(st[k2][r] - mrun); st[k2][r] = p; lrun += p; }
            u32x4 pw; pw.x = pk2(st[0][0], st[0][1]); pw.y = pk2(st[0][2], st[0][3]); pw.z = pk2(st[1][0], st[1][1]); pw.w = pk2(st[1][2], st[1][3]);
            const bf16x8 pb = __builtin_bit_cast(bf16x8, pw);
            LAS unsigned char* tb = gb + (4 * kg + (n >> 2)) * AT_GROW + 8 * (n & 3);
#pragma unroll
            for (int mt = 0; mt < 16; ++mt) {
                const s16x4 v1 = __builtin_amdgcn_ds_read_tr16_b64_v4i16((LAS s16x4*)(tb + 32 * mt));
                const s16x4 v2 = __builtin_amdgcn_ds_read_tr16_b64_v4i16((LAS s16x4*)(tb + 16 * AT_GROW + 32 * mt));
                const bf16x8 av = (bf16x8){v1[0], v1[1], v1[2], v1[3], v2[0], v2[1], v2[2], v2[3]};
                oacc[mt] = __builtin_amdgcn_mfma_f32_16x16x32_bf16(av, pb, oacc[mt], 0, 0, 0);
            }
        }
        lrun += __shfl_xor(lrun, 16); lrun += __shfl_xor(lrun, 32);
        const float inv = 1.0f / lrun;
        if (n < 8) {
#pragma unroll
            for (int mt = 0; mt < 16; ++mt) { const f32x4 o = oacc[mt] * inv; u32x2 w; w.x = pk2(o[0], o[1]); w.y = pk2(o[2], o[3]); *(u32x2*)(qrow + n * 256 + 16 * mt + 4 * kg) = w; }
        }
    }
#ifdef DBG_TIME_ATT
    if (tid == 0) { const unsigned tn_ = (unsigned)__builtin_amdgcn_s_memrealtime(); ((LAS unsigned*)(lds + LDS_MISC))[20] += tn_ - tk0; tk0 = tn_; }
#endif
}
__device__ __forceinline__ void ln_finish(f32x4 (&v)[4], const float* gam, const float* bet, float* orow, bf16_t* brow, int lane) {
    float s = 0.f;
#pragma unroll
    for (int j = 0; j < 4; ++j) s += (v[j][0] + v[j][1]) + (v[j][2] + v[j][3]);
    const float mean = wave_sum(s) * (1.0f / 1024.0f); float s2 = 0.f;
#pragma unroll
    for (int j = 0; j < 4; ++j) { v[j] = v[j] - mean; s2 += (v[j][0] * v[j][0] + v[j][1] * v[j][1]) + (v[j][2] * v[j][2] + v[j][3] * v[j][3]); }
    const float rstd = 1.0f / __builtin_sqrtf(wave_sum(s2) * (1.0f / 1024.0f) + LN_EPS);
#pragma unroll
    for (int j = 0; j < 4; ++j) { const f32x4 g = *(const f32x4*)(gam + 256 * j + 4 * lane), bb = *(const f32x4*)(bet + 256 * j + 4 * lane);
        v[j] = v[j] * rstd * g + bb;
        if (orow != nullptr) *(f32x4*)(orow + 256 * j + 4 * lane) = v[j];
        u32x2 w; w.x = pk2(v[j][0], v[j][1]); w.y = pk2(v[j][2], v[j][3]); *(u32x2*)(brow + 256 * j + 4 * lane) = w; }
}
struct RouteP { int* r_e; int* r_pos; int* r_slot; float* r_g; unsigned* gcnt; };

__device__ __forceinline__ void ln1_route_block(LAS unsigned char* lds, int blk, float* xo, bf16_t* xb, const float* gam, const float* bet, const float* rbias, const RouteP& R, int tid) {
    const int wave = __builtin_amdgcn_readfirstlane(tid >> 6), lane = tid & 63;
    const LAS float* WR = (const LAS float*)lds; LAS int* lcnt = (LAS int*)(lds + 65536); LAS int* basee = (LAS int*)(lds + 65600); LAS int* tok = (LAS int*)(lds + 65664);
    __syncthreads();
    if (tid < 16) lcnt[tid] = 0;
    __syncthreads();
    u32x2 wn[4];
#pragma unroll
    for (int j = 0; j < 4; ++j) wn[j] = *(const u32x2*)(xb + ((size_t)blk * 128 + wave * 16) * 1024 + 256 * j + 4 * lane);
    for (int rr = 0; rr < 16; ++rr) {
        const int rl = wave * 16 + rr; const size_t row = (size_t)blk * 128 + rl;
        f32x4 v[4];
#pragma unroll
        for (int j = 0; j < 4; ++j) { const u32x2 w = wn[j]; v[j] = (f32x4){bf_lo(w.x), bf_hi(w.x), bf_lo(w.y), bf_hi(w.y)}; }
        { const size_t rn = row + (rr + 1 < 16 ? 1 : 0);
#pragma unroll
          for (int j = 0; j < 4; ++j) wn[j] = *(const u32x2*)(xb + rn * 1024 + 256 * j + 4 * lane); }
        ln_finish(v, gam, bet, nullptr, xb + row * 1024, lane);
        float aff[16], sel[16];
#pragma unroll
        for (int e = 0; e < 16; ++e) { float p = 0.f;
#pragma unroll
            for (int j = 0; j < 4; ++j) { const f32x4 w = *(const LAS f32x4*)(WR + e * 1024 + 256 * j + 4 * lane); p += (v[j][0] * w[0] + v[j][1] * w[1]) + (v[j][2] * w[2] + v[j][3] * w[3]); }
            const float lg = wave_sum(p); aff[e] = 1.0f / (1.0f + expf(-lg)); sel[e] = aff[e] + rbias[e]; }
        float gbv = -3.0e38f; int gb = 0;
#pragma unroll
        for (int g = 0; g < 4; ++g) { float m1 = -3.0e38f, m2 = -3.0e38f;
#pragma unroll
            for (int i = 0; i < 4; ++i) { const float x = sel[4 * g + i]; if (x > m1) { m2 = m1; m1 = x; } else if (x > m2) m2 = x; }
            const float gs_ = m1 + m2; if (gs_ > gbv) { gbv = gs_; gb = g; } }
        float s0 = -3.0e38f, a0 = 0.f; int e0 = 0;
#pragma unroll
        for (int e = 0; e < 16; ++e) { const bool in = (e >> 2) == gb; if (in && sel[e] > s0) { s0 = sel[e]; a0 = aff[e]; e0 = e; } }
        float s1 = -3.0e38f, a1 = 0.f; int e1 = 0;
#pragma unroll
        for (int e = 0; e < 16; ++e) { const bool in = ((e >> 2) == gb) && (e != e0); if (in && sel[e] > s1) { s1 = sel[e]; a1 = aff[e]; e1 = e; } }
        if (lane == 0) {
            const float inv = 1.0f / (a0 + a1);
            const int p0 = __hip_atomic_fetch_add(lcnt + e0, 1, __ATOMIC_RELAXED, __HIP_MEMORY_SCOPE_WORKGROUP);
            const int p1 = __hip_atomic_fetch_add(lcnt + e1, 1, __ATOMIC_RELAXED, __HIP_MEMORY_SCOPE_WORKGROUP);
            tok[rl * 4 + 0] = e0; tok[rl * 4 + 1] = p0; tok[rl * 4 + 2] = e1; tok[rl * 4 + 3] = p1;
            *(f32x2*)(R.r_g + row * 2) = (f32x2){a0 * inv, a1 * inv};
        }
    }
    __syncthreads();
    if (tid < 16) basee[tid] = (int)__hip_atomic_fetch_add(R.gcnt + tid * 64, (unsigned)lcnt[tid], __ATOMIC_RELAXED, __HIP_MEMORY_SCOPE_AGENT);
    __syncthreads();
    if (tid < 256) { const int rl = tid >> 1, k = tid & 1; const int e = tok[rl * 4 + 2 * k], p = tok[rl * 4 + 2 * k + 1]; const size_t o = ((size_t)blk * 128 + rl) * 2 + k; R.r_e[o] = e; R.r_pos[o] = basee[e] + p; }
}
__device__ __forceinline__ void moe_offsets(LAS int* offp, const unsigned* gcnt, int tid) {
    __syncthreads();
    if (tid == 0) { int o = 0;
        for (int e = 0; e < 16; ++e) { offp[e] = o; const int c = (int)__hip_atomic_load(gcnt + e * 64, __ATOMIC_RELAXED, __HIP_MEMORY_SCOPE_AGENT); o += (c + 255) & ~255; }
        offp[16] = o; }
    __syncthreads();
}
#ifndef MK_PER_PHASE
#define MK_PER_PHASE 0
#endif
#ifndef EN_MASK
#define EN_MASK 0xFFF
#endif
#ifndef EN_M1
#define EN_M1 1
#endif
#ifndef EN_M2
#define EN_M2 1
#endif
#ifndef DBG_REP_P0A
#define DBG_REP_P0A 1
#endif
#ifndef EN_2A
#define EN_2A 1
#endif
#ifndef EN_2R
#define EN_2R 1
#endif
#define EN_A ((EN_MASK >> 0) & 1)
#define EN_B ((EN_MASK >> 1) & 1)
#define EN_0 ((EN_MASK >> 2) & 1)
#define EN_1 ((EN_MASK >> 3) & 1)
#define EN_2 ((EN_MASK >> 4) & 1)
#define EN_3 ((EN_MASK >> 5) & 1)
#define EN_4 ((EN_MASK >> 6) & 1)
#define EN_5 ((EN_MASK >> 7) & 1)
#define EN_6 ((EN_MASK >> 8) & 1)
#define EN_7 ((EN_MASK >> 9) & 1)
#define EN_8 ((EN_MASK >> 10) & 1)
#define EN_9 ((EN_MASK >> 11) & 1)
constexpr int NPH_L = 10, NPH = 2 + NL * NPH_L;
struct Args { const float* in[25]; float* out; unsigned char* ws; int ph_lo, ph_hi; };

__global__ void __launch_bounds__(NTHR, 2) fwd(Args a) {
    extern __shared__ __attribute__((aligned(16))) unsigned char lds_raw[];
    LAS unsigned char* lds = (LAS unsigned char*)lds_raw;
    const int G = gridDim.x, bx = blockIdx.x, vcu = (G % 8 == 0) ? (bx % 8) * (G / 8) + bx / 8 : bx;
    const int NGW = G * NWAVES;
#define PH_LOCALS int tid = wave_s * 64 + lane_id(); asm volatile("" : "+v"(tid)); const int lane = tid & 63, wave = wave_s, gw = vcu * NWAVES + wave; (void)lane; (void)gw;
    volatile LAS unsigned* MISC = (volatile LAS unsigned*)(lds + LDS_MISC);
    const int wave_s = __builtin_amdgcn_readfirstlane((int)threadIdx.x >> 6);
    if (threadIdx.x < 64) MISC[threadIdx.x] = 0u;
    __syncthreads();
    unsigned char* ws = a.ws;
    unsigned* ctl = (unsigned*)(ws + WS_CTL);
    const int lo = a.ph_lo, hi = a.ph_hi;
    XcdBarrier bar; bar.bar = ctl + CW_BAR; bar.x = 0; bar.st = MISC + 8;
    if (hi - lo > 1) bar = xcd_barrier_post(ctl + CW_BAR, MISC + 8);
#define IN(k) (lo <= (k) && (k) < hi)
#ifdef DBG_TIME
    if (blockIdx.x == 0 && threadIdx.x == 0) ctl[12288 + 63] = (unsigned)__builtin_amdgcn_s_memrealtime();
#define SEAM(k) do { if (IN(k) && IN((k) + 1)) { xcd_barrier(bar, wave_s == 0 && lane_id() == 0); if (bx == 0 && wave_s == 0 && lane_id() == 0) ctl[12288 + (k)] = (unsigned)__builtin_amdgcn_s_memrealtime(); } } while (0)
#else
#define SEAM(k) do { if (IN(k) && IN((k) + 1)) xcd_barrier(bar, wave_s == 0 && lane_id() == 0); } while (0)
#endif
    float* xo = a.out;
    bf16_t* xb = (bf16_t*)(ws + WS_XB);
    unsigned char* R = ws + WS_R;

    for (int rep_ = 0; rep_ < (DBG_REP_P0A); ++rep_)
    if (EN_A && IN(0)) { PH_LOCALS
        LAS float* scr = (LAS float*)(lds + wave * 8448);
        constexpr int PER_L = 4160;
        for (int it = gw; it < NL * PER_L; it += NGW) {
            const int l = it / PER_L; int r = it - l * PER_L;
            const float* win = a.in[1] + (size_t)l * 1024 * DIN;
            unsigned char* wm = ws + WS_WMIX + (size_t)l * WMIX_STRIDE;
            if (r < 1024) { tr_item(win, DIN, 0, 2048, (bf16_t*)(wm + OFF_WIN), 1024, 0, r, 64, scr, lane); continue; } r -= 1024;
            if (r < 512) { tr_item(win, DIN, 3072, 840, (bf16_t*)(wm + OFF_WIN) + (size_t)4096 * 1024, 1024, 0, r, 32, scr, lane); continue; } r -= 512;
            if (r < 1024) { tr_item(win, DIN, 3912, 2048, (bf16_t*)(wm + OFF_WG), 1024, 0, r, 64, scr, lane); continue; } r -= 1024;
            if (r < 512) { tr_item(a.in[12] + (size_t)l * 1048576, 1024, 0, 1024, (bf16_t*)(wm + OFF_WPR), 1024, 0, r, 32, scr, lane); continue; } r -= 512;
            if (r < 512) { tr_item(a.in[14] + (size_t)l * 1048576, 1024, 0, 1024, (bf16_t*)(wm + OFF_WO), 1024, 0, r, 32, scr, lane); continue; } r -= 512;
            if (r < 512) { tr_item(a.in[13] + (size_t)l * 1048576, 1024, 0, 1024, (bf16_t*)(R + R_PT + (size_t)l * 2 * MiB), 1024, 0, r, 32, scr, lane); continue; } r -= 512;
            { const int m = r >> 5, g = (r >> 1) & 15, nb = r & 1;
              const float* src = (m ? a.in[6] : a.in[4]) + (size_t)(l * 16 + g) * 4096;
              bf16_t* dst = (bf16_t*)(ws + WS_WSM + (size_t)l * 262144 + (size_t)m * 131072) + g * 4096;
              tr_item(src, 64, 0, 64, dst, 64, 0, nb, 2, scr, lane); }
        }
        const size_t gt = (size_t)vcu * NTHR + tid, GT = (size_t)G * NTHR;
        for (size_t i = gt; i < (size_t)NL * 1024 * 128; i += GT) { const int l = (int)(i >> 17), k = (int)(i >> 7) & 1023, j8 = (int)i & 127;
            const float* s = a.in[1] + ((size_t)l * 1024 + k) * DIN + 2048 + 8 * j8; const f32x4 v0 = *(const f32x4*)s, v1 = *(const f32x4*)(s + 4);
            *(u32x4*)((bf16_t*)(R + R_WQ + (size_t)l * 2 * MiB) + (size_t)k * 1024 + 8 * j8) = pack8(v0, v1); }
        for (size_t i = gt; i < (size_t)2 * NL * 8 * 256 * 32; i += GT) { const int which = (int)(i >> 18); const int r = (int)(i & 262143); const int lh = r >> 13, c = (r >> 5) & 255, d8 = r & 31; const int h = lh & 7;
            u32x4 o = (u32x4){0u, 0u, 0u, 0u};
            if ((d8 >> 4) == (h & 1)) { const float* s = (which ? a.in[11] : a.in[10]) + ((size_t)lh * 256 + c) * 128 + 8 * (d8 & 15); o = pack8(*(const f32x4*)s, *(const f32x4*)(s + 4)); }
            *(u32x4*)((bf16_t*)(R + (which ? R_UVP : R_UKP)) + ((size_t)lh * 256 + c) * 1024 + 8 * d8) = o; }
        for (size_t i = gt; i < (size_t)T * 128; i += GT) { const float* s = a.in[0] + i * 8; const f32x4 v0 = *(const f32x4*)s, v1 = *(const f32x4*)(s + 4);
            *(u32x4*)(xb + i * 8) = pack8(v0, v1); }
    }
    SEAM(0);
    if (EN_B && IN(1)) {
        SchedPro S{R, G, vcu}; EpiPro E{ws + WS_WMIX};
        gs::gemm_stream<true>(lds, S, E, wave_s);
    }
    SEAM(1);

    for (int l = 0; l < NL; ++l) {
        const int pb = 2 + l * NPH_L;
        unsigned char* wm = ws + WS_WMIX + (size_t)l * WMIX_STRIDE;
        bf16_t* xrnn = (bf16_t*)(R + R_XRNN); bf16_t* grnn = (bf16_t*)(R + R_GRNN); bf16_t* qlat = (bf16_t*)(R + R_QLAT); bf16_t* ckv = (bf16_t*)(R + R_CKV);
        bf16_t* qidx = (bf16_t*)(R + R_QIDX); bf16_t* kidx = (bf16_t*)(R + R_KIDX); float* widx = (float*)(R + R_WIDX);
        if (EN_0 && IN(pb + 0)) {
            SchedDense S{(const char*)xb, (const char*)(wm + OFF_WIN), 2048u, 2048u, 16, T / 256, 20, G, vcu};
            EpiInproj E{xrnn, grnn, qlat, ckv, qidx, kidx, widx};
            gs::gemm_stream<true>(lds, S, E, wave_s);
#ifdef DBG_REP_INPROJ
            gs::gemm_stream<true>(lds, S, E, wave_s);
#endif
        }
        SEAM(pb + 0);
        RnnP RP{xrnn, grnn, (float*)(R + R_TOT), (const bf16_t*)(ws + WS_WSM + (size_t)l * 262144), (const bf16_t*)(ws + WS_WSM + (size_t)l * 262144 + 131072),
                a.in[2] + (size_t)l * 4096, a.in[3] + (size_t)l * 1024, a.in[5] + (size_t)l * 1024, a.in[7] + (size_t)l * 1024, a.in[8] + (size_t)l * 1024};
        if (EN_1 && IN(pb + 1)) { PH_LOCALS
#ifdef DBG_TIME
            if (tid == 0) MISC[24] = (unsigned)__builtin_amdgcn_s_memrealtime();
#endif
            for (int it = gw; it < 2048; it += NGW) rnn_item<1>(RP, it, lds + wave * 8448, lane);
#ifdef DBG_TIME
            if (tid == 0) MISC[25] = (unsigned)__builtin_amdgcn_s_memrealtime();
#endif
#ifdef DBG_REP_RNN
            for (int it = gw; it < 2048; it += NGW) rnn_item<1>(RP, it, lds + wave * 8448, lane);
#endif
            for (int row = gw; row < T; row += 4 * NGW) ckv_norm_rows4(ckv, row, NGW, T, a.in[9] + (size_t)l * 256, lane);
#ifdef DBG_TIME
            if (tid == 0) MISC[26] = (unsigned)__builtin_amdgcn_s_memrealtime();
#endif
            LAS float* scr = (LAS float*)(lds + wave * 8448);
            for (int it = gw; it < 16 * 768; it += NGW) { const int e = it / 768; int r = it - e * 768; const size_t le = (size_t)l * 16 + e;
                bf16_t* gu = (bf16_t*)(ws + WS_WEXP) + (size_t)e * 1048576; bf16_t* dn = (bf16_t*)(ws + WS_WEXP + OFF_DN) + (size_t)e * 524288;
                if (r < 256) { tr_item(a.in[19] + le * 524288, 512, 0, 512, gu, 1024, 1, r, 16, scr, lane); continue; } r -= 256;
                if (r < 256) { tr_item(a.in[20] + le * 524288, 512, 0, 512, gu + 4 * 1024, 1024, 1, r, 16, scr, lane); continue; } r -= 256;
                tr_item(a.in[21] + le * 524288, 1024, 0, 1024, dn, 512, 0, r, 32, scr, lane); }
#ifdef DBG_TIME
            if (l == 1 && bx == 0 && tid == 0) { const unsigned tq3 = (unsigned)__builtin_amdgcn_s_memrealtime();
                ctl[12288 + 48] = MISC[25] - MISC[24]; ctl[12288 + 49] = MISC[26] - MISC[25]; ctl[12288 + 50] = tq3 - MISC[26]; ctl[12288 + 51] = tq3 - MISC[24]; }
#endif
        }
        SEAM(pb + 1);
        if (EN_2 && IN(pb + 2)) { PH_LOCALS
            __syncthreads();
            if (tid < 256) ((LAS float*)(lds + AT_BIAS))[tid] = a.in[24][tid];
            if (tid < 128) { const int d = tid; int bk = d; if (d >= 16) { bk = 16 + (int)(logf((float)d / 16.0f) / 2.0794415416798357f * 16.0f); bk = bk > 31 ? 31 : bk; } ((LAS int*)(lds + AT_BKT))[d] = bk; }
            __syncthreads();
            for (int i = tid; i < 1024; i += NTHR) ((LAS float*)(lds + AT_BIAS2))[i] = ((const LAS float*)(lds + AT_BIAS))[((const LAS int*)(lds + AT_BKT))[i >> 3] * 8 + (i & 7)];
            AttnP AP{qidx, kidx, ckv, widx, qlat, (unsigned long long*)(R + R_MSCR + (size_t)bx * 393216)};
#ifdef DBG_TIME
            unsigned tph0 = (unsigned)__builtin_amdgcn_s_memrealtime();
#endif
#ifdef DBG_STATIC_UNITS
            if (EN_2A) for (int p = vcu; p < 512; p += G) { const int b = p >> 8, uu = p & 255;
#pragma unroll 1
                for (int k2 = 0; k2 < 2; ++k2) { attn_unit(lds, AP, b, k2 ? uu : 511 - uu, tid);
#ifdef DBG_TIME
                    if (tid == 0) MISC[21] = MISC[21] + 1u;
#endif
                } }
#else
            if (EN_2A) for (;;) {
                __syncthreads();
                if (tid == 0) MISC[4] = __hip_atomic_fetch_add(ctl + CW_QUEUE + l * 64, 1u, __ATOMIC_RELAXED, __HIP_MEMORY_SCOPE_AGENT);
                __syncthreads();
                const unsigned tk = MISC[4];
                if (tk >= 1024u) break;
                attn_unit(lds, AP, (int)(tk & 1u), 511 - (int)(tk >> 1), tid);
#ifdef DBG_TIME
                if (tid == 0) MISC[21] = MISC[21] + 1u;
#endif
            }
            __syncthreads();
#endif
#ifdef DBG_TIME
            if (l == 1 && bx == 0 && tid == 0) { for (int i_ = 0; i_ < 6; ++i_) ctl[12288 + 40 + i_] = ((LAS unsigned*)(lds + LDS_MISC))[16 + i_]; ctl[12288 + 46] = ((LAS unsigned*)(lds + LDS_MISC))[16]; }
            if (l == 0 && tid == 0) { for (int i_ = 0; i_ < 6; ++i_) ((LAS unsigned*)(lds + LDS_MISC))[16 + i_] = 0u; }
            __syncthreads();
            unsigned tph1 = (unsigned)__builtin_amdgcn_s_memrealtime();
            if (l == 1 && bx == 0 && tid == 0) ctl[12288 + 47] = tph1 - tph0;
            if (l == 1 && tid == 0) { __hip_atomic_fetch_max(ctl + 12288 + 59, tph1 - tph0, __ATOMIC_RELAXED, __HIP_MEMORY_SCOPE_AGENT); __hip_atomic_fetch_max(ctl + 12288 + 58, 0x40000000u - (tph1 - tph0), __ATOMIC_RELAXED, __HIP_MEMORY_SCOPE_AGENT); }
#endif
            if (EN_2R) for (int it = gw; it < 2048; it += NGW) rnn_item<2>(RP, it, lds + wave * 8448, lane);
#ifdef DBG_TIME
            { __syncthreads(); const unsigned tph2 = (unsigned)__builtin_amdgcn_s_memrealtime();
              if (l == 1 && tid == 0) __hip_atomic_fetch_max(ctl + 12288 + 57, tph2 - tph1, __ATOMIC_RELAXED, __HIP_MEMORY_SCOPE_AGENT); }
#endif
        }
        SEAM(pb + 2);
        if (EN_3 && IN(pb + 3)) {
            if (EN_M1) { SchedMerge1 S{(const char*)xb, (const char*)grnn, (const char*)(wm + OFF_WG), (const char*)(wm + OFF_WPR), G, vcu};
              EpiMerge1 E{R + R_MSCR + (size_t)bx * 131072, R + R_MSCR2, (bf16_t*)(R + R_MERGED)};
              gs::gemm_stream<true>(lds, S, E, wave_s); }
            if (EN_M2) { SchedDense S{(const char*)qlat, (const char*)(wm + OFF_WVO), 4096u, 4096u, 32, T / 256, 4, G, vcu};
              EpiMerge2 E{R + R_MSCR2, (bf16_t*)(R + R_MERGED)};
              gs::gemm_stream<true>(lds, S, E, wave_s); }
        }
        SEAM(pb + 3);
        if (EN_4 && IN(pb + 4)) {
            SchedDense S{(const char*)(R + R_MERGED), (const char*)(wm + OFF_WO), 2048u, 2048u, 16, T / 256, 4, G, vcu};
            EpiOut E{xb};
            gs::gemm_stream<true>(lds, S, E, wave_s);
        }
        SEAM(pb + 4);
        RouteP RT{(int*)(R + R_ROUTE), (int*)(R + R_ROUTE + 262144), (int*)(R + R_ROUTE + 524288), (float*)(R + R_ROUTE + 786432), ctl + CW_CNT + l * 16 * 64};
        LAS int* offp = (LAS int*)(lds + LDS_MISC - 128);
        if (EN_5 && IN(pb + 5)) { PH_LOCALS
            __syncthreads();
            { float wv[32];
#pragma unroll
              for (int j = 0; j < 32; ++j) wv[j] = a.in[17][tid + j * NTHR];
#pragma unroll
              for (int j = 0; j < 32; ++j) { const int i = tid + j * NTHR; ((LAS float*)lds)[(i & 15) * 1024 + (i >> 4)] = wv[j]; } }
            for (int blk = vcu; blk < T / 128; blk += G) ln1_route_block(lds, blk, xo, xb, a.in[15] + (size_t)l * 1024, a.in[16] + (size_t)l * 1024, a.in[18], RT, tid);
        }
        SEAM(pb + 5);
        int* tokof = (int*)(R + R_ROUTE + 1048576);
        if (EN_6 && IN(pb + 6)) { PH_LOCALS
            moe_offsets(offp, RT.gcnt, tid);
            for (int p = vcu * NTHR + tid; p < 2 * T; p += G * NTHR) { const int e = RT.r_e[p], slot = offp[e] + RT.r_pos[p]; RT.r_slot[p] = slot; tokof[slot] = p >> 1; }
            if (vcu == 0 && tid < 256) {
                for (int e = 0; e < 16; ++e) { const int cnt = (int)__hip_atomic_load(RT.gcnt + e * 64, __ATOMIC_RELAXED, __HIP_MEMORY_SCOPE_AGENT); const int s0 = offp[e] + cnt;
                    if (s0 + tid < offp[e + 1]) tokof[s0 + tid] = 0; } }
        }
        SEAM(pb + 6);
        if (EN_7 && IN(pb + 7)) { PH_LOCALS
            moe_offsets(offp, RT.gcnt, tid);
            SchedMoEG S{(const char*)xb, (const char*)(ws + WS_WEXP), 2048u, 2048u, (size_t)2097152, 16, 4, G, vcu, offp, tokof};
            EpiGU E{(bf16_t*)(R + R_HE)};
            gs::gemm_stream<true, SchedMoEG, EpiGU, true>(lds, S, E, wave_s);
        }
        SEAM(pb + 7);
        if (EN_8 && IN(pb + 8)) { PH_LOCALS
            moe_offsets(offp, RT.gcnt, tid);
            SchedMoE S{(const char*)(R + R_HE), (const char*)(ws + WS_WEXP + OFF_DN), 1024u, 1024u, (size_t)1048576, 8, 4, G, vcu, offp};
            EpiBf16 E{(bf16_t*)(R + R_XG), 1024};
            gs::gemm_stream<true>(lds, S, E, wave_s);
        }
        SEAM(pb + 8);
        if (EN_9 && IN(pb + 9)) { PH_LOCALS
            const bf16_t* Y = (const bf16_t*)(R + R_XG);
            u32x2 xwn[4], y0n[4], y1n[4]; int s0n, s1n; f32x2 ggc, ggn;
            { const int r0 = gw < T ? gw : T - 1, r1 = gw + NGW < T ? gw + NGW : T - 1;
              const int a0 = RT.r_slot[2 * r0], a1 = RT.r_slot[2 * r0 + 1]; ggc = *(const f32x2*)(RT.r_g + 2 * (size_t)r0);
#pragma unroll
              for (int j = 0; j < 4; ++j) { xwn[j] = *(const u32x2*)(xb + (size_t)r0 * 1024 + 256 * j + 4 * lane); y0n[j] = *(const u32x2*)(Y + (size_t)a0 * 1024 + 256 * j + 4 * lane); y1n[j] = *(const u32x2*)(Y + (size_t)a1 * 1024 + 256 * j + 4 * lane); }
              s0n = RT.r_slot[2 * r1]; s1n = RT.r_slot[2 * r1 + 1]; ggn = *(const f32x2*)(RT.r_g + 2 * (size_t)r1); }
            for (int row = gw; row < T; row += NGW) {
                const f32x2 gg = ggc;
                u32x2 xwc[4], y0c[4], y1c[4];
#pragma unroll
                for (int j = 0; j < 4; ++j) { xwc[j] = xwn[j]; y0c[j] = y0n[j]; y1c[j] = y1n[j]; }
                { const int r1 = row + NGW < T ? row + NGW : T - 1, r2 = row + 2 * NGW < T ? row + 2 * NGW : T - 1;
                  const int a0 = s0n, a1 = s1n; ggc = ggn;
#pragma unroll
                  for (int j = 0; j < 4; ++j) { xwn[j] = *(const u32x2*)(xb + (size_t)r1 * 1024 + 256 * j + 4 * lane); y0n[j] = *(const u32x2*)(Y + (size_t)a0 * 1024 + 256 * j + 4 * lane); y1n[j] = *(const u32x2*)(Y + (size_t)a1 * 1024 + 256 * j + 4 * lane); }
                  s0n = RT.r_slot[2 * r2]; s1n = RT.r_slot[2 * r2 + 1]; ggn = *(const f32x2*)(RT.r_g + 2 * (size_t)r2); }
                f32x4 v[4];
#pragma unroll
                for (int j = 0; j < 4; ++j) { const u32x2 xw = xwc[j]; const f32x4 x1 = {bf_lo(xw.x), bf_hi(xw.x), bf_lo(xw.y), bf_hi(xw.y)};
                    const u32x2 y0 = y0c[j], y1 = y1c[j];
                    v[j][0] = ALPHA * x1[0] + gg.x * bf_lo(y0.x) + gg.y * bf_lo(y1.x); v[j][1] = ALPHA * x1[1] + gg.x * bf_hi(y0.x) + gg.y * bf_hi(y1.x);
                    v[j][2] = ALPHA * x1[2] + gg.x * bf_lo(y0.y) + gg.y * bf_lo(y1.y); v[j][3] = ALPHA * x1[3] + gg.x * bf_hi(y0.y) + gg.y * bf_hi(y1.y); }
                ln_finish(v, a.in[22] + (size_t)l * 1024, a.in[23] + (size_t)l * 1024, l == NL - 1 ? xo + (size_t)row * 1024 : nullptr, xb + (size_t)row * 1024, lane);
#ifdef DBG_TIME
                if (l == NL - 1) {
                    const unsigned ta = __hip_atomic_load(ctl + 12288 + (DBG_TA), __ATOMIC_RELAXED, __HIP_MEMORY_SCOPE_AGENT), tb = __hip_atomic_load(ctl + 12288 + (DBG_TB), __ATOMIC_RELAXED, __HIP_MEMORY_SCOPE_AGENT);
                    unsigned k_ = (DBG_Q) == 0 ? (40u * ta + tb / 2u) / (tb ? tb : 1u) : ((DBG_TA) == 58 ? (0x40000000u - ta) : (ta - tb)) / (unsigned)((DBG_Q) ? (DBG_Q) : 1); k_ = k_ > 45u ? 45u : k_;
                    const float sc_ = 1.0f - 0.02f * (float)k_;
#pragma unroll
                    for (int j = 0; j < 4; ++j) *(f32x4*)(xo + (size_t)row * 1024 + 256 * j + 4 * lane) = v[j] * sc_; }
#endif
            }
        }
        SEAM(pb + 9);
    }
#undef IN
#undef SEAM
}

#ifdef DUMP_OFF
__global__ void dump_k(const bf16_t* src, float* dst, size_t ld, size_t col0) { for (size_t i = (size_t)blockIdx.x * blockDim.x + threadIdx.x; i < (size_t)T * 1024; i += (size_t)gridDim.x * blockDim.x) dst[i] = bf2f(src[(i >> 10) * ld + col0 + (i & 1023)]); }
#endif
extern "C" void kernel_launch(void* const* d_in, const int* in_sizes, int n_in, void* d_out, int out_size, void* d_ws, size_t ws_size, hipStream_t stream) {
    static int grid = 0;
    if (grid == 0) {
        if (n_in != 25 || out_size != T * D || ws_size < WS_END) { fprintf(stderr, "kernel_launch: unexpected shapes (n_in %d, out %d, ws %zu < %zu)\n", n_in, out_size, ws_size, (size_t)WS_END); grid = -1; return; }
        int dev = 0, cus = 0, per_cu = 0;
        if (hipGetDevice(&dev) != hipSuccess || hipDeviceGetAttribute(&cus, hipDeviceAttributeMultiprocessorCount, dev) != hipSuccess) { grid = -1; return; }
        if (hipFuncSetAttribute((const void*)fwd, hipFuncAttributeMaxDynamicSharedMemorySize, LDS_BYTES) != hipSuccess) { fprintf(stderr, "kernel_launch: hipFuncSetAttribute failed\n"); grid = -1; return; }
        if (hipOccupancyMaxActiveBlocksPerMultiprocessor(&per_cu, (const void*)fwd, NTHR, LDS_BYTES) != hipSuccess || per_cu < 1) fprintf(stderr, "kernel_launch: occupancy query says %d\n", per_cu);
        (void)hipGetLastError();
        grid = cus < 256 ? cus : 256;
    }
    if (grid < 0) return;
    (void)hipMemsetAsync((char*)d_ws + WS_CTL, 0, CTL_BYTES, stream);
    Args a{};
    for (int i = 0; i < 25; ++i) a.in[i] = (const float*)d_in[i];
    a.out = (float*)d_out; a.ws = (unsigned char*)d_ws;
#if MK_PER_PHASE
#ifndef PH_LIMIT
#define PH_LIMIT NPH
#endif
    for (int ph = 0; ph < PH_LIMIT; ++ph) { a.ph_lo = ph; a.ph_hi = ph + 1; hipLaunchKernelGGL(fwd, dim3(grid), dim3(NTHR), LDS_BYTES, stream, a); }
#else
    a.ph_lo = 0; a.ph_hi = NPH; hipLaunchKernelGGL(fwd, dim3(grid), dim3(NTHR), LDS_BYTES, stream, a);
#endif
#ifdef DUMP_OFF
    hipLaunchKernelGGL(dump_k, dim3(2048), dim3(256), 0, stream, (const bf16_t*)((const char*)d_ws + (DUMP_OFF)), (float*)d_out, (size_t)(DUMP_LD), (size_t)(DUMP_COL));
#endif
}
```

```cpp
#include <hip/hip_runtime.h>
#include <cstdio>
#include <cstdint>

#define GAS __attribute__((address_space(1)))
#define LAS __attribute__((address_space(3)))
typedef unsigned short bf16_t;
typedef short bf16x8 __attribute__((ext_vector_type(8)));
typedef short s16x4 __attribute__((ext_vector_type(4)));
typedef float f32x2 __attribute__((ext_vector_type(2)));
typedef float f32x4 __attribute__((ext_vector_type(4)));
typedef float f32x16 __attribute__((ext_vector_type(16)));
typedef unsigned u32x2 __attribute__((ext_vector_type(2)));
typedef unsigned u32x4 __attribute__((ext_vector_type(4)));

constexpr int NB = 2, SEQ = 16384, T = NB * SEQ, D = 1024, NL = 4, DIN = 5960;
constexpr int NE = 16;
constexpr float ALPHA = 1.681792830507429f;
constexpr float LN_EPS = 1e-5f, RMS_EPS = 1e-6f;
constexpr int NWAVES = 8, NTHR = 512;

constexpr size_t MiB = 1u << 20;
constexpr size_t WS_CTL = 0, CTL_BYTES = 1 * MiB;
constexpr size_t WS_XB = 1 * MiB;
constexpr size_t WS_WMIX = 65 * MiB, WMIX_STRIDE = 22 * MiB;
constexpr size_t OFF_WIN = 0, OFF_WG = 10 * MiB, OFF_WPR = 14 * MiB, OFF_WVO = 16 * MiB, OFF_WO = 20 * MiB;
constexpr size_t WS_WSM = 153 * MiB;
constexpr size_t WS_WEXP = 154 * MiB;
constexpr size_t OFF_DN = 32 * MiB;
constexpr size_t WS_R = 202 * MiB;
constexpr size_t R_XRNN = 0, R_GRNN = 64 * MiB, R_QLAT = 128 * MiB, R_CKV = 256 * MiB, R_QIDX = 272 * MiB, R_KIDX = 304 * MiB, R_WIDX = 308 * MiB,
                 R_TOT = 309 * MiB, R_MSCR = 310 * MiB, R_MSCR2 = 342 * MiB, R_END = 406 * MiB;
constexpr size_t R_MERGED = R_XRNN;
constexpr size_t R_XG = 0, R_HE = 136 * MiB, R_ROUTE = 204 * MiB;
constexpr size_t R_WQ = 0, R_UKP = 8 * MiB, R_PT = 24 * MiB, R_UVP = 32 * MiB;
constexpr size_t WS_END = WS_R + R_END;
constexpr int MP_MAX = 2 * T + NE * 256;

constexpr int CW_TMO = 0;
constexpr int CW_BAR = 4096;
constexpr int CW_CNT = 8192;
constexpr int CW_QUEUE = 14336;

constexpr int LDS_BYTES = 163840;
constexpr int LDS_MISC = LDS_BYTES - 256;

#define RLX_AGENT __ATOMIC_RELAXED, __HIP_MEMORY_SCOPE_AGENT
__device__ __forceinline__ unsigned f2bf(float f) { unsigned u = __builtin_bit_cast(unsigned, f); return (u + 0x7fffu + ((u >> 16) & 1u)) >> 16; }
typedef __bf16 bf16x2_t __attribute__((ext_vector_type(2)));
__device__ __forceinline__ unsigned pk2(float lo, float hi) { const f32x2 v = {lo, hi}; const bf16x2_t b = __builtin_convertvector(v, bf16x2_t); return __builtin_bit_cast(unsigned, b); }
__device__ __forceinline__ float bf_lo(unsigned w) { return __builtin_bit_cast(float, w << 16); }
__device__ __forceinline__ float bf_hi(unsigned w) { return __builtin_bit_cast(float, w & 0xffff0000u); }
__device__ __forceinline__ float bf2f(bf16_t h) { return __builtin_bit_cast(float, ((unsigned)h) << 16); }
__device__ __forceinline__ float fast_exp(float x) { return __builtin_amdgcn_exp2f(x * 1.4426950408889634f); }
__device__ __forceinline__ float fast_rcp(float x) { return __builtin_amdgcn_rcpf(x); }
__device__ __forceinline__ float sigmoidf_(float x) { return fast_rcp(1.0f + fast_exp(-x)); }
__device__ __forceinline__ float gelu_tanh(float x) { const float y = 0.7978845608028654f * (x + 0.044715f * x * x * x); const float e = fast_exp(2.0f * y); const float th = 1.0f - 2.0f * fast_rcp(e + 1.0f); return 0.5f * x * (1.0f + th); }
template <int CTRL> __device__ __forceinline__ float dpp_f(float v) { return __builtin_bit_cast(float, __builtin_amdgcn_update_dpp(0, __builtin_bit_cast(int, v), CTRL, 0xf, 0xf, true)); }
__device__ __forceinline__ float wave_sum(float v) {
    v += dpp_f<0xB1>(v); v += dpp_f<0x4E>(v); v += dpp_f<0x141>(v); v += dpp_f<0x140>(v);
    const int vi = __builtin_bit_cast(int, v);
    return (__builtin_bit_cast(float, __builtin_amdgcn_readlane(vi, 0)) + __builtin_bit_cast(float, __builtin_amdgcn_readlane(vi, 16))) +
           (__builtin_bit_cast(float, __builtin_amdgcn_readlane(vi, 32)) + __builtin_bit_cast(float, __builtin_amdgcn_readlane(vi, 48)));
}

__device__ __forceinline__ int lane_id() { unsigned z = 0u; asm volatile("" : "+v"(z)); return (int)__builtin_amdgcn_mbcnt_hi(~0u, __builtin_amdgcn_mbcnt_lo(~0u, z)); }
#define XB_TMO      128
#define XB_XCNT(j)  (256  + 64 * (j))
#define XB_XSUB(j)  (1280 + 64 * (j))
#define XB_XGEN(j)  (2304 + 64 * (j))
#define XB_TOP      3328
#define XB_TOPGEN   3392
#define XCD_BAR_WORDS 3456
#define XB_SPIN_CAP (1u << 18)
__device__ __forceinline__ unsigned xb_ld(unsigned* p)              { return __hip_atomic_load(p, __ATOMIC_RELAXED, __HIP_MEMORY_SCOPE_AGENT); }
__device__ __forceinline__ unsigned xb_add(unsigned* p, unsigned v) { return __hip_atomic_fetch_add(p, v, __ATOMIC_RELAXED, __HIP_MEMORY_SCOPE_AGENT); }
__device__ __forceinline__ unsigned xb_xcc_id() { return (unsigned)__builtin_amdgcn_s_getreg((3 << 11) | 20) & 0xFu; }
#define XB_SPIN(cond, bar) do { unsigned _sp = 0; while (cond) { __builtin_amdgcn_s_sleep(1); \
    if ((++_sp & 255u) == 0u) { if (xb_ld(&(bar)[XB_TMO])) break; if (_sp > XB_SPIN_CAP) { atomicAdd(&(bar)[XB_TMO], 1u); break; } } } } while (0)
struct XcdBarrier { unsigned* bar; unsigned x; volatile LAS unsigned* st; };
__device__ __forceinline__ XcdBarrier xcd_barrier_post(unsigned* bar, volatile LAS unsigned* st) {
    XcdBarrier b; b.bar = bar; b.x = xb_xcc_id(); b.st = st;
    if (threadIdx.x == 0) (void)xb_add(&bar[XB_XCNT(b.x)], 1u);
    return b;
}
__device__ __forceinline__ void xcd_barrier_complete(unsigned* bar, unsigned x, unsigned& nloc, unsigned& nx) {
    const unsigned G = gridDim.x * gridDim.y * gridDim.z;
    unsigned sum, cnt, mine, sp = 0u;
    for (;;) {
        sum = 0u; cnt = 0u; mine = 0u;
#pragma unroll
        for (unsigned j = 0; j < 16; ++j) { const unsigned c = xb_ld(&bar[XB_XCNT(j)]); sum += c; cnt += (c > 0u) ? 1u : 0u; mine = (j == x) ? c : mine; }
        if (sum == G) break;
        __builtin_amdgcn_s_sleep(1);
        if ((++sp & 255u) == 0u) { if (xb_ld(&bar[XB_TMO])) break; if (sp > XB_SPIN_CAP) { atomicAdd(&bar[XB_TMO], 1u); break; } }
    }
    nloc = mine > 0u ? mine : 1u; nx = cnt > 0u ? cnt : 1u;
}
__device__ __forceinline__ void xcd_barrier(const XcdBarrier& b, bool is_t0) {
    asm volatile("s_waitcnt vmcnt(0)" ::: "memory");
    __syncthreads();
    if (is_t0) {
        unsigned* bar = b.bar;
        __builtin_amdgcn_s_waitcnt(0);
        unsigned nloc = b.st[0], nx = b.st[1];
        if (nloc == 0u) { xcd_barrier_complete(bar, b.x, nloc, nx); b.st[0] = nloc; b.st[1] = nx; }
        const unsigned old = xb_add(&bar[XB_XSUB(b.x)], 1u);
        const unsigned gen = old / nloc;
        if (old + 1u == (gen + 1u) * nloc) {
            __builtin_amdgcn_fence(__ATOMIC_RELEASE, "agent");
            asm volatile("s_waitcnt vmcnt(0)" ::: "memory");
            const unsigned og = xb_add(&bar[XB_TOP], 1u);
            const unsigned tg = og / nx;
            if (og + 1u == (tg + 1u) * nx) xb_add(&bar[XB_TOPGEN], 1u);
            else XB_SPIN(xb_ld(&bar[XB_TOPGEN]) == tg, bar);
            __builtin_amdgcn_fence(__ATOMIC_ACQUIRE, "agent");
            xb_add(&bar[XB_XGEN(b.x)], 1u);
            asm volatile("s_waitcnt vmcnt(0)" ::: "memory");
        } else {
            XB_SPIN(xb_ld(&bar[XB_XGEN(b.x)]) == gen, bar);
            __builtin_amdgcn_fence(__ATOMIC_ACQUIRE, "agent");
            asm volatile("s_waitcnt vmcnt(0)" ::: "memory");
        }
    }
    __syncthreads();
}
namespace gs {
constexpr int BM = 256, BK = 64, HALF = 128, HTB = HALF * BK * 2, STAGE_BYTES = 8 * HTB, NXCD = 8, WGM = 8;
__host__ __device__ __forceinline__ int lds_byte(int r, int c) { const int st = (r >> 4) * 2 + (c >> 5), rr = r & 15, cc = c & 31, ob = rr * 64 + cc * 2; return st * 1024 + (ob ^ (((ob >> 9) & 1) << 5)); }
__host__ __device__ __forceinline__ void stage_rc(int b, int& R, int& C) { const int st = b / 1024, sb = b % 1024, swz = sb ^ (((sb >> 9) & 1) << 5); R = (st >> 1) * 16 + swz / 64; C = (st & 1) * 32 + (swz % 64) / 2; }
__host__ __device__ __forceinline__ int perm32(int rho) { const int n = rho >> 4, i = rho & 15; return 8 * (i >> 2) + 4 * n + (i & 3); }

struct UD { const char* A; const char* B; unsigned lda, ldb; int nt; int kind, pm, pn, aux; };

__device__ __forceinline__ bool tile_of(long L, int nM, int nN, int& pm, int& pn) {
    const int nwg = nM * nN; if (L >= nwg) return false;
    int wgid = (int)L; { const int q = nwg / NXCD, r = nwg % NXCD, xcd = wgid % NXCD, off = wgid / NXCD; wgid = (xcd < r ? xcd * (q + 1) : r * (q + 1) + (xcd - r) * q) + off; }
    const int nig = WGM * nN, gid = wgid / nig, fm = gid * WGM, gsz = (nM - fm) < WGM ? (nM - fm) : WGM;
    pm = fm + ((wgid % nig) % gsz); pn = (wgid % nig) / gsz; return true;
}

template <bool PERM, class Sched, class Epi, bool GATHER = false>
__device__ __forceinline__ void gemm_stream(LAS unsigned char* lds, const Sched& S, const Epi& E, int wave_s) {
    int tid = wave_s * 64 + lane_id(); asm volatile("" : "+v"(tid));
    const int wid = __builtin_amdgcn_readfirstlane(tid >> 6), lane = tid & 63, wr = wid >> 2, wc = wid & 3, fr = lane & 15, fq = lane >> 4;
    int rA[2], rB[2], cb[2];
#pragma unroll
    for (int i = 0; i < 2; ++i) { int R, C; stage_rc(tid * 16 + i * 8192, R, C); rA[i] = R; rB[i] = PERM ? ((R & ~31) + perm32(R & 31)) : R; cb[i] = C * 2; }
    const size_t kstep = (size_t)(BK * 2);
    const unsigned ldsw = (unsigned)wid * 1024u;
    const int aoff = lds_byte(wr * 64 + fr, fq * 8), boff = lds_byte(wc * 32 + fr, fq * 8);
#define GS_SA(b, h) (((b) * 2 + (h)) * HTB)
#define GS_SB(b, h) ((4 + (b) * 2 + (h)) * HTB)
#define GS_STAGE(bufoff, gbase, voff) do { _Pragma("unroll") for (int _i = 0; _i < 2; ++_i) \
        __builtin_amdgcn_global_load_lds((const unsigned*)((const char*)(gbase) + (voff)[_i]), (LAS unsigned*)(lds + (bufoff) + ldsw + _i * 8192), 16, 0, 0); } while (0)
#define GS_LDA(dst, b, h) do { _Pragma("unroll") for (int m = 0; m < 4; ++m) _Pragma("unroll") for (int k = 0; k < 2; ++k) dst[m][k] = *(const LAS bf16x8*)(lds + GS_SA(b, h) + aoff + m * 2048 + k * 1024); } while (0)
#define GS_LDB(dst, b, h) do { _Pragma("unroll") for (int n = 0; n < 2; ++n) _Pragma("unroll") for (int k = 0; k < 2; ++k) dst[n][k] = *(const LAS bf16x8*)(lds + GS_SB(b, h) + boff + n * 2048 + k * 1024); } while (0)
#define GS_MMA(ai, bj, At, Bt) do { __builtin_amdgcn_s_setprio(1); _Pragma("unroll") for (int m = 0; m < 4; ++m) _Pragma("unroll") for (int n = 0; n < 2; ++n) _Pragma("unroll") for (int k = 0; k < 2; ++k) \
        acc[ai][bj][m][n] = __builtin_amdgcn_mfma_f32_16x16x32_bf16(Bt[n][k], At[m][k], acc[ai][bj][m][n], 0, 0, 0); __builtin_amdgcn_s_setprio(0); } while (0)
#define GS_WAIT_V(n) asm volatile("s_waitcnt vmcnt(" #n ")" ::: "memory")
#define GS_WAIT_L(n) asm volatile("s_waitcnt lgkmcnt(" #n ")" ::: "memory")
#define GS_BAR __builtin_amdgcn_s_barrier()
#define GS_SCHED __builtin_amdgcn_sched_barrier(0)
    UD cur, nxt; int ui = 0; const bool prime = false;
    if (!S.next(0, cur)) return;
    f32x4 acc[2][2][4][2];
#pragma unroll
    for (int a = 0; a < 2; ++a)
#pragma unroll
        for (int b = 0; b < 2; ++b)
#pragma unroll
            for (int m = 0; m < 4; ++m)
#pragma unroll
                for (int n = 0; n < 2; ++n) acc[a][b][m][n] = (f32x4){0.f, 0.f, 0.f, 0.f};
    bf16x8 At[4][2], B0[2][2], B1[2][2];
    unsigned vAc[2], vBc[2], vAc1[2] = {0u, 0u};
#pragma unroll
    for (int i = 0; i < 2; ++i) { vAc[i] = (unsigned)rA[i] * cur.lda + (unsigned)cb[i]; vBc[i] = (unsigned)rB[i] * cur.ldb + (unsigned)cb[i]; }
    if constexpr (GATHER) { const int* rm = S.rmap + cur.pm * 256;
#pragma unroll
        for (int i = 0; i < 2; ++i) { vAc[i] = (unsigned)rm[rA[i]] * cur.lda + (unsigned)cb[i]; vAc1[i] = (unsigned)rm[HALF + rA[i]] * cur.lda + (unsigned)cb[i]; } }
    const char* cA = cur.A; const char* cB = cur.B; size_t hA = GATHER ? (size_t)0 : (size_t)HALF * cur.lda, hB = (size_t)HALF * cur.ldb;
    GS_STAGE(GS_SB(0, 0), cB, vBc); GS_STAGE(GS_SA(0, 0), cA, vAc); GS_STAGE(GS_SB(0, 1), cB + hB, vBc); GS_STAGE(GS_SA(0, 1), cA + hA, (GATHER ? vAc1 : vAc));
    if (wr == 1) GS_BAR;
    GS_WAIT_V(4); GS_BAR;
    GS_STAGE(GS_SB(1, 0), cB + kstep, vBc); GS_STAGE(GS_SA(1, 0), cA + kstep, vAc); GS_STAGE(GS_SB(1, 1), cB + hB + kstep, vBc);
    GS_WAIT_V(6); GS_BAR;
    for (;;) {
        const bool has_next = S.next(ui + 1, nxt);
        const char* nA = has_next ? nxt.A : cA; const char* nB = has_next ? nxt.B : cB;
        const unsigned nlda = has_next ? nxt.lda : cur.lda, nldb = has_next ? nxt.ldb : cur.ldb;
        unsigned vAn[2], vBn[2], vAn1[2] = {0u, 0u};
#pragma unroll
        for (int i = 0; i < 2; ++i) { vAn[i] = (unsigned)rA[i] * nlda + (unsigned)cb[i]; vBn[i] = (unsigned)rB[i] * nldb + (unsigned)cb[i]; }
        if constexpr (GATHER) { const int* rm = S.rmap + (has_next ? nxt.pm : cur.pm) * 256;
#pragma unroll
            for (int i = 0; i < 2; ++i) { vAn[i] = (unsigned)rm[rA[i]] * nlda + (unsigned)cb[i]; vAn1[i] = (unsigned)rm[HALF + rA[i]] * nlda + (unsigned)cb[i]; } }
        const size_t hAn = GATHER ? (size_t)0 : (size_t)HALF * nlda, hBn = (size_t)HALF * nldb;
        const int nt = cur.nt;
        for (int t = 0; t < nt; t += 2) {
            const bool last = (t == nt - 2);
            const char* a1 = cA + (size_t)(t + 1) * kstep;
            const char* a2 = last ? nA : cA + (size_t)(t + 2) * kstep; const char* b2 = last ? nB : cB + (size_t)(t + 2) * kstep;
            const char* a3 = a2 + kstep; const char* b3 = b2 + kstep;
            unsigned vA2[2], vB2[2], vA21[2];
#pragma unroll
            for (int i = 0; i < 2; ++i) { vA2[i] = last ? vAn[i] : vAc[i]; vB2[i] = last ? vBn[i] : vBc[i]; vA21[i] = last ? vAn1[i] : vAc1[i]; }
            const size_t hA2 = last ? hAn : hA, hB2 = last ? hBn : hB;
            GS_LDB(B0, 0, 0); GS_SCHED; GS_LDA(At, 0, 0); GS_STAGE(GS_SA(1, 1), a1 + hA, (GATHER ? vAc1 : vAc));
            GS_WAIT_L(8); GS_BAR; GS_WAIT_L(0); GS_MMA(0, 0, At, B0); GS_BAR; GS_SCHED;
            GS_LDB(B1, 0, 1); GS_STAGE(GS_SB(0, 0), b2, vB2);
            GS_BAR; GS_WAIT_L(0); GS_MMA(0, 1, At, B1); GS_BAR;
            GS_LDA(At, 0, 1); GS_STAGE(GS_SA(0, 0), a2, vA2);
            GS_BAR; GS_WAIT_L(0); GS_MMA(1, 0, At, B0); GS_BAR; GS_SCHED;
            GS_STAGE(GS_SB(0, 1), b2 + hB2, vB2);
            GS_WAIT_V(6); GS_BAR; GS_MMA(1, 1, At, B1); GS_BAR;
            GS_LDB(B0, 1, 0); GS_SCHED; GS_LDA(At, 1, 0); GS_STAGE(GS_SA(0, 1), a2 + hA2, (GATHER ? vA21 : vA2));
            GS_WAIT_L(8); GS_BAR; GS_WAIT_L(0); GS_MMA(0, 0, At, B0); GS_BAR; GS_SCHED;
            GS_LDB(B1, 1, 1); GS_STAGE(GS_SB(1, 0), b3, vB2);
            GS_BAR; GS_WAIT_L(0); GS_MMA(0, 1, At, B1); GS_BAR;
            GS_LDA(At, 1, 1); GS_STAGE(GS_SA(1, 0), a3, vA2);
            GS_BAR; GS_WAIT_L(0); GS_MMA(1, 0, At, B0); GS_BAR; GS_SCHED;
            GS_STAGE(GS_SB(1, 1), b3 + hB2, vB2);
            GS_WAIT_V(6); GS_BAR; GS_MMA(1, 1, At, B1); GS_BAR;
        }
        if (!prime) { int tz = wave_s * 64 + lane_id(); asm volatile("" : "+v"(tz)); const int w2 = __builtin_amdgcn_readfirstlane(tz >> 6), l2 = tz & 63; E(acc, cur, w2 >> 2, w2 & 3, l2 & 15, l2 >> 4, tz); }
        if (!has_next) break;
#pragma unroll
        for (int a = 0; a < 2; ++a)
#pragma unroll
            for (int b = 0; b < 2; ++b)
#pragma unroll
                for (int m = 0; m < 4; ++m)
#pragma unroll
                    for (int n = 0; n < 2; ++n) acc[a][b][m][n] = (f32x4){0.f, 0.f, 0.f, 0.f};
        cur = nxt; cA = nA; cB = nB; hA = hAn; hB = hBn;
#pragma unroll
        for (int i = 0; i < 2; ++i) { vAc[i] = vAn[i]; vBc[i] = vBn[i]; vAc1[i] = vAn1[i]; }
        ++ui;
    }
    GS_WAIT_V(0);
    if (wr == 0) GS_BAR;
    GS_BAR;
#undef GS_SA
#undef GS_SB
#undef GS_STAGE
#undef GS_LDA
#undef GS_LDB
#undef GS_MMA
#undef GS_WAIT_V
#undef GS_WAIT_L
#undef GS_BAR
#undef GS_SCHED
}
}
using gs::UD;
__device__ __forceinline__ u32x4 pack8(f32x4 v0, f32x4 v1) { u32x4 w; w.x = pk2(v0[0], v0[1]); w.y = pk2(v0[2], v0[3]); w.z = pk2(v1[0], v1[1]); w.w = pk2(v1[2], v1[3]); return w; }
__device__ __forceinline__ void unpack8(u32x4 w, f32x4& v0, f32x4& v1) { v0 = (f32x4){bf_lo(w.x), bf_hi(w.x), bf_lo(w.y), bf_hi(w.y)}; v1 = (f32x4){bf_lo(w.z), bf_hi(w.z), bf_lo(w.w), bf_hi(w.w)}; }

struct EpiInproj {
    bf16_t *xrnn, *grnn, *qlat, *ckv, *qidx, *kidx; float* widx;
    __device__ __forceinline__ void operator()(const f32x4 (&acc)[2][2][4][2], const UD& u, int wr, int wc, int fr, int fq, int tid) const {
        const int pn = u.pn; const size_t row0 = (size_t)u.pm * 256 + wr * 64 + fr;
        if (pn < 19) {
            bf16_t* base; int ldc, colt; float sc = 1.f; bool gl = false;
            if (pn < 4) { base = xrnn; ldc = 1024; colt = 256 * pn; }
            else if (pn < 8) { base = grnn; ldc = 1024; colt = 256 * (pn - 4); gl = true; }
            else if (pn < 16) { base = qlat; ldc = 2048; colt = 256 * (pn - 8); }
            else if (pn == 16) { base = ckv; ldc = 256; colt = 0; }
            else { base = qidx; ldc = 512; colt = 256 * (pn - 17); sc = 0.125f; }
#pragma unroll
            for (int ai = 0; ai < 2; ++ai)
#pragma unroll
                for (int m = 0; m < 4; ++m) { bf16_t* rowp = base + (row0 + ai * 128 + m * 16) * ldc + colt + wc * 32 + 8 * fq;
#pragma unroll
                    for (int bj = 0; bj < 2; ++bj) { f32x4 v0 = acc[ai][bj][m][0], v1 = acc[ai][bj][m][1];
                        if (gl) {
#pragma unroll
                            for (int j = 0; j < 4; ++j) { v0[j] = gelu_tanh(v0[j]); v1[j] = gelu_tanh(v1[j]); } }
                        v0 = v0 * sc; v1 = v1 * sc;
                        *(u32x4*)(rowp + bj * 128) = pack8(v0, v1); } }
        } else {
#pragma unroll
            for (int ai = 0; ai < 2; ++ai)
#pragma unroll
                for (int m = 0; m < 4; ++m) { const size_t row = row0 + ai * 128 + m * 16; const f32x4 v0 = acc[ai][0][m][0], v1 = acc[ai][0][m][1];
                    if (wc < 2) *(u32x4*)(kidx + row * 64 + wc * 32 + 8 * fq) = pack8(v0, v1);
                    else if (wc == 2 && fq == 0) { *(f32x4*)(widx + row * 8) = v0 * 0.35355339059327373f; *(f32x4*)(widx + row * 8 + 4) = v1 * 0.35355339059327373f; } }
        }
    }
};
struct EpiMerge1 {
    unsigned char* s1b; unsigned char* s2b; bf16_t* merged;
    __device__ __forceinline__ void operator()(const f32x4 (&acc)[2][2][4][2], const UD& u, int wr, int wc, int fr, int fq, int tid) const {
        const int kind = u.kind;
        u32x4* s1 = (u32x4*)s1b + tid; u32x4* s2 = (u32x4*)(s2b + (size_t)(u.pm * 4 + u.pn) * 131072) + tid;
#pragma unroll
        for (int ai = 0; ai < 2; ++ai)
#pragma unroll
            for (int bj = 0; bj < 2; ++bj)
#pragma unroll
                for (int m = 0; m < 4; ++m) { const int slot = (ai * 2 + bj) * 4 + m; f32x4 v0 = acc[ai][bj][m][0], v1 = acc[ai][bj][m][1];
                    if (kind != 1) {
#pragma unroll
                        for (int j = 0; j < 4; ++j) { v0[j] = sigmoidf_(v0[j]); v1[j] = sigmoidf_(v1[j]); }
#ifdef DBG_S1_CONST
                        { const float cv = (float)(u.pm * 4 + u.pn + 1) * (1.0f / 512.0f); v0 = (f32x4){cv, cv, cv, cv}; v1 = v0; }
#endif
                        (kind == 0 ? s1 : s2)[slot * 512] = pack8(v0, v1);
                    } else {
                        f32x4 a0, a1; unpack8(__builtin_nontemporal_load(s1 + slot * 512), a0, a1);
#ifdef DBG_NO_S1
                        a0 = (f32x4){1.f, 1.f, 1.f, 1.f}; a1 = a0;
#endif
                        const size_t row = (size_t)u.pm * 256 + ai * 128 + wr * 64 + m * 16 + fr;
                        *(u32x4*)(merged + row * 1024 + u.pn * 256 + bj * 128 + wc * 32 + 8 * fq) = pack8(a0 * v0, a1 * v1);
#ifdef DBG_OUT_S1
                        *(u32x4*)(merged + row * 1024 + u.pn * 256 + bj * 128 + wc * 32 + 8 * fq) = pack8(a0, a1);
#endif
                    }
                    if (m & 1) asm volatile("" ::: "memory"); }
    }
};
struct EpiMerge2 {
    unsigned char* s2b; bf16_t* merged;
    __device__ __forceinline__ void operator()(const f32x4 (&acc)[2][2][4][2], const UD& u, int wr, int wc, int fr, int fq, int tid) const {
        const u32x4* s2 = (const u32x4*)(s2b + (size_t)(u.pm * 4 + u.pn) * 131072) + tid;
#pragma unroll
        for (int ai = 0; ai < 2; ++ai)
#pragma unroll
            for (int bj = 0; bj < 2; ++bj)
#pragma unroll
                for (int m = 0; m < 4; ++m) { const int slot = (ai * 2 + bj) * 4 + m;
                    const size_t row = (size_t)u.pm * 256 + ai * 128 + wr * 64 + m * 16 + fr;
                    u32x4* mp = (u32x4*)(merged + row * 1024 + u.pn * 256 + bj * 128 + wc * 32 + 8 * fq);
                    f32x4 a0, a1, b0, b1; unpack8(__builtin_nontemporal_load(mp), a0, a1); unpack8(__builtin_nontemporal_load(s2 + slot * 512), b0, b1);
#ifdef DBG_NO_S2
                    b0 = (f32x4){1.f, 1.f, 1.f, 1.f}; b1 = b0;
#endif
#ifdef DBG_NO_MRG
                    a0 = (f32x4){0.f, 0.f, 0.f, 0.f}; a1 = a0;
#endif
                    *mp = pack8(a0 + b0 * acc[ai][bj][m][0], a1 + b1 * acc[ai][bj][m][1]);
                    if (m & 1) asm volatile("" ::: "memory"); }
    }
};
struct EpiOut {
    bf16_t* xb;
    __device__ __forceinline__ void operator()(const f32x4 (&acc)[2][2][4][2], const UD& u, int wr, int wc, int fr, int fq, int tid) const {
#pragma unroll
        for (int ai = 0; ai < 2; ++ai)
#pragma unroll
            for (int m = 0; m < 4; ++m) { bf16_t* rowp = xb + ((size_t)u.pm * 256 + ai * 128 + wr * 64 + m * 16 + fr) * 1024 + u.pn * 256 + wc * 32 + 8 * fq;
#pragma unroll
                for (int bj = 0; bj < 2; ++bj) { u32x4* p = (u32x4*)(rowp + bj * 128); const u32x4 xv = *p; f32x4 v0 = acc[ai][bj][m][0], v1 = acc[ai][bj][m][1];
                    v0[0] += ALPHA * bf_lo(xv.x); v0[1] += ALPHA * bf_hi(xv.x); v0[2] += ALPHA * bf_lo(xv.y); v0[3] += ALPHA * bf_hi(xv.y);
                    v1[0] += ALPHA * bf_lo(xv.z); v1[1] += ALPHA * bf_hi(xv.z); v1[2] += ALPHA * bf_lo(xv.w); v1[3] += ALPHA * bf_hi(xv.w);
                    *p = pack8(v0, v1); } }
    }
};
struct EpiGU {
    bf16_t* he;
    __device__ __forceinline__ void operator()(const f32x4 (&acc)[2][2][4][2], const UD& u, int wr, int wc, int fr, int fq, int tid) const {
#pragma unroll
        for (int ai = 0; ai < 2; ++ai)
#pragma unroll
            for (int m = 0; m < 4; ++m) { bf16_t* rowp = he + ((size_t)u.pm * 256 + ai * 128 + wr * 64 + m * 16 + fr) * 512 + u.pn * 128 + wc * 16 + 4 * fq;
#pragma unroll
                for (int bj = 0; bj < 2; ++bj) { const f32x4 g = acc[ai][bj][m][0], up = acc[ai][bj][m][1]; f32x4 o;
#pragma unroll
                    for (int j = 0; j < 4; ++j) o[j] = g[j] * sigmoidf_(g[j]) * up[j];
                    u32x2 w; w.x = pk2(o[0], o[1]); w.y = pk2(o[2], o[3]); *(u32x2*)(rowp + bj * 64) = w; } }
    }
};
struct EpiBf16 {
    bf16_t* out; int ldc;
    __device__ __forceinline__ void operator()(const f32x4 (&acc)[2][2][4][2], const UD& u, int wr, int wc, int fr, int fq, int tid) const {
#pragma unroll
        for (int ai = 0; ai < 2; ++ai)
#pragma unroll
            for (int m = 0; m < 4; ++m) { bf16_t* rowp = out + ((size_t)u.pm * 256 + ai * 128 + wr * 64 + m * 16 + fr) * ldc + u.pn * 256 + wc * 32 + 8 * fq;
#pragma unroll
                for (int bj = 0; bj < 2; ++bj) *(u32x4*)(rowp + bj * 128) = pack8(acc[ai][bj][m][0], acc[ai][bj][m][1]); }
    }
};
struct EpiPro {
    unsigned char* wmix;
    __device__ __forceinline__ void operator()(const f32x4 (&acc)[2][2][4][2], const UD& u, int wr, int wc, int fr, int fq, int tid) const {
        const int l = u.aux >> 3, h = u.aux & 7, p = u.pn;
        bf16_t* base; int ldc; float sc;
        if (u.kind == 0) { base = (bf16_t*)(wmix + (size_t)l * WMIX_STRIDE + OFF_WIN) + (size_t)(2048 + 256 * h) * 1024 + 256 * p; ldc = 1024; sc = 0.08838834764831845f; }
        else { base = (bf16_t*)(wmix + (size_t)l * WMIX_STRIDE + OFF_WVO) + (size_t)(256 * p) * 2048 + 256 * h; ldc = 2048; sc = 1.f; }
#pragma unroll
        for (int ai = 0; ai < 2; ++ai)
#pragma unroll
            for (int m = 0; m < 4; ++m) { bf16_t* rowp = base + (size_t)(ai * 128 + wr * 64 + m * 16 + fr) * ldc + wc * 32 + 8 * fq;
#pragma unroll
                for (int bj = 0; bj < 2; ++bj) *(u32x4*)(rowp + bj * 128) = pack8(acc[ai][bj][m][0] * sc, acc[ai][bj][m][1] * sc); }
    }
};

struct SchedDense {
    const char* A; const char* B; unsigned lda, ldb; int nt, nM, nN, G, c;
    __device__ __forceinline__ bool next(int i, UD& u) const {
        int pm, pn; if (!gs::tile_of((long)i * G + c, nM, nN, pm, pn)) return false;
        u.A = A + (size_t)pm * 256 * lda; u.B = B + (size_t)pn * 256 * ldb; u.lda = lda; u.ldb = ldb; u.nt = nt; u.kind = 0; u.pm = pm; u.pn = pn; u.aux = 0; return true;
    }
};
struct SchedMerge1 {
    const char *xb, *yrnn, *wg, *wpr; int G, c;
    __device__ __forceinline__ bool next(int i_, UD& u) const { int i = i_;
#ifdef DBG_DUPFIRST
        if (i > 0) i -= 1;
#endif
#ifdef DBG_ORDER201
        const int ti = i / 3, kk_ = i - 3 * ti, k = kk_ == 0 ? 2 : kk_ - 1;
#else
        const int ti = i / 3, k = i - 3 * ti;
#endif
        int pm, pn; if (!gs::tile_of((long)ti * G + c, T / 256, 4, pm, pn)) return false;
        u.kind = k; u.pm = pm; u.pn = pn; u.aux = 0; u.lda = 2048; u.ldb = 2048; u.nt = 16;
#ifdef DBG_K0_AS_K1
        if (k == 0) { u.A = yrnn + (size_t)pm * 256 * 2048; u.B = wpr + (size_t)pn * 256 * 2048; }
#else
        if (k == 0) { u.A = xb + (size_t)pm * 256 * 2048; u.B = wg + (size_t)pn * 256 * 2048; }
#endif
        else if (k == 1) { u.A = yrnn + (size_t)pm * 256 * 2048; u.B = wpr + (size_t)pn * 256 * 2048; }
        else { u.A = xb + (size_t)pm * 256 * 2048; u.B = wg + (size_t)(1024 + pn * 256) * 2048; }
        return true;
    }
};
struct SchedMoE {
    const char* A; const char* B; unsigned lda, ldb; size_t bstride; int nt, nN, G, c; const LAS int* offp;
    __device__ __forceinline__ bool next(int i, UD& u) const {
        const int nM = offp[16] >> 8; int pm, pn; if (!gs::tile_of((long)i * G + c, nM, nN, pm, pn)) return false;
        int e = 0;
#pragma unroll 1
        for (int j = 1; j < 16; ++j) e += (pm * 256 >= offp[j]) ? 1 : 0;
        u.A = A + (size_t)pm * 256 * lda; u.B = B + (size_t)e * bstride + (size_t)pn * 256 * ldb; u.lda = lda; u.ldb = ldb; u.nt = nt; u.kind = 0; u.pm = pm; u.pn = pn; u.aux = e; return true;
    }
};
struct SchedMoEG {
    const char* A; const char* B; unsigned lda, ldb; size_t bstride; int nt, nN, G, c; const LAS int* offp; const int* rmap;
    __device__ __forceinline__ bool next(int i, UD& u) const {
        const int nM = offp[16] >> 8; int pm, pn; if (!gs::tile_of((long)i * G + c, nM, nN, pm, pn)) return false;
        int e = 0;
#pragma unroll 1
        for (int j = 1; j < 16; ++j) e += (pm * 256 >= offp[j]) ? 1 : 0;
        u.A = A; u.B = B + (size_t)e * bstride + (size_t)pn * 256 * ldb; u.lda = lda; u.ldb = ldb; u.nt = nt; u.kind = 0; u.pm = pm; u.pn = pn; u.aux = e; return true;
    }
};
struct SchedPro {
    const unsigned char* tmp; int G, c;
    __device__ __forceinline__ bool next(int i, UD& u) const {
        const long L = (long)i * G + c; if (L >= 256) return false;
        const int kind = (int)(L >> 7), l = (int)(L >> 5) & 3, h = (int)(L >> 2) & 7, p = (int)L & 3;
        u.kind = kind; u.aux = l * 8 + h; u.pm = 0; u.pn = p; u.nt = 4; u.lda = 2048; u.ldb = 2048;
        if (kind == 0) { u.A = (const char*)tmp + R_UKP + ((size_t)(l * 8 + h) * 256) * 2048;
                         u.B = (const char*)tmp + R_WQ + (size_t)l * 2 * MiB + (size_t)(256 * p) * 2048 + (size_t)(h >> 1) * 512; }
        else { u.A = (const char*)tmp + R_PT + (size_t)l * 2 * MiB + (size_t)(256 * p) * 2048 + (size_t)(h >> 1) * 512;
               u.B = (const char*)tmp + R_UVP + ((size_t)(l * 8 + h) * 256) * 2048; }
        return true;
    }
};

__device__ __forceinline__ void tr_item(const float* src, int ld, int c0, int nvalid, bf16_t* dst, int lddst, int mode, int item, int nblk, LAS float* scr, int lane) {
    const int kb = item / nblk, nb = item - kb * nblk, k0 = 64 * kb, n0 = 32 * nb;
    const int cc = 4 * (lane & 7); const bool ok = n0 + cc < nvalid;
    f32x4 tv_[8];
#pragma unroll
    for (int i = 0; i < 8; ++i) { const int kk = 8 * i + (lane >> 3); tv_[i] = ok ? *(const f32x4*)(src + (size_t)(k0 + kk) * ld + c0 + n0 + cc) : (f32x4){0.f, 0.f, 0.f, 0.f}; }
#pragma unroll
    for (int i = 0; i < 8; ++i) { const int kk = 8 * i + (lane >> 3);
#pragma unroll
        for (int j = 0; j < 4; ++j) scr[kk * 33 + cc + j] = tv_[i][j]; }
    asm volatile("s_waitcnt lgkmcnt(0)" ::: "memory");
    const int c = lane & 7;
#pragma unroll
    for (int j = 0; j < 4; ++j) { const int nl = (lane >> 3) + 8 * j; const int nn = n0 + nl; const int row = mode ? (8 * (nn >> 2) + (nn & 3)) : nn; const LAS float* s = scr + (8 * c) * 33 + nl;
        u32x4 o; o.x = pk2(s[0 * 33], s[1 * 33]); o.y = pk2(s[2 * 33], s[3 * 33]); o.z = pk2(s[4 * 33], s[5 * 33]); o.w = pk2(s[6 * 33], s[7 * 33]);
        *(u32x4*)(dst + (size_t)row * lddst + k0 + 8 * c) = o; }
    asm volatile("s_waitcnt lgkmcnt(0)" ::: "memory");
}
__device__ __forceinline__ float expm1_acc(float x) {
    if (x > -0.35f) { float p = 1.0f + x * (1.0f / 8.0f); p = 1.0f + x * (1.0f / 7.0f) * p; p = 1.0f + x * (1.0f / 6.0f) * p; p = 1.0f + x * (1.0f / 5.0f) * p; p = 1.0f + x * 0.25f * p; p = 1.0f + x * (1.0f / 3.0f) * p; p = 1.0f + x * 0.5f * p; return x * p; }
    return fast_exp(x) - 1.0f;
}
struct RnnP { const bf16_t* xrnn; bf16_t* gy; float* tot; const bf16_t *waT, *wxT; const float *convw, *convb, *ba, *bx, *lam; };
template <int PASS>
__device__ __forceinline__ void rnn_item(const RnnP& P, int item, LAS unsigned char* wlds, int lane) {
    const int b = item >> 10, g = (item >> 6) & 15, seg = item & 63, ch0 = 64 * g;
    const int row = lane & 15, kg = lane >> 4, col = lane & 15;
    LAS float* CW = (LAS float*)wlds;
    LAS float* XR = CW + 320;
#pragma unroll
    for (int k = 0; k < 4; ++k) CW[k * 64 + lane] = P.convw[k * 1024 + ch0 + lane];
    CW[256 + lane] = P.convb[ch0 + lane];
    bf16x8 Ba[4][2], Bx[4][2];
#pragma unroll
    for (int jt = 0; jt < 4; ++jt)
#pragma unroll
        for (int s = 0; s < 2; ++s) { const size_t o = ((size_t)g * 64 + 16 * jt + col) * 64 + 32 * s + 8 * kg; Ba[jt][s] = *(const bf16x8*)(P.waT + o); Bx[jt][s] = *(const bf16x8*)(P.wxT + o); }
    float cba[4], cbx[4], sp8[4], h0[4], Pc[4];
#pragma unroll
    for (int jt = 0; jt < 4; ++jt) { const int ch = ch0 + 16 * jt + col; cba[jt] = P.ba[ch]; cbx[jt] = P.bx[ch]; const float lm = P.lam[ch]; sp8[jt] = -8.0f * log1pf(expf(-lm)); h0[jt] = 0.f; Pc[jt] = 1.f; }
    float* totp = P.tot + ((size_t)(b * 64) * 1024 + ch0 + col) * 2;
    if (PASS == 2 && seg > 0) {
        const int Q = (seg + 3) >> 2, slo = kg * Q;
        float Pq[4] = {1.f, 1.f, 1.f, 1.f}, Hq[4] = {0.f, 0.f, 0.f, 0.f};
        for (int i0 = 0; i0 < Q; i0 += 4) {
            f32x2 ph[4][4];
#pragma unroll
            for (int i = 0; i < 4; ++i) { int s2 = slo + i0 + i; s2 = s2 < seg ? s2 : seg - 1;
#pragma unroll
                for (int jt = 0; jt < 4; ++jt) ph[i][jt] = *(const f32x2*)(totp + ((size_t)s2 * 1024 + 16 * jt) * 2); }
#pragma unroll
            for (int i = 0; i < 4; ++i) { const bool ok = (i0 + i < Q) && (slo + i0 + i < seg);
#pragma unroll
                for (int jt = 0; jt < 4; ++jt) { const float px = ok ? ph[i][jt].x : 1.f, hy = ok ? ph[i][jt].y : 0.f; Hq[jt] = px * Hq[jt] + hy; Pq[jt] = Pq[jt] * px; } }
        }
#pragma unroll
        for (int jt = 0; jt < 4; ++jt) {
            const float H0 = __shfl(Hq[jt], col), P1 = __shfl(Pq[jt], col + 16), H1 = __shfl(Hq[jt], col + 16), P2 = __shfl(Pq[jt], col + 32), H2 = __shfl(Hq[jt], col + 32),
                        P3 = __shfl(Pq[jt], col + 48), H3 = __shfl(Hq[jt], col + 48);
            float h = H0; h = P1 * h + H1; h = P2 * h + H2; h = P3 * h + H3; h0[jt] = h; }
    }
    asm volatile("s_waitcnt lgkmcnt(0)" ::: "memory");
    const size_t rowb = (size_t)b * SEQ;
    u32x4 xn[4][2];
    { const int tA0 = seg * 256 + row;
#pragma unroll
      for (int dt = 0; dt < 4; ++dt) { const int tt = tA0 - 3 + dt;
#pragma unroll
          for (int s = 0; s < 2; ++s) xn[dt][s] = (tt >= 0) ? *(const u32x4*)(P.xrnn + (rowb + tt) * 1024 + ch0 + 32 * s + 8 * kg) : (u32x4){0u, 0u, 0u, 0u}; } }
    for (int tile = 0; tile < 16; ++tile) {
        const int t0 = seg * 256 + tile * 16;
        u32x4 xw[4][2];
#pragma unroll
        for (int dt = 0; dt < 4; ++dt)
#pragma unroll
            for (int s = 0; s < 2; ++s) xw[dt][s] = xn[dt][s];
        if (tile + 1 < 16) { const int tB = t0 + 16 + row;
#pragma unroll
            for (int dt = 0; dt < 4; ++dt) { const int tt = tB - 3 + dt;
#pragma unroll
                for (int s = 0; s < 2; ++s) xn[dt][s] = *(const u32x4*)(P.xrnn + (rowb + tt) * 1024 + ch0 + 32 * s + 8 * kg); } }
        bf16_t gq[4][4];
        if (PASS == 2) { const bf16_t* gp0 = P.gy + (rowb + t0 + 4 * kg) * 1024 + ch0 + col;
#pragma unroll
            for (int jt = 0; jt < 4; ++jt)
#pragma unroll
                for (int r = 0; r < 4; ++r) gq[jt][r] = gp0[(size_t)r * 1024 + 16 * jt]; }
        bf16x8 Af[2];
#pragma unroll
        for (int s = 0; s < 2; ++s) {
            const int cl = 32 * s + 8 * kg;
            f32x4 o0 = *(LAS f32x4*)(CW + 256 + cl), o1 = *(LAS f32x4*)(CW + 256 + cl + 4);
#pragma unroll
            for (int dt = 0; dt < 4; ++dt) { const f32x4 w0 = *(LAS f32x4*)(CW + dt * 64 + cl), w1 = *(LAS f32x4*)(CW + dt * 64 + cl + 4); const u32x4 x = xw[dt][s];
                o0[0] += w0[0] * bf_lo(x.x); o0[1] += w0[1] * bf_hi(x.x); o0[2] += w0[2] * bf_lo(x.y); o0[3] += w0[3] * bf_hi(x.y);
                o1[0] += w1[0] * bf_lo(x.z); o1[1] += w1[1] * bf_hi(x.z); o1[2] += w1[2] * bf_lo(x.w); o1[3] += w1[3] * bf_hi(x.w); }
            *(LAS f32x4*)(XR + row * 68 + cl) = o0; *(LAS f32x4*)(XR + row * 68 + cl + 4) = o1;
            const u32x4 pk = pack8(o0, o1); Af[s] = __builtin_bit_cast(bf16x8, pk);
        }
        f32x4 ar[4], ax[4];
#pragma unroll
        for (int jt = 0; jt < 4; ++jt) { ar[jt] = (f32x4){0.f, 0.f, 0.f, 0.f}; ax[jt] = ar[jt];
#pragma unroll
            for (int s = 0; s < 2; ++s) { ar[jt] = __builtin_amdgcn_mfma_f32_16x16x32_bf16(Af[s], Ba[jt][s], ar[jt], 0, 0, 0); ax[jt] = __builtin_amdgcn_mfma_f32_16x16x32_bf16(Af[s], Bx[jt][s], ax[jt], 0, 0, 0); } }
        asm volatile("s_waitcnt lgkmcnt(0)" ::: "memory");
#pragma unroll
        for (int jt = 0; jt < 4; ++jt) {
            float Pp[4], Hp[4]; float pr = 1.f, hr = 0.f;
#pragma unroll
            for (int r = 0; r < 4; ++r) {
                const float xr = XR[(4 * kg + r) * 68 + 16 * jt + col];
                const float rg = sigmoidf_(ar[jt][r] + cba[jt]), ig = sigmoidf_(ax[jt][r] + cbx[jt]);
                const float la = sp8[jt] * rg; const float a = fast_exp(la); const float em = a - 1.0f;
                const float mm = __builtin_amdgcn_sqrtf(fmaxf(-em * (2.0f + em), 0.f));
                const float uu = mm * ig * xr;
                hr = a * hr + uu; pr = pr * a; Pp[r] = pr; Hp[r] = hr;
            }
            const float P0 = __shfl(pr, col), P1 = __shfl(pr, col + 16), P2 = __shfl(pr, col + 32), P3 = __shfl(pr, col + 48);
            const float H0 = __shfl(hr, col), H1 = __shfl(hr, col + 16), H2 = __shfl(hr, col + 32), H3 = __shfl(hr, col + 48);
            const float h1 = P0 * h0[jt] + H0, h2 = P1 * h1 + H1, h3 = P2 * h2 + H2, h4 = P3 * h3 + H3;
            if (PASS == 2) {
                const float hs = kg == 0 ? h0[jt] : (kg == 1 ? h1 : (kg == 2 ? h2 : h3));
                bf16_t* gp = P.gy + (rowb + t0 + 4 * kg) * 1024 + ch0 + 16 * jt + col;
#pragma unroll
                for (int r = 0; r < 4; ++r) { const float hv = Pp[r] * hs + Hp[r]; const float gg = bf2f(gq[jt][r]); gp[(size_t)r * 1024] = (bf16_t)f2bf(hv * gg); }
            } else Pc[jt] = Pc[jt] * (P0 * P1) * (P2 * P3);
            h0[jt] = h4;
        }
    }
    if (PASS == 1 && kg == 0) {
#pragma unroll
        for (int jt = 0; jt < 4; ++jt) *(f32x2*)(totp + ((size_t)seg * 1024 + 16 * jt) * 2) = (f32x2){Pc[jt], h0[jt]};
    }
}
__device__ __forceinline__ void ckv_norm_rows4(bf16_t* base, int row0, int rstep, int nrows, const float* gain, int lane) {
    u32x2 w[4];
#pragma unroll
    for (int i = 0; i < 4; ++i) { const int r = row0 + i * rstep; w[i] = *(const u32x2*)(base + (size_t)(r < nrows ? r : row0) * 256 + 4 * lane); }
    const f32x4 gn = *(const f32x4*)(gain + 4 * lane);
#pragma unroll
    for (int i = 0; i < 4; ++i) { const int r = row0 + i * rstep;
        const float v0 = bf_lo(w[i].x), v1 = bf_hi(w[i].x), v2 = bf_lo(w[i].y), v3 = bf_hi(w[i].y);
        const float ss = wave_sum(v0 * v0 + v1 * v1 + v2 * v2 + v3 * v3);
        const float rs = 1.0f / __builtin_sqrtf(ss * (1.0f / 256.0f) + RMS_EPS);
        u32x2 o; o.x = pk2(v0 * rs * gn[0], v1 * rs * gn[1]); o.y = pk2(v2 * rs * gn[2], v3 * rs * gn[3]);
        if (r < nrows) *(u32x2*)(base + (size_t)r * 256 + 4 * lane) = o; }
}
constexpr int AT_CAND = 0, AT_KBUF = 65536, AT_KROW = 144, AT_KCH = 256 * AT_KROW, AT_SEL = 139264, AT_BIAS = 155648, AT_BKT = 156672, AT_GROW = 544, AT_GBUF = 32 * AT_GROW;
constexpr int AT_NBIN = 512, AT_CAP = 256, AT_LCAP = 1024, AT_TIEF = 157184, AT_BIAS2 = 157440;
#ifndef AT_SAMPLE_MIN_U
#define AT_SAMPLE_MIN_U 64
#endif
#ifndef AT_LBREF
#define AT_LBREF 0
#endif
struct AttnP { const bf16_t *qidx, *kidx, *ckv; const float* widx; bf16_t* qlat; unsigned long long* cbuf; };

__device__ __forceinline__ unsigned ord_key(float s) { const unsigned b = __builtin_bit_cast(unsigned, s); return (b & 0x80000000u) ? ~b : (b | 0x80000000u); }

__device__ __forceinline__ void hist_scan(const LAS unsigned* hq, int lane, int kth, int& bsel, int& cat, int& abat) {
    const u32x4 w0 = *(const LAS u32x4*)(hq + 8 * lane), w1 = *(const LAS u32x4*)(hq + 8 * lane + 4);
    int cnt[8];
    cnt[0] = (int)w0.x; cnt[1] = (int)w0.y; cnt[2] = (int)w0.z; cnt[3] = (int)w0.w; cnt[4] = (int)w1.x; cnt[5] = (int)w1.y; cnt[6] = (int)w1.z; cnt[7] = (int)w1.w;
    int s = 0;
#pragma unroll
    for (int i = 0; i < 8; ++i) s += cnt[i];
    int S = s;
#pragma unroll
    for (int off = 1; off < 64; off <<= 1) { const int v = __shfl_down(S, off); if (lane + off < 64) S += v; }
    bsel = -1; cat = 0; abat = 0;
    const unsigned long long mk = __ballot(S >= kth);
    if (mk != 0ull) {
        const int Ls = 63 - __builtin_clzll(mk);
        int above = S - s; bool found = false;
#pragma unroll
        for (int bb = 7; bb >= 0; --bb) { const int c = cnt[bb]; if (!found && above + c >= kth) { bsel = 8 * lane + bb; cat = c; abat = above; found = true; } above += c; }
        bsel = __shfl(bsel, Ls); cat = __shfl(cat, Ls); abat = __shfl(abat, Ls);
    }
}
__device__ __forceinline__ int key_row(int r, bool sm, int u) { if (sm) { r = r * 8 + (u & 7); r = r < SEQ ? r : SEQ - 1; } return r; }
template <int MODE>
__device__ __forceinline__ void attn_pass(LAS unsigned char* lds, const bf16x8 (&afr)[4], const float (&wq)[2][9], const bf16_t* kbase, int u, int wave, int lane, int tid,
                                          const int (&b0e)[2], const int (&neede)[2], const int (&tiee)[2], int (&csel)[2], int (&ccand)[2], unsigned long long* cbw, int samp = 0) {
    const int hh = lane >> 5, kcol = lane & 31;
    LAS unsigned* HIST = (LAS unsigned*)lds; LAS unsigned long long* CAND = (LAS unsigned long long*)(lds + AT_CAND); LAS unsigned short* SEL = (LAS unsigned short*)(lds + AT_SEL);
    const bool sm = (MODE == 0) && (samp != 0);
    const int nst = u >> 3, nch = sm ? ((nst + 7) >> 3) : (u >> 3) + 1;
    float lbt[2];
#pragma unroll
    for (int e = 0; e < 2; ++e) lbt[e] = ((MODE == 1 || MODE == 3) && b0e[e] >= 1) ? (float)b0e[e] : -3.0e38f;
    u32x4 st[4];
    const int lofs = (tid >> 3) * AT_KROW + (tid & 7) * 16;
#define AT_KADDR(C, I) (kbase + (size_t)key_row((C) * 256 + (tid >> 3) + 64 * (I), sm, u) * 64 + (tid & 7) * 8)
#pragma unroll
    for (int i = 0; i < 4; ++i) st[i] = *(const u32x4*)AT_KADDR(0, i);
#pragma unroll
    for (int i = 0; i < 4; ++i) *(LAS u32x4*)(lds + AT_KBUF + lofs + i * 64 * AT_KROW) = st[i];
    __syncthreads();
    for (int c = 0; c < nch; ++c) {
        if (c + 1 < nch) {
#pragma unroll
            for (int i = 0; i < 4; ++i) st[i] = *(const u32x4*)AT_KADDR(c + 1, i);
        }
        const LAS unsigned char* kb = lds + AT_KBUF + (c & 1) * AT_KCH + kcol * AT_KROW + hh * 16;
        const int ntile = sm ? ((nst - 8 * c) < 8 ? (nst - 8 * c) : 8) : ((c + 1 < nch) ? 8 : (u & 7) + 1);
#define AT_READ(BF, TT) do { _Pragma("unroll") for (int ks = 0; ks < 4; ++ks) BF[ks] = *(const LAS bf16x8*)(kb + (TT) * 32 * AT_KROW + ks * 32); } while (0)
#define AT_MFMA(ACC, BF) do { _Pragma("unroll") for (int i_ = 0; i_ < 16; ++i_) ACC[i_] = 0.f; \
            _Pragma("unroll") for (int ks = 0; ks < 4; ++ks) ACC = __builtin_amdgcn_mfma_f32_32x32x16_bf16(afr[ks], BF[ks], ACC, 0, 0, 0); } while (0)
          \

#define AT_POST(ACC, KT, DIAG) do { const int kt = (KT); \
            float sc[2]; \
            _Pragma("unroll") for (int e = 0; e < 2; ++e) { float s = 0.f; \
                _Pragma("unroll") for (int i = 0; i < 8; ++i) s = __builtin_fmaf(wq[e][i], __builtin_amdgcn_fmed3f(ACC[8 * e + i], 0.f, 3.0e38f), s); \
                sc[e] = s; } \
            _Pragma("unroll") for (int e = 0; e < 2; ++e) { \
                const int q = 4 * wave + 2 * hh + e; \
                const float tv = __builtin_fmaf(sc[e], wq[e][8], 256.0f); \
                const bool cz = !(DIAG) || (kt < u) || (kcol <= q); \
                const bool live = cz && tv >= lbt[e]; \
                if (MODE == 3) { \
                    const unsigned long long m3 = __ballot(live); \
                    { \
                        const unsigned h3 = hh ? (unsigned)(m3 >> 32) : (unsigned)m3; \
                        const int pa = ccand[e] + __builtin_popcount(h3 & ((1u << kcol) - 1u)); \
                        if (live) { u32x2 ent;      \
                             ent.x = (unsigned)(kt * 32 + kcol); ent.y = __builtin_bit_cast(unsigned, sc[e]); \
                            *(u32x2*)((char*)cbw + ((unsigned)((2 * hh + e) * AT_LCAP + pa) * 8u)) = ent; } \
                        ccand[e] += __builtin_popcount(h3); \
                    } \
                } else if (MODE == 0) { \
                    const int bin = (int)__builtin_amdgcn_fmed3f(tv, 0.0f, 511.5f); \
                    LAS unsigned* hp = HIST + q * AT_NBIN + bin; \
                    if (cz) __hip_atomic_fetch_add(hp, 1u, __ATOMIC_RELAXED, __HIP_MEMORY_SCOPE_WORKGROUP); \
                } else if (__ballot(live) != 0ull) { \
                    const int bin = (int)__builtin_amdgcn_fmed3f(tv, 0.0f, 511.5f); \
                    const int key = kt * 32 + kcol; \
                    const bool cc = live && bin == b0e[e]; \
                    const unsigned long long m2 = __ballot(cc); const unsigned h2 = hh ? (unsigned)(m2 >> 32) : (unsigned)m2; \
                    const int pc = ccand[e] + __builtin_popcount(h2 & ((1u << kcol) - 1u)); \
                    if (cc && !tiee[e] && pc < AT_CAP) CAND[q * AT_CAP + pc] = ((unsigned long long)ord_key(sc[e]) << 32) | (unsigned)(0xFFFFu - key); \
                    ccand[e] += __builtin_popcount(h2); \
                    const bool cs = live && (bin > b0e[e] || (tiee[e] && cc && pc < neede[e])); \
                    const unsigned long long m1 = __ballot(cs); const unsigned h1 = hh ? (unsigned)(m1 >> 32) : (unsigned)m1; \
                    if (cs) SEL[q * 256 + csel[e] + __builtin_popcount(h1 & ((1u << kcol) - 1u))] = (unsigned short)key; \
                    csel[e] += __builtin_popcount(h1); \
                } \
            } } while (0)
#define AT_TILES(NT, DIAG, PRAG) do { \
        AT_READ(B0, 0); if ((NT) > 1) AT_READ(B1, 1); \
        AT_MFMA(accA, B0); \
        PRAG for (int tt = 0; tt < (NT); tt += 2) { \
            if (tt + 2 < (NT)) AT_READ(B0, tt + 2); \
            if (tt + 1 < (NT)) AT_MFMA(accB, B1); \
            AT_POST(accA, c * 8 + tt, DIAG); \
            if (tt + 1 < (NT)) { \
                if (tt + 3 < (NT)) AT_READ(B1, tt + 3); \
                if (tt + 2 < (NT)) AT_MFMA(accA, B0); \
                AT_POST(accB, c * 8 + tt + 1, DIAG); \
            } \
        } } while (0)
        f32x16 accA, accB; bf16x8 B0[4], B1[4];
        if (sm ? (ntile == 8) : (c + 1 < nch)) AT_TILES(8, false, _Pragma("unroll"));
        else AT_TILES(ntile, true, _Pragma("unroll 1"));
#undef AT_TILES
#undef AT_POST
#undef AT_KADDR
#undef AT_READ
#undef AT_MFMA
        if (MODE == 0 && AT_LBREF && c + 1 < nch && (c < 4 || (c & 3) == 3)) {
#pragma unroll
            for (int q = 0; q < 4; ++q) { int bs, c1, c2; hist_scan(HIST + (4 * wave + q) * AT_NBIN, lane, 256, bs, c1, c2);
                const float lb = bs >= 1 ? (float)bs : -3.0e38f;
                if ((q >> 1) == hh) lbt[q & 1] = lb; }
        }
        if (c + 1 < nch) {
#pragma unroll
            for (int i = 0; i < 4; ++i) *(LAS u32x4*)(lds + AT_KBUF + ((c + 1) & 1) * AT_KCH + lofs + i * 64 * AT_KROW) = st[i];
        }
        __syncthreads();
    }
}

__device__ __forceinline__ void attn_unit(LAS unsigned char* lds, const AttnP& P, int b, int u, int tid_) {
    int tid = tid_; asm volatile("" : "+v"(tid));
    const int wave = __builtin_amdgcn_readfirstlane(tid >> 6), lane = tid & 63, hh = lane >> 5, kcol = lane & 31;
    LAS unsigned* HIST = (LAS unsigned*)lds; LAS unsigned long long* CAND = (LAS unsigned long long*)(lds + AT_CAND); LAS unsigned short* SEL = (LAS unsigned short*)(lds + AT_SEL);
    const LAS float* BIAS2 = (const LAS float*)(lds + AT_BIAS2);
    const int t0 = 32 * u; const size_t rowb = (size_t)b * SEQ;
    __syncthreads();
#pragma unroll
    for (int i = 0; i < 8; ++i) *(LAS u32x4*)(lds + (i * 512 + tid) * 16) = (u32x4){0u, 0u, 0u, 0u};
    if (tid == 0) *(LAS unsigned*)(lds + AT_TIEF) = 0u;
    bf16x8 afr[4]; float wq[2][9];
    { const int rho = kcol, j = rho >> 3, r = rho & 3, hq = (rho >> 2) & 1, head = 4 * (j & 1) + r, qloc = 2 * hq + (j >> 1);
      const bf16_t* qp = P.qidx + (rowb + t0 + 4 * wave + qloc) * 512 + head * 64 + 8 * hh;
#pragma unroll
      for (int ks = 0; ks < 4; ++ks) afr[ks] = *(const bf16x8*)(qp + ks * 16);
#pragma unroll
      for (int e = 0; e < 2; ++e) { const float* wp = P.widx + (rowb + t0 + 4 * wave + 2 * hh + e) * 8; const f32x4 a = *(const f32x4*)wp, c = *(const f32x4*)(wp + 4);
          wq[e][0] = a[0]; wq[e][1] = a[1]; wq[e][2] = a[2]; wq[e][3] = a[3]; wq[e][4] = c[0]; wq[e][5] = c[1]; wq[e][6] = c[2]; wq[e][7] = c[3];
          const float ss = (a[0] * a[0] + a[1] * a[1]) + (a[2] * a[2] + a[3] * a[3]) + (c[0] * c[0] + c[1] * c[1]) + (c[2] * c[2] + c[3] * c[3]);
          wq[e][8] = 32.0f / __builtin_sqrtf(fmaxf(ss, 1.0e-12f)); } }
    const bf16_t* kbase = P.kidx + rowb * 64;
    int b0e[2] = {0, 0}, neede[2] = {0, 0}, tiee[2] = {0, 0}, csel[2] = {0, 0}, ccand[2] = {0, 0};
    int b0q[4], needq[4], nb0q[4], csq[4];
    unsigned long long* cbw = P.cbuf + (size_t)(4 * wave) * AT_LCAP;
#pragma unroll 1
    for (int att = (u >= AT_SAMPLE_MIN_U) ? 0 : 1; att < 2; ++att) {
        int tl = tid; asm volatile("" : "+v"(tl));
        const int ll = tl & 63, hl = ll >> 5;
        if (att == 1 && u >= AT_SAMPLE_MIN_U) {
            __syncthreads();
#pragma unroll
            for (int i = 0; i < 8; ++i) *(LAS u32x4*)(lds + (i * 512 + tl) * 16) = (u32x4){0u, 0u, 0u, 0u};
            if (tl == 0) *(LAS unsigned*)(lds + AT_TIEF) = 0u;
        }
        csel[0] = 0; csel[1] = 0; ccand[0] = 0; ccand[1] = 0;
        attn_pass<0>(lds, afr, wq, kbase, u, wave, ll, tl, b0e, neede, tiee, csel, ccand, nullptr, att == 0 ? 1 : 0);
        const int kth = att == 0 ? 64 : 256;
#pragma unroll
        for (int q = 0; q < 4; ++q) {
            const int nq = t0 + 4 * wave + q + 1;
            int bsel, cat, abat; hist_scan(HIST + (4 * wave + q) * AT_NBIN, ll, kth, bsel, cat, abat);
            if (att == 1 && nq <= 256) { bsel = -1; cat = 0; abat = 0; }
            b0q[q] = bsel; nb0q[q] = cat; needq[q] = (nq > 256) ? (256 - abat) : 0;
        }
        b0e[0] = hl ? b0q[2] : b0q[0]; b0e[1] = hl ? b0q[3] : b0q[1];
        neede[0] = hl ? needq[2] : needq[0]; neede[1] = hl ? needq[3] : needq[1];
        tiee[0] = (att == 1) && ((hl ? nb0q[2] : nb0q[0]) > AT_CAP); tiee[1] = (att == 1) && ((hl ? nb0q[3] : nb0q[1]) > AT_CAP);
        if ((tiee[0] | tiee[1]) != 0) *(LAS unsigned*)(lds + AT_TIEF) = 1u;
        __syncthreads();
        if (att == 1 && *(const LAS unsigned*)(lds + AT_TIEF) != 0u) {
            attn_pass<1>(lds, afr, wq, kbase, u, wave, ll, tl, b0e, neede, tiee, csel, ccand, cbw);
#pragma unroll
            for (int q = 0; q < 4; ++q) { const int cv = (q & 1) ? csel[1] : csel[0]; csq[q] = __builtin_amdgcn_readlane(cv, (q >> 1) * 32); }
            break;
        }
        if (att == 0) {
#pragma unroll
            for (int i = 0; i < 8; ++i) *(LAS u32x4*)(lds + wave * 8192 + (i * 64 + ll) * 16) = (u32x4){0u, 0u, 0u, 0u};
        }
        attn_pass<3>(lds, afr, wq, kbase, u, wave, ll, tl, b0e, neede, tiee, csel, ccand, cbw);
        asm volatile("s_waitcnt vmcnt(0)" ::: "memory");
        if (att == 0) {
            bool ok = true;
#pragma unroll
            for (int q = 0; q < 4; ++q) {
                const int cv = (q & 1) ? ccand[1] : ccand[0]; const int nraw = __builtin_amdgcn_readlane(cv, (q >> 1) * 32); ok = ok && nraw >= 256 && nraw <= AT_LCAP;
                const int n = nraw > AT_LCAP ? AT_LCAP : nraw;
                const float scl = (q & 2) ? __shfl(wq[q & 1][8], 32) : __shfl(wq[q & 1][8], 0);
#pragma unroll
                for (int jb = 0; jb < AT_LCAP / 256; ++jb) {
                    if (256 * jb < n) {
                        unsigned long long ent[4];
#pragma unroll
                        for (int j = 0; j < 4; ++j) { const int i = 256 * jb + 64 * j + ll; ent[j] = (i < n) ? __builtin_nontemporal_load(cbw + q * AT_LCAP + i) : 0ull; }
#pragma unroll
                        for (int j = 0; j < 4; ++j) { const int i = 256 * jb + 64 * j + ll; const float scv = __builtin_bit_cast(float, (unsigned)(ent[j] >> 32));
                            const int bin = (int)__builtin_amdgcn_fmed3f(__builtin_fmaf(scv, scl, 256.0f), 0.0f, 511.5f);
                            if (i < n) __hip_atomic_fetch_add(HIST + (4 * wave + q) * AT_NBIN + bin, 1u, __ATOMIC_RELAXED, __HIP_MEMORY_SCOPE_WORKGROUP); }
                    }
                }
            }
            asm volatile("s_waitcnt lgkmcnt(0)" ::: "memory");
#pragma unroll
            for (int q = 0; q < 4; ++q) {
                int bsel, cat, abat; hist_scan(HIST + (4 * wave + q) * AT_NBIN, ll, 256, bsel, cat, abat);
                ok = ok && bsel >= 0;
                b0q[q] = bsel; nb0q[q] = cat; needq[q] = 256 - abat;
            }
            if (!ok) *(LAS unsigned*)(lds + AT_TIEF) = 1u;
            __syncthreads();
            if (*(const LAS unsigned*)(lds + AT_TIEF) != 0u) continue;
        }
#pragma unroll
        for (int q = 0; q < 4; ++q) {
            const int cv = (q & 1) ? ccand[1] : ccand[0]; int n = __builtin_amdgcn_readlane(cv, (q >> 1) * 32); n = n > AT_LCAP ? AT_LCAP : n;
            const int b0 = b0q[q], need = needq[q]; const bool tieq = nb0q[q] > AT_CAP;
            const float scl = (q & 2) ? __shfl(wq[q & 1][8], 32) : __shfl(wq[q & 1][8], 0);
            int cs = 0, cc = 0;
#pragma unroll
            for (int jb = 0; jb < AT_LCAP / 256; ++jb) {
                if (256 * jb < n) {
                    unsigned long long ent[4];
#pragma unroll
                    for (int j = 0; j < 4; ++j) { const int i = 256 * jb + 64 * j + ll; ent[j] = (i < n) ? __builtin_nontemporal_load(cbw + q * AT_LCAP + i) : 0ull; }
#pragma unroll
                    for (int j = 0; j < 4; ++j) {
                        const unsigned long long v = ent[j]; const bool in = 256 * jb + 64 * j + ll < n;
                        const float scv = __builtin_bit_cast(float, (unsigned)(v >> 32));
                        const int bin = (int)__builtin_amdgcn_fmed3f(__builtin_fmaf(scv, scl, 256.0f), 0.0f, 511.5f);
                        const bool isc = in && bin == b0;
                        const unsigned long long mc = __ballot(isc);
                        const int pc = cc + __builtin_popcountll(mc & ((1ull << ll) - 1ull));
                        const bool isa = in && (bin > b0 || (tieq && isc && pc < need));
                        const unsigned long long ms = __ballot(isa);
                        if (isa) SEL[(4 * wave + q) * 256 + cs + __builtin_popcountll(ms & ((1ull << ll) - 1ull))] = (unsigned short)(v & 0xFFFFu);
                        if (isc && !tieq && pc < AT_CAP) CAND[(4 * wave + q) * AT_CAP + pc] = ((unsigned long long)ord_key(scv) << 32) | (unsigned)(0xFFFFu - (unsigned)(v & 0xFFFFu));
                        cs += __builtin_popcountll(ms); cc += __builtin_popcountll(mc);
                    }
                }
            }
            csq[q] = cs;
            asm volatile("" ::: "memory");
        }
        break;
    }
    int nselq[4];
#pragma unroll
    for (int q = 0; q < 4; ++q) {
        int cs = csq[q];
        const int need = needq[q], nb0 = nb0q[q];
        if (need > 0 && nb0 <= AT_CAP) {
            const int nc = nb0;
            const LAS unsigned long long* cq = CAND + (4 * wave + q) * AT_CAP;
            for (int i0 = 0; i0 < nc; i0 += 64) {
                const int i = i0 + lane; const unsigned long long mine = (i < nc) ? cq[i] : 0ull;
                int rank = 0; for (int j = 0; j < nc; ++j) rank += (cq[j] > mine) ? 1 : 0;
                const bool pick = (i < nc) && rank < need;
                const unsigned long long mk = __ballot(pick);
                if (pick) SEL[(4 * wave + q) * 256 + cs + __builtin_popcountll(mk & ((1ull << lane) - 1ull))] = (unsigned short)(0xFFFFu - (unsigned)(mine & 0xFFFFu));
                cs += __builtin_popcountll(mk);
            }
        }
        nselq[q] = cs;
    }
    asm volatile("s_waitcnt lgkmcnt(0)" ::: "memory");
#ifdef DBG_TIME_ATT
    if (tid == 0) { const unsigned tn_ = (unsigned)__builtin_amdgcn_s_memrealtime(); ((LAS unsigned*)(lds + LDS_MISC))[19] += tn_ - tk0; tk0 = tn_; }
#endif
    __syncthreads();
    LAS unsigned char* gb = lds + wave * AT_GBUF;
    const int n = lane & 15, kg = lane >> 4, head = n & 7;
#pragma unroll 1
    for (int qi = 0; qi < 4; ++qi) {
        const int q = 4 * wave + qi, t = t0 + q;
        const int nsel = qi == 0 ? nselq[0] : (qi == 1 ? nselq[1] : (qi == 2 ? nselq[2] : nselq[3]));
        const LAS unsigned short* sel = SEL + q * 256;
        bf16_t* qrow = P.qlat + (rowb + t) * 2048;
        bf16x8 qb[8];
#pragma unroll
        for (int ks = 0; ks < 8; ++ks) { qb[ks] = (bf16x8){0, 0, 0, 0, 0, 0, 0, 0}; if (n < 8) qb[ks] = *(const bf16x8*)(qrow + n * 256 + 32 * ks + 8 * kg); }
        f32x4 oacc[16];
#pragma unroll
        for (int mt = 0; mt < 16; ++mt) oacc[mt] = (f32x4){0.f, 0.f, 0.f, 0.f};
        float mrun = -1e30f, lrun = 0.f;
        const int nchunk = (nsel + 31) >> 5;
#pragma unroll 1
        for (int c = 0; c < nchunk; ++c) {
            const int jn = 32 * c + kcol; const int idxc = (jn < nsel) ? (int)sel[jn] : 0;
            { u32x4 pre[16];
              const unsigned offc = ((unsigned)rowb + (unsigned)idxc) * 512u;
#pragma unroll
              for (int i = 0; i < 16; ++i) { const unsigned o0 = (unsigned)__builtin_amdgcn_readlane((int)offc, 2 * i), o1 = (unsigned)__builtin_amdgcn_readlane((int)offc, 2 * i + 1);
                  pre[i] = *(const u32x4*)((const char*)P.ckv + ((hh ? o1 : o0) + (unsigned)kcol * 16u)); }
#pragma unroll
              for (int i = 0; i < 16; ++i) *(LAS u32x4*)(gb + (2 * i + hh) * AT_GROW + kcol * 16) = pre[i];
            }
            f32x4 st[2];
#pragma unroll
            for (int k2 = 0; k2 < 2; ++k2) { st[k2] = (f32x4){0.f, 0.f, 0.f, 0.f};
#pragma unroll
                for (int ks = 0; ks < 8; ++ks) { const bf16x8 a = *(const LAS bf16x8*)(gb + (16 * k2 + n) * AT_GROW + (32 * ks + 8 * kg) * 2); st[k2] = __builtin_amdgcn_mfma_f32_16x16x32_bf16(a, qb[ks], st[k2], 0, 0, 0); } }
            float mloc = -1e30f;
#pragma unroll
            for (int k2 = 0; k2 < 2; ++k2)
#pragma unroll
                for (int r = 0; r < 4; ++r) { const int jj = 16 * k2 + 4 * kg + r; const int idx = (32 * c + jj < nsel) ? (int)sel[32 * c + jj] : 0; int d = t - idx; d = d < 127 ? d : 127;
                    float lg = st[k2][r] + BIAS2[d * 8 + head]; if (32 * c + jj >= nsel) lg = -1e30f;
                    st[k2][r] = lg; mloc = fmaxf(mloc, lg); }
            if (c == 0) { mloc = fmaxf(mloc, __shfl_xor(mloc, 16)); mloc = fmaxf(mloc, __shfl_xor(mloc, 32)); mrun = mloc; }
            else if (__ballot(mloc > mrun + 60.0f) != 0ull) {
                mloc = fmaxf(mloc, __shfl_xor(mloc, 16)); mloc = fmaxf(mloc, __shfl_xor(mloc, 32));
                const float mnew = fmaxf(mrun, mloc), alpha = fast_exp(mrun - mnew);
                lrun = lrun * alpha; mrun = mnew;
#pragma unroll
                for (int mt = 0; mt < 16; ++mt) oacc[mt] = oacc[mt] * alpha;
            }
#pragma unroll
            for (int k2 = 0; k2 < 2; ++k2)
#pragma unroll
                for (int r = 0; r < 4; ++r) { const float p = fast_exp(st[k2][r] - mrun); st[k2][r] = p; lrun += p; }
            u32x4 pw; pw.x = pk2(st[0][0], st[0][1]); pw.y = pk2(st[0][2], st[0][3]); pw.z = pk2(st[1][0], st[1][1]); pw.w = pk2(st[1][2], st[1][3]);
            const bf16x8 pb = __builtin_bit_cast(bf16x8, pw);
            LAS unsigned char* tb = gb + (4 * kg + (n >> 2)) * AT_GROW + 8 * (n & 3);
#pragma unroll
            for (int mt = 0; mt < 16; ++mt) {
                const s16x4 v1 = __builtin_amdgcn_ds_read_tr16_b64_v4i16((LAS s16x4*)(tb + 32 * mt));
                const s16x4 v2 = __builtin_amdgcn_ds_read_tr16_b64_v4i16((LAS s16x4*)(tb + 16 * AT_GROW + 32 * mt));
                const bf16x8 av = (bf16x8){v1[0], v1[1], v1[2], v1[3], v2[0], v2[1], v2[2], v2[3]};
                oacc[mt] = __builtin_amdgcn_mfma_f32_16x16x32_bf16(av, pb, oacc[mt], 0, 0, 0);
            }
        }
        lrun += __shfl_xor(lrun, 16); lrun += __shfl_xor(lrun, 32);
        const float inv = 1.0f / lrun;
        if (n < 8) {
#pragma unroll
            for (int mt = 0; mt < 16; ++mt) { const f32x4 o = oacc[mt] * inv; u32x2 w; w.x = pk2(o[0], o[1]); w.y = pk2(o[2], o[3]); *(u32x2*)(qrow + n * 256 + 16 * mt + 4 * kg) = w; }
        }
    }
#ifdef DBG_TIME_ATT
    if (tid == 0) { const unsigned tn_ = (unsigned)__builtin_amdgcn_s_memrealtime(); ((LAS unsigned*)(lds + LDS_MISC))[20] += tn_ - tk0; tk0 = tn_; }
#endif
}
__device__ __forceinline__ void ln_finish(f32x4 (&v)[4], const float* gam, const float* bet, float* orow, bf16_t* brow, int lane) {
    float s = 0.f;
#pragma unroll
    for (int j = 0; j < 4; ++j) s += (v[j][0] + v[j][1]) + (v[j][2] + v[j][3]);
    const float mean = wave_sum(s) * (1.0f / 1024.0f); float s2 = 0.f;
#pragma unroll
    for (int j = 0; j < 4; ++j) { v[j] = v[j] - mean; s2 += (v[j][0] * v[j][0] + v[j][1] * v[j][1]) + (v[j][2] * v[j][2] + v[j][3] * v[j][3]); }
    const float rstd = 1.0f / __builtin_sqrtf(wave_sum(s2) * (1.0f / 1024.0f) + LN_EPS);
#pragma unroll
    for (int j = 0; j < 4; ++j) { const f32x4 g = *(const f32x4*)(gam + 256 * j + 4 * lane), bb = *(const f32x4*)(bet + 256 * j + 4 * lane);
        v[j] = v[j] * rstd * g + bb;
        if (orow != nullptr) *(f32x4*)(orow + 256 * j + 4 * lane) = v[j];
        u32x2 w; w.x = pk2(v[j][0], v[j][1]); w.y = pk2(v[j][2], v[j][3]); *(u32x2*)(brow + 256 * j + 4 * lane) = w; }
}
struct RouteP { int* r_e; int* r_pos; int* r_slot; float* r_g; unsigned* gcnt; };

__device__ __forceinline__ void ln1_route_block(LAS unsigned char* lds, int blk, float* xo, bf16_t* xb, const float* gam, const float* bet, const float* rbias, const RouteP& R, int tid) {
    const int wave = __builtin_amdgcn_readfirstlane(tid >> 6), lane = tid & 63;
    const LAS float* WR = (const LAS float*)lds; LAS int* lcnt = (LAS int*)(lds + 65536); LAS int* basee = (LAS int*)(lds + 65600); LAS int* tok = (LAS int*)(lds + 65664);
    __syncthreads();
    if (tid < 16) lcnt[tid] = 0;
    __syncthreads();
    u32x2 wn[4];
#pragma unroll
    for (int j = 0; j < 4; ++j) wn[j] = *(const u32x2*)(xb + ((size_t)blk * 128 + wave * 16) * 1024 + 256 * j + 4 * lane);
    for (int rr = 0; rr < 16; ++rr) {
        const int rl = wave * 16 + rr; const size_t row = (size_t)blk * 128 + rl;
        f32x4 v[4];
#pragma unroll
        for (int j = 0; j < 4; ++j) { const u32x2 w = wn[j]; v[j] = (f32x4){bf_lo(w.x), bf_hi(w.x), bf_lo(w.y), bf_hi(w.y)}; }
        { const size_t rn = row + (rr + 1 < 16 ? 1 : 0);
#pragma unroll
          for (int j = 0; j < 4; ++j) wn[j] = *(const u32x2*)(xb + rn * 1024 + 256 * j + 4 * lane); }
        ln_finish(v, gam, bet, nullptr, xb + row * 1024, lane);
        float aff[16], sel[16];
#pragma unroll
        for (int e = 0; e < 16; ++e) { float p = 0.f;
#pragma unroll
            for (int j = 0; j < 4; ++j) { const f32x4 w = *(const LAS f32x4*)(WR + e * 1024 + 256 * j + 4 * lane); p += (v[j][0] * w[0] + v[j][1] * w[1]) + (v[j][2] * w[2] + v[j][3] * w[3]); }
            const float lg = wave_sum(p); aff[e] = 1.0f / (1.0f + expf(-lg)); sel[e] = aff[e] + rbias[e]; }
        float gbv = -3.0e38f; int gb = 0;
#pragma unroll
        for (int g = 0; g < 4; ++g) { float m1 = -3.0e38f, m2 = -3.0e38f;
#pragma unroll
            for (int i = 0; i < 4; ++i) { const float x = sel[4 * g + i]; if (x > m1) { m2 = m1; m1 = x; } else if (x > m2) m2 = x; }
            const float gs_ = m1 + m2; if (gs_ > gbv) { gbv = gs_; gb = g; } }
        float s0 = -3.0e38f, a0 = 0.f; int e0 = 0;
#pragma unroll
        for (int e = 0; e < 16; ++e) { const bool in = (e >> 2) == gb; if (in && sel[e] > s0) { s0 = sel[e]; a0 = aff[e]; e0 = e; } }
        float s1 = -3.0e38f, a1 = 0.f; int e1 = 0;
#pragma unroll
        for (int e = 0; e < 16; ++e) { const bool in = ((e >> 2) == gb) && (e != e0); if (in && sel[e] > s1) { s1 = sel[e]; a1 = aff[e]; e1 = e; } }
        if (lane == 0) {
            const float inv = 1.0f / (a0 + a1);
            const int p0 = __hip_atomic_fetch_add(lcnt + e0, 1, __ATOMIC_RELAXED, __HIP_MEMORY_SCOPE_WORKGROUP);
            const int p1 = __hip_atomic_fetch_add(lcnt + e1, 1, __ATOMIC_RELAXED, __HIP_MEMORY_SCOPE_WORKGROUP);
            tok[rl * 4 + 0] = e0; tok[rl * 4 + 1] = p0; tok[rl * 4 + 2] = e1; tok[rl * 4 + 3] = p1;
            *(f32x2*)(R.r_g + row * 2) = (f32x2){a0 * inv, a1 * inv};
        }
    }
    __syncthreads();
    if (tid < 16) basee[tid] = (int)__hip_atomic_fetch_add(R.gcnt + tid * 64, (unsigned)lcnt[tid], __ATOMIC_RELAXED, __HIP_MEMORY_SCOPE_AGENT);
    __syncthreads();
    if (tid < 256) { const int rl = tid >> 1, k = tid & 1; const int e = tok[rl * 4 + 2 * k], p = tok[rl * 4 + 2 * k + 1]; const size_t o = ((size_t)blk * 128 + rl) * 2 + k; R.r_e[o] = e; R.r_pos[o] = basee[e] + p; }
}
__device__ __forceinline__ void moe_offsets(LAS int* offp, const unsigned* gcnt, int tid) {
    __syncthreads();
    if (tid == 0) { int o = 0;
        for (int e = 0; e < 16; ++e) { offp[e] = o; const int c = (int)__hip_atomic_load(gcnt + e * 64, __ATOMIC_RELAXED, __HIP_MEMORY_SCOPE_AGENT); o += (c + 255) & ~255; }
        offp[16] = o; }
    __syncthreads();
}
#ifndef MK_PER_PHASE
#define MK_PER_PHASE 0
#endif
#ifndef EN_MASK
#define EN_MASK 0xFFF
#endif
#ifndef EN_M1
#define EN_M1 1
#endif
#ifndef EN_M2
#define EN_M2 1
#endif
#ifndef DBG_REP_P0A
#define DBG_REP_P0A 1
#endif
#ifndef EN_2A
#define EN_2A 1
#endif
#ifndef EN_2R
#define EN_2R 1
#endif
#define EN_A ((EN_MASK >> 0) & 1)
#define EN_B ((EN_MASK >> 1) & 1)
#define EN_0 ((EN_MASK >> 2) & 1)
#define EN_1 ((EN_MASK >> 3) & 1)
#define EN_2 ((EN_MASK >> 4) & 1)
#define EN_3 ((EN_MASK >> 5) & 1)
#define EN_4 ((EN_MASK >> 6) & 1)
#define EN_5 ((EN_MASK >> 7) & 1)
#define EN_6 ((EN_MASK >> 8) & 1)
#define EN_7 ((EN_MASK >> 9) & 1)
#define EN_8 ((EN_MASK >> 10) & 1)
#define EN_9 ((EN_MASK >> 11) & 1)
constexpr int NPH_L = 10, NPH = 2 + NL * NPH_L;
struct Args { const float* in[25]; float* out; unsigned char* ws; int ph_lo, ph_hi; };

__global__ void __launch_bounds__(NTHR, 2) fwd(Args a) {
    extern __shared__ __attribute__((aligned(16))) unsigned char lds_raw[];
    LAS unsigned char* lds = (LAS unsigned char*)lds_raw;
    const int G = gridDim.x, bx = blockIdx.x, vcu = (G % 8 == 0) ? (bx % 8) * (G / 8) + bx / 8 : bx;
    const int NGW = G * NWAVES;
#define PH_LOCALS int tid = wave_s * 64 + lane_id(); asm volatile("" : "+v"(tid)); const int lane = tid & 63, wave = wave_s, gw = vcu * NWAVES + wave; (void)lane; (void)gw;
    volatile LAS unsigned* MISC = (volatile LAS unsigned*)(lds + LDS_MISC);
    const int wave_s = __builtin_amdgcn_readfirstlane((int)threadIdx.x >> 6);
    if (threadIdx.x < 64) MISC[threadIdx.x] = 0u;
    __syncthreads();
    unsigned char* ws = a.ws;
    unsigned* ctl = (unsigned*)(ws + WS_CTL);
    const int lo = a.ph_lo, hi = a.ph_hi;
    XcdBarrier bar; bar.bar = ctl + CW_BAR; bar.x = 0; bar.st = MISC + 8;
    if (hi - lo > 1) bar = xcd_barrier_post(ctl + CW_BAR, MISC + 8);
#define IN(k) (lo <= (k) && (k) < hi)
#ifdef DBG_TIME
    if (blockIdx.x == 0 && threadIdx.x == 0) ctl[12288 + 63] = (unsigned)__builtin_amdgcn_s_memrealtime();
#define SEAM(k) do { if (IN(k) && IN((k) + 1)) { xcd_barrier(bar, wave_s == 0 && lane_id() == 0); if (bx == 0 && wave_s == 0 && lane_id() == 0) ctl[12288 + (k)] = (unsigned)__builtin_amdgcn_s_memrealtime(); } } while (0)
#else
#define SEAM(k) do { if (IN(k) && IN((k) + 1)) xcd_barrier(bar, wave_s == 0 && lane_id() == 0); } while (0)
#endif
    float* xo = a.out;
    bf16_t* xb = (bf16_t*)(ws + WS_XB);
    unsigned char* R = ws + WS_R;

    for (int rep_ = 0; rep_ < (DBG_REP_P0A); ++rep_)
    if (EN_A && IN(0)) { PH_LOCALS
        LAS float* scr = (LAS float*)(lds + wave * 8448);
        constexpr int PER_L = 4160;
        for (int it = gw; it < NL * PER_L; it += NGW) {
            const int l = it / PER_L; int r = it - l * PER_L;
            const float* win = a.in[1] + (size_t)l * 1024 * DIN;
            unsigned char* wm = ws + WS_WMIX + (size_t)l * WMIX_STRIDE;
            if (r < 1024) { tr_item(win, DIN, 0, 2048, (bf16_t*)(wm + OFF_WIN), 1024, 0, r, 64, scr, lane); continue; } r -= 1024;
            if (r < 512) { tr_item(win, DIN, 3072, 840, (bf16_t*)(wm + OFF_WIN) + (size_t)4096 * 1024, 1024, 0, r, 32, scr, lane); continue; } r -= 512;
            if (r < 1024) { tr_item(win, DIN, 3912, 2048, (bf16_t*)(wm + OFF_WG), 1024, 0, r, 64, scr, lane); continue; } r -= 1024;
            if (r < 512) { tr_item(a.in[12] + (size_t)l * 1048576, 1024, 0, 1024, (bf16_t*)(wm + OFF_WPR), 1024, 0, r, 32, scr, lane); continue; } r -= 512;
            if (r < 512) { tr_item(a.in[14] + (size_t)l * 1048576, 1024, 0, 1024, (bf16_t*)(wm + OFF_WO), 1024, 0, r, 32, scr, lane); continue; } r -= 512;
            if (r < 512) { tr_item(a.in[13] + (size_t)l * 1048576, 1024, 0, 1024, (bf16_t*)(R + R_PT + (size_t)l * 2 * MiB), 1024, 0, r, 32, scr, lane); continue; } r -= 512;
            { const int m = r >> 5, g = (r >> 1) & 15, nb = r & 1;
              const float* src = (m ? a.in[6] : a.in[4]) + (size_t)(l * 16 + g) * 4096;
              bf16_t* dst = (bf16_t*)(ws + WS_WSM + (size_t)l * 262144 + (size_t)m * 131072) + g * 4096;
              tr_item(src, 64, 0, 64, dst, 64, 0, nb, 2, scr, lane); }
        }
        const size_t gt = (size_t)vcu * NTHR + tid, GT = (size_t)G * NTHR;
        for (size_t i = gt; i < (size_t)NL * 1024 * 128; i += GT) { const int l = (int)(i >> 17), k = (int)(i >> 7) & 1023, j8 = (int)i & 127;
            const float* s = a.in[1] + ((size_t)l * 1024 + k) * DIN + 2048 + 8 * j8; const f32x4 v0 = *(const f32x4*)s, v1 = *(const f32x4*)(s + 4);
            *(u32x4*)((bf16_t*)(R + R_WQ + (size_t)l * 2 * MiB) + (size_t)k * 1024 + 8 * j8) = pack8(v0, v1); }
        for (size_t i = gt; i < (size_t)2 * NL * 8 * 256 * 32; i += GT) { const int which = (int)(i >> 18); const int r = (int)(i & 262143); const int lh = r >> 13, c = (r >> 5) & 255, d8 = r & 31; const int h = lh & 7;
            u32x4 o = (u32x4){0u, 0u, 0u, 0u};
            if ((d8 >> 4) == (h & 1)) { const float* s = (which ? a.in[11] : a.in[10]) + ((size_t)lh * 256 + c) * 128 + 8 * (d8 & 15); o = pack8(*(const f32x4*)s, *(const f32x4*)(s + 4)); }
            *(u32x4*)((bf16_t*)(R + (which ? R_UVP : R_UKP)) + ((size_t)lh * 256 + c) * 1024 + 8 * d8) = o; }
        for (size_t i = gt; i < (size_t)T * 128; i += GT) { const float* s = a.in[0] + i * 8; const f32x4 v0 = *(const f32x4*)s, v1 = *(const f32x4*)(s + 4);
            *(u32x4*)(xb + i * 8) = pack8(v0, v1); }
    }
    SEAM(0);
    if (EN_B && IN(1)) {
        SchedPro S{R, G, vcu}; EpiPro E{ws + WS_WMIX};
        gs::gemm_stream<true>(lds, S, E, wave_s);
    }
    SEAM(1);

    for (int l = 0; l < NL; ++l) {
        const int pb = 2 + l * NPH_L;
        unsigned char* wm = ws + WS_WMIX + (size_t)l * WMIX_STRIDE;
        bf16_t* xrnn = (bf16_t*)(R + R_XRNN); bf16_t* grnn = (bf16_t*)(R + R_GRNN); bf16_t* qlat = (bf16_t*)(R + R_QLAT); bf16_t* ckv = (bf16_t*)(R + R_CKV);
        bf16_t* qidx = (bf16_t*)(R + R_QIDX); bf16_t* kidx = (bf16_t*)(R + R_KIDX); float* widx = (float*)(R + R_WIDX);
        if (EN_0 && IN(pb + 0)) {
            SchedDense S{(const char*)xb, (const char*)(wm + OFF_WIN), 2048u, 2048u, 16, T / 256, 20, G, vcu};
            EpiInproj E{xrnn, grnn, qlat, ckv, qidx, kidx, widx};
            gs::gemm_stream<true>(lds, S, E, wave_s);
#ifdef DBG_REP_INPROJ
            gs::gemm_stream<true>(lds, S, E, wave_s);
#endif
        }
        SEAM(pb + 0);
        RnnP RP{xrnn, grnn, (float*)(R + R_TOT), (const bf16_t*)(ws + WS_WSM + (size_t)l * 262144), (const bf16_t*)(ws + WS_WSM + (size_t)l * 262144 + 131072),
                a.in[2] + (size_t)l * 4096, a.in[3] + (size_t)l * 1024, a.in[5] + (size_t)l * 1024, a.in[7] + (size_t)l * 1024, a.in[8] + (size_t)l * 1024};
        if (EN_1 && IN(pb + 1)) { PH_LOCALS
#ifdef DBG_TIME
            if (tid == 0) MISC[24] = (unsigned)__builtin_amdgcn_s_memrealtime();
#endif
            for (int it = gw; it < 2048; it += NGW) rnn_item<1>(RP, it, lds + wave * 8448, lane);
#ifdef DBG_TIME
            if (tid == 0) MISC[25] = (unsigned)__builtin_amdgcn_s_memrealtime();
#endif
#ifdef DBG_REP_RNN
            for (int it = gw; it < 2048; it += NGW) rnn_item<1>(RP, it, lds + wave * 8448, lane);
#endif
            for (int row = gw; row < T; row += 4 * NGW) ckv_norm_rows4(ckv, row, NGW, T, a.in[9] + (size_t)l * 256, lane);
#ifdef DBG_TIME
            if (tid == 0) MISC[26] = (unsigned)__builtin_amdgcn_s_memrealtime();
#endif
            LAS float* scr = (LAS float*)(lds + wave * 8448);
            for (int it = gw; it < 16 * 768; it += NGW) { const int e = it / 768; int r = it - e * 768; const size_t le = (size_t)l * 16 + e;
                bf16_t* gu = (bf16_t*)(ws + WS_WEXP) + (size_t)e * 1048576; bf16_t* dn = (bf16_t*)(ws + WS_WEXP + OFF_DN) + (size_t)e * 524288;
                if (r < 256) { tr_item(a.in[19] + le * 524288, 512, 0, 512, gu, 1024, 1, r, 16, scr, lane); continue; } r -= 256;
                if (r < 256) { tr_item(a.in[20] + le * 524288, 512, 0, 512, gu + 4 * 1024, 1024, 1, r, 16, scr, lane); continue; } r -= 256;
                tr_item(a.in[21] + le * 524288, 1024, 0, 1024, dn, 512, 0, r, 32, scr, lane); }
#ifdef DBG_TIME
            if (l == 1 && bx == 0 && tid == 0) { const unsigned tq3 = (unsigned)__builtin_amdgcn_s_memrealtime();
                ctl[12288 + 48] = MISC[25] - MISC[24]; ctl[12288 + 49] = MISC[26] - MISC[25]; ctl[12288 + 50] = tq3 - MISC[26]; ctl[12288 + 51] = tq3 - MISC[24]; }
#endif
        }
        SEAM(pb + 1);
        if (EN_2 && IN(pb + 2)) { PH_LOCALS
            __syncthreads();
            if (tid < 256) ((LAS float*)(lds + AT_BIAS))[tid] = a.in[24][tid];
            if (tid < 128) { const int d = tid; int bk = d; if (d >= 16) { bk = 16 + (int)(logf((float)d / 16.0f) / 2.0794415416798357f * 16.0f); bk = bk > 31 ? 31 : bk; } ((LAS int*)(lds + AT_BKT))[d] = bk; }
            __syncthreads();
            for (int i = tid; i < 1024; i += NTHR) ((LAS float*)(lds + AT_BIAS2))[i] = ((const LAS float*)(lds + AT_BIAS))[((const LAS int*)(lds + AT_BKT))[i >> 3] * 8 + (i & 7)];
            AttnP AP{qidx, kidx, ckv, widx, qlat, (unsigned long long*)(R + R_MSCR + (size_t)bx * 393216)};
#ifdef DBG_TIME
            unsigned tph0 = (unsigned)__builtin_amdgcn_s_memrealtime();
#endif
#ifdef DBG_STATIC_UNITS
            if (EN_2A) for (int p = vcu; p < 512; p += G) { const int b = p >> 8, uu = p & 255;
#pragma unroll 1
                for (int k2 = 0; k2 < 2; ++k2) { attn_unit(lds, AP, b, k2 ? uu : 511 - uu, tid);
#ifdef DBG_TIME
                    if (tid == 0) MISC[21] = MISC[21] + 1u;
#endif
                } }
#else
            if (EN_2A) for (;;) {
                __syncthreads();
                if (tid == 0) MISC[4] = __hip_atomic_fetch_add(ctl + CW_QUEUE + l * 64, 1u, __ATOMIC_RELAXED, __HIP_MEMORY_SCOPE_AGENT);
                __syncthreads();
                const unsigned tk = MISC[4];
                if (tk >= 1024u) break;
                attn_unit(lds, AP, (int)(tk & 1u), 511 - (int)(tk >> 1), tid);
#ifdef DBG_TIME
                if (tid == 0) MISC[21] = MISC[21] + 1u;
#endif
            }
            __syncthreads();
#endif
#ifdef DBG_TIME
            if (l == 1 && bx == 0 && tid == 0) { for (int i_ = 0; i_ < 6; ++i_) ctl[12288 + 40 + i_] = ((LAS unsigned*)(lds + LDS_MISC))[16 + i_]; ctl[12288 + 46] = ((LAS unsigned*)(lds + LDS_MISC))[16]; }
            if (l == 0 && tid == 0) { for (int i_ = 0; i_ < 6; ++i_) ((LAS unsigned*)(lds + LDS_MISC))[16 + i_] = 0u; }
            __syncthreads();
            unsigned tph1 = (unsigned)__builtin_amdgcn_s_memrealtime();
            if (l == 1 && bx == 0 && tid == 0) ctl[12288 + 47] = tph1 - tph0;
            if (l == 1 && tid == 0) { __hip_atomic_fetch_max(ctl + 12288 + 59, tph1 - tph0, __ATOMIC_RELAXED, __HIP_MEMORY_SCOPE_AGENT); __hip_atomic_fetch_max(ctl + 12288 + 58, 0x40000000u - (tph1 - tph0), __ATOMIC_RELAXED, __HIP_MEMORY_SCOPE_AGENT); }
#endif
            if (EN_2R) for (int it = gw; it < 2048; it += NGW) rnn_item<2>(RP, it, lds + wave * 8448, lane);
#ifdef DBG_TIME
            { __syncthreads(); const unsigned tph2 = (unsigned)__builtin_amdgcn_s_memrealtime();
              if (l == 1 && tid == 0) __hip_atomic_fetch_max(ctl + 12288 + 57, tph2 - tph1, __ATOMIC_RELAXED, __HIP_MEMORY_SCOPE_AGENT); }
#endif
        }
        SEAM(pb + 2);
        if (EN_3 && IN(pb + 3)) {
            if (EN_M1) { SchedMerge1 S{(const char*)xb, (const char*)grnn, (const char*)(wm + OFF_WG), (const char*)(wm + OFF_WPR), G, vcu};
              EpiMerge1 E{R + R_MSCR + (size_t)bx * 131072, R + R_MSCR2, (bf16_t*)(R + R_MERGED)};
              gs::gemm_stream<true>(lds, S, E, wave_s); }
            if (EN_M2) { SchedDense S{(const char*)qlat, (const char*)(wm + OFF_WVO), 4096u, 4096u, 32, T / 256, 4, G, vcu};
              EpiMerge2 E{R + R_MSCR2, (bf16_t*)(R + R_MERGED)};
              gs::gemm_stream<true>(lds, S, E, wave_s); }
        }
        SEAM(pb + 3);
        if (EN_4 && IN(pb + 4)) {
            SchedDense S{(const char*)(R + R_MERGED), (const char*)(wm + OFF_WO), 2048u, 2048u, 16, T / 256, 4, G, vcu};
            EpiOut E{xb};
            gs::gemm_stream<true>(lds, S, E, wave_s);
        }
        SEAM(pb + 4);
        RouteP RT{(int*)(R + R_ROUTE), (int*)(R + R_ROUTE + 262144), (int*)(R + R_ROUTE + 524288), (float*)(R + R_ROUTE + 786432), ctl + CW_CNT + l * 16 * 64};
        LAS int* offp = (LAS int*)(lds + LDS_MISC - 128);
        if (EN_5 && IN(pb + 5)) { PH_LOCALS
            __syncthreads();
            { float wv[32];
#pragma unroll
              for (int j = 0; j < 32; ++j) wv[j] = a.in[17][tid + j * NTHR];
#pragma unroll
              for (int j = 0; j < 32; ++j) { const int i = tid + j * NTHR; ((LAS float*)lds)[(i & 15) * 1024 + (i >> 4)] = wv[j]; } }
            for (int blk = vcu; blk < T / 128; blk += G) ln1_route_block(lds, blk, xo, xb, a.in[15] + (size_t)l * 1024, a.in[16] + (size_t)l * 1024, a.in[18], RT, tid);
        }
        SEAM(pb + 5);
        int* tokof = (int*)(R + R_ROUTE + 1048576);
        if (EN_6 && IN(pb + 6)) { PH_LOCALS
            moe_offsets(offp, RT.gcnt, tid);
            for (int p = vcu * NTHR + tid; p < 2 * T; p += G * NTHR) { const int e = RT.r_e[p], slot = offp[e] + RT.r_pos[p]; RT.r_slot[p] = slot; tokof[slot] = p >> 1; }
            if (vcu == 0 && tid < 256) {
                for (int e = 0; e < 16; ++e) { const int cnt = (int)__hip_atomic_load(RT.gcnt + e * 64, __ATOMIC_RELAXED, __HIP_MEMORY_SCOPE_AGENT); const int s0 = offp[e] + cnt;
                    if (s0 + tid < offp[e + 1]) tokof[s0 + tid] = 0; } }
        }
        SEAM(pb + 6);
        if (EN_7 && IN(pb + 7)) { PH_LOCALS
            moe_offsets(offp, RT.gcnt, tid);
            SchedMoEG S{(const char*)xb, (const char*)(ws + WS_WEXP), 2048u, 2048u, (size_t)2097152, 16, 4, G, vcu, offp, tokof};
            EpiGU E{(bf16_t*)(R + R_HE)};
            gs::gemm_stream<true, SchedMoEG, EpiGU, true>(lds, S, E, wave_s);
        }
        SEAM(pb + 7);
        if (EN_8 && IN(pb + 8)) { PH_LOCALS
            moe_offsets(offp, RT.gcnt, tid);
            SchedMoE S{(const char*)(R + R_HE), (const char*)(ws + WS_WEXP + OFF_DN), 1024u, 1024u, (size_t)1048576, 8, 4, G, vcu, offp};
            EpiBf16 E{(bf16_t*)(R + R_XG), 1024};
            gs::gemm_stream<true>(lds, S, E, wave_s);
        }
        SEAM(pb + 8);
        if (EN_9 && IN(pb + 9)) { PH_LOCALS
            const bf16_t* Y = (const bf16_t*)(R + R_XG);
            u32x2 xwn[4], y0n[4], y1n[4]; int s0n, s1n; f32x2 ggc, ggn;
            { const int r0 = gw < T ? gw : T - 1, r1 = gw + NGW < T ? gw + NGW : T - 1;
              const int a0 = RT.r_slot[2 * r0], a1 = RT.r_slot[2 * r0 + 1]; ggc = *(const f32x2*)(RT.r_g + 2 * (size_t)r0);
#pragma unroll
              for (int j = 0; j < 4; ++j) { xwn[j] = *(const u32x2*)(xb + (size_t)r0 * 1024 + 256 * j + 4 * lane); y0n[j] = *(const u32x2*)(Y + (size_t)a0 * 1024 + 256 * j + 4 * lane); y1n[j] = *(const u32x2*)(Y + (size_t)a1 * 1024 + 256 * j + 4 * lane); }
              s0n = RT.r_slot[2 * r1]; s1n = RT.r_slot[2 * r1 + 1]; ggn = *(const f32x2*)(RT.r_g + 2 * (size_t)r1); }
            for (int row = gw; row < T; row += NGW) {
                const f32x2 gg = ggc;
                u32x2 xwc[4], y0c[4], y1c[4];
#pragma unroll
                for (int j = 0; j < 4; ++j) { xwc[j] = xwn[j]; y0c[j] = y0n[j]; y1c[j] = y1n[j]; }
                { const int r1 = row + NGW < T ? row + NGW : T - 1, r2 = row + 2 * NGW < T ? row + 2 * NGW : T - 1;
                  const int a0 = s0n, a1 = s1n; ggc = ggn;
#pragma unroll
                  for (int j = 0; j < 4; ++j) { xwn[j] = *(const u32x2*)(xb + (size_t)r1 * 1024 + 256 * j + 4 * lane); y0n[j] = *(const u32x2*)(Y + (size_t)a0 * 1024 + 256 * j + 4 * lane); y1n[j] = *(const u32x2*)(Y + (size_t)a1 * 1024 + 256 * j + 4 * lane); }
                  s0n = RT.r_slot[2 * r2]; s1n = RT.r_slot[2 * r2 + 1]; ggn = *(const f32x2*)(RT.r_g + 2 * (size_t)r2); }
                f32x4 v[4];
#pragma unroll
                for (int j = 0; j < 4; ++j) { const u32x2 xw = xwc[j]; const f32x4 x1 = {bf_lo(xw.x), bf_hi(xw.x), bf_lo(xw.y), bf_hi(xw.y)};
                    const u32x2 y0 = y0c[j], y1 = y1c[j];
                    v[j][0] = ALPHA * x1[0] + gg.x * bf_lo(y0.x) + gg.y * bf_lo(y1.x); v[j][1] = ALPHA * x1[1] + gg.x * bf_hi(y0.x) + gg.y * bf_hi(y1.x);
                    v[j][2] = ALPHA * x1[2] + gg.x * bf_lo(y0.y) + gg.y * bf_lo(y1.y); v[j][3] = ALPHA * x1[3] + gg.x * bf_hi(y0.y) + gg.y * bf_hi(y1.y); }
                ln_finish(v, a.in[22] + (size_t)l * 1024, a.in[23] + (size_t)l * 1024, l == NL - 1 ? xo + (size_t)row * 1024 : nullptr, xb + (size_t)row * 1024, lane);
#ifdef DBG_TIME
                if (l == NL - 1) {
                    const unsigned ta = __hip_atomic_load(ctl + 12288 + (DBG_TA), __ATOMIC_RELAXED, __HIP_MEMORY_SCOPE_AGENT), tb = __hip_atomic_load(ctl + 12288 + (DBG_TB), __ATOMIC_RELAXED, __HIP_MEMORY_SCOPE_AGENT);
                    unsigned k_ = (DBG_Q) == 0 ? (40u * ta + tb / 2u) / (tb ? tb : 1u) : ((DBG_TA) == 58 ? (0x40000000u - ta) : (ta - tb)) / (unsigned)((DBG_Q) ? (DBG_Q) : 1); k_ = k_ > 45u ? 45u : k_;
                    const float sc_ = 1.0f - 0.02f * (float)k_;
#pragma unroll
                    for (int j = 0; j < 4; ++j) *(f32x4*)(xo + (size_t)row * 1024 + 256 * j + 4 * lane) = v[j] * sc_; }
#endif
            }
        }
        SEAM(pb + 9);
    }
#undef IN
#undef SEAM
}

#ifdef DUMP_OFF
__global__ void dump_k(const bf16_t* src, float* dst, size_t ld, size_t col0) { for (size_t i = (size_t)blockIdx.x * blockDim.x + threadIdx.x; i < (size_t)T * 1024; i += (size_t)gridDim.x * blockDim.x) dst[i] = bf2f(src[(i >> 10) * ld + col0 + (i & 1023)]); }
#endif
extern "C" void kernel_launch(void* const* d_in, const int* in_sizes, int n_in, void* d_out, int out_size, void* d_ws, size_t ws_size, hipStream_t stream) {
    static int grid = 0;
    if (grid == 0) {
        if (n_in != 25 || out_size != T * D || ws_size < WS_END) { fprintf(stderr, "kernel_launch: unexpected shapes (n_in %d, out %d, ws %zu < %zu)\n", n_in, out_size, ws_size, (size_t)WS_END); grid = -1; return; }
        int dev = 0, cus = 0, per_cu = 0;
        if (hipGetDevice(&dev) != hipSuccess || hipDeviceGetAttribute(&cus, hipDeviceAttributeMultiprocessorCount, dev) != hipSuccess) { grid = -1; return; }
        if (hipFuncSetAttribute((const void*)fwd, hipFuncAttributeMaxDynamicSharedMemorySize, LDS_BYTES) != hipSuccess) { fprintf(stderr, "kernel_launch: hipFuncSetAttribute failed\n"); grid = -1; return; }
        if (hipOccupancyMaxActiveBlocksPerMultiprocessor(&per_cu, (const void*)fwd, NTHR, LDS_BYTES) != hipSuccess || per_cu < 1) fprintf(stderr, "kernel_launch: occupancy query says %d\n", per_cu);
        (void)hipGetLastError();
        grid = cus < 256 ? cus : 256;
    }
    if (grid < 0) return;
    (void)hipMemsetAsync((char*)d_ws + WS_CTL, 0, CTL_BYTES, stream);
    Args a{};
    for (int i = 0; i < 25; ++i) a.in[i] = (const float*)d_in[i];
    a.out = (float*)d_out; a.ws = (unsigned char*)d_ws;
#if MK_PER_PHASE
#ifndef PH_LIMIT
#define PH_LIMIT NPH
#endif
    for (int ph = 0; ph < PH_LIMIT; ++ph) { a.ph_lo = ph; a.ph_hi = ph + 1; hipLaunchKernelGGL(fwd, dim3(grid), dim3(NTHR), LDS_BYTES, stream, a); }
#else
    a.ph_lo = 0; a.ph_hi = NPH; hipLaunchKernelGGL(fwd, dim3(grid), dim3(NTHR), LDS_BYTES, stream, a);
#endif
#ifdef DUMP_OFF
    hipLaunchKernelGGL(dump_k, dim3(2048), dim3(256), 0, stream, (const bf16_t*)((const char*)d_ws + (DUMP_OFF)), (float*)d_out, (size_t)(DUMP_LD), (size_t)(DUMP_COL));
#endif
}
```

```cpp
#include <hip/hip_runtime.h>
#include <cstdio>
#include <cstdint>

#define GAS __attribute__((address_space(1)))
#define LAS __attribute__((address_space(3)))
typedef unsigned short bf16_t;
typedef short bf16x8 __attribute__((ext_vector_type(8)));
typedef short s16x4 __attribute__((ext_vector_type(4)));
typedef float f32x2 __attribute__((ext_vector_type(2)));
typedef float f32x4 __attribute__((ext_vector_type(4)));
typedef float f32x16 __attribute__((ext_vector_type(16)));
typedef unsigned u32x2 __attribute__((ext_vector_type(2)));
typedef unsigned u32x4 __attribute__((ext_vector_type(4)));

constexpr int NB = 2, SEQ = 16384, T = NB * SEQ, D = 1024, NL = 4, DIN = 5960;
constexpr int NE = 16;
constexpr float ALPHA = 1.681792830507429f;
constexpr float LN_EPS = 1e-5f, RMS_EPS = 1e-6f;
constexpr int NWAVES = 8, NTHR = 512;

constexpr size_t MiB = 1u << 20;
constexpr size_t WS_CTL = 0, CTL_BYTES = 1 * MiB;
constexpr size_t WS_XB = 1 * MiB;
constexpr size_t WS_WMIX = 65 * MiB, WMIX_STRIDE = 22 * MiB;
constexpr size_t OFF_WIN = 0, OFF_WG = 10 * MiB, OFF_WPR = 14 * MiB, OFF_WVO = 16 * MiB, OFF_WO = 20 * MiB;
constexpr size_t WS_WSM = 153 * MiB;
constexpr size_t WS_WEXP = 154 * MiB;
constexpr size_t OFF_DN = 32 * MiB;
constexpr size_t WS_R = 202 * MiB;
constexpr size_t R_XRNN = 0, R_GRNN = 64 * MiB, R_QLAT = 128 * MiB, R_CKV = 256 * MiB, R_QIDX = 272 * MiB, R_KIDX = 304 * MiB, R_WIDX = 308 * MiB,
                 R_TOT = 309 * MiB, R_MSCR = 310 * MiB, R_MSCR2 = 342 * MiB, R_END = 406 * MiB;
constexpr size_t R_MERGED = R_XRNN;
constexpr size_t R_XG = 0, R_HE = 136 * MiB, R_ROUTE = 204 * MiB;
constexpr size_t R_WQ = 0, R_UKP = 8 * MiB, R_PT = 24 * MiB, R_UVP = 32 * MiB;
constexpr size_t WS_END = WS_R + R_END;
constexpr int MP_MAX = 2 * T + NE * 256;

constexpr int CW_TMO = 0;
constexpr int CW_BAR = 4096;
constexpr int CW_CNT = 8192;
constexpr int CW_QUEUE = 14336;

constexpr int LDS_BYTES = 163840;
constexpr int LDS_MISC = LDS_BYTES - 256;

#define RLX_AGENT __ATOMIC_RELAXED, __HIP_MEMORY_SCOPE_AGENT
__device__ __forceinline__ unsigned f2bf(float f) { unsigned u = __builtin_bit_cast(unsigned, f); return (u + 0x7fffu + ((u >> 16) & 1u)) >> 16; }
typedef __bf16 bf16x2_t __attribute__((ext_vector_type(2)));
__device__ __forceinline__ unsigned pk2(float lo, float hi) { const f32x2 v = {lo, hi}; const bf16x2_t b = __builtin_convertvector(v, bf16x2_t); return __builtin_bit_cast(unsigned, b); }
__device__ __forceinline__ float bf_lo(unsigned w) { return __builtin_bit_cast(float, w << 16); }
__device__ __forceinline__ float bf_hi(unsigned w) { return __builtin_bit_cast(float, w & 0xffff0000u); }
__device__ __forceinline__ float bf2f(bf16_t h) { return __builtin_bit_cast(float, ((unsigned)h) << 16); }
__device__ __forceinline__ float fast_exp(float x) { return __builtin_amdgcn_exp2f(x * 1.4426950408889634f); }
__device__ __forceinline__ float fast_rcp(float x) { return __builtin_amdgcn_rcpf(x); }
__device__ __forceinline__ float sigmoidf_(float x) { return fast_rcp(1.0f + fast_exp(-x)); }
__device__ __forceinline__ float gelu_tanh(float x) { const float y = 0.7978845608028654f * (x + 0.044715f * x * x * x); const float e = fast_exp(2.0f * y); const float th = 1.0f - 2.0f * fast_rcp(e + 1.0f); return 0.5f * x * (1.0f + th); }
template <int CTRL> __device__ __forceinline__ float dpp_f(float v) { return __builtin_bit_cast(float, __builtin_amdgcn_update_dpp(0, __builtin_bit_cast(int, v), CTRL, 0xf, 0xf, true)); }
__device__ __forceinline__ float wave_sum(float v) {
    v += dpp_f<0xB1>(v); v += dpp_f<0x4E>(v); v += dpp_f<0x141>(v); v += dpp_f<0x140>(v);
    const int vi = __builtin_bit_cast(int, v);
    return (__builtin_bit_cast(float, __builtin_amdgcn_readlane(vi, 0)) + __builtin_bit_cast(float, __builtin_amdgcn_readlane(vi, 16))) +
           (__builtin_bit_cast(float, __builtin_amdgcn_readlane(vi, 32)) + __builtin_bit_cast(float, __builtin_amdgcn_readlane(vi, 48)));
}

__device__ __forceinline__ int lane_id() { unsigned z = 0u; asm volatile("" : "+v"(z)); return (int)__builtin_amdgcn_mbcnt_hi(~0u, __builtin_amdgcn_mbcnt_lo(~0u, z)); }
#define XB_TMO      128
#define XB_XCNT(j)  (256  + 64 * (j))
#define XB_XSUB(j)  (1280 + 64 * (j))
#define XB_XGEN(j)  (2304 + 64 * (j))
#define XB_TOP      3328
#define XB_TOPGEN   3392
#define XCD_BAR_WORDS 3456
#define XB_SPIN_CAP (1u << 18)
__device__ __forceinline__ unsigned xb_ld(unsigned* p)              { return __hip_atomic_load(p, __ATOMIC_RELAXED, __HIP_MEMORY_SCOPE_AGENT); }
__device__ __forceinline__ unsigned xb_add(unsigned* p, unsigned v) { return __hip_atomic_fetch_add(p, v, __ATOMIC_RELAXED, __HIP_MEMORY_SCOPE_AGENT); }
__device__ __forceinline__ unsigned xb_xcc_id() { return (unsigned)__builtin_amdgcn_s_getreg((3 << 11) | 20) & 0xFu; }
#define XB_SPIN(cond, bar) do { unsigned _sp = 0; while (cond) { __builtin_amdgcn_s_sleep(1); \
    if ((++_sp & 255u) == 0u) { if (xb_ld(&(bar)[XB_TMO])) break; if (_sp > XB_SPIN_CAP) { atomicAdd(&(bar)[XB_TMO], 1u); break; } } } } while (0)
struct XcdBarrier { unsigned* bar; unsigned x; volatile LAS unsigned* st; };
__device__ __forceinline__ XcdBarrier xcd_barrier_post(unsigned* bar, volatile LAS unsigned* st) {
    XcdBarrier b; b.bar = bar; b.x = xb_xcc_id(); b.st = st;
    if (threadIdx.x == 0) (void)xb_add(&bar[XB_XCNT(b.x)], 1u);
    return b;
}
__device__ __forceinline__ void xcd_barrier_complete(unsigned* bar, unsigned x, unsigned& nloc, unsigned& nx) {
    const unsigned G = gridDim.x * gridDim.y * gridDim.z;
    unsigned sum, cnt, mine, sp = 0u;
    for (;;) {
        sum = 0u; cnt = 0u; mine = 0u;
#pragma unroll
        for (unsigned j = 0; j < 16; ++j) { const unsigned c = xb_ld(&bar[XB_XCNT(j)]); sum += c; cnt += (c > 0u) ? 1u : 0u; mine = (j == x) ? c : mine; }
        if (sum == G) break;
        __builtin_amdgcn_s_sleep(1);
        if ((++sp & 255u) == 0u) { if (xb_ld(&bar[XB_TMO])) break; if (sp > XB_SPIN_CAP) { atomicAdd(&bar[XB_TMO], 1u); break; } }
    }
    nloc = mine > 0u ? mine : 1u; nx = cnt > 0u ? cnt : 1u;
}
__device__ __forceinline__ void xcd_barrier(const XcdBarrier& b, bool is_t0) {
    asm volatile("s_waitcnt vmcnt(0)" ::: "memory");
    __syncthreads();
    if (is_t0) {
        unsigned* bar = b.bar;
        __builtin_amdgcn_s_waitcnt(0);
        unsigned nloc = b.st[0], nx = b.st[1];
        if (nloc == 0u) { xcd_barrier_complete(bar, b.x, nloc, nx); b.st[0] = nloc; b.st[1] = nx; }
        const unsigned old = xb_add(&bar[XB_XSUB(b.x)], 1u);
        const unsigned gen = old / nloc;
        if (old + 1u == (gen + 1u) * nloc) {
            __builtin_amdgcn_fence(__ATOMIC_RELEASE, "agent");
            asm volatile("s_waitcnt vmcnt(0)" ::: "memory");
            const unsigned og = xb_add(&bar[XB_TOP], 1u);
            const unsigned tg = og / nx;
            if (og + 1u == (tg + 1u) * nx) xb_add(&bar[XB_TOPGEN], 1u);
            else XB_SPIN(xb_ld(&bar[XB_TOPGEN]) == tg, bar);
            __builtin_amdgcn_fence(__ATOMIC_ACQUIRE, "agent");
            xb_add(&bar[XB_XGEN(b.x)], 1u);
            asm volatile("s_waitcnt vmcnt(0)" ::: "memory");
        } else {
            XB_SPIN(xb_ld(&bar[XB_XGEN(b.x)]) == gen, bar);
            __builtin_amdgcn_fence(__ATOMIC_ACQUIRE, "agent");
            asm volatile("s_waitcnt vmcnt(0)" ::: "memory");
        }
    }
    __syncthreads();
}
namespace gs {
constexpr int BM = 256, BK = 64, HALF = 128, HTB = HALF * BK * 2, STAGE_BYTES = 8 * HTB, NXCD = 8, WGM = 8;
__host__ __device__ __forceinline__ int lds_byte(int r, int c) { const int st = (r >> 4) * 2 + (c >> 5), rr = r & 15, cc = c & 31, ob = rr * 64 + cc * 2; return st * 1024 + (ob ^ (((ob >> 9) & 1) << 5)); }
__host__ __device__ __forceinline__ void stage_rc(int b, int& R, int& C) { const int st = b / 1024, sb = b % 1024, swz = sb ^ (((sb >> 9) & 1) << 5); R = (st >> 1) * 16 + swz / 64; C = (st & 1) * 32 + (swz % 64) / 2; }
__host__ __device__ __forceinline__ int perm32(int rho) { const int n = rho >> 4, i = rho & 15; return 8 * (i >> 2) + 4 * n + (i & 3); }

struct UD { const char* A; const char* B; unsigned lda, ldb; int nt; int kind, pm, pn, aux; };

__device__ __forceinline__ bool tile_of(long L, int nM, int nN, int& pm, int& pn) {
    const int nwg = nM * nN; if (L >= nwg) return false;
    int wgid = (int)L; { const int q = nwg / NXCD, r = nwg % NXCD, xcd = wgid % NXCD, off = wgid / NXCD; wgid = (xcd < r ? xcd * (q + 1) : r * (q + 1) + (xcd - r) * q) + off; }
    const int nig = WGM * nN, gid = wgid / nig, fm = gid * WGM, gsz = (nM - fm) < WGM ? (nM - fm) : WGM;
    pm = fm + ((wgid % nig) % gsz); pn = (wgid % nig) / gsz; return true;
}

template <bool PERM, class Sched, class Epi, bool GATHER = false>
__device__ __forceinline__ void gemm_stream(LAS unsigned char* lds, const Sched& S, const Epi& E, int wave_s) {
    int tid = wave_s * 64 + lane_id(); asm volatile("" : "+v"(tid));
    const int wid = __builtin_amdgcn_readfirstlane(tid >> 6), lane = tid & 63, wr = wid >> 2, wc = wid & 3, fr = lane & 15, fq = lane >> 4;
    int rA[2], rB[2], cb[2];
#pragma unroll
    for (int i = 0; i < 2; ++i) { int R, C; stage_rc(tid * 16 + i * 8192, R, C); rA[i] = R; rB[i] = PERM ? ((R & ~31) + perm32(R & 31)) : R; cb[i] = C * 2; }
    const size_t kstep = (size_t)(BK * 2);
    const unsigned ldsw = (unsigned)wid * 1024u;
    const int aoff = lds_byte(wr * 64 + fr, fq * 8), boff = lds_byte(wc * 32 + fr, fq * 8);
#define GS_SA(b, h) (((b) * 2 + (h)) * HTB)
#define GS_SB(b, h) ((4 + (b) * 2 + (h)) * HTB)
#define GS_STAGE(bufoff, gbase, voff) do { _Pragma("unroll") for (int _i = 0; _i < 2; ++_i) \
        __builtin_amdgcn_global_load_lds((const unsigned*)((const char*)(gbase) + (voff)[_i]), (LAS unsigned*)(lds + (bufoff) + ldsw + _i * 8192), 16, 0, 0); } while (0)
#define GS_LDA(dst, b, h) do { _Pragma("unroll") for (int m = 0; m < 4; ++m) _Pragma("unroll") for (int k = 0; k < 2; ++k) dst[m][k] = *(const LAS bf16x8*)(lds + GS_SA(b, h) + aoff + m * 2048 + k * 1024); } while (0)
#define GS_LDB(dst, b, h) do { _Pragma("unroll") for (int n = 0; n < 2; ++n) _Pragma("unroll") for (int k = 0; k < 2; ++k) dst[n][k] = *(const LAS bf16x8*)(lds + GS_SB(b, h) + boff + n * 2048 + k * 1024); } while (0)
#define GS_MMA(ai, bj, At, Bt) do { __builtin_amdgcn_s_setprio(1); _Pragma("unroll") for (int m = 0; m < 4; ++m) _Pragma("unroll") for (int n = 0; n < 2; ++n) _Pragma("unroll") for (int k = 0; k < 2; ++k) \
        acc[ai][bj][m][n] = __builtin_amdgcn_mfma_f32_16x16x32_bf16(Bt[n][k], At[m][k], acc[ai][bj][m][n], 0, 0, 0); __builtin_amdgcn_s_setprio(0); } while (0)
#define GS_WAIT_V(n) asm volatile("s_waitcnt vmcnt(" #n ")" ::: "memory")
#define GS_WAIT_L(n) asm volatile("s_waitcnt lgkmcnt(" #n ")" ::: "memory")
#define GS_BAR __builtin_amdgcn_s_barrier()
#define GS_SCHED __builtin_amdgcn_sched_barrier(0)
    UD cur, nxt; int ui = 0; const bool prime = false;
    if (!S.next(0, cur)) return;
    f32x4 acc[2][2][4][2];
#pragma unroll
    for (int a = 0; a < 2; ++a)
#pragma unroll
        for (int b = 0; b < 2; ++b)
#pragma unroll
            for (int m = 0; m < 4; ++m)
#pragma unroll
                for (int n = 0; n < 2; ++n) acc[a][b][m][n] = (f32x4){0.f, 0.f, 0.f, 0.f};
    bf16x8 At[4][2], B0[2][2], B1[2][2];
    unsigned vAc[2], vBc[2], vAc1[2] = {0u, 0u};
#pragma unroll
    for (int i = 0; i < 2; ++i) { vAc[i] = (unsigned)rA[i] * cur.lda + (unsigned)cb[i]; vBc[i] = (unsigned)rB[i] * cur.ldb + (unsigned)cb[i]; }
    if constexpr (GATHER) { const int* rm = S.rmap + cur.pm * 256;
#pragma unroll
        for (int i = 0; i < 2; ++i) { vAc[i] = (unsigned)rm[rA[i]] * cur.lda + (unsigned)cb[i]; vAc1[i] = (unsigned)rm[HALF + rA[i]] * cur.lda + (unsigned)cb[i]; } }
    const char* cA = cur.A; const char* cB = cur.B; size_t hA = GATHER ? (size_t)0 : (size_t)HALF * cur.lda, hB = (size_t)HALF * cur.ldb;
    GS_STAGE(GS_SB(0, 0), cB, vBc); GS_STAGE(GS_SA(0, 0), cA, vAc); GS_STAGE(GS_SB(0, 1), cB + hB, vBc); GS_STAGE(GS_SA(0, 1), cA + hA, (GATHER ? vAc1 : vAc));
    if (wr == 1) GS_BAR;
    GS_WAIT_V(4); GS_BAR;
    GS_STAGE(GS_SB(1, 0), cB + kstep, vBc); GS_STAGE(GS_SA(1, 0), cA + kstep, vAc); GS_STAGE(GS_SB(1, 1), cB + hB + kstep, vBc);
    GS_WAIT_V(6); GS_BAR;
    for (;;) {
        const bool has_next = S.next(ui + 1, nxt);
        const char* nA = has_next ? nxt.A : cA; const char* nB = has_next ? nxt.B : cB;
        const unsigned nlda = has_next ? nxt.lda : cur.lda, nldb = has_next ? nxt.ldb : cur.ldb;
        unsigned vAn[2], vBn[2], vAn1[2] = {0u, 0u};
#pragma unroll
        for (int i = 0; i < 2; ++i) { vAn[i] = (unsigned)rA[i] * nlda + (unsigned)cb[i]; vBn[i] = (unsigned)rB[i] * nldb + (unsigned)cb[i]; }
        if constexpr (GATHER) { const int* rm = S.rmap + (has_next ? nxt.pm : cur.pm) * 256;
#pragma unroll
            for (int i = 0; i < 2; ++i) { vAn[i] = (unsigned)rm[rA[i]] * nlda + (unsigned)cb[i]; vAn1[i] = (unsigned)rm[HALF + rA[i]] * nlda + (unsigned)cb[i]; } }
        const size_t hAn = GATHER ? (size_t)0 : (size_t)HALF * nlda, hBn = (size_t)HALF * nldb;
        const int nt = cur.nt;
        for (int t = 0; t < nt; t += 2) {
            const bool last = (t == nt - 2);
            const char* a1 = cA + (size_t)(t + 1) * kstep;
            const char* a2 = last ? nA : cA + (size_t)(t + 2) * kstep; const char* b2 = last ? nB : cB + (size_t)(t + 2) * kstep;
            const char* a3 = a2 + kstep; const char* b3 = b2 + kstep;
            unsigned vA2[2], vB2[2], vA21[2];
#pragma unroll
            for (int i = 0; i < 2; ++i) { vA2[i] = last ? vAn[i] : vAc[i]; vB2[i] = last ? vBn[i] : vBc[i]; vA21[i] = last ? vAn1[i] : vAc1[i]; }
            const size_t hA2 = last ? hAn : hA, hB2 = last ? hBn : hB;
            GS_LDB(B0, 0, 0); GS_SCHED; GS_LDA(At, 0, 0); GS_STAGE(GS_SA(1, 1), a1 + hA, (GATHER ? vAc1 : vAc));
            GS_WAIT_L(8); GS_BAR; GS_WAIT_L(0); GS_MMA(0, 0, At, B0); GS_BAR; GS_SCHED;
            GS_LDB(B1, 0, 1); GS_STAGE(GS_SB(0, 0), b2, vB2);
            GS_BAR; GS_WAIT_L(0); GS_MMA(0, 1, At, B1); GS_BAR;
            GS_LDA(At, 0, 1); GS_STAGE(GS_SA(0, 0), a2, vA2);
            GS_BAR; GS_WAIT_L(0); GS_MMA(1, 0, At, B0); GS_BAR; GS_SCHED;
            GS_STAGE(GS_SB(0, 1), b2 + hB2, vB2);
            GS_WAIT_V(6); GS_BAR; GS_MMA(1, 1, At, B1); GS_BAR;
            GS_LDB(B0, 1, 0); GS_SCHED; GS_LDA(At, 1, 0); GS_STAGE(GS_SA(0, 1), a2 + hA2, (GATHER ? vA21 : vA2));
            GS_WAIT_L(8); GS_BAR; GS_WAIT_L(0); GS_MMA(0, 0, At, B0); GS_BAR; GS_SCHED;
            GS_LDB(B1, 1, 1); GS_STAGE(GS_SB(1, 0), b3, vB2);
            GS_BAR; GS_WAIT_L(0); GS_MMA(0, 1, At, B1); GS_BAR;
            GS_LDA(At, 1, 1); GS_STAGE(GS_SA(1, 0), a3, vA2);
            GS_BAR; GS_WAIT_L(0); GS_MMA(1, 0, At, B0); GS_BAR; GS_SCHED;
            GS_STAGE(GS_SB(1, 1), b3 + hB2, vB2);
            GS_WAIT_V(6); GS_BAR; GS_MMA(1, 1, At, B1); GS_BAR;
        }
        if (!prime) { int tz = wave_s * 64 + lane_id(); asm volatile("" : "+v"(tz)); const int w2 = __builtin_amdgcn_readfirstlane(tz >> 6), l2 = tz & 63; E(acc, cur, w2 >> 2, w2 & 3, l2 & 15, l2 >> 4, tz); }
        if (!has_next) break;
#pragma unroll
        for (int a = 0; a < 2; ++a)
#pragma unroll
            for (int b = 0; b < 2; ++b)
#pragma unroll
                for (int m = 0; m < 4; ++m)
#pragma unroll
                    for (int n = 0; n < 2; ++n) acc[a][b][m][n] = (f32x4){0.f, 0.f, 0.f, 0.f};
        cur = nxt; cA = nA; cB = nB; hA = hAn; hB = hBn;
#pragma unroll
        for (int i = 0; i < 2; ++i) { vAc[i] = vAn[i]; vBc[i] = vBn[i]; vAc1[i] = vAn1[i]; }
        ++ui;
    }
    GS_WAIT_V(0);
    if (wr == 0) GS_BAR;
    GS_BAR;
#undef GS_SA
#undef GS_SB
#undef GS_STAGE
#undef GS_LDA
#undef GS_LDB
#undef GS_MMA
#undef GS_WAIT_V
#undef GS_WAIT_L
#undef GS_BAR
#undef GS_SCHED
}
}
using gs::UD;
__device__ __forceinline__ u32x4 pack8(f32x4 v0, f32x4 v1) { u32x4 w; w.x = pk2(v0[0], v0[1]); w.y = pk2(v0[2], v0[3]); w.z = pk2(v1[0], v1[1]); w.w = pk2(v1[2], v1[3]); return w; }
__device__ __forceinline__ void unpack8(u32x4 w, f32x4& v0, f32x4& v1) { v0 = (f32x4){bf_lo(w.x), bf_hi(w.x), bf_lo(w.y), bf_hi(w.y)}; v1 = (f32x4){bf_lo(w.z), bf_hi(w.z), bf_lo(w.w), bf_hi(w.w)}; }

struct EpiInproj {
    bf16_t *xrnn, *grnn, *qlat, *ckv, *qidx, *kidx; float* widx;
    __device__ __forceinline__ void operator()(const f32x4 (&acc)[2][2][4][2], const UD& u, int wr, int wc, int fr, int fq, int tid) const {
        const int pn = u.pn; const size_t row0 = (size_t)u.pm * 256 + wr * 64 + fr;
        if (pn < 19) {
            bf16_t* base; int ldc, colt; float sc = 1.f; bool gl = false;
            if (pn < 4) { base = xrnn; ldc = 1024; colt = 256 * pn; }
            else if (pn < 8) { base = grnn; ldc = 1024; colt = 256 * (pn - 4); gl = true; }
            else if (pn < 16) { base = qlat; ldc = 2048; colt = 256 * (pn - 8); }
            else if (pn == 16) { base = ckv; ldc = 256; colt = 0; }
            else { base = qidx; ldc = 512; colt = 256 * (pn - 17); sc = 0.125f; }
#pragma unroll
            for (int ai = 0; ai < 2; ++ai)
#pragma unroll
                for (int m = 0; m < 4; ++m) { bf16_t* rowp = base + (row0 + ai * 128 + m * 16) * ldc + colt + wc * 32 + 8 * fq;
#pragma unroll
                    for (int bj = 0; bj < 2; ++bj) { f32x4 v0 = acc[ai][bj][m][0], v1 = acc[ai][bj][m][1];
                        if (gl) {
#pragma unroll
                            for (int j = 0; j < 4; ++j) { v0[j] = gelu_tanh(v0[j]); v1[j] = gelu_tanh(v1[j]); } }
                        v0 = v0 * sc; v1 = v1 * sc;
                        *(u32x4*)(rowp + bj * 128) = pack8(v0, v1); } }
        } else {
#pragma unroll
            for (int ai = 0; ai < 2; ++ai)
#pragma unroll
                for (int m = 0; m < 4; ++m) { const size_t row = row0 + ai * 128 + m * 16; const f32x4 v0 = acc[ai][0][m][0], v1 = acc[ai][0][m][1];
                    if (wc < 2) *(u32x4*)(kidx + row * 64 + wc * 32 + 8 * fq) = pack8(v0, v1);
                    else if (wc == 2 && fq == 0) { *(f32x4*)(widx + row * 8) = v0 * 0.35355339059327373f; *(f32x4*)(widx + row * 8 + 4) = v1 * 0.35355339059327373f; } }
        }
    }
};
struct EpiMerge1 {
    unsigned char* s1b; unsigned char* s2b; bf16_t* merged;
    __device__ __forceinline__ void operator()(const f32x4 (&acc)[2][2][4][2], const UD& u, int wr, int wc, int fr, int fq, int tid) const {
        const int kind = u.kind;
        u32x4* s1 = (u32x4*)s1b + tid; u32x4* s2 = (u32x4*)(s2b + (size_t)(u.pm * 4 + u.pn) * 131072) + tid;
#pragma unroll
        for (int ai = 0; ai < 2; ++ai)
#pragma unroll
            for (int bj = 0; bj < 2; ++bj)
#pragma unroll
                for (int m = 0; m < 4; ++m) { const int slot = (ai * 2 + bj) * 4 + m; f32x4 v0 = acc[ai][bj][m][0], v1 = acc[ai][bj][m][1];
                    if (kind != 1) {
#pragma unroll
                        for (int j = 0; j < 4; ++j) { v0[j] = sigmoidf_(v0[j]); v1[j] = sigmoidf_(v1[j]); }
#ifdef DBG_S1_CONST
                        { const float cv = (float)(u.pm * 4 + u.pn + 1) * (1.0f / 512.0f); v0 = (f32x4){cv, cv, cv, cv}; v1 = v0; }
#endif
                        (kind == 0 ? s1 : s2)[slot * 512] = pack8(v0, v1);
                    } else {
                        f32x4 a0, a1; unpack8(__builtin_nontemporal_load(s1 + slot * 512), a0, a1);
#ifdef DBG_NO_S1
                        a0 = (f32x4){1.f, 1.f, 1.f, 1.f}; a1 = a0;
#endif
                        const size_t row = (size_t)u.pm * 256 + ai * 128 + wr * 64 + m * 16 + fr;
                        *(u32x4*)(merged + row * 1024 + u.pn * 256 + bj * 128 + wc * 32 + 8 * fq) = pack8(a0 * v0, a1 * v1);
#ifdef DBG_OUT_S1
                        *(u32x4*)(merged + row * 1024 + u.pn * 256 + bj * 128 + wc * 32 + 8 * fq) = pack8(a0, a1);
#endif
                    }
                    if (m & 1) asm volatile("" ::: "memory"); }
    }
};
struct EpiMerge2 {
    unsigned char* s2b; bf16_t* merged;
    __device__ __forceinline__ void operator()(const f32x4 (&acc)[2][2][4][2], const UD& u, int wr, int wc, int fr, int fq, int tid) const {
        const u32x4* s2 = (const u32x4*)(s2b + (size_t)(u.pm * 4 + u.pn) * 131072) + tid;
#pragma unroll
        for (int ai = 0; ai < 2; ++ai)
#pragma unroll
            for (int bj = 0; bj < 2; ++bj)
#pragma unroll
                for (int m = 0; m < 4; ++m) { const int slot = (ai * 2 + bj) * 4 + m;
                    const size_t row = (size_t)u.pm * 256 + ai * 128 + wr * 64 + m * 16 + fr;
                    u32x4* mp = (u32x4*)(merged + row * 1024 + u.pn * 256 + bj * 128 + wc * 32 + 8 * fq);
                    f32x4 a0, a1, b0, b1; unpack8(__builtin_nontemporal_load(mp), a0, a1); unpack8(__builtin_nontemporal_load(s2 + slot * 512), b0, b1);
#ifdef DBG_NO_S2
                    b0 = (f32x4){1.f, 1.f, 1.f, 1.f}; b1 = b0;
#endif
#ifdef DBG_NO_MRG
                    a0 = (f32x4){0.f, 0.f, 0.f, 0.f}; a1 = a0;
#endif
                    *mp = pack8(a0 + b0 * acc[ai][bj][m][0], a1 + b1 * acc[ai][bj][m][1]);
                    if (m & 1) asm volatile("" ::: "memory"); }
    }
};
struct EpiOut {
    bf16_t* xb;
    __device__ __forceinline__ void operator()(const f32x4 (&acc)[2][2][4][2], const UD& u, int wr, int wc, int fr, int fq, int tid) const {
#pragma unroll
        for (int ai = 0; ai < 2; ++ai)
#pragma unroll
            for (int m = 0; m < 4; ++m) { bf16_t* rowp = xb + ((size_t)u.pm * 256 + ai * 128 + wr * 64 + m * 16 + fr) * 1024 + u.pn * 256 + wc * 32 + 8 * fq;
#pragma unroll
                for (int bj = 0; bj < 2; ++bj) { u32x4* p = (u32x4*)(rowp + bj * 128); const u32x4 xv = *p; f32x4 v0 = acc[ai][bj][m][0], v1 = acc[ai][bj][m][1];
                    v0[0] += ALPHA * bf_lo(xv.x); v0[1] += ALPHA * bf_hi(xv.x); v0[2] += ALPHA * bf_lo(xv.y); v0[3] += ALPHA * bf_hi(xv.y);
                    v1[0] += ALPHA * bf_lo(xv.z); v1[1] += ALPHA * bf_hi(xv.z); v1[2] += ALPHA * bf_lo(xv.w); v1[3] += ALPHA * bf_hi(xv.w);
                    *p = pack8(v0, v1); } }
    }
};
struct EpiGU {
    bf16_t* he;
    __device__ __forceinline__ void operator()(const f32x4 (&acc)[2][2][4][2], const UD& u, int wr, int wc, int fr, int fq, int tid) const {
#pragma unroll
        for (int ai = 0; ai < 2; ++ai)
#pragma unroll
            for (int m = 0; m < 4; ++m) { bf16_t* rowp = he + ((size_t)u.pm * 256 + ai * 128 + wr * 64 + m * 16 + fr) * 512 + u.pn * 128 + wc * 16 + 4 * fq;
#pragma unroll
                for (int bj = 0; bj < 2; ++bj) { const f32x4 g = acc[ai][bj][m][0], up = acc[ai][bj][m][1]; f32x4 o;
#pragma unroll
                    for (int j = 0; j < 4; ++j) o[j] = g[j] * sigmoidf_(g[j]) * up[j];
                    u32x2 w; w.x = pk2(o[0], o[1]); w.y = pk2(o[2], o[3]); *(u32x2*)(rowp + bj * 64) = w; } }
    }
};
struct EpiBf16 {
    bf16_t* out; int ldc;
    __device__ __forceinline__ void operator()(const f32x4 (&acc)[2][2][4][2], const UD& u, int wr, int wc, int fr, int fq, int tid) const {
#pragma unroll
        for (int ai = 0; ai < 2; ++ai)
#pragma unroll
            for (int m = 0; m < 4; ++m) { bf16_t* rowp = out + ((size_t)u.pm * 256 + ai * 128 + wr * 64 + m * 16 + fr) * ldc + u.pn * 256 + wc * 32 + 8 * fq;
#pragma unroll
                for (int bj = 0; bj < 2; ++bj) *(u32x4*)(rowp + bj * 128) = pack8(acc[ai][bj][m][0], acc[ai][bj][m][1]); }
    }
};
struct EpiPro {
    unsigned char* wmix;
    __device__ __forceinline__ void operator()(const f32x4 (&acc)[2][2][4][2], const UD& u, int wr, int wc, int fr, int fq, int tid) const {
        const int l = u.aux >> 3, h = u.aux & 7, p = u.pn;
        bf16_t* base; int ldc; float sc;
        if (u.kind == 0) { base = (bf16_t*)(wmix + (size_t)l * WMIX_STRIDE + OFF_WIN) + (size_t)(2048 + 256 * h) * 1024 + 256 * p; ldc = 1024; sc = 0.08838834764831845f; }
        else { base = (bf16_t*)(wmix + (size_t)l * WMIX_STRIDE + OFF_WVO) + (size_t)(256 * p) * 2048 + 256 * h; ldc = 2048; sc = 1.f; }
#pragma unroll
        for (int ai = 0; ai < 2; ++ai)
#pragma unroll
            for (int m = 0; m < 4; ++m) { bf16_t* rowp = base + (size_t)(ai * 128 + wr * 64 + m * 16 + fr) * ldc + wc * 32 + 8 * fq;
#pragma unroll
                for (int bj = 0; bj < 2; ++bj) *(u32x4*)(rowp + bj * 128) = pack8(acc[ai][bj][m][0] * sc, acc[ai][bj][m][1] * sc); }
    }
};

struct SchedDense {
    const char* A; const char* B; unsigned lda, ldb; int nt, nM, nN, G, c;
    __device__ __forceinline__ bool next(int i, UD& u) const {
        int pm, pn; if (!gs::tile_of((long)i * G + c, nM, nN, pm, pn)) return false;
        u.A = A + (size_t)pm * 256 * lda; u.B = B + (size_t)pn * 256 * ldb; u.lda = lda; u.ldb = ldb; u.nt = nt; u.kind = 0; u.pm = pm; u.pn = pn; u.aux = 0; return true;
    }
};
struct SchedMerge1 {
    const char *xb, *yrnn, *wg, *wpr; int G, c;
    __device__ __forceinline__ bool next(int i_, UD& u) const { int i = i_;
#ifdef DBG_DUPFIRST
        if (i > 0) i -= 1;
#endif
#ifdef DBG_ORDER201
        const int ti = i / 3, kk_ = i - 3 * ti, k = kk_ == 0 ? 2 : kk_ - 1;
#else
        const int ti = i / 3, k = i - 3 * ti;
#endif
        int pm, pn; if (!gs::tile_of((long)ti * G + c, T / 256, 4, pm, pn)) return false;
        u.kind = k; u.pm = pm; u.pn = pn; u.aux = 0; u.lda = 2048; u.ldb = 2048; u.nt = 16;
#ifdef DBG_K0_AS_K1
        if (k == 0) { u.A = yrnn + (size_t)pm * 256 * 2048; u.B = wpr + (size_t)pn * 256 * 2048; }
#else
        if (k == 0) { u.A = xb + (size_t)pm * 256 * 2048; u.B = wg + (size_t)pn * 256 * 2048; }
#endif
        else if (k == 1) { u.A = yrnn + (size_t)pm * 256 * 2048; u.B = wpr + (size_t)pn * 256 * 2048; }
        else { u.A = xb + (size_t)pm * 256 * 2048; u.B = wg + (size_t)(1024 + pn * 256) * 2048; }
        return true;
    }
};
struct SchedMoE {
    const char* A; const char* B; unsigned lda, ldb; size_t bstride; int nt, nN, G, c; const LAS int* offp;
    __device__ __forceinline__ bool next(int i, UD& u) const {
        const int nM = offp[16] >> 8; int pm, pn; if (!gs::tile_of((long)i * G + c, nM, nN, pm, pn)) return false;
        int e = 0;
#pragma unroll 1
        for (int j = 1; j < 16; ++j) e += (pm * 256 >= offp[j]) ? 1 : 0;
        u.A = A + (size_t)pm * 256 * lda; u.B = B + (size_t)e * bstride + (size_t)pn * 256 * ldb; u.lda = lda; u.ldb = ldb; u.nt = nt; u.kind = 0; u.pm = pm; u.pn = pn; u.aux = e; return true;
    }
};
struct SchedMoEG {
    const char* A; const char* B; unsigned lda, ldb; size_t bstride; int nt, nN, G, c; const LAS int* offp; const int* rmap;
    __device__ __forceinline__ bool next(int i, UD& u) const {
        const int nM = offp[16] >> 8; int pm, pn; if (!gs::tile_of((long)i * G + c, nM, nN, pm, pn)) return false;
        int e = 0;
#pragma unroll 1
        for (int j = 1; j < 16; ++j) e += (pm * 256 >= offp[j]) ? 1 : 0;
        u.A = A; u.B = B + (size_t)e * bstride + (size_t)pn * 256 * ldb; u.lda = lda; u.ldb = ldb; u.nt = nt; u.kind = 0; u.pm = pm; u.pn = pn; u.aux = e; return true;
    }
};
struct SchedPro {
    const unsigned char* tmp; int G, c;
    __device__ __forceinline__ bool next(int i, UD& u) const {
        const long L = (long)i * G + c; if (L >= 256) return false;
        const int kind = (int)(L >> 7), l = (int)(L >> 5) & 3, h = (int)(L >> 2) & 7, p = (int)L & 3;
        u.kind = kind; u.aux = l * 8 + h; u.pm = 0; u.pn = p; u.nt = 4; u.lda = 2048; u.ldb = 2048;
        if (kind == 0) { u.A = (const char*)tmp + R_UKP + ((size_t)(l * 8 + h) * 256) * 2048;
                         u.B = (const char*)tmp + R_WQ + (size_t)l * 2 * MiB + (size_t)(256 * p) * 2048 + (size_t)(h >> 1) * 512; }
        else { u.A = (const char*)tmp + R_PT + (size_t)l * 2 * MiB + (size_t)(256 * p) * 2048 + (size_t)(h >> 1) * 512;
               u.B = (const char*)tmp + R_UVP + ((size_t)(l * 8 + h) * 256) * 2048; }
        return true;
    }
};

__device__ __forceinline__ void tr_item(const float* src, int ld, int c0, int nvalid, bf16_t* dst, int lddst, int mode, int item, int nblk, LAS float* scr, int lane) {
    const int kb = item / nblk, nb = item - kb * nblk, k0 = 64 * kb, n0 = 32 * nb;
    const int cc = 4 * (lane & 7); const bool ok = n0 + cc < nvalid;
    f32x4 tv_[8];
#pragma unroll
    for (int i = 0; i < 8; ++i) { const int kk = 8 * i + (lane >> 3); tv_[i] = ok ? *(const f32x4*)(src + (size_t)(k0 + kk) * ld + c0 + n0 + cc) : (f32x4){0.f, 0.f, 0.f, 0.f}; }
#pragma unroll
    for (int i = 0; i < 8; ++i) { const int kk = 8 * i + (lane >> 3);
#pragma unroll
        for (int j = 0; j < 4; ++j) scr[kk * 33 + cc + j] = tv_[i][j]; }
    asm volatile("s_waitcnt lgkmcnt(0)" ::: "memory");
    const int c = lane & 7;
#pragma unroll
    for (int j = 0; j < 4; ++j) { const int nl = (lane >> 3) + 8 * j; const int nn = n0 + nl; const int row = mode ? (8 * (nn >> 2) + (nn & 3)) : nn; const LAS float* s = scr + (8 * c) * 33 + nl;
        u32x4 o; o.x = pk2(s[0 * 33], s[1 * 33]); o.y = pk2(s[2 * 33], s[3 * 33]); o.z = pk2(s[4 * 33], s[5 * 33]); o.w = pk2(s[6 * 33], s[7 * 33]);
        *(u32x4*)(dst + (size_t)row * lddst + k0 + 8 * c) = o; }
    asm volatile("s_waitcnt lgkmcnt(0)" ::: "memory");
}
__device__ __forceinline__ float expm1_acc(float x) {
    if (x > -0.35f) { float p = 1.0f + x * (1.0f / 8.0f); p = 1.0f + x * (1.0f / 7.0f) * p; p = 1.0f + x * (1.0f / 6.0f) * p; p = 1.0f + x * (1.0f / 5.0f) * p; p = 1.0f + x * 0.25f * p; p = 1.0f + x * (1.0f / 3.0f) * p; p = 1.0f + x * 0.5f * p; return x * p; }
    return fast_exp(x) - 1.0f;
}
struct RnnP { const bf16_t* xrnn; bf16_t* gy; float* tot; const bf16_t *waT, *wxT; const float *convw, *convb, *ba, *bx, *lam; };
template <int PASS>
__device__ __forceinline__ void rnn_item(const RnnP& P, int item, LAS unsigned char* wlds, int lane) {
    const int b = item >> 10, g = (item >> 6) & 15, seg = item & 63, ch0 = 64 * g;
    const int row = lane & 15, kg = lane >> 4, col = lane & 15;
    LAS float* CW = (LAS float*)wlds;
    LAS float* XR = CW + 320;
#pragma unroll
    for (int k = 0; k < 4; ++k) CW[k * 64 + lane] = P.convw[k * 1024 + ch0 + lane];
    CW[256 + lane] = P.convb[ch0 + lane];
    bf16x8 Ba[4][2], Bx[4][2];
#pragma unroll
    for (int jt = 0; jt < 4; ++jt)
#pragma unroll
        for (int s = 0; s < 2; ++s) { const size_t o = ((size_t)g * 64 + 16 * jt + col) * 64 + 32 * s + 8 * kg; Ba[jt][s] = *(const bf16x8*)(P.waT + o); Bx[jt][s] = *(const bf16x8*)(P.wxT + o); }
    float cba[4], cbx[4], sp8[4], h0[4], Pc[4];
#pragma unroll
    for (int jt = 0; jt < 4; ++jt) { const int ch = ch0 + 16 * jt + col; cba[jt] = -1.4426950408889634f * P.ba[ch]; cbx[jt] = -1.4426950408889634f * P.bx[ch]; const float lm = P.lam[ch]; sp8[jt] = -8.0f * 1.4426950408889634f * log1pf(expf(-lm));   h0[jt] = 0.f; Pc[jt] = 1.f; }
    float* totp = P.tot + ((size_t)(b * 64) * 1024 + ch0 + col) * 2;
    if (PASS == 2 && seg > 0) {
        const int Q = (seg + 3) >> 2, slo = kg * Q;
        float Pq[4] = {1.f, 1.f, 1.f, 1.f}, Hq[4] = {0.f, 0.f, 0.f, 0.f};
        for (int i0 = 0; i0 < Q; i0 += 4) {
            f32x2 ph[4][4];
#pragma unroll
            for (int i = 0; i < 4; ++i) { int s2 = slo + i0 + i; s2 = s2 < seg ? s2 : seg - 1;
#pragma unroll
                for (int jt = 0; jt < 4; ++jt) ph[i][jt] = *(const f32x2*)(totp + ((size_t)s2 * 1024 + 16 * jt) * 2); }
#pragma unroll
            for (int i = 0; i < 4; ++i) { const bool ok = (i0 + i < Q) && (slo + i0 + i < seg);
#pragma unroll
                for (int jt = 0; jt < 4; ++jt) { const float px = ok ? ph[i][jt].x : 1.f, hy = ok ? ph[i][jt].y : 0.f; Hq[jt] = px * Hq[jt] + hy; Pq[jt] = Pq[jt] * px; } }
        }
#pragma unroll
        for (int jt = 0; jt < 4; ++jt) {
            const float H0 = __shfl(Hq[jt], col), P1 = __shfl(Pq[jt], col + 16), H1 = __shfl(Hq[jt], col + 16), P2 = __shfl(Pq[jt], col + 32), H2 = __shfl(Hq[jt], col + 32),
                        P3 = __shfl(Pq[jt], col + 48), H3 = __shfl(Hq[jt], col + 48);
            float h = H0; h = P1 * h + H1; h = P2 * h + H2; h = P3 * h + H3; h0[jt] = h; }
    }
    asm volatile("s_waitcnt lgkmcnt(0)" ::: "memory");
    const size_t rowb = (size_t)b * SEQ;
    u32x4 xn[4][2];
    { const int tA0 = seg * 256 + row;
#pragma unroll
      for (int dt = 0; dt < 4; ++dt) { const int tt = tA0 - 3 + dt;
#pragma unroll
          for (int s = 0; s < 2; ++s) xn[dt][s] = (tt >= 0) ? *(const u32x4*)(P.xrnn + (rowb + tt) * 1024 + ch0 + 32 * s + 8 * kg) : (u32x4){0u, 0u, 0u, 0u}; } }
    for (int tile = 0; tile < 16; ++tile) {
        const int t0 = seg * 256 + tile * 16;
        u32x4 xw[4][2];
#pragma unroll
        for (int dt = 0; dt < 4; ++dt)
#pragma unroll
            for (int s = 0; s < 2; ++s) xw[dt][s] = xn[dt][s];
        if (tile + 1 < 16) { const int tB = t0 + 16 + row;
#pragma unroll
            for (int dt = 0; dt < 4; ++dt) { const int tt = tB - 3 + dt;
#pragma unroll
                for (int s = 0; s < 2; ++s) xn[dt][s] = *(const u32x4*)(P.xrnn + (rowb + tt) * 1024 + ch0 + 32 * s + 8 * kg); } }
        bf16_t gq[4][4];
        if (PASS == 2) { const bf16_t* gp0 = P.gy + (rowb + t0 + 4 * kg) * 1024 + ch0 + col;
#pragma unroll
            for (int jt = 0; jt < 4; ++jt)
#pragma unroll
                for (int r = 0; r < 4; ++r) gq[jt][r] = gp0[(size_t)r * 1024 + 16 * jt]; }
        bf16x8 Af[2];
#pragma unroll
        for (int s = 0; s < 2; ++s) {
            const int cl = 32 * s + 8 * kg;
            f32x4 o0 = *(LAS f32x4*)(CW + 256 + cl), o1 = *(LAS f32x4*)(CW + 256 + cl + 4);
#pragma unroll
            for (int dt = 0; dt < 4; ++dt) { const f32x4 w0 = *(LAS f32x4*)(CW + dt * 64 + cl), w1 = *(LAS f32x4*)(CW + dt * 64 + cl + 4); const u32x4 x = xw[dt][s];
                o0[0] += w0[0] * bf_lo(x.x); o0[1] += w0[1] * bf_hi(x.x); o0[2] += w0[2] * bf_lo(x.y); o0[3] += w0[3] * bf_hi(x.y);
                o1[0] += w1[0] * bf_lo(x.z); o1[1] += w1[1] * bf_hi(x.z); o1[2] += w1[2] * bf_lo(x.w); o1[3] += w1[3] * bf_hi(x.w); }
            *(LAS f32x4*)(XR + row * 68 + cl) = o0; *(LAS f32x4*)(XR + row * 68 + cl + 4) = o1;
            const u32x4 pk = pack8(o0, o1); Af[s] = __builtin_bit_cast(bf16x8, pk);
        }
        f32x4 ar[4], ax[4];
#pragma unroll
        for (int jt = 0; jt < 4; ++jt) { ar[jt] = (f32x4){0.f, 0.f, 0.f, 0.f}; ax[jt] = ar[jt];
#pragma unroll
            for (int s = 0; s < 2; ++s) { ar[jt] = __builtin_amdgcn_mfma_f32_16x16x32_bf16(Af[s], Ba[jt][s], ar[jt], 0, 0, 0); ax[jt] = __builtin_amdgcn_mfma_f32_16x16x32_bf16(Af[s], Bx[jt][s], ax[jt], 0, 0, 0); } }
        asm volatile("s_waitcnt lgkmcnt(0)" ::: "memory");
#pragma unroll
        for (int jt = 0; jt < 4; ++jt) {
            float Pp[4], Hp[4]; float pr = 1.f, hr = 0.f;
#pragma unroll
            for (int r = 0; r < 4; ++r) {
                const float xr = XR[(4 * kg + r) * 68 + 16 * jt + col];
                const float rg = fast_rcp(1.0f + __builtin_amdgcn_exp2f(__builtin_fmaf(ar[jt][r], -1.4426950408889634f, cba[jt]))), ig = fast_rcp(1.0f + __builtin_amdgcn_exp2f(__builtin_fmaf(ax[jt][r], -1.4426950408889634f, cbx[jt])));
                const float a = __builtin_amdgcn_exp2f(sp8[jt] * rg); const float em = a - 1.0f;
                const float mm = __builtin_amdgcn_sqrtf(fmaxf(-em * (2.0f + em), 0.f));
                const float uu = mm * ig * xr;
                hr = a * hr + uu; pr = pr * a; Pp[r] = pr; Hp[r] = hr;
            }
            const float P0 = __shfl(pr, col), P1 = __shfl(pr, col + 16), P2 = __shfl(pr, col + 32), P3 = __shfl(pr, col + 48);
            const float H0 = __shfl(hr, col), H1 = __shfl(hr, col + 16), H2 = __shfl(hr, col + 32), H3 = __shfl(hr, col + 48);
            const float h1 = P0 * h0[jt] + H0, h2 = P1 * h1 + H1, h3 = P2 * h2 + H2, h4 = P3 * h3 + H3;
            if (PASS == 2) {
                const float hs = kg == 0 ? h0[jt] : (kg == 1 ? h1 : (kg == 2 ? h2 : h3));
                bf16_t* gp = P.gy + (rowb + t0 + 4 * kg) * 1024 + ch0 + 16 * jt + col;
#pragma unroll
                for (int r = 0; r < 4; ++r) { const float hv = Pp[r] * hs + Hp[r]; const float gg = bf2f(gq[jt][r]); gp[(size_t)r * 1024] = (bf16_t)pk2(hv * gg, 0.f); }
            } else Pc[jt] = Pc[jt] * (P0 * P1) * (P2 * P3);
            h0[jt] = h4;
        }
    }
    if (PASS == 1 && kg == 0) {
#pragma unroll
        for (int jt = 0; jt < 4; ++jt) *(f32x2*)(totp + ((size_t)seg * 1024 + 16 * jt) * 2) = (f32x2){Pc[jt], h0[jt]};
    }
}
__device__ __forceinline__ void ckv_norm_rows4(bf16_t* base, int row0, int rstep, int nrows, const float* gain, int lane) {
    u32x2 w[4];
#pragma unroll
    for (int i = 0; i < 4; ++i) { const int r = row0 + i * rstep; w[i] = *(const u32x2*)(base + (size_t)(r < nrows ? r : row0) * 256 + 4 * lane); }
    const f32x4 gn = *(const f32x4*)(gain + 4 * lane);
#pragma unroll
    for (int i = 0; i < 4; ++i) { const int r = row0 + i * rstep;
        const float v0 = bf_lo(w[i].x), v1 = bf_hi(w[i].x), v2 = bf_lo(w[i].y), v3 = bf_hi(w[i].y);
        const float ss = wave_sum(v0 * v0 + v1 * v1 + v2 * v2 + v3 * v3);
        const float rs = 1.0f / __builtin_sqrtf(ss * (1.0f / 256.0f) + RMS_EPS);
        u32x2 o; o.x = pk2(v0 * rs * gn[0], v1 * rs * gn[1]); o.y = pk2(v2 * rs * gn[2], v3 * rs * gn[3]);
        if (r < nrows) *(u32x2*)(base + (size_t)r * 256 + 4 * lane) = o; }
}
constexpr int AT_CAND = 0, AT_KBUF = 65536, AT_KROW = 144, AT_KCH = 256 * AT_KROW, AT_SEL = 139264, AT_BIAS = 155648, AT_BKT = 156672, AT_GROW = 544, AT_GBUF = 32 * AT_GROW;
constexpr int AT_NBIN = 512, AT_CAP = 256, AT_LCAP = 1024, AT_TIEF = 157184, AT_BIAS2 = 157440;
#ifndef AT_SAMPLE_MIN_U
#define AT_SAMPLE_MIN_U 64
#endif
#ifndef AT_LBREF
#define AT_LBREF 0
#endif
struct AttnP { const bf16_t *qidx, *kidx, *ckv; const float* widx; bf16_t* qlat; unsigned long long* cbuf; };

__device__ __forceinline__ unsigned ord_key(float s) { const unsigned b = __builtin_bit_cast(unsigned, s); return (b & 0x80000000u) ? ~b : (b | 0x80000000u); }

__device__ __forceinline__ void hist_scan(const LAS unsigned* hq, int lane, int kth, int& bsel, int& cat, int& abat) {
    const u32x4 w0 = *(const LAS u32x4*)(hq + 8 * lane), w1 = *(const LAS u32x4*)(hq + 8 * lane + 4);
    int cnt[8];
    cnt[0] = (int)w0.x; cnt[1] = (int)w0.y; cnt[2] = (int)w0.z; cnt[3] = (int)w0.w; cnt[4] = (int)w1.x; cnt[5] = (int)w1.y; cnt[6] = (int)w1.z; cnt[7] = (int)w1.w;
    int s = 0;
#pragma unroll
    for (int i = 0; i < 8; ++i) s += cnt[i];
    int S = s;
#pragma unroll
    for (int off = 1; off < 64; off <<= 1) { const int v = __shfl_down(S, off); if (lane + off < 64) S += v; }
    bsel = -1; cat = 0; abat = 0;
    const unsigned long long mk = __ballot(S >= kth);
    if (mk != 0ull) {
        const int Ls = 63 - __builtin_clzll(mk);
        int above = S - s; bool found = false;
#pragma unroll
        for (int bb = 7; bb >= 0; --bb) { const int c = cnt[bb]; if (!found && above + c >= kth) { bsel = 8 * lane + bb; cat = c; abat = above; found = true; } above += c; }
        bsel = __shfl(bsel, Ls); cat = __shfl(cat, Ls); abat = __shfl(abat, Ls);
    }
}
__device__ __forceinline__ int key_row(int r, bool sm, int u) { if (sm) { r = r * 8 + (u & 7); r = r < SEQ ? r : SEQ - 1; } return r; }
template <int MODE>
__device__ __forceinline__ void attn_pass(LAS unsigned char* lds, const bf16x8 (&afr)[4], const float (&wq)[2][9], const bf16_t* kbase, int u, int wave, int lane, int tid,
                                          const int (&b0e)[2], const int (&neede)[2], const int (&tiee)[2], int (&csel)[2], int (&ccand)[2], unsigned long long* cbw, int samp = 0) {
    const int hh = lane >> 5, kcol = lane & 31;
    LAS unsigned* HIST = (LAS unsigned*)lds; LAS unsigned long long* CAND = (LAS unsigned long long*)(lds + AT_CAND); LAS unsigned short* SEL = (LAS unsigned short*)(lds + AT_SEL);
    const bool sm = (MODE == 0) && (samp != 0);
    const int nst = u >> 3, nch = sm ? ((nst + 7) >> 3) : (u >> 3) + 1;
    float lbt[2];
#pragma unroll
    for (int e = 0; e < 2; ++e) lbt[e] = ((MODE == 1 || MODE == 3) && b0e[e] >= 1) ? (float)b0e[e] : -3.0e38f;
    u32x4 st[4];
    const int lofs = (tid >> 3) * AT_KROW + (tid & 7) * 16;
#define AT_KADDR(C, I) (kbase + (size_t)key_row((C) * 256 + (tid >> 3) + 64 * (I), sm, u) * 64 + (tid & 7) * 8)
#pragma unroll
    for (int i = 0; i < 4; ++i) st[i] = *(const u32x4*)AT_KADDR(0, i);
#pragma unroll
    for (int i = 0; i < 4; ++i) *(LAS u32x4*)(lds + AT_KBUF + lofs + i * 64 * AT_KROW) = st[i];
    __syncthreads();
    for (int c = 0; c < nch; ++c) {
        if (c + 1 < nch) {
#pragma unroll
            for (int i = 0; i < 4; ++i) st[i] = *(const u32x4*)AT_KADDR(c + 1, i);
        }
        const LAS unsigned char* kb = lds + AT_KBUF + (c & 1) * AT_KCH + kcol * AT_KROW + hh * 16;
        const int ntile = sm ? ((nst - 8 * c) < 8 ? (nst - 8 * c) : 8) : ((c + 1 < nch) ? 8 : (u & 7) + 1);
#define AT_READ(BF, TT) do { _Pragma("unroll") for (int ks = 0; ks < 4; ++ks) BF[ks] = *(const LAS bf16x8*)(kb + (TT) * 32 * AT_KROW + ks * 32); } while (0)
#define AT_MFMA(ACC, BF) do { _Pragma("unroll") for (int i_ = 0; i_ < 16; ++i_) ACC[i_] = 0.f; \
            _Pragma("unroll") for (int ks = 0; ks < 4; ++ks) ACC = __builtin_amdgcn_mfma_f32_32x32x16_bf16(afr[ks], BF[ks], ACC, 0, 0, 0); } while (0)
          \

#define AT_POST(ACC, KT, DIAG) do { const int kt = (KT); \
            float sc[2]; \
            _Pragma("unroll") for (int e = 0; e < 2; ++e) { float s = 0.f; \
                _Pragma("unroll") for (int i = 0; i < 8; ++i) s = __builtin_fmaf(wq[e][i], __builtin_amdgcn_fmed3f(ACC[8 * e + i], 0.f, 3.0e38f), s); \
                sc[e] = s; } \
            _Pragma("unroll") for (int e = 0; e < 2; ++e) { \
                const int q = 4 * wave + 2 * hh + e; \
                const float tv = __builtin_fmaf(sc[e], wq[e][8], 256.0f); \
                const bool cz = !(DIAG) || (kt < u) || (kcol <= q); \
                const bool live = cz && tv >= lbt[e]; \
                if (MODE == 3) { \
                    const unsigned long long m3 = __ballot(live); \
                    { \
                        const unsigned h3 = hh ? (unsigned)(m3 >> 32) : (unsigned)m3; \
                        const int pa = ccand[e] + __builtin_popcount(h3 & ((1u << kcol) - 1u)); \
                        if (live) { u32x2 ent;      \
                             ent.x = (unsigned)(kt * 32 + kcol); ent.y = __builtin_bit_cast(unsigned, sc[e]); \
                            *(u32x2*)((char*)cbw + ((unsigned)((2 * hh + e) * AT_LCAP + pa) * 8u)) = ent; } \
                        ccand[e] += __builtin_popcount(h3); \
                    } \
                } else if (MODE == 0) { \
                    const int bin = (int)__builtin_amdgcn_fmed3f(tv, 0.0f, 511.5f); \
                    LAS unsigned* hp = HIST + q * AT_NBIN + bin; \
                    if (cz) __hip_atomic_fetch_add(hp, 1u, __ATOMIC_RELAXED, __HIP_MEMORY_SCOPE_WORKGROUP); \
                } else if (__ballot(live) != 0ull) { \
                    const int bin = (int)__builtin_amdgcn_fmed3f(tv, 0.0f, 511.5f); \
                    const int key = kt * 32 + kcol; \
                    const bool cc = live && bin == b0e[e]; \
                    const unsigned long long m2 = __ballot(cc); const unsigned h2 = hh ? (unsigned)(m2 >> 32) : (unsigned)m2; \
                    const int pc = ccand[e] + __builtin_popcount(h2 & ((1u << kcol) - 1u)); \
                    if (cc && !tiee[e] && pc < AT_CAP) CAND[q * AT_CAP + pc] = ((unsigned long long)ord_key(sc[e]) << 32) | (unsigned)(0xFFFFu - key); \
                    ccand[e] += __builtin_popcount(h2); \
                    const bool cs = live && (bin > b0e[e] || (tiee[e] && cc && pc < neede[e])); \
                    const unsigned long long m1 = __ballot(cs); const unsigned h1 = hh ? (unsigned)(m1 >> 32) : (unsigned)m1; \
                    if (cs) SEL[q * 256 + csel[e] + __builtin_popcount(h1 & ((1u << kcol) - 1u))] = (unsigned short)key; \
                    csel[e] += __builtin_popcount(h1); \
                } \
            } } while (0)
#define AT_TILES(NT, DIAG, PRAG) do { \
        AT_READ(B0, 0); if ((NT) > 1) AT_READ(B1, 1); \
        AT_MFMA(accA, B0); \
        PRAG for (int tt = 0; tt < (NT); tt += 2) { \
            if (tt + 2 < (NT)) AT_READ(B0, tt + 2); \
            if (tt + 1 < (NT)) AT_MFMA(accB, B1); \
            AT_POST(accA, c * 8 + tt, DIAG); \
            if (tt + 1 < (NT)) { \
                if (tt + 3 < (NT)) AT_READ(B1, tt + 3); \
                if (tt + 2 < (NT)) AT_MFMA(accA, B0); \
                AT_POST(accB, c * 8 + tt + 1, DIAG); \
            } \
        } } while (0)
        f32x16 accA, accB; bf16x8 B0[4], B1[4];
        if (sm ? (ntile == 8) : (c + 1 < nch)) AT_TILES(8, false, _Pragma("unroll"));
        else AT_TILES(ntile, true, _Pragma("unroll 1"));
#undef AT_TILES
#undef AT_POST
#undef AT_KADDR
#undef AT_READ
#undef AT_MFMA
        if (MODE == 0 && AT_LBREF && c + 1 < nch && (c < 4 || (c & 3) == 3)) {
#pragma unroll
            for (int q = 0; q < 4; ++q) { int bs, c1, c2; hist_scan(HIST + (4 * wave + q) * AT_NBIN, lane, 256, bs, c1, c2);
                const float lb = bs >= 1 ? (float)bs : -3.0e38f;
                if ((q >> 1) == hh) lbt[q & 1] = lb; }
        }
        if (c + 1 < nch) {
#pragma unroll
            for (int i = 0; i < 4; ++i) *(LAS u32x4*)(lds + AT_KBUF + ((c + 1) & 1) * AT_KCH + lofs + i * 64 * AT_KROW) = st[i];
        }
        __syncthreads();
    }
}

__device__ __forceinline__ void attn_unit(LAS unsigned char* lds, const AttnP& P, int b, int u, int tid_) {
    int tid = tid_; asm volatile("" : "+v"(tid));
    const int wave = __builtin_amdgcn_readfirstlane(tid >> 6), lane = tid & 63, hh = lane >> 5, kcol = lane & 31;
    LAS unsigned* HIST = (LAS unsigned*)lds; LAS unsigned long long* CAND = (LAS unsigned long long*)(lds + AT_CAND); LAS unsigned short* SEL = (LAS unsigned short*)(lds + AT_SEL);
    const LAS float* BIAS2 = (const LAS float*)(lds + AT_BIAS2);
    const int t0 = 32 * u; const size_t rowb = (size_t)b * SEQ;
    __syncthreads();
#pragma unroll
    for (int i = 0; i < 8; ++i) *(LAS u32x4*)(lds + (i * 512 + tid) * 16) = (u32x4){0u, 0u, 0u, 0u};
    if (tid == 0) *(LAS unsigned*)(lds + AT_TIEF) = 0u;
    bf16x8 afr[4]; float wq[2][9];
    { const int rho = kcol, j = rho >> 3, r = rho & 3, hq = (rho >> 2) & 1, head = 4 * (j & 1) + r, qloc = 2 * hq + (j >> 1);
      const bf16_t* qp = P.qidx + (rowb + t0 + 4 * wave + qloc) * 512 + head * 64 + 8 * hh;
#pragma unroll
      for (int ks = 0; ks < 4; ++ks) afr[ks] = *(const bf16x8*)(qp + ks * 16);
#pragma unroll
      for (int e = 0; e < 2; ++e) { const float* wp = P.widx + (rowb + t0 + 4 * wave + 2 * hh + e) * 8; const f32x4 a = *(const f32x4*)wp, c = *(const f32x4*)(wp + 4);
          wq[e][0] = a[0]; wq[e][1] = a[1]; wq[e][2] = a[2]; wq[e][3] = a[3]; wq[e][4] = c[0]; wq[e][5] = c[1]; wq[e][6] = c[2]; wq[e][7] = c[3];
          const float ss = (a[0] * a[0] + a[1] * a[1]) + (a[2] * a[2] + a[3] * a[3]) + (c[0] * c[0] + c[1] * c[1]) + (c[2] * c[2] + c[3] * c[3]);
          wq[e][8] = 32.0f / __builtin_sqrtf(fmaxf(ss, 1.0e-12f)); } }
    const bf16_t* kbase = P.kidx + rowb * 64;
    int b0e[2] = {0, 0}, neede[2] = {0, 0}, tiee[2] = {0, 0}, csel[2] = {0, 0}, ccand[2] = {0, 0};
    int b0q[4], needq[4], nb0q[4], csq[4];
    unsigned long long* cbw = P.cbuf + (size_t)(4 * wave) * AT_LCAP;
#pragma unroll 1
    for (int att = (u >= AT_SAMPLE_MIN_U) ? 0 : 1; att < 2; ++att) {
        int tl = tid; asm volatile("" : "+v"(tl));
        const int ll = tl & 63, hl = ll >> 5;
        if (att == 1 && u >= AT_SAMPLE_MIN_U) {
            __syncthreads();
#pragma unroll
            for (int i = 0; i < 8; ++i) *(LAS u32x4*)(lds + (i * 512 + tl) * 16) = (u32x4){0u, 0u, 0u, 0u};
            if (tl == 0) *(LAS unsigned*)(lds + AT_TIEF) = 0u;
        }
        csel[0] = 0; csel[1] = 0; ccand[0] = 0; ccand[1] = 0;
        attn_pass<0>(lds, afr, wq, kbase, u, wave, ll, tl, b0e, neede, tiee, csel, ccand, nullptr, att == 0 ? 1 : 0);
        const int kth = att == 0 ? 64 : 256;
#pragma unroll
        for (int q = 0; q < 4; ++q) {
            const int nq = t0 + 4 * wave + q + 1;
            int bsel, cat, abat; hist_scan(HIST + (4 * wave + q) * AT_NBIN, ll, kth, bsel, cat, abat);
            if (att == 1 && nq <= 256) { bsel = -1; cat = 0; abat = 0; }
            b0q[q] = bsel; nb0q[q] = cat; needq[q] = (nq > 256) ? (256 - abat) : 0;
        }
        b0e[0] = hl ? b0q[2] : b0q[0]; b0e[1] = hl ? b0q[3] : b0q[1];
        neede[0] = hl ? needq[2] : needq[0]; neede[1] = hl ? needq[3] : needq[1];
        tiee[0] = (att == 1) && ((hl ? nb0q[2] : nb0q[0]) > AT_CAP); tiee[1] = (att == 1) && ((hl ? nb0q[3] : nb0q[1]) > AT_CAP);
        if ((tiee[0] | tiee[1]) != 0) *(LAS unsigned*)(lds + AT_TIEF) = 1u;
        __syncthreads();
        if (att == 1 && *(const LAS unsigned*)(lds + AT_TIEF) != 0u) {
            attn_pass<1>(lds, afr, wq, kbase, u, wave, ll, tl, b0e, neede, tiee, csel, ccand, cbw);
#pragma unroll
            for (int q = 0; q < 4; ++q) { const int cv = (q & 1) ? csel[1] : csel[0]; csq[q] = __builtin_amdgcn_readlane(cv, (q >> 1) * 32); }
            break;
        }
        if (att == 0) {
#pragma unroll
            for (int i = 0; i < 8; ++i) *(LAS u32x4*)(lds + wave * 8192 + (i * 64 + ll) * 16) = (u32x4){0u, 0u, 0u, 0u};
        }
        attn_pass<3>(lds, afr, wq, kbase, u, wave, ll, tl, b0e, neede, tiee, csel, ccand, cbw);
        asm volatile("s_waitcnt vmcnt(0)" ::: "memory");
        if (att == 0) {
            bool ok = true;
#pragma unroll
            for (int q = 0; q < 4; ++q) {
                const int cv = (q & 1) ? ccand[1] : ccand[0]; const int nraw = __builtin_amdgcn_readlane(cv, (q >> 1) * 32); ok = ok && nraw >= 256 && nraw <= AT_LCAP;
                const int n = nraw > AT_LCAP ? AT_LCAP : nraw;
                const float scl = (q & 2) ? __shfl(wq[q & 1][8], 32) : __shfl(wq[q & 1][8], 0);
#pragma unroll
                for (int jb = 0; jb < AT_LCAP / 256; ++jb) {
                    if (256 * jb < n) {
                        unsigned long long ent[4];
#pragma unroll
                        for (int j = 0; j < 4; ++j) { const int i = 256 * jb + 64 * j + ll; ent[j] = (i < n) ? __builtin_nontemporal_load(cbw + q * AT_LCAP + i) : 0ull; }
#pragma unroll
                        for (int j = 0; j < 4; ++j) { const int i = 256 * jb + 64 * j + ll; const float scv = __builtin_bit_cast(float, (unsigned)(ent[j] >> 32));
                            const int bin = (int)__builtin_amdgcn_fmed3f(__builtin_fmaf(scv, scl, 256.0f), 0.0f, 511.5f);
                            if (i < n) __hip_atomic_fetch_add(HIST + (4 * wave + q) * AT_NBIN + bin, 1u, __ATOMIC_RELAXED, __HIP_MEMORY_SCOPE_WORKGROUP); }
                    }
                }
            }
            asm volatile("s_waitcnt lgkmcnt(0)" ::: "memory");
#pragma unroll
            for (int q = 0; q < 4; ++q) {
                int bsel, cat, abat; hist_scan(HIST + (4 * wave + q) * AT_NBIN, ll, 256, bsel, cat, abat);
                ok = ok && bsel >= 0;
                b0q[q] = bsel; nb0q[q] = cat; needq[q] = 256 - abat;
            }
            if (!ok) *(LAS unsigned*)(lds + AT_TIEF) = 1u;
            __syncthreads();
            if (*(const LAS unsigned*)(lds + AT_TIEF) != 0u) continue;
        }
#pragma unroll
        for (int q = 0; q < 4; ++q) {
            const int cv = (q & 1) ? ccand[1] : ccand[0]; int n = __builtin_amdgcn_readlane(cv, (q >> 1) * 32); n = n > AT_LCAP ? AT_LCAP : n;
            const int b0 = b0q[q], need = needq[q]; const bool tieq = nb0q[q] > AT_CAP;
            const float scl = (q & 2) ? __shfl(wq[q & 1][8], 32) : __shfl(wq[q & 1][8], 0);
            int cs = 0, cc = 0;
#pragma unroll
            for (int jb = 0; jb < AT_LCAP / 256; ++jb) {
                if (256 * jb < n) {
                    unsigned long long ent[4];
#pragma unroll
                    for (int j = 0; j < 4; ++j) { const int i = 256 * jb + 64 * j + ll; ent[j] = (i < n) ? __builtin_nontemporal_load(cbw + q * AT_LCAP + i) : 0ull; }
#pragma unroll
                    for (int j = 0; j < 4; ++j) {
                        const unsigned long long v = ent[j]; const bool in = 256 * jb + 64 * j + ll < n;
                        const float scv = __builtin_bit_cast(float, (unsigned)(v >> 32));
                        const int bin = (int)__builtin_amdgcn_fmed3f(__builtin_fmaf(scv, scl, 256.0f), 0.0f, 511.5f);
                        const bool isc = in && bin == b0;
                        const unsigned long long mc = __ballot(isc);
                        const int pc = cc + __builtin_popcountll(mc & ((1ull << ll) - 1ull));
                        const bool isa = in && (bin > b0 || (tieq && isc && pc < need));
                        const unsigned long long ms = __ballot(isa);
                        if (isa) SEL[(4 * wave + q) * 256 + cs + __builtin_popcountll(ms & ((1ull << ll) - 1ull))] = (unsigned short)(v & 0xFFFFu);
                        if (isc && !tieq && pc < AT_CAP) CAND[(4 * wave + q) * AT_CAP + pc] = ((unsigned long long)ord_key(scv) << 32) | (unsigned)(0xFFFFu - (unsigned)(v & 0xFFFFu));
                        cs += __builtin_popcountll(ms); cc += __builtin_popcountll(mc);
                    }
                }
            }
            csq[q] = cs;
            asm volatile("" ::: "memory");
        }
        break;
    }
    int nselq[4];
#pragma unroll
    for (int q = 0; q < 4; ++q) {
        int cs = csq[q];
        const int need = needq[q], nb0 = nb0q[q];
        if (need > 0 && nb0 <= AT_CAP) {
            const int nc = nb0;
            const LAS unsigned long long* cq = CAND + (4 * wave + q) * AT_CAP;
            for (int i0 = 0; i0 < nc; i0 += 64) {
                const int i = i0 + lane; const unsigned long long mine = (i < nc) ? cq[i] : 0ull;
                int rank = 0; for (int j = 0; j < nc; ++j) rank += (cq[j] > mine) ? 1 : 0;
                const bool pick = (i < nc) && rank < need;
                const unsigned long long mk = __ballot(pick);
                if (pick) SEL[(4 * wave + q) * 256 + cs + __builtin_popcountll(mk & ((1ull << lane) - 1ull))] = (unsigned short)(0xFFFFu - (unsigned)(mine & 0xFFFFu));
                cs += __builtin_popcountll(mk);
            }
        }
        nselq[q] = cs;
    }
    asm volatile("s_waitcnt lgkmcnt(0)" ::: "memory");
#ifdef DBG_TIME_ATT
    if (tid == 0) { const unsigned tn_ = (unsigned)__builtin_amdgcn_s_memrealtime(); ((LAS unsigned*)(lds + LDS_MISC))[19] += tn_ - tk0; tk0 = tn_; }
#endif
    __syncthreads();
    LAS unsigned char* gb = lds + wave * AT_GBUF;
    const int n = lane & 15, kg = lane >> 4, head = n & 7;
#pragma unroll 1
    for (int qi = 0; qi < 4; ++qi) {
        const int q = 4 * wave + qi, t = t0 + q;
        const int nsel = qi == 0 ? nselq[0] : (qi == 1 ? nselq[1] : (qi == 2 ? nselq[2] : nselq[3]));
        const LAS unsigned short* sel = SEL + q * 256;
        bf16_t* qrow = P.qlat + (rowb + t) * 2048;
        bf16x8 qb[8];
#pragma unroll
        for (int ks = 0; ks < 8; ++ks) { qb[ks] = (bf16x8){0, 0, 0, 0, 0, 0, 0, 0}; if (n < 8) qb[ks] = *(const bf16x8*)(qrow + n * 256 + 32 * ks + 8 * kg); }
        f32x4 oacc[16];
#pragma unroll
        for (int mt = 0; mt < 16; ++mt) oacc[mt] = (f32x4){0.f, 0.f, 0.f, 0.f};
        float mrun = -1e30f, lrun = 0.f;
        const int nchunk = (nsel + 31) >> 5;
#pragma unroll 1
        for (int c = 0; c < nchunk; ++c) {
            const int jn = 32 * c + kcol; const int idxc = (jn < nsel) ? (int)sel[jn] : 0;
            { u32x4 pre[16];
              const unsigned offc = ((unsigned)rowb + (unsigned)idxc) * 512u;
#pragma unroll
              for (int i = 0; i < 16; ++i) { const unsigned o0 = (unsigned)__builtin_amdgcn_readlane((int)offc, 2 * i), o1 = (unsigned)__builtin_amdgcn_readlane((int)offc, 2 * i + 1);
                  pre[i] = *(const u32x4*)((const char*)P.ckv + ((hh ? o1 : o0) + (unsigned)kcol * 16u)); }
#pragma unroll
              for (int i = 0; i < 16; ++i) *(LAS u32x4*)(gb + (2 * i + hh) * AT_GROW + kcol * 16) = pre[i];
            }
            f32x4 st[2];
#pragma unroll
            for (int k2 = 0; k2 < 2; ++k2) { st[k2] = (f32x4){0.f, 0.f, 0.f, 0.f};
#pragma unroll
                for (int ks = 0; ks < 8; ++ks) { const bf16x8 a = *(const LAS bf16x8*)(gb + (16 * k2 + n) * AT_GROW + (32 * ks + 8 * kg) * 2); st[k2] = __builtin_amdgcn_mfma_f32_16x16x32_bf16(a, qb[ks], st[k2], 0, 0, 0); } }
            float mloc = -1e30f;
#pragma unroll
            for (int k2 = 0; k2 < 2; ++k2)
#pragma unroll
                for (int r = 0; r < 4; ++r) { const int jj = 16 * k2 + 4 * kg + r; const int idx = (32 * c + jj < nsel) ? (int)sel[32 * c + jj] : 0; int d = t - idx; d = d < 127 ? d : 127;
                    float lg = st[k2][r] + BIAS2[d * 8 + head]; if (32 * c + jj >= nsel) lg = -1e30f;
                    st[k2][r] = lg; mloc = fmaxf(mloc, lg); }
            if (c == 0) { mloc = fmaxf(mloc, __shfl_xor(mloc, 16)); mloc = fmaxf(mloc, __shfl_xor(mloc, 32)); mrun = mloc; }
            else if (__ballot(mloc > mrun + 60.0f) != 0ull) {
                mloc = fmaxf(mloc, __shfl_xor(mloc, 16)); mloc = fmaxf(mloc, __shfl_xor(mloc, 32));
                const float mnew = fmaxf(mrun, mloc), alpha = fast_exp(mrun - mnew);
                lrun = lrun * alpha; mrun = mnew;
#pragma unroll
                for (int mt = 0; mt < 16; ++mt) oacc[mt] = oacc[mt] * alpha;
            }
#pragma unroll
            for (int k2 = 0; k2 < 2; ++k2)
#pragma unroll
                for (int r = 0; r < 4; ++r) { const float p = fast_exp(st[k2][r] - mrun); st[k2][r] = p; lrun += p; }
            u32x4 pw; pw.x = pk2(st[0][0], st[0][1]); pw.y = pk2(st[0][2], st[0][3]); pw.z = pk2(st[1][0], st[1][1]); pw.w = pk2(st[1][2], st[1][3]);
            const bf16x8 pb = __builtin_bit_cast(bf16x8, pw);
            LAS unsigned char* tb = gb + (4 * kg + (n >> 2)) * AT_GROW + 8 * (n & 3);
#pragma unroll
            for (int mt = 0; mt < 16; ++mt) {
                const s16x4 v1 = __builtin_amdgcn_ds_read_tr16_b64_v4i16((LAS s16x4*)(tb + 32 * mt));
                const s16x4 v2 = __builtin_amdgcn_ds_read_tr16_b64_v4i16((LAS s16x4*)(tb + 16 * AT_GROW + 32 * mt));
                const bf16x8 av = (bf16x8){v1[0], v1[1], v1[2], v1[3], v2[0], v2[1], v2[2], v2[3]};
                oacc[mt] = __builtin_amdgcn_mfma_f32_16x16x32_bf16(av, pb, oacc[mt], 0, 0, 0);
            }
        }
        lrun += __shfl_xor(lrun, 16); lrun += __shfl_xor(lrun, 32);
        const float inv = 1.0f / lrun;
        if (n < 8) {
#pragma unroll
            for (int mt = 0; mt < 16; ++mt) { const f32x4 o = oacc[mt] * inv; u32x2 w; w.x = pk2(o[0], o[1]); w.y = pk2(o[2], o[3]); *(u32x2*)(qrow + n * 256 + 16 * mt + 4 * kg) = w; }
        }
    }
#ifdef DBG_TIME_ATT
    if (tid == 0) { const unsigned tn_ = (unsigned)__builtin_amdgcn_s_memrealtime(); ((LAS unsigned*)(lds + LDS_MISC))[20] += tn_ - tk0; tk0 = tn_; }
#endif
}
__device__ __forceinline__ void ln_finish(f32x4 (&v)[4], const float* gam, const float* bet, float* orow, bf16_t* brow, int lane) {
    float s = 0.f;
#pragma unroll
    for (int j = 0; j < 4; ++j) s += (v[j][0] + v[j][1]) + (v[j][2] + v[j][3]);
    const float mean = wave_sum(s) * (1.0f / 1024.0f); float s2 = 0.f;
#pragma unroll
    for (int j = 0; j < 4; ++j) { v[j] = v[j] - mean; s2 += (v[j][0] * v[j][0] + v[j][1] * v[j][1]) + (v[j][2] * v[j][2] + v[j][3] * v[j][3]); }
    const float rstd = 1.0f / __builtin_sqrtf(wave_sum(s2) * (1.0f / 1024.0f) + LN_EPS);
#pragma unroll
    for (int j = 0; j < 4; ++j) { const f32x4 g = *(const f32x4*)(gam + 256 * j + 4 * lane), bb = *(const f32x4*)(bet + 256 * j + 4 * lane);
        v[j] = v[j] * rstd * g + bb;
        if (orow != nullptr) *(f32x4*)(orow + 256 * j + 4 * lane) = v[j];
        u32x2 w; w.x = pk2(v[j][0], v[j][1]); w.y = pk2(v[j][2], v[j][3]); *(u32x2*)(brow + 256 * j + 4 * lane) = w; }
}
struct RouteP { int* r_e; int* r_pos; int* r_slot; float* r_g; unsigned* gcnt; };

__device__ __forceinline__ void ln1_route_block(LAS unsigned char* lds, int blk, float* xo, bf16_t* xb, const float* gam, const float* bet, const float* rbias, const RouteP& R, int tid) {
    const int wave = __builtin_amdgcn_readfirstlane(tid >> 6), lane = tid & 63;
    const LAS float* WR = (const LAS float*)lds; LAS int* lcnt = (LAS int*)(lds + 65536); LAS int* basee = (LAS int*)(lds + 65600); LAS int* tok = (LAS int*)(lds + 65664);
    __syncthreads();
    if (tid < 16) lcnt[tid] = 0;
    __syncthreads();
    u32x2 wn[4];
#pragma unroll
    for (int j = 0; j < 4; ++j) wn[j] = *(const u32x2*)(xb + ((size_t)blk * 128 + wave * 16) * 1024 + 256 * j + 4 * lane);
    for (int rr = 0; rr < 16; ++rr) {
        const int rl = wave * 16 + rr; const size_t row = (size_t)blk * 128 + rl;
        f32x4 v[4];
#pragma unroll
        for (int j = 0; j < 4; ++j) { const u32x2 w = wn[j]; v[j] = (f32x4){bf_lo(w.x), bf_hi(w.x), bf_lo(w.y), bf_hi(w.y)}; }
        { const size_t rn = row + (rr + 1 < 16 ? 1 : 0);
#pragma unroll
          for (int j = 0; j < 4; ++j) wn[j] = *(const u32x2*)(xb + rn * 1024 + 256 * j + 4 * lane); }
        ln_finish(v, gam, bet, nullptr, xb + row * 1024, lane);
        float aff[16], sel[16];
#pragma unroll
        for (int e = 0; e < 16; ++e) { float p = 0.f;
#pragma unroll
            for (int j = 0; j < 4; ++j) { const f32x4 w = *(const LAS f32x4*)(WR + e * 1024 + 256 * j + 4 * lane); p += (v[j][0] * w[0] + v[j][1] * w[1]) + (v[j][2] * w[2] + v[j][3] * w[3]); }
            const float lg = wave_sum(p); aff[e] = 1.0f / (1.0f + expf(-lg)); sel[e] = aff[e] + rbias[e]; }
        float gbv = -3.0e38f; int gb = 0;
#pragma unroll
        for (int g = 0; g < 4; ++g) { float m1 = -3.0e38f, m2 = -3.0e38f;
#pragma unroll
            for (int i = 0; i < 4; ++i) { const float x = sel[4 * g + i]; if (x > m1) { m2 = m1; m1 = x; } else if (x > m2) m2 = x; }
            const float gs_ = m1 + m2; if (gs_ > gbv) { gbv = gs_; gb = g; } }
        float s0 = -3.0e38f, a0 = 0.f; int e0 = 0;
#pragma unroll
        for (int e = 0; e < 16; ++e) { const bool in = (e >> 2) == gb; if (in && sel[e] > s0) { s0 = sel[e]; a0 = aff[e]; e0 = e; } }
        float s1 = -3.0e38f, a1 = 0.f; int e1 = 0;
#pragma unroll
        for (int e = 0; e < 16; ++e) { const bool in = ((e >> 2) == gb) && (e != e0); if (in && sel[e] > s1) { s1 = sel[e]; a1 = aff[e]; e1 = e; } }
        if (lane == 0) {
            const float inv = 1.0f / (a0 + a1);
            const int p0 = __hip_atomic_fetch_add(lcnt + e0, 1, __ATOMIC_RELAXED, __HIP_MEMORY_SCOPE_WORKGROUP);
            const int p1 = __hip_atomic_fetch_add(lcnt + e1, 1, __ATOMIC_RELAXED, __HIP_MEMORY_SCOPE_WORKGROUP);
            tok[rl * 4 + 0] = e0; tok[rl * 4 + 1] = p0; tok[rl * 4 + 2] = e1; tok[rl * 4 + 3] = p1;
            *(f32x2*)(R.r_g + row * 2) = (f32x2){a0 * inv, a1 * inv};
        }
    }
    __syncthreads();
    if (tid < 16) basee[tid] = (int)__hip_atomic_fetch_add(R.gcnt + tid * 64, (unsigned)lcnt[tid], __ATOMIC_RELAXED, __HIP_MEMORY_SCOPE_AGENT);
    __syncthreads();
    if (tid < 256) { const int rl = tid >> 1, k = tid & 1; const int e = tok[rl * 4 + 2 * k], p = tok[rl * 4 + 2 * k + 1]; const size_t o = ((size_t)blk * 128 + rl) * 2 + k; R.r_e[o] = e; R.r_pos[o] = basee[e] + p; }
}
__device__ __forceinline__ void moe_offsets(LAS int* offp, const unsigned* gcnt, int tid) {
    __syncthreads();
    if (tid == 0) { int o = 0;
        for (int e = 0; e < 16; ++e) { offp[e] = o; const int c = (int)__hip_atomic_load(gcnt + e * 64, __ATOMIC_RELAXED, __HIP_MEMORY_SCOPE_AGENT); o += (c + 255) & ~255; }
        offp[16] = o; }
    __syncthreads();
}
#ifndef MK_PER_PHASE
#define MK_PER_PHASE 0
#endif
#ifndef EN_MASK
#define EN_MASK 0xFFF
#endif
#ifndef EN_M1
#define EN_M1 1
#endif
#ifndef EN_M2
#define EN_M2 1
#endif
#ifndef DBG_REP_P0A
#define DBG_REP_P0A 1
#endif
#ifndef EN_2A
#define EN_2A 1
#endif
#ifndef EN_2R
#define EN_2R 1
#endif
#define EN_A ((EN_MASK >> 0) & 1)
#define EN_B ((EN_MASK >> 1) & 1)
#define EN_0 ((EN_MASK >> 2) & 1)
#define EN_1 ((EN_MASK >> 3) & 1)
#define EN_2 ((EN_MASK >> 4) & 1)
#define EN_3 ((EN_MASK >> 5) & 1)
#define EN_4 ((EN_MASK >> 6) & 1)
#define EN_5 ((EN_MASK >> 7) & 1)
#define EN_6 ((EN_MASK >> 8) & 1)
#define EN_7 ((EN_MASK >> 9) & 1)
#define EN_8 ((EN_MASK >> 10) & 1)
#define EN_9 ((EN_MASK >> 11) & 1)
constexpr int NPH_L = 10, NPH = 2 + NL * NPH_L;
struct Args { const float* in[25]; float* out; unsigned char* ws; int ph_lo, ph_hi; };

__global__ void __launch_bounds__(NTHR, 2) fwd(Args a) {
    extern __shared__ __attribute__((aligned(16))) unsigned char lds_raw[];
    LAS unsigned char* lds = (LAS unsigned char*)lds_raw;
    const int G = gridDim.x, bx = blockIdx.x, vcu = (G % 8 == 0) ? (bx % 8) * (G / 8) + bx / 8 : bx;
    const int NGW = G * NWAVES;
#define PH_LOCALS int tid = wave_s * 64 + lane_id(); asm volatile("" : "+v"(tid)); const int lane = tid & 63, wave = wave_s, gw = vcu * NWAVES + wave; (void)lane; (void)gw;
    volatile LAS unsigned* MISC = (volatile LAS unsigned*)(lds + LDS_MISC);
    const int wave_s = __builtin_amdgcn_readfirstlane((int)threadIdx.x >> 6);
    if (threadIdx.x < 64) MISC[threadIdx.x] = 0u;
    __syncthreads();
    unsigned char* ws = a.ws;
    unsigned* ctl = (unsigned*)(ws + WS_CTL);
    const int lo = a.ph_lo, hi = a.ph_hi;
    XcdBarrier bar; bar.bar = ctl + CW_BAR; bar.x = 0; bar.st = MISC + 8;
    if (hi - lo > 1) bar = xcd_barrier_post(ctl + CW_BAR, MISC + 8);
#define IN(k) (lo <= (k) && (k) < hi)
#ifdef DBG_TIME
    if (blockIdx.x == 0 && threadIdx.x == 0) ctl[12288 + 63] = (unsigned)__builtin_amdgcn_s_memrealtime();
#define SEAM(k) do { if (IN(k) && IN((k) + 1)) { xcd_barrier(bar, wave_s == 0 && lane_id() == 0); if (bx == 0 && wave_s == 0 && lane_id() == 0) ctl[12288 + (k)] = (unsigned)__builtin_amdgcn_s_memrealtime(); } } while (0)
#else
#define SEAM(k) do { if (IN(k) && IN((k) + 1)) xcd_barrier(bar, wave_s == 0 && lane_id() == 0); } while (0)
#endif
    float* xo = a.out;
    bf16_t* xb = (bf16_t*)(ws + WS_XB);
    unsigned char* R = ws + WS_R;

    for (int rep_ = 0; rep_ < (DBG_REP_P0A); ++rep_)
    if (EN_A && IN(0)) { PH_LOCALS
        LAS float* scr = (LAS float*)(lds + wave * 8448);
        constexpr int PER_L = 4160;
        for (int it = gw; it < NL * PER_L; it += NGW) {
            const int l = it / PER_L; int r = it - l * PER_L;
            const float* win = a.in[1] + (size_t)l * 1024 * DIN;
            unsigned char* wm = ws + WS_WMIX + (size_t)l * WMIX_STRIDE;
            if (r < 1024) { tr_item(win, DIN, 0, 2048, (bf16_t*)(wm + OFF_WIN), 1024, 0, r, 64, scr, lane); continue; } r -= 1024;
            if (r < 512) { tr_item(win, DIN, 3072, 840, (bf16_t*)(wm + OFF_WIN) + (size_t)4096 * 1024, 1024, 0, r, 32, scr, lane); continue; } r -= 512;
            if (r < 1024) { tr_item(win, DIN, 3912, 2048, (bf16_t*)(wm + OFF_WG), 1024, 0, r, 64, scr, lane); continue; } r -= 1024;
            if (r < 512) { tr_item(a.in[12] + (size_t)l * 1048576, 1024, 0, 1024, (bf16_t*)(wm + OFF_WPR), 1024, 0, r, 32, scr, lane); continue; } r -= 512;
            if (r < 512) { tr_item(a.in[14] + (size_t)l * 1048576, 1024, 0, 1024, (bf16_t*)(wm + OFF_WO), 1024, 0, r, 32, scr, lane); continue; } r -= 512;
            if (r < 512) { tr_item(a.in[13] + (size_t)l * 1048576, 1024, 0, 1024, (bf16_t*)(R + R_PT + (size_t)l * 2 * MiB), 1024, 0, r, 32, scr, lane); continue; } r -= 512;
            { const int m = r >> 5, g = (r >> 1) & 15, nb = r & 1;
              const float* src = (m ? a.in[6] : a.in[4]) + (size_t)(l * 16 + g) * 4096;
              bf16_t* dst = (bf16_t*)(ws + WS_WSM + (size_t)l * 262144 + (size_t)m * 131072) + g * 4096;
              tr_item(src, 64, 0, 64, dst, 64, 0, nb, 2, scr, lane); }
        }
        const size_t gt = (size_t)vcu * NTHR + tid, GT = (size_t)G * NTHR;
        for (size_t i = gt; i < (size_t)NL * 1024 * 128; i += GT) { const int l = (int)(i >> 17), k = (int)(i >> 7) & 1023, j8 = (int)i & 127;
            const float* s = a.in[1] + ((size_t)l * 1024 + k) * DIN + 2048 + 8 * j8; const f32x4 v0 = *(const f32x4*)s, v1 = *(const f32x4*)(s + 4);
            *(u32x4*)((bf16_t*)(R + R_WQ + (size_t)l * 2 * MiB) + (size_t)k * 1024 + 8 * j8) = pack8(v0, v1); }
        for (size_t i = gt; i < (size_t)2 * NL * 8 * 256 * 32; i += GT) { const int which = (int)(i >> 18); const int r = (int)(i & 262143); const int lh = r >> 13, c = (r >> 5) & 255, d8 = r & 31; const int h = lh & 7;
            u32x4 o = (u32x4){0u, 0u, 0u, 0u};
            if ((d8 >> 4) == (h & 1)) { const float* s = (which ? a.in[11] : a.in[10]) + ((size_t)lh * 256 + c) * 128 + 8 * (d8 & 15); o = pack8(*(const f32x4*)s, *(const f32x4*)(s + 4)); }
            *(u32x4*)((bf16_t*)(R + (which ? R_UVP : R_UKP)) + ((size_t)lh * 256 + c) * 1024 + 8 * d8) = o; }
        for (size_t i = gt; i < (size_t)T * 128; i += GT) { const float* s = a.in[0] + i * 8; const f32x4 v0 = *(const f32x4*)s, v1 = *(const f32x4*)(s + 4);
            *(u32x4*)(xb + i * 8) = pack8(v0, v1); }
    }
    SEAM(0);
    if (EN_B && IN(1)) {
        SchedPro S{R, G, vcu}; EpiPro E{ws + WS_WMIX};
        gs::gemm_stream<true>(lds, S, E, wave_s);
    }
    SEAM(1);

    for (int l = 0; l < NL; ++l) {
        const int pb = 2 + l * NPH_L;
        unsigned char* wm = ws + WS_WMIX + (size_t)l * WMIX_STRIDE;
        bf16_t* xrnn = (bf16_t*)(R + R_XRNN); bf16_t* grnn = (bf16_t*)(R + R_GRNN); bf16_t* qlat = (bf16_t*)(R + R_QLAT); bf16_t* ckv = (bf16_t*)(R + R_CKV);
        bf16_t* qidx = (bf16_t*)(R + R_QIDX); bf16_t* kidx = (bf16_t*)(R + R_KIDX); float* widx = (float*)(R + R_WIDX);
        if (EN_0 && IN(pb + 0)) {
            SchedDense S{(const char*)xb, (const char*)(wm + OFF_WIN), 2048u, 2048u, 16, T / 256, 20, G, vcu};
            EpiInproj E{xrnn, grnn, qlat, ckv, qidx, kidx, widx};
            gs::gemm_stream<true>(lds, S, E, wave_s);
#ifdef DBG_REP_INPROJ
            gs::gemm_stream<true>(lds, S, E, wave_s);
#endif
        }
        SEAM(pb + 0);
        RnnP RP{xrnn, grnn, (float*)(R + R_TOT), (const bf16_t*)(ws + WS_WSM + (size_t)l * 262144), (const bf16_t*)(ws + WS_WSM + (size_t)l * 262144 + 131072),
                a.in[2] + (size_t)l * 4096, a.in[3] + (size_t)l * 1024, a.in[5] + (size_t)l * 1024, a.in[7] + (size_t)l * 1024, a.in[8] + (size_t)l * 1024};
        if (EN_1 && IN(pb + 1)) { PH_LOCALS
#ifdef DBG_TIME
            if (tid == 0) MISC[24] = (unsigned)__builtin_amdgcn_s_memrealtime();
#endif
            for (int it = gw; it < 2048; it += NGW) rnn_item<1>(RP, it, lds + wave * 8448, lane);
#ifdef DBG_TIME
            if (tid == 0) MISC[25] = (unsigned)__builtin_amdgcn_s_memrealtime();
#endif
#ifdef DBG_REP_RNN
            for (int it = gw; it < 2048; it += NGW) rnn_item<1>(RP, it, lds + wave * 8448, lane);
#endif
            for (int row = gw; row < T; row += 4 * NGW) ckv_norm_rows4(ckv, row, NGW, T, a.in[9] + (size_t)l * 256, lane);
#ifdef DBG_TIME
            if (tid == 0) MISC[26] = (unsigned)__builtin_amdgcn_s_memrealtime();
#endif
            LAS float* scr = (LAS float*)(lds + wave * 8448);
            for (int it = gw; it < 16 * 768; it += NGW) { const int e = it / 768; int r = it - e * 768; const size_t le = (size_t)l * 16 + e;
                bf16_t* gu = (bf16_t*)(ws + WS_WEXP) + (size_t)e * 1048576; bf16_t* dn = (bf16_t*)(ws + WS_WEXP + OFF_DN) + (size_t)e * 524288;
                if (r < 256) { tr_item(a.in[19] + le * 524288, 512, 0, 512, gu, 1024, 1, r, 16, scr, lane); continue; } r -= 256;
                if (r < 256) { tr_item(a.in[20] + le * 524288, 512, 0, 512, gu + 4 * 1024, 1024, 1, r, 16, scr, lane); continue; } r -= 256;
                tr_item(a.in[21] + le * 524288, 1024, 0, 1024, dn, 512, 0, r, 32, scr, lane); }
#ifdef DBG_TIME
            if (l == 1 && bx == 0 && tid == 0) { const unsigned tq3 = (unsigned)__builtin_amdgcn_s_memrealtime();
                ctl[12288 + 48] = MISC[25] - MISC[24]; ctl[12288 + 49] = MISC[26] - MISC[25]; ctl[12288 + 50] = tq3 - MISC[26]; ctl[12288 + 51] = tq3 - MISC[24]; }
#endif
        }
        SEAM(pb + 1);
        if (EN_2 && IN(pb + 2)) { PH_LOCALS
            __syncthreads();
            if (tid < 256) ((LAS float*)(lds + AT_BIAS))[tid] = a.in[24][tid];
            if (tid < 128) { const int d = tid; int bk = d; if (d >= 16) { bk = 16 + (int)(logf((float)d / 16.0f) / 2.0794415416798357f * 16.0f); bk = bk > 31 ? 31 : bk; } ((LAS int*)(lds + AT_BKT))[d] = bk; }
            __syncthreads();
            for (int i = tid; i < 1024; i += NTHR) ((LAS float*)(lds + AT_BIAS2))[i] = ((const LAS float*)(lds + AT_BIAS))[((const LAS int*)(lds + AT_BKT))[i >> 3] * 8 + (i & 7)];
            AttnP AP{qidx, kidx, ckv, widx, qlat, (unsigned long long*)(R + R_MSCR + (size_t)bx * 393216)};
#ifdef DBG_TIME
            unsigned tph0 = (unsigned)__builtin_amdgcn_s_memrealtime();
#endif
#ifdef DBG_STATIC_UNITS
            if (EN_2A) for (int p = vcu; p < 512; p += G) { const int b = p >> 8, uu = p & 255;
#pragma unroll 1
                for (int k2 = 0; k2 < 2; ++k2) { attn_unit(lds, AP, b, k2 ? uu : 511 - uu, tid);
#ifdef DBG_TIME
                    if (tid == 0) MISC[21] = MISC[21] + 1u;
#endif
                } }
#else
            if (EN_2A) for (;;) {
                __syncthreads();
                if (tid == 0) MISC[4] = __hip_atomic_fetch_add(ctl + CW_QUEUE + l * 64, 1u, __ATOMIC_RELAXED, __HIP_MEMORY_SCOPE_AGENT);
                __syncthreads();
                const unsigned tk = MISC[4];
                if (tk >= 1024u) break;
                attn_unit(lds, AP, (int)(tk & 1u), 511 - (int)(tk >> 1), tid);
#ifdef DBG_TIME
                if (tid == 0) MISC[21] = MISC[21] + 1u;
#endif
            }
            __syncthreads();
#endif
#ifdef DBG_TIME
            if (l == 1 && bx == 0 && tid == 0) { for (int i_ = 0; i_ < 6; ++i_) ctl[12288 + 40 + i_] = ((LAS unsigned*)(lds + LDS_MISC))[16 + i_]; ctl[12288 + 46] = ((LAS unsigned*)(lds + LDS_MISC))[16]; }
            if (l == 0 && tid == 0) { for (int i_ = 0; i_ < 6; ++i_) ((LAS unsigned*)(lds + LDS_MISC))[16 + i_] = 0u; }
            __syncthreads();
            unsigned tph1 = (unsigned)__builtin_amdgcn_s_memrealtime();
            if (l == 1 && bx == 0 && tid == 0) ctl[12288 + 47] = tph1 - tph0;
            if (l == 1 && tid == 0) { __hip_atomic_fetch_max(ctl + 12288 + 59, tph1 - tph0, __ATOMIC_RELAXED, __HIP_MEMORY_SCOPE_AGENT); __hip_atomic_fetch_max(ctl + 12288 + 58, 0x40000000u - (tph1 - tph0), __ATOMIC_RELAXED, __HIP_MEMORY_SCOPE_AGENT); }
#endif
            if (EN_2R) for (int it = gw; it < 2048; it += NGW) rnn_item<2>(RP, it, lds + wave * 8448, lane);
#ifdef DBG_TIME
            { __syncthreads(); const unsigned tph2 = (unsigned)__builtin_amdgcn_s_memrealtime();
              if (l == 1 && tid == 0) __hip_atomic_fetch_max(ctl + 12288 + 57, tph2 - tph1, __ATOMIC_RELAXED, __HIP_MEMORY_SCOPE_AGENT); }
#endif
        }
        SEAM(pb + 2);
        if (EN_3 && IN(pb + 3)) {
            if (EN_M1) { SchedMerge1 S{(const char*)xb, (const char*)grnn, (const char*)(wm + OFF_WG), (const char*)(wm + OFF_WPR), G, vcu};
              EpiMerge1 E{R + R_MSCR + (size_t)bx * 131072, R + R_MSCR2, (bf16_t*)(R + R_MERGED)};
              gs::gemm_stream<true>(lds, S, E, wave_s); }
            if (EN_M2) { SchedDense S{(const char*)qlat, (const char*)(wm + OFF_WVO), 4096u, 4096u, 32, T / 256, 4, G, vcu};
              EpiMerge2 E{R + R_MSCR2, (bf16_t*)(R + R_MERGED)};
              gs::gemm_stream<true>(lds, S, E, wave_s); }
        }
        SEAM(pb + 3);
        if (EN_4 && IN(pb + 4)) {
            SchedDense S{(const char*)(R + R_MERGED), (const char*)(wm + OFF_WO), 2048u, 2048u, 16, T / 256, 4, G, vcu};
            EpiOut E{xb};
            gs::gemm_stream<true>(lds, S, E, wave_s);
        }
        SEAM(pb + 4);
        RouteP RT{(int*)(R + R_ROUTE), (int*)(R + R_ROUTE + 262144), (int*)(R + R_ROUTE + 524288), (float*)(R + R_ROUTE + 786432), ctl + CW_CNT + l * 16 * 64};
        LAS int* offp = (LAS int*)(lds + LDS_MISC - 128);
        if (EN_5 && IN(pb + 5)) { PH_LOCALS
            __syncthreads();
            { float wv[32];
#pragma unroll
              for (int j = 0; j < 32; ++j) wv[j] = a.in[17][tid + j * NTHR];
#pragma unroll
              for (int j = 0; j < 32; ++j) { const int i = tid + j * NTHR; ((LAS float*)lds)[(i & 15) * 1024 + (i >> 4)] = wv[j]; } }
            for (int blk = vcu; blk < T / 128; blk += G) ln1_route_block(lds, blk, xo, xb, a.in[15] + (size_t)l * 1024, a.in[16] + (size_t)l * 1024, a.in[18], RT, tid);
        }
        SEAM(pb + 5);
        int* tokof = (int*)(R + R_ROUTE + 1048576);
        if (EN_6 && IN(pb + 6)) { PH_LOCALS
            moe_offsets(offp, RT.gcnt, tid);
            for (int p = vcu * NTHR + tid; p < 2 * T; p += G * NTHR) { const int e = RT.r_e[p], slot = offp[e] + RT.r_pos[p]; RT.r_slot[p] = slot; tokof[slot] = p >> 1; }
            if (vcu == 0 && tid < 256) {
                for (int e = 0; e < 16; ++e) { const int cnt = (int)__hip_atomic_load(RT.gcnt + e * 64, __ATOMIC_RELAXED, __HIP_MEMORY_SCOPE_AGENT); const int s0 = offp[e] + cnt;
                    if (s0 + tid < offp[e + 1]) tokof[s0 + tid] = 0; } }
        }
        SEAM(pb + 6);
        if (EN_7 && IN(pb + 7)) { PH_LOCALS
            moe_offsets(offp, RT.gcnt, tid);
            SchedMoEG S{(const char*)xb, (const char*)(ws + WS_WEXP), 2048u, 2048u, (size_t)2097152, 16, 4, G, vcu, offp, tokof};
            EpiGU E{(bf16_t*)(R + R_HE)};
            gs::gemm_stream<true, SchedMoEG, EpiGU, true>(lds, S, E, wave_s);
        }
        SEAM(pb + 7);
        if (EN_8 && IN(pb + 8)) { PH_LOCALS
            moe_offsets(offp, RT.gcnt, tid);
            SchedMoE S{(const char*)(R + R_HE), (const char*)(ws + WS_WEXP + OFF_DN), 1024u, 1024u, (size_t)1048576, 8, 4, G, vcu, offp};
            EpiBf16 E{(bf16_t*)(R + R_XG), 1024};
            gs::gemm_stream<true>(lds, S, E, wave_s);
        }
        SEAM(pb + 8);
        if (EN_9 && IN(pb + 9)) { PH_LOCALS
            const bf16_t* Y = (const bf16_t*)(R + R_XG);
            u32x2 xwn[4], y0n[4], y1n[4]; int s0n, s1n; f32x2 ggc, ggn;
            { const int r0 = gw < T ? gw : T - 1, r1 = gw + NGW < T ? gw + NGW : T - 1;
              const int a0 = RT.r_slot[2 * r0], a1 = RT.r_slot[2 * r0 + 1]; ggc = *(const f32x2*)(RT.r_g + 2 * (size_t)r0);
#pragma unroll
              for (int j = 0; j < 4; ++j) { xwn[j] = *(const u32x2*)(xb + (size_t)r0 * 1024 + 256 * j + 4 * lane); y0n[j] = *(const u32x2*)(Y + (size_t)a0 * 1024 + 256 * j + 4 * lane); y1n[j] = *(const u32x2*)(Y + (size_t)a1 * 1024 + 256 * j + 4 * lane); }
              s0n = RT.r_slot[2 * r1]; s1n = RT.r_slot[2 * r1 + 1]; ggn = *(const f32x2*)(RT.r_g + 2 * (size_t)r1); }
            for (int row = gw; row < T; row += NGW) {
                const f32x2 gg = ggc;
                u32x2 xwc[4], y0c[4], y1c[4];
#pragma unroll
                for (int j = 0; j < 4; ++j) { xwc[j] = xwn[j]; y0c[j] = y0n[j]; y1c[j] = y1n[j]; }
                { const int r1 = row + NGW < T ? row + NGW : T - 1, r2 = row + 2 * NGW < T ? row + 2 * NGW : T - 1;
                  const int a0 = s0n, a1 = s1n; ggc = ggn;
#pragma unroll
                  for (int j = 0; j < 4; ++j) { xwn[j] = *(const u32x2*)(xb + (size_t)r1 * 1024 + 256 * j + 4 * lane); y0n[j] = *(const u32x2*)(Y + (size_t)a0 * 1024 + 256 * j + 4 * lane); y1n[j] = *(const u32x2*)(Y + (size_t)a1 * 1024 + 256 * j + 4 * lane); }
                  s0n = RT.r_slot[2 * r2]; s1n = RT.r_slot[2 * r2 + 1]; ggn = *(const f32x2*)(RT.r_g + 2 * (size_t)r2); }
                f32x4 v[4];
#pragma unroll
                for (int j = 0; j < 4; ++j) { const u32x2 xw = xwc[j]; const f32x4 x1 = {bf_lo(xw.x), bf_hi(xw.x), bf_lo(xw.y), bf_hi(xw.y)};
                    const u32x2 y0 = y0c[j], y1 = y1c[j];
                    v[j][0] = ALPHA * x1[0] + gg.x * bf_lo(y0.x) + gg.y * bf_lo(y1.x); v[j][1] = ALPHA * x1[1] + gg.x * bf_hi(y0.x) + gg.y * bf_hi(y1.x);
                    v[j][2] = ALPHA * x1[2] + gg.x * bf_lo(y0.y) + gg.y * bf_lo(y1.y); v[j][3] = ALPHA * x1[3] + gg.x * bf_hi(y0.y) + gg.y * bf_hi(y1.y); }
                ln_finish(v, a.in[22] + (size_t)l * 1024, a.in[23] + (size_t)l * 1024, l == NL - 1 ? xo + (size_t)row * 1024 : nullptr, xb + (size_t)row * 1024, lane);
#ifdef DBG_TIME
                if (l == NL - 1) {
                    const unsigned ta = __hip_atomic_load(ctl + 12288 + (DBG_TA), __ATOMIC_RELAXED, __HIP_MEMORY_SCOPE_AGENT), tb = __hip_atomic_load(ctl + 12288 + (DBG_TB), __ATOMIC_RELAXED, __HIP_MEMORY_SCOPE_AGENT);
                    unsigned k_ = (DBG_Q) == 0 ? (40u * ta + tb / 2u) / (tb ? tb : 1u) : ((DBG_TA) == 58 ? (0x40000000u - ta) : (ta - tb)) / (unsigned)((DBG_Q) ? (DBG_Q) : 1); k_ = k_ > 45u ? 45u : k_;
                    const float sc_ = 1.0f - 0.02f * (float)k_;
#pragma unroll
                    for (int j = 0; j < 4; ++j) *(f32x4*)(xo + (size_t)row * 1024 + 256 * j + 4 * lane) = v[j] * sc_; }
#endif
            }
        }
        SEAM(pb + 9);
    }
#undef IN
#undef SEAM
}

#ifdef DUMP_OFF
__global__ void dump_k(const bf16_t* src, float* dst, size_t ld, size_t col0) { for (size_t i = (size_t)blockIdx.x * blockDim.x + threadIdx.x; i < (size_t)T * 1024; i += (size_t)gridDim.x * blockDim.x) dst[i] = bf2f(src[(i >> 10) * ld + col0 + (i & 1023)]); }
#endif
extern "C" void kernel_launch(void* const* d_in, const int* in_sizes, int n_in, void* d_out, int out_size, void* d_ws, size_t ws_size, hipStream_t stream) {
    static int grid = 0;
    if (grid == 0) {
        if (n_in != 25 || out_size != T * D || ws_size < WS_END) { fprintf(stderr, "kernel_launch: unexpected shapes (n_in %d, out %d, ws %zu < %zu)\n", n_in, out_size, ws_size, (size_t)WS_END); grid = -1; return; }
        int dev = 0, cus = 0, per_cu = 0;
        if (hipGetDevice(&dev) != hipSuccess || hipDeviceGetAttribute(&cus, hipDeviceAttributeMultiprocessorCount, dev) != hipSuccess) { grid = -1; return; }
        if (hipFuncSetAttribute((const void*)fwd, hipFuncAttributeMaxDynamicSharedMemorySize, LDS_BYTES) != hipSuccess) { fprintf(stderr, "kernel_launch: hipFuncSetAttribute failed\n"); grid = -1; return; }
        if (hipOccupancyMaxActiveBlocksPerMultiprocessor(&per_cu, (const void*)fwd, NTHR, LDS_BYTES) != hipSuccess || per_cu < 1) fprintf(stderr, "kernel_launch: occupancy query says %d\n", per_cu);
        (void)hipGetLastError();
        grid = cus < 256 ? cus : 256;
    }
    if (grid < 0) return;
    (void)hipMemsetAsync((char*)d_ws + WS_CTL, 0, CTL_BYTES, stream);
    Args a{};
    for (int i = 0; i < 25; ++i) a.in[i] = (const float*)d_in[i];
    a.out = (float*)d_out; a.ws = (unsigned char*)d_ws;
#if MK_PER_PHASE
#ifndef PH_LIMIT
#define PH_LIMIT NPH
#endif
    for (int ph = 0; ph < PH_LIMIT; ++ph) { a.ph_lo = ph; a.ph_hi = ph + 1; hipLaunchKernelGGL(fwd, dim3(grid), dim3(NTHR), LDS_BYTES, stream, a); }
#else
    a.ph_lo = 0; a.ph_hi = NPH; hipLaunchKernelGGL(fwd, dim3(grid), dim3(NTHR), LDS_BYTES, stream, a);
#endif
#ifdef DUMP_OFF
    hipLaunchKernelGGL(dump_k, dim3(2048), dim3(256), 0, stream, (const bf16_t*)((const char*)d_ws + (DUMP_OFF)), (float*)d_out, (size_t)(DUMP_LD), (size_t)(DUMP_COL));
#endif
}
```

```cpp
#include <hip/hip_runtime.h>
#include <cstdio>
#include <cstdint>

#define GAS __attribute__((address_space(1)))
#define LAS __attribute__((address_space(3)))
typedef unsigned short bf16_t;
typedef short bf16x8 __attribute__((ext_vector_type(8)));
typedef short s16x4 __attribute__((ext_vector_type(4)));
typedef float f32x2 __attribute__((ext_vector_type(2)));
typedef float f32x4 __attribute__((ext_vector_type(4)));
typedef float f32x16 __attribute__((ext_vector_type(16)));
typedef unsigned u32x2 __attribute__((ext_vector_type(2)));
typedef unsigned u32x4 __attribute__((ext_vector_type(4)));

constexpr int NB = 2, SEQ = 16384, T = NB * SEQ, D = 1024, NL = 4, DIN = 5960;
constexpr int NE = 16;
constexpr float ALPHA = 1.681792830507429f;
constexpr float LN_EPS = 1e-5f, RMS_EPS = 1e-6f;
constexpr int NWAVES = 8, NTHR = 512;

constexpr size_t MiB = 1u << 20;
constexpr size_t WS_CTL = 0, CTL_BYTES = 1 * MiB;
constexpr size_t WS_XB = 1 * MiB;
constexpr size_t WS_WMIX = 65 * MiB, WMIX_STRIDE = 22 * MiB;
constexpr size_t OFF_WIN = 0, OFF_WG = 10 * MiB, OFF_WPR = 14 * MiB, OFF_WVO = 16 * MiB, OFF_WO = 20 * MiB;
constexpr size_t WS_WSM = 153 * MiB;
constexpr size_t WS_WEXP = 154 * MiB;
constexpr size_t OFF_DN = 32 * MiB;
constexpr size_t WS_R = 202 * MiB;
constexpr size_t R_XRNN = 0, R_GRNN = 64 * MiB, R_QLAT = 128 * MiB, R_CKV = 256 * MiB, R_QIDX = 272 * MiB, R_KIDX = 304 * MiB, R_WIDX = 308 * MiB,
                 R_TOT = 309 * MiB, R_MSCR = 310 * MiB, R_MSCR2 = 342 * MiB, R_END = 406 * MiB;
constexpr size_t R_MERGED = R_XRNN;
constexpr size_t R_XG = 0, R_HE = 136 * MiB, R_ROUTE = 204 * MiB;
constexpr size_t R_WQ = 0, R_UKP = 8 * MiB, R_PT = 24 * MiB, R_UVP = 32 * MiB;
constexpr size_t WS_END = WS_R + R_END;
constexpr int MP_MAX = 2 * T + NE * 256;

constexpr int CW_TMO = 0;
constexpr int CW_BAR = 4096;
constexpr int CW_CNT = 8192;
constexpr int CW_QUEUE = 14336;

constexpr int LDS_BYTES = 163840;
constexpr int LDS_MISC = LDS_BYTES - 256;

#define RLX_AGENT __ATOMIC_RELAXED, __HIP_MEMORY_SCOPE_AGENT
__device__ __forceinline__ unsigned f2bf(float f) { unsigned u = __builtin_bit_cast(unsigned, f); return (u + 0x7fffu + ((u >> 16) & 1u)) >> 16; }
typedef __bf16 bf16x2_t __attribute__((ext_vector_type(2)));
__device__ __forceinline__ unsigned pk2(float lo, float hi) { const f32x2 v = {lo, hi}; const bf16x2_t b = __builtin_convertvector(v, bf16x2_t); return __builtin_bit_cast(unsigned, b); }
__device__ __forceinline__ float bf_lo(unsigned w) { return __builtin_bit_cast(float, w << 16); }
__device__ __forceinline__ float bf_hi(unsigned w) { return __builtin_bit_cast(float, w & 0xffff0000u); }
__device__ __forceinline__ float bf2f(bf16_t h) { return __builtin_bit_cast(float, ((unsigned)h) << 16); }
__device__ __forceinline__ float fast_exp(float x) { return __builtin_amdgcn_exp2f(x * 1.4426950408889634f); }
__device__ __forceinline__ float fast_rcp(float x) { return __builtin_amdgcn_rcpf(x); }
__device__ __forceinline__ float sigmoidf_(float x) { return fast_rcp(1.0f + fast_exp(-x)); }
__device__ __forceinline__ float gelu_tanh(float x) { const float y = 0.7978845608028654f * (x + 0.044715f * x * x * x); const float e = fast_exp(2.0f * y); const float th = 1.0f - 2.0f * fast_rcp(e + 1.0f); return 0.5f * x * (1.0f + th); }
template <int CTRL> __device__ __forceinline__ float dpp_f(float v) { return __builtin_bit_cast(float, __builtin_amdgcn_update_dpp(0, __builtin_bit_cast(int, v), CTRL, 0xf, 0xf, true)); }
__device__ __forceinline__ float wave_sum(float v) {
    v += dpp_f<0xB1>(v); v += dpp_f<0x4E>(v); v += dpp_f<0x141>(v); v += dpp_f<0x140>(v);
    const int vi = __builtin_bit_cast(int, v);
    return (__builtin_bit_cast(float, __builtin_amdgcn_readlane(vi, 0)) + __builtin_bit_cast(float, __builtin_amdgcn_readlane(vi, 16))) +
           (__builtin_bit_cast(float, __builtin_amdgcn_readlane(vi, 32)) + __builtin_bit_cast(float, __builtin_amdgcn_readlane(vi, 48)));
}

__device__ __forceinline__ int lane_id() { unsigned z = 0u; asm volatile("" : "+v"(z)); return (int)__builtin_amdgcn_mbcnt_hi(~0u, __builtin_amdgcn_mbcnt_lo(~0u, z)); }
#define XB_TMO      128
#define XB_XCNT(j)  (256  + 64 * (j))
#define XB_XSUB(j)  (1280 + 64 * (j))
#define XB_XGEN(j)  (2304 + 64 * (j))
#define XB_TOP      3328
#define XB_TOPGEN   3392
#define XCD_BAR_WORDS 3456
#define XB_SPIN_CAP (1u << 18)
__device__ __forceinline__ unsigned xb_ld(unsigned* p)              { return __hip_atomic_load(p, __ATOMIC_RELAXED, __HIP_MEMORY_SCOPE_AGENT); }
__device__ __forceinline__ unsigned xb_add(unsigned* p, unsigned v) { return __hip_atomic_fetch_add(p, v, __ATOMIC_RELAXED, __HIP_MEMORY_SCOPE_AGENT); }
__device__ __forceinline__ unsigned xb_xcc_id() { return (unsigned)__builtin_amdgcn_s_getreg((3 << 11) | 20) & 0xFu; }
#define XB_SPIN(cond, bar) do { unsigned _sp = 0; while (cond) { __builtin_amdgcn_s_sleep(1); \
    if ((++_sp & 255u) == 0u) { if (xb_ld(&(bar)[XB_TMO])) break; if (_sp > XB_SPIN_CAP) { atomicAdd(&(bar)[XB_TMO], 1u); break; } } } } while (0)
struct XcdBarrier { unsigned* bar; unsigned x; volatile LAS unsigned* st; };
__device__ __forceinline__ XcdBarrier xcd_barrier_post(unsigned* bar, volatile LAS unsigned* st) {
    XcdBarrier b; b.bar = bar; b.x = xb_xcc_id(); b.st = st;
    if (threadIdx.x == 0) (void)xb_add(&bar[XB_XCNT(b.x)], 1u);
    return b;
}
__device__ __forceinline__ void xcd_barrier_complete(unsigned* bar, unsigned x, unsigned& nloc, unsigned& nx) {
    const unsigned G = gridDim.x * gridDim.y * gridDim.z;
    unsigned sum, cnt, mine, sp = 0u;
    for (;;) {
        sum = 0u; cnt = 0u; mine = 0u;
#pragma unroll
        for (unsigned j = 0; j < 16; ++j) { const unsigned c = xb_ld(&bar[XB_XCNT(j)]); sum += c; cnt += (c > 0u) ? 1u : 0u; mine = (j == x) ? c : mine; }
        if (sum == G) break;
        __builtin_amdgcn_s_sleep(1);
        if ((++sp & 255u) == 0u) { if (xb_ld(&bar[XB_TMO])) break; if (sp > XB_SPIN_CAP) { atomicAdd(&bar[XB_TMO], 1u); break; } }
    }
    nloc = mine > 0u ? mine : 1u; nx = cnt > 0u ? cnt : 1u;
}
__device__ __forceinline__ void xcd_barrier(const XcdBarrier& b, bool is_t0) {
    asm volatile("s_waitcnt vmcnt(0)" ::: "memory");
    __syncthreads();
    if (is_t0) {
        unsigned* bar = b.bar;
        __builtin_amdgcn_s_waitcnt(0);
        unsigned nloc = b.st[0], nx = b.st[1];
        if (nloc == 0u) { xcd_barrier_complete(bar, b.x, nloc, nx); b.st[0] = nloc; b.st[1] = nx; }
        const unsigned old = xb_add(&bar[XB_XSUB(b.x)], 1u);
        const unsigned gen = old / nloc;
        if (old + 1u == (gen + 1u) * nloc) {
            __builtin_amdgcn_fence(__ATOMIC_RELEASE, "agent");
            asm volatile("s_waitcnt vmcnt(0)" ::: "memory");
            const unsigned og = xb_add(&bar[XB_TOP], 1u);
            const unsigned tg = og / nx;
            if (og + 1u == (tg + 1u) * nx) xb_add(&bar[XB_TOPGEN], 1u);
            else XB_SPIN(xb_ld(&bar[XB_TOPGEN]) == tg, bar);
            __builtin_amdgcn_fence(__ATOMIC_ACQUIRE, "agent");
            xb_add(&bar[XB_XGEN(b.x)], 1u);
            asm volatile("s_waitcnt vmcnt(0)" ::: "memory");
        } else {
            XB_SPIN(xb_ld(&bar[XB_XGEN(b.x)]) == gen, bar);
            __builtin_amdgcn_fence(__ATOMIC_ACQUIRE, "agent");
            asm volatile("s_waitcnt vmcnt(0)" ::: "memory");
        }
    }
    __syncthreads();
}
namespace gs {
constexpr int BM = 256, BK = 64, HALF = 128, HTB = HALF * BK * 2, STAGE_BYTES = 8 * HTB, NXCD = 8, WGM = 8;
__host__ __device__ __forceinline__ int lds_byte(int r, int c) { const int st = (r >> 4) * 2 + (c >> 5), rr = r & 15, cc = c & 31, ob = rr * 64 + cc * 2; return st * 1024 + (ob ^ (((ob >> 9) & 1) << 5)); }
__host__ __device__ __forceinline__ void stage_rc(int b, int& R, int& C) { const int st = b / 1024, sb = b % 1024, swz = sb ^ (((sb >> 9) & 1) << 5); R = (st >> 1) * 16 + swz / 64; C = (st & 1) * 32 + (swz % 64) / 2; }
__host__ __device__ __forceinline__ int perm32(int rho) { const int n = rho >> 4, i = rho & 15; return 8 * (i >> 2) + 4 * n + (i & 3); }

struct UD { const char* A; const char* B; unsigned lda, ldb; int nt; int kind, pm, pn, aux; };

__device__ __forceinline__ bool tile_of(long L, int nM, int nN, int& pm, int& pn) {
    const int nwg = nM * nN; if (L >= nwg) return false;
    int wgid = (int)L; { const int q = nwg / NXCD, r = nwg % NXCD, xcd = wgid % NXCD, off = wgid / NXCD; wgid = (xcd < r ? xcd * (q + 1) : r * (q + 1) + (xcd - r) * q) + off; }
    const int nig = WGM * nN, gid = wgid / nig, fm = gid * WGM, gsz = (nM - fm) < WGM ? (nM - fm) : WGM;
    pm = fm + ((wgid % nig) % gsz); pn = (wgid % nig) / gsz; return true;
}

template <bool PERM, class Sched, class Epi, bool GATHER = false>
__device__ __forceinline__ void gemm_stream(LAS unsigned char* lds, const Sched& S, const Epi& E, int wave_s) {
    int tid = wave_s * 64 + lane_id(); asm volatile("" : "+v"(tid));
    const int wid = __builtin_amdgcn_readfirstlane(tid >> 6), lane = tid & 63, wr = wid >> 2, wc = wid & 3, fr = lane & 15, fq = lane >> 4;
    int rA[2], rB[2], cb[2];
#pragma unroll
    for (int i = 0; i < 2; ++i) { int R, C; stage_rc(tid * 16 + i * 8192, R, C); rA[i] = R; rB[i] = PERM ? ((R & ~31) + perm32(R & 31)) : R; cb[i] = C * 2; }
    const size_t kstep = (size_t)(BK * 2);
    const unsigned ldsw = (unsigned)wid * 1024u;
    const int aoff = lds_byte(wr * 64 + fr, fq * 8), boff = lds_byte(wc * 32 + fr, fq * 8);
#define GS_SA(b, h) (((b) * 2 + (h)) * HTB)
#define GS_SB(b, h) ((4 + (b) * 2 + (h)) * HTB)
#define GS_STAGE(bufoff, gbase, voff) do { _Pragma("unroll") for (int _i = 0; _i < 2; ++_i) \
        __builtin_amdgcn_global_load_lds((const unsigned*)((const char*)(gbase) + (voff)[_i]), (LAS unsigned*)(lds + (bufoff) + ldsw + _i * 8192), 16, 0, 0); } while (0)
#define GS_LDA(dst, b, h) do { _Pragma("unroll") for (int m = 0; m < 4; ++m) _Pragma("unroll") for (int k = 0; k < 2; ++k) dst[m][k] = *(const LAS bf16x8*)(lds + GS_SA(b, h) + aoff + m * 2048 + k * 1024); } while (0)
#define GS_LDB(dst, b, h) do { _Pragma("unroll") for (int n = 0; n < 2; ++n) _Pragma("unroll") for (int k = 0; k < 2; ++k) dst[n][k] = *(const LAS bf16x8*)(lds + GS_SB(b, h) + boff + n * 2048 + k * 1024); } while (0)
#define GS_MMA(ai, bj, At, Bt) do { __builtin_amdgcn_s_setprio(1); _Pragma("unroll") for (int m = 0; m < 4; ++m) _Pragma("unroll") for (int n = 0; n < 2; ++n) _Pragma("unroll") for (int k = 0; k < 2; ++k) \
        acc[ai][bj][m][n] = __builtin_amdgcn_mfma_f32_16x16x32_bf16(Bt[n][k], At[m][k], acc[ai][bj][m][n], 0, 0, 0); __builtin_amdgcn_s_setprio(0); } while (0)
#define GS_WAIT_V(n) asm volatile("s_waitcnt vmcnt(" #n ")" ::: "memory")
#define GS_WAIT_L(n) asm volatile("s_waitcnt lgkmcnt(" #n ")" ::: "memory")
#define GS_BAR __builtin_amdgcn_s_barrier()
#define GS_SCHED __builtin_amdgcn_sched_barrier(0)
    UD cur, nxt; int ui = 0; const bool prime = false;
    if (!S.next(0, cur)) return;
    f32x4 acc[2][2][4][2];
#pragma unroll
    for (int a = 0; a < 2; ++a)
#pragma unroll
        for (int b = 0; b < 2; ++b)
#pragma unroll
            for (int m = 0; m < 4; ++m)
#pragma unroll
                for (int n = 0; n < 2; ++n) acc[a][b][m][n] = (f32x4){0.f, 0.f, 0.f, 0.f};
    bf16x8 At[4][2], B0[2][2], B1[2][2];
    unsigned vAc[2], vBc[2], vAc1[2] = {0u, 0u};
#pragma unroll
    for (int i = 0; i < 2; ++i) { vAc[i] = (unsigned)rA[i] * cur.lda + (unsigned)cb[i]; vBc[i] = (unsigned)rB[i] * cur.ldb + (unsigned)cb[i]; }
    if constexpr (GATHER) { const int* rm = S.rmap + cur.pm * 256;
#pragma unroll
        for (int i = 0; i < 2; ++i) { vAc[i] = (unsigned)rm[rA[i]] * cur.lda + (unsigned)cb[i]; vAc1[i] = (unsigned)rm[HALF + rA[i]] * cur.lda + (unsigned)cb[i]; } }
    const char* cA = cur.A; const char* cB = cur.B; size_t hA = GATHER ? (size_t)0 : (size_t)HALF * cur.lda, hB = (size_t)HALF * cur.ldb;
    GS_STAGE(GS_SB(0, 0), cB, vBc); GS_STAGE(GS_SA(0, 0), cA, vAc); GS_STAGE(GS_SB(0, 1), cB + hB, vBc); GS_STAGE(GS_SA(0, 1), cA + hA, (GATHER ? vAc1 : vAc));
    if (wr == 1) GS_BAR;
    GS_WAIT_V(4); GS_BAR;
    GS_STAGE(GS_SB(1, 0), cB + kstep, vBc); GS_STAGE(GS_SA(1, 0), cA + kstep, vAc); GS_STAGE(GS_SB(1, 1), cB + hB + kstep, vBc);
    GS_WAIT_V(6); GS_BAR;
    for (;;) {
        const bool has_next = S.next(ui + 1, nxt);
        const char* nA = has_next ? nxt.A : cA; const char* nB = has_next ? nxt.B : cB;
        const unsigned nlda = has_next ? nxt.lda : cur.lda, nldb = has_next ? nxt.ldb : cur.ldb;
        unsigned vAn[2], vBn[2], vAn1[2] = {0u, 0u};
#pragma unroll
        for (int i = 0; i < 2; ++i) { vAn[i] = (unsigned)rA[i] * nlda + (unsigned)cb[i]; vBn[i] = (unsigned)rB[i] * nldb + (unsigned)cb[i]; }
        if constexpr (GATHER) { const int* rm = S.rmap + (has_next ? nxt.pm : cur.pm) * 256;
#pragma unroll
            for (int i = 0; i < 2; ++i) { vAn[i] = (unsigned)rm[rA[i]] * nlda + (unsigned)cb[i]; vAn1[i] = (unsigned)rm[HALF + rA[i]] * nlda + (unsigned)cb[i]; } }
        const size_t hAn = GATHER ? (size_t)0 : (size_t)HALF * nlda, hBn = (size_t)HALF * nldb;
        const int nt = cur.nt;
        for (int t = 0; t < nt; t += 2) {
            const bool last = (t == nt - 2);
            const char* a1 = cA + (size_t)(t + 1) * kstep;
            const char* a2 = last ? nA : cA + (size_t)(t + 2) * kstep; const char* b2 = last ? nB : cB + (size_t)(t + 2) * kstep;
            const char* a3 = a2 + kstep; const char* b3 = b2 + kstep;
            unsigned vA2[2], vB2[2], vA21[2];
#pragma unroll
            for (int i = 0; i < 2; ++i) { vA2[i] = last ? vAn[i] : vAc[i]; vB2[i] = last ? vBn[i] : vBc[i]; vA21[i] = last ? vAn1[i] : vAc1[i]; }
            const size_t hA2 = last ? hAn : hA, hB2 = last ? hBn : hB;
            GS_LDB(B0, 0, 0); GS_SCHED; GS_LDA(At, 0, 0); GS_STAGE(GS_SA(1, 1), a1 + hA, (GATHER ? vAc1 : vAc));
            GS_WAIT_L(8); GS_BAR; GS_WAIT_L(0); GS_MMA(0, 0, At, B0); GS_BAR; GS_SCHED;
            GS_LDB(B1, 0, 1); GS_STAGE(GS_SB(0, 0), b2, vB2);
            GS_BAR; GS_WAIT_L(0); GS_MMA(0, 1, At, B1); GS_BAR;
            GS_LDA(At, 0, 1); GS_STAGE(GS_SA(0, 0), a2, vA2);
            GS_BAR; GS_WAIT_L(0); GS_MMA(1, 0, At, B0); GS_BAR; GS_SCHED;
            GS_STAGE(GS_SB(0, 1), b2 + hB2, vB2);
            GS_WAIT_V(6); GS_BAR; GS_MMA(1, 1, At, B1); GS_BAR;
            GS_LDB(B0, 1, 0); GS_SCHED; GS_LDA(At, 1, 0); GS_STAGE(GS_SA(0, 1), a2 + hA2, (GATHER ? vA21 : vA2));
            GS_WAIT_L(8); GS_BAR; GS_WAIT_L(0); GS_MMA(0, 0, At, B0); GS_BAR; GS_SCHED;
            GS_LDB(B1, 1, 1); GS_STAGE(GS_SB(1, 0), b3, vB2);
            GS_BAR; GS_WAIT_L(0); GS_MMA(0, 1, At, B1); GS_BAR;
            GS_LDA(At, 1, 1); GS_STAGE(GS_SA(1, 0), a3, vA2);
            GS_BAR; GS_WAIT_L(0); GS_MMA(1, 0, At, B0); GS_BAR; GS_SCHED;
            GS_STAGE(GS_SB(1, 1), b3 + hB2, vB2);
            GS_WAIT_V(6); GS_BAR; GS_MMA(1, 1, At, B1); GS_BAR;
        }
        if (!prime) { int tz = wave_s * 64 + lane_id(); asm volatile("" : "+v"(tz)); const int w2 = __builtin_amdgcn_readfirstlane(tz >> 6), l2 = tz & 63; E(acc, cur, w2 >> 2, w2 & 3, l2 & 15, l2 >> 4, tz); }
        if (!has_next) break;
#pragma unroll
        for (int a = 0; a < 2; ++a)
#pragma unroll
            for (int b = 0; b < 2; ++b)
#pragma unroll
                for (int m = 0; m < 4; ++m)
#pragma unroll
                    for (int n = 0; n < 2; ++n) acc[a][b][m][n] = (f32x4){0.f, 0.f, 0.f, 0.f};
        cur = nxt; cA = nA; cB = nB; hA = hAn; hB = hBn;
#pragma unroll
        for (int i = 0; i < 2; ++i) { vAc[i] = vAn[i]; vBc[i] = vBn[i]; vAc1[i] = vAn1[i]; }
        ++ui;
    }
    GS_WAIT_V(0);
    if (wr == 0) GS_BAR;
    GS_BAR;
#undef GS_SA
#undef GS_SB
#undef GS_STAGE
#undef GS_LDA
#undef GS_LDB
#undef GS_MMA
#undef GS_WAIT_V
#undef GS_WAIT_L
#undef GS_BAR
#undef GS_SCHED
}
}
using gs::UD;
__device__ __forceinline__ u32x4 pack8(f32x4 v0, f32x4 v1) { u32x4 w; w.x = pk2(v0[0], v0[1]); w.y = pk2(v0[2], v0[3]); w.z = pk2(v1[0], v1[1]); w.w = pk2(v1[2], v1[3]); return w; }
__device__ __forceinline__ void unpack8(u32x4 w, f32x4& v0, f32x4& v1) { v0 = (f32x4){bf_lo(w.x), bf_hi(w.x), bf_lo(w.y), bf_hi(w.y)}; v1 = (f32x4){bf_lo(w.z), bf_hi(w.z), bf_lo(w.w), bf_hi(w.w)}; }

struct EpiInproj {
    bf16_t *xrnn, *grnn, *qlat, *ckv, *qidx, *kidx; float* widx;
    __device__ __forceinline__ void operator()(const f32x4 (&acc)[2][2][4][2], const UD& u, int wr, int wc, int fr, int fq, int tid) const {
        const int pn = u.pn; const size_t row0 = (size_t)u.pm * 256 + wr * 64 + fr;
        if (pn < 19) {
            bf16_t* base; int ldc, colt; float sc = 1.f; bool gl = false;
            if (pn < 4) { base = xrnn; ldc = 1024; colt = 256 * pn; }
            else if (pn < 8) { base = grnn; ldc = 1024; colt = 256 * (pn - 4); gl = true; }
            else if (pn < 16) { base = qlat; ldc = 2048; colt = 256 * (pn - 8); }
            else if (pn == 16) { base = ckv; ldc = 256; colt = 0; }
            else { base = qidx; ldc = 512; colt = 256 * (pn - 17); sc = 0.125f; }
#pragma unroll
            for (int ai = 0; ai < 2; ++ai)
#pragma unroll
                for (int m = 0; m < 4; ++m) { bf16_t* rowp = base + (row0 + ai * 128 + m * 16) * ldc + colt + wc * 32 + 8 * fq;
#pragma unroll
                    for (int bj = 0; bj < 2; ++bj) { f32x4 v0 = acc[ai][bj][m][0], v1 = acc[ai][bj][m][1];
                        if (gl) {
#pragma unroll
                            for (int j = 0; j < 4; ++j) { v0[j] = gelu_tanh(v0[j]); v1[j] = gelu_tanh(v1[j]); } }
                        v0 = v0 * sc; v1 = v1 * sc;
                        *(u32x4*)(rowp + bj * 128) = pack8(v0, v1); } }
        } else {
#pragma unroll
            for (int ai = 0; ai < 2; ++ai)
#pragma unroll
                for (int m = 0; m < 4; ++m) { const size_t row = row0 + ai * 128 + m * 16; const f32x4 v0 = acc[ai][0][m][0], v1 = acc[ai][0][m][1];
                    if (wc < 2) *(u32x4*)(kidx + row * 64 + wc * 32 + 8 * fq) = pack8(v0, v1);
                    else if (wc == 2 && fq == 0) { *(f32x4*)(widx + row * 8) = v0 * 0.35355339059327373f; *(f32x4*)(widx + row * 8 + 4) = v1 * 0.35355339059327373f; } }
        }
    }
};
struct EpiMerge1 {
    unsigned char* s1b; unsigned char* s2b; bf16_t* merged;
    __device__ __forceinline__ void operator()(const f32x4 (&acc)[2][2][4][2], const UD& u, int wr, int wc, int fr, int fq, int tid) const {
        const int kind = u.kind;
        u32x4* s1 = (u32x4*)s1b + tid; u32x4* s2 = (u32x4*)(s2b + (size_t)(u.pm * 4 + u.pn) * 131072) + tid;
#pragma unroll
        for (int ai = 0; ai < 2; ++ai)
#pragma unroll
            for (int bj = 0; bj < 2; ++bj)
#pragma unroll
                for (int m = 0; m < 4; ++m) { const int slot = (ai * 2 + bj) * 4 + m; f32x4 v0 = acc[ai][bj][m][0], v1 = acc[ai][bj][m][1];
                    if (kind != 1) {
#pragma unroll
                        for (int j = 0; j < 4; ++j) { v0[j] = sigmoidf_(v0[j]); v1[j] = sigmoidf_(v1[j]); }
#ifdef DBG_S1_CONST
                        { const float cv = (float)(u.pm * 4 + u.pn + 1) * (1.0f / 512.0f); v0 = (f32x4){cv, cv, cv, cv}; v1 = v0; }
#endif
                        (kind == 0 ? s1 : s2)[slot * 512] = pack8(v0, v1);
                    } else {
                        f32x4 a0, a1; unpack8(__builtin_nontemporal_load(s1 + slot * 512), a0, a1);
#ifdef DBG_NO_S1
                        a0 = (f32x4){1.f, 1.f, 1.f, 1.f}; a1 = a0;
#endif
                        const size_t row = (size_t)u.pm * 256 + ai * 128 + wr * 64 + m * 16 + fr;
                        *(u32x4*)(merged + row * 1024 + u.pn * 256 + bj * 128 + wc * 32 + 8 * fq) = pack8(a0 * v0, a1 * v1);
#ifdef DBG_OUT_S1
                        *(u32x4*)(merged + row * 1024 + u.pn * 256 + bj * 128 + wc * 32 + 8 * fq) = pack8(a0, a1);
#endif
                    }
                    if (m & 1) asm volatile("" ::: "memory"); }
    }
};
struct EpiMerge2 {
    unsigned char* s2b; bf16_t* merged;
    __device__ __forceinline__ void operator()(const f32x4 (&acc)[2][2][4][2], const UD& u, int wr, int wc, int fr, int fq, int tid) const {
        const u32x4* s2 = (const u32x4*)(s2b + (size_t)(u.pm * 4 + u.pn) * 131072) + tid;
#pragma unroll
        for (int ai = 0; ai < 2; ++ai)
#pragma unroll
            for (int bj = 0; bj < 2; ++bj)
#pragma unroll
                for (int m = 0; m < 4; ++m) { const int slot = (ai * 2 + bj) * 4 + m;
                    const size_t row = (size_t)u.pm * 256 + ai * 128 + wr * 64 + m * 16 + fr;
                    u32x4* mp = (u32x4*)(merged + row * 1024 + u.pn * 256 + bj * 128 + wc * 32 + 8 * fq);
                    f32x4 a0, a1, b0, b1; unpack8(__builtin_nontemporal_load(mp), a0, a1); unpack8(__builtin_nontemporal_load(s2 + slot * 512), b0, b1);
#ifdef DBG_NO_S2
                    b0 = (f32x4){1.f, 1.f, 1.f, 1.f}; b1 = b0;
#endif
#ifdef DBG_NO_MRG
                    a0 = (f32x4){0.f, 0.f, 0.f, 0.f}; a1 = a0;
#endif
                    *mp = pack8(a0 + b0 * acc[ai][bj][m][0], a1 + b1 * acc[ai][bj][m][1]);
                    if (m & 1) asm volatile("" ::: "memory"); }
    }
};
struct EpiOut {
    bf16_t* xb;
    __device__ __forceinline__ void operator()(const f32x4 (&acc)[2][2][4][2], const UD& u, int wr, int wc, int fr, int fq, int tid) const {
#pragma unroll
        for (int ai = 0; ai < 2; ++ai)
#pragma unroll
            for (int m = 0; m < 4; ++m) { bf16_t* rowp = xb + ((size_t)u.pm * 256 + ai * 128 + wr * 64 + m * 16 + fr) * 1024 + u.pn * 256 + wc * 32 + 8 * fq;
#pragma unroll
                for (int bj = 0; bj < 2; ++bj) { u32x4* p = (u32x4*)(rowp + bj * 128); const u32x4 xv = *p; f32x4 v0 = acc[ai][bj][m][0], v1 = acc[ai][bj][m][1];
                    v0[0] += ALPHA * bf_lo(xv.x); v0[1] += ALPHA * bf_hi(xv.x); v0[2] += ALPHA * bf_lo(xv.y); v0[3] += ALPHA * bf_hi(xv.y);
                    v1[0] += ALPHA * bf_lo(xv.z); v1[1] += ALPHA * bf_hi(xv.z); v1[2] += ALPHA * bf_lo(xv.w); v1[3] += ALPHA * bf_hi(xv.w);
                    *p = pack8(v0, v1); } }
    }
};
struct EpiGU {
    bf16_t* he;
    __device__ __forceinline__ void operator()(const f32x4 (&acc)[2][2][4][2], const UD& u, int wr, int wc, int fr, int fq, int tid) const {
#pragma unroll
        for (int ai = 0; ai < 2; ++ai)
#pragma unroll
            for (int m = 0; m < 4; ++m) { bf16_t* rowp = he + ((size_t)u.pm * 256 + ai * 128 + wr * 64 + m * 16 + fr) * 512 + u.pn * 128 + wc * 16 + 4 * fq;
#pragma unroll
                for (int bj = 0; bj < 2; ++bj) { const f32x4 g = acc[ai][bj][m][0], up = acc[ai][bj][m][1]; f32x4 o;
#pragma unroll
                    for (int j = 0; j < 4; ++j) o[j] = g[j] * sigmoidf_(g[j]) * up[j];
                    u32x2 w; w.x = pk2(o[0], o[1]); w.y = pk2(o[2], o[3]); *(u32x2*)(rowp + bj * 64) = w; } }
    }
};
struct EpiBf16 {
    bf16_t* out; int ldc;
    __device__ __forceinline__ void operator()(const f32x4 (&acc)[2][2][4][2], const UD& u, int wr, int wc, int fr, int fq, int tid) const {
#pragma unroll
        for (int ai = 0; ai < 2; ++ai)
#pragma unroll
            for (int m = 0; m < 4; ++m) { bf16_t* rowp = out + ((size_t)u.pm * 256 + ai * 128 + wr * 64 + m * 16 + fr) * ldc + u.pn * 256 + wc * 32 + 8 * fq;
#pragma unroll
                for (int bj = 0; bj < 2; ++bj) *(u32x4*)(rowp + bj * 128) = pack8(acc[ai][bj][m][0], acc[ai][bj][m][1]); }
    }
};
struct EpiPro {
    unsigned char* wmix;
    __device__ __forceinline__ void operator()(const f32x4 (&acc)[2][2][4][2], const UD& u, int wr, int wc, int fr, int fq, int tid) const {
        const int l = u.aux >> 3, h = u.aux & 7, p = u.pn;
        bf16_t* base; int ldc; float sc;
        if (u.kind == 0) { base = (bf16_t*)(wmix + (size_t)l * WMIX_STRIDE + OFF_WIN) + (size_t)(2048 + 256 * h) * 1024 + 256 * p; ldc = 1024; sc = 0.08838834764831845f; }
        else { base = (bf16_t*)(wmix + (size_t)l * WMIX_STRIDE + OFF_WVO) + (size_t)(256 * p) * 2048 + 256 * h; ldc = 2048; sc = 1.f; }
#pragma unroll
        for (int ai = 0; ai < 2; ++ai)
#pragma unroll
            for (int m = 0; m < 4; ++m) { bf16_t* rowp = base + (size_t)(ai * 128 + wr * 64 + m * 16 + fr) * ldc + wc * 32 + 8 * fq;
#pragma unroll
                for (int bj = 0; bj < 2; ++bj) *(u32x4*)(rowp + bj * 128) = pack8(acc[ai][bj][m][0] * sc, acc[ai][bj][m][1] * sc); }
    }
};

struct SchedDense {
    const char* A; const char* B; unsigned lda, ldb; int nt, nM, nN, G, c;
    __device__ __forceinline__ bool next(int i, UD& u) const {
        int pm, pn; if (!gs::tile_of((long)i * G + c, nM, nN, pm, pn)) return false;
        u.A = A + (size_t)pm * 256 * lda; u.B = B + (size_t)pn * 256 * ldb; u.lda = lda; u.ldb = ldb; u.nt = nt; u.kind = 0; u.pm = pm; u.pn = pn; u.aux = 0; return true;
    }
};
struct SchedMerge1 {
    const char *xb, *yrnn, *wg, *wpr; int G, c;
    __device__ __forceinline__ bool next(int i_, UD& u) const { int i = i_;
#ifdef DBG_DUPFIRST
        if (i > 0) i -= 1;
#endif
#ifdef DBG_ORDER201
        const int ti = i / 3, kk_ = i - 3 * ti, k = kk_ == 0 ? 2 : kk_ - 1;
#else
        const int ti = i / 3, k = i - 3 * ti;
#endif
        int pm, pn; if (!gs::tile_of((long)ti * G + c, T / 256, 4, pm, pn)) return false;
        u.kind = k; u.pm = pm; u.pn = pn; u.aux = 0; u.lda = 2048; u.ldb = 2048; u.nt = 16;
#ifdef DBG_K0_AS_K1
        if (k == 0) { u.A = yrnn + (size_t)pm * 256 * 2048; u.B = wpr + (size_t)pn * 256 * 2048; }
#else
        if (k == 0) { u.A = xb + (size_t)pm * 256 * 2048; u.B = wg + (size_t)pn * 256 * 2048; }
#endif
        else if (k == 1) { u.A = yrnn + (size_t)pm * 256 * 2048; u.B = wpr + (size_t)pn * 256 * 2048; }
        else { u.A = xb + (size_t)pm * 256 * 2048; u.B = wg + (size_t)(1024 + pn * 256) * 2048; }
        return true;
    }
};
struct SchedMoE {
    const char* A; const char* B; unsigned lda, ldb; size_t bstride; int nt, nN, G, c; const LAS int* offp;
    __device__ __forceinline__ bool next(int i, UD& u) const {
        const int nM = offp[16] >> 8; int pm, pn; if (!gs::tile_of((long)i * G + c, nM, nN, pm, pn)) return false;
        int e = 0;
#pragma unroll 1
        for (int j = 1; j < 16; ++j) e += (pm * 256 >= offp[j]) ? 1 : 0;
        u.A = A + (size_t)pm * 256 * lda; u.B = B + (size_t)e * bstride + (size_t)pn * 256 * ldb; u.lda = lda; u.ldb = ldb; u.nt = nt; u.kind = 0; u.pm = pm; u.pn = pn; u.aux = e; return true;
    }
};
struct SchedMoEG {
    const char* A; const char* B; unsigned lda, ldb; size_t bstride; int nt, nN, G, c; const LAS int* offp; const int* rmap;
    __device__ __forceinline__ bool next(int i, UD& u) const {
        const int nM = offp[16] >> 8; int pm, pn; if (!gs::tile_of((long)i * G + c, nM, nN, pm, pn)) return false;
        int e = 0;
#pragma unroll 1
        for (int j = 1; j < 16; ++j) e += (pm * 256 >= offp[j]) ? 1 : 0;
        u.A = A; u.B = B + (size_t)e * bstride + (size_t)pn * 256 * ldb; u.lda = lda; u.ldb = ldb; u.nt = nt; u.kind = 0; u.pm = pm; u.pn = pn; u.aux = e; return true;
    }
};
struct SchedPro {
    const unsigned char* tmp; int G, c;
    __device__ __forceinline__ bool next(int i, UD& u) const {
        const long L = (long)i * G + c; if (L >= 256) return false;
        const int kind = (int)(L >> 7), l = (int)(L >> 5) & 3, h = (int)(L >> 2) & 7, p = (int)L & 3;
        u.kind = kind; u.aux = l * 8 + h; u.pm = 0; u.pn = p; u.nt = 4; u.lda = 2048; u.ldb = 2048;
        if (kind == 0) { u.A = (const char*)tmp + R_UKP + ((size_t)(l * 8 + h) * 256) * 2048;
                         u.B = (const char*)tmp + R_WQ + (size_t)l * 2 * MiB + (size_t)(256 * p) * 2048 + (size_t)(h >> 1) * 512; }
        else { u.A = (const char*)tmp + R_PT + (size_t)l * 2 * MiB + (size_t)(256 * p) * 2048 + (size_t)(h >> 1) * 512;
               u.B = (const char*)tmp + R_UVP + ((size_t)(l * 8 + h) * 256) * 2048; }
        return true;
    }
};

__device__ __forceinline__ void tr_item(const float* src, int ld, int c0, int nvalid, bf16_t* dst, int lddst, int mode, int item, int nblk, LAS float* scr, int lane) {
    const int kb = item / nblk, nb = item - kb * nblk, k0 = 64 * kb, n0 = 32 * nb;
    const int cc = 4 * (lane & 7); const bool ok = n0 + cc < nvalid;
    f32x4 tv_[8];
#pragma unroll
    for (int i = 0; i < 8; ++i) { const int kk = 8 * i + (lane >> 3); tv_[i] = ok ? *(const f32x4*)(src + (size_t)(k0 + kk) * ld + c0 + n0 + cc) : (f32x4){0.f, 0.f, 0.f, 0.f}; }
#pragma unroll
    for (int i = 0; i < 8; ++i) { const int kk = 8 * i + (lane >> 3);
#pragma unroll
        for (int j = 0; j < 4; ++j) scr[kk * 33 + cc + j] = tv_[i][j]; }
    asm volatile("s_waitcnt lgkmcnt(0)" ::: "memory");
    const int c = lane & 7;
#pragma unroll
    for (int j = 0; j < 4; ++j) { const int nl = (lane >> 3) + 8 * j; const int nn = n0 + nl; const int row = mode ? (8 * (nn >> 2) + (nn & 3)) : nn; const LAS float* s = scr + (8 * c) * 33 + nl;
        u32x4 o; o.x = pk2(s[0 * 33], s[1 * 33]); o.y = pk2(s[2 * 33], s[3 * 33]); o.z = pk2(s[4 * 33], s[5 * 33]); o.w = pk2(s[6 * 33], s[7 * 33]);
        *(u32x4*)(dst + (size_t)row * lddst + k0 + 8 * c) = o; }
    asm volatile("s_waitcnt lgkmcnt(0)" ::: "memory");
}
__device__ __forceinline__ float expm1_acc(float x) {
    if (x > -0.35f) { float p = 1.0f + x * (1.0f / 8.0f); p = 1.0f + x * (1.0f / 7.0f) * p; p = 1.0f + x * (1.0f / 6.0f) * p; p = 1.0f + x * (1.0f / 5.0f) * p; p = 1.0f + x * 0.25f * p; p = 1.0f + x * (1.0f / 3.0f) * p; p = 1.0f + x * 0.5f * p; return x * p; }
    return fast_exp(x) - 1.0f;
}
struct RnnP { const bf16_t* xrnn; bf16_t* gy; float* tot; const bf16_t *waT, *wxT; const float *convw, *convb, *ba, *bx, *lam; };
template <int PASS>
__device__ __forceinline__ void rnn_item(const RnnP& P, int item, LAS unsigned char* wlds, int lane) {
    const int b = item >> 10, g = (item >> 6) & 15, seg = item & 63, ch0 = 64 * g;
    const int row = lane & 15, kg = lane >> 4, col = lane & 15;
    LAS float* CW = (LAS float*)wlds;
    LAS float* XR = CW + 320;
#pragma unroll
    for (int k = 0; k < 4; ++k) CW[k * 64 + lane] = P.convw[k * 1024 + ch0 + lane];
    CW[256 + lane] = P.convb[ch0 + lane];
    bf16x8 Ba[4][2], Bx[4][2];
#pragma unroll
    for (int jt = 0; jt < 4; ++jt)
#pragma unroll
        for (int s = 0; s < 2; ++s) { const size_t o = ((size_t)g * 64 + 16 * jt + col) * 64 + 32 * s + 8 * kg; Ba[jt][s] = *(const bf16x8*)(P.waT + o); Bx[jt][s] = *(const bf16x8*)(P.wxT + o); }
    float cba[4], cbx[4], sp8[4], h0[4], Pc[4];
#pragma unroll
    for (int jt = 0; jt < 4; ++jt) { const int ch = ch0 + 16 * jt + col; cba[jt] = -1.4426950408889634f * P.ba[ch]; cbx[jt] = -1.4426950408889634f * P.bx[ch]; const float lm = P.lam[ch]; sp8[jt] = -8.0f * 1.4426950408889634f * log1pf(expf(-lm));   h0[jt] = 0.f; Pc[jt] = 1.f; }
    float* totp = P.tot + ((size_t)(b * 64) * 1024 + ch0 + col) * 2;
    if (PASS == 2 && seg > 0) {
        const int Q = (seg + 3) >> 2, slo = kg * Q;
        float Pq[4] = {1.f, 1.f, 1.f, 1.f}, Hq[4] = {0.f, 0.f, 0.f, 0.f};
        for (int i0 = 0; i0 < Q; i0 += 4) {
            f32x2 ph[4][4];
#pragma unroll
            for (int i = 0; i < 4; ++i) { int s2 = slo + i0 + i; s2 = s2 < seg ? s2 : seg - 1;
#pragma unroll
                for (int jt = 0; jt < 4; ++jt) ph[i][jt] = *(const f32x2*)(totp + ((size_t)s2 * 1024 + 16 * jt) * 2); }
#pragma unroll
            for (int i = 0; i < 4; ++i) { const bool ok = (i0 + i < Q) && (slo + i0 + i < seg);
#pragma unroll
                for (int jt = 0; jt < 4; ++jt) { const float px = ok ? ph[i][jt].x : 1.f, hy = ok ? ph[i][jt].y : 0.f; Hq[jt] = px * Hq[jt] + hy; Pq[jt] = Pq[jt] * px; } }
        }
#pragma unroll
        for (int jt = 0; jt < 4; ++jt) {
            const float H0 = __shfl(Hq[jt], col), P1 = __shfl(Pq[jt], col + 16), H1 = __shfl(Hq[jt], col + 16), P2 = __shfl(Pq[jt], col + 32), H2 = __shfl(Hq[jt], col + 32),
                        P3 = __shfl(Pq[jt], col + 48), H3 = __shfl(Hq[jt], col + 48);
            float h = H0; h = P1 * h + H1; h = P2 * h + H2; h = P3 * h + H3; h0[jt] = h; }
    }
    asm volatile("s_waitcnt lgkmcnt(0)" ::: "memory");
    const size_t rowb = (size_t)b * SEQ;
    u32x4 xn[4][2];
    { const int tA0 = seg * 256 + row;
#pragma unroll
      for (int dt = 0; dt < 4; ++dt) { const int tt = tA0 - 3 + dt;
#pragma unroll
          for (int s = 0; s < 2; ++s) xn[dt][s] = (tt >= 0) ? *(const u32x4*)(P.xrnn + (rowb + tt) * 1024 + ch0 + 32 * s + 8 * kg) : (u32x4){0u, 0u, 0u, 0u}; } }
    for (int tile = 0; tile < 16; ++tile) {
        const int t0 = seg * 256 + tile * 16;
        u32x4 xw[4][2];
#pragma unroll
        for (int dt = 0; dt < 4; ++dt)
#pragma unroll
            for (int s = 0; s < 2; ++s) xw[dt][s] = xn[dt][s];
        if (tile + 1 < 16) { const int tB = t0 + 16 + row;
#pragma unroll
            for (int dt = 0; dt < 4; ++dt) { const int tt = tB - 3 + dt;
#pragma unroll
                for (int s = 0; s < 2; ++s) xn[dt][s] = *(const u32x4*)(P.xrnn + (rowb + tt) * 1024 + ch0 + 32 * s + 8 * kg); } }
        bf16_t gq[4][4];
        if (PASS == 2) { const bf16_t* gp0 = P.gy + (rowb + t0 + 4 * kg) * 1024 + ch0 + col;
#pragma unroll
            for (int jt = 0; jt < 4; ++jt)
#pragma unroll
                for (int r = 0; r < 4; ++r) gq[jt][r] = gp0[(size_t)r * 1024 + 16 * jt]; }
        bf16x8 Af[2];
#pragma unroll
        for (int s = 0; s < 2; ++s) {
            const int cl = 32 * s + 8 * kg;
            f32x4 o0 = *(LAS f32x4*)(CW + 256 + cl), o1 = *(LAS f32x4*)(CW + 256 + cl + 4);
#pragma unroll
            for (int dt = 0; dt < 4; ++dt) { const f32x4 w0 = *(LAS f32x4*)(CW + dt * 64 + cl), w1 = *(LAS f32x4*)(CW + dt * 64 + cl + 4); const u32x4 x = xw[dt][s];
                o0[0] += w0[0] * bf_lo(x.x); o0[1] += w0[1] * bf_hi(x.x); o0[2] += w0[2] * bf_lo(x.y); o0[3] += w0[3] * bf_hi(x.y);
                o1[0] += w1[0] * bf_lo(x.z); o1[1] += w1[1] * bf_hi(x.z); o1[2] += w1[2] * bf_lo(x.w); o1[3] += w1[3] * bf_hi(x.w); }
            *(LAS f32x4*)(XR + row * 68 + cl) = o0; *(LAS f32x4*)(XR + row * 68 + cl + 4) = o1;
            const u32x4 pk = pack8(o0, o1); Af[s] = __builtin_bit_cast(bf16x8, pk);
        }
        f32x4 ar[4], ax[4];
#pragma unroll
        for (int jt = 0; jt < 4; ++jt) { ar[jt] = (f32x4){0.f, 0.f, 0.f, 0.f}; ax[jt] = ar[jt];
#pragma unroll
            for (int s = 0; s < 2; ++s) { ar[jt] = __builtin_amdgcn_mfma_f32_16x16x32_bf16(Af[s], Ba[jt][s], ar[jt], 0, 0, 0); ax[jt] = __builtin_amdgcn_mfma_f32_16x16x32_bf16(Af[s], Bx[jt][s], ax[jt], 0, 0, 0); } }
        asm volatile("s_waitcnt lgkmcnt(0)" ::: "memory");
#pragma unroll
        for (int jt = 0; jt < 4; ++jt) {
            float Pp[4], Hp[4]; float pr = 1.f, hr = 0.f;
#pragma unroll
            for (int r = 0; r < 4; ++r) {
                const float xr = XR[(4 * kg + r) * 68 + 16 * jt + col];
                const float rg = fast_rcp(1.0f + __builtin_amdgcn_exp2f(__builtin_fmaf(ar[jt][r], -1.4426950408889634f, cba[jt]))), ig = fast_rcp(1.0f + __builtin_amdgcn_exp2f(__builtin_fmaf(ax[jt][r], -1.4426950408889634f, cbx[jt])));
                const float a = __builtin_amdgcn_exp2f(sp8[jt] * rg); const float em = a - 1.0f;
                const float mm = __builtin_amdgcn_sqrtf(fmaxf(-em * (2.0f + em), 0.f));
                const float uu = mm * ig * xr;
                hr = a * hr + uu; pr = pr * a; Pp[r] = pr; Hp[r] = hr;
            }
            const float P0 = __shfl(pr, col), P1 = __shfl(pr, col + 16), P2 = __shfl(pr, col + 32), P3 = __shfl(pr, col + 48);
            const float H0 = __shfl(hr, col), H1 = __shfl(hr, col + 16), H2 = __shfl(hr, col + 32), H3 = __shfl(hr, col + 48);
            const float h1 = P0 * h0[jt] + H0, h2 = P1 * h1 + H1, h3 = P2 * h2 + H2, h4 = P3 * h3 + H3;
            if (PASS == 2) {
                const float hs = kg == 0 ? h0[jt] : (kg == 1 ? h1 : (kg == 2 ? h2 : h3));
                bf16_t* gp = P.gy + (rowb + t0 + 4 * kg) * 1024 + ch0 + 16 * jt + col;
#pragma unroll
                for (int r = 0; r < 4; ++r) { const float hv = Pp[r] * hs + Hp[r]; const float gg = bf2f(gq[jt][r]); gp[(size_t)r * 1024] = (bf16_t)pk2(hv * gg, 0.f); }
            } else Pc[jt] = Pc[jt] * (P0 * P1) * (P2 * P3);
            h0[jt] = h4;
        }
    }
    if (PASS == 1 && kg == 0) {
#pragma unroll
        for (int jt = 0; jt < 4; ++jt) *(f32x2*)(totp + ((size_t)seg * 1024 + 16 * jt) * 2) = (f32x2){Pc[jt], h0[jt]};
    }
}
__device__ __forceinline__ void ckv_norm_rows4(bf16_t* base, int row0, int rstep, int nrows, const float* gain, int lane) {
    u32x2 w[4];
#pragma unroll
    for (int i = 0; i < 4; ++i) { const int r = row0 + i * rstep; w[i] = *(const u32x2*)(base + (size_t)(r < nrows ? r : row0) * 256 + 4 * lane); }
    const f32x4 gn = *(const f32x4*)(gain + 4 * lane);
#pragma unroll
    for (int i = 0; i < 4; ++i) { const int r = row0 + i * rstep;
        const float v0 = bf_lo(w[i].x), v1 = bf_hi(w[i].x), v2 = bf_lo(w[i].y), v3 = bf_hi(w[i].y);
        const float ss = wave_sum(v0 * v0 + v1 * v1 + v2 * v2 + v3 * v3);
        const float rs = 1.0f / __builtin_sqrtf(ss * (1.0f / 256.0f) + RMS_EPS);
        u32x2 o; o.x = pk2(v0 * rs * gn[0], v1 * rs * gn[1]); o.y = pk2(v2 * rs * gn[2], v3 * rs * gn[3]);
        if (r < nrows) *(u32x2*)(base + (size_t)r * 256 + 4 * lane) = o; }
}
constexpr int AT_CAND = 0, AT_KBUF = 65536, AT_KROW = 144, AT_KCH = 256 * AT_KROW, AT_SEL = 139264, AT_BIAS = 155648, AT_BKT = 156672, AT_GROW = 544, AT_GBUF = 32 * AT_GROW;
constexpr int AT_NBIN = 512, AT_CAP = 256, AT_LCAP = 1024, AT_TIEF = 157184, AT_BIAS2 = 157440;
#ifndef AT_SAMPLE_MIN_U
#define AT_SAMPLE_MIN_U 64
#endif
#ifndef AT_LBREF
#define AT_LBREF 0
#endif
struct AttnP { const bf16_t *qidx, *kidx, *ckv; const float* widx; bf16_t* qlat; unsigned long long* cbuf; };

__device__ __forceinline__ unsigned ord_key(float s) { const unsigned b = __builtin_bit_cast(unsigned, s); return (b & 0x80000000u) ? ~b : (b | 0x80000000u); }

__device__ __forceinline__ void hist_scan(const LAS unsigned* hq, int lane, int kth, int& bsel, int& cat, int& abat) {
    const u32x4 w0 = *(const LAS u32x4*)(hq + 8 * lane), w1 = *(const LAS u32x4*)(hq + 8 * lane + 4);
    int cnt[8];
    cnt[0] = (int)w0.x; cnt[1] = (int)w0.y; cnt[2] = (int)w0.z; cnt[3] = (int)w0.w; cnt[4] = (int)w1.x; cnt[5] = (int)w1.y; cnt[6] = (int)w1.z; cnt[7] = (int)w1.w;
    int s = 0;
#pragma unroll
    for (int i = 0; i < 8; ++i) s += cnt[i];
    int S = s;
#pragma unroll
    for (int off = 1; off < 64; off <<= 1) { const int v = __shfl_down(S, off); if (lane + off < 64) S += v; }
    bsel = -1; cat = 0; abat = 0;
    const unsigned long long mk = __ballot(S >= kth);
    if (mk != 0ull) {
        const int Ls = 63 - __builtin_clzll(mk);
        int above = S - s; bool found = false;
#pragma unroll
        for (int bb = 7; bb >= 0; --bb) { const int c = cnt[bb]; if (!found && above + c >= kth) { bsel = 8 * lane + bb; cat = c; abat = above; found = true; } above += c; }
        bsel = __shfl(bsel, Ls); cat = __shfl(cat, Ls); abat = __shfl(abat, Ls);
    }
}
__device__ __forceinline__ int key_row(int r, bool sm, int u) { if (sm) { r = r * 8 + (u & 7); r = r < SEQ ? r : SEQ - 1; } return r; }
template <int MODE>
__device__ __forceinline__ void attn_pass(LAS unsigned char* lds, const bf16x8 (&afr)[4], const float (&wq)[2][9], const bf16_t* kbase, int u, int wave, int lane, int tid,
                                          const int (&b0e)[2], const int (&neede)[2], const int (&tiee)[2], int (&csel)[2], int (&ccand)[2], unsigned long long* cbw, int samp = 0) {
    const int hh = lane >> 5, kcol = lane & 31;
    LAS unsigned* HIST = (LAS unsigned*)lds; LAS unsigned long long* CAND = (LAS unsigned long long*)(lds + AT_CAND); LAS unsigned short* SEL = (LAS unsigned short*)(lds + AT_SEL);
    const bool sm = (MODE == 0) && (samp != 0);
    const int nst = u >> 3, nch = sm ? ((nst + 7) >> 3) : (u >> 3) + 1;
    float lbt[2];
#pragma unroll
    for (int e = 0; e < 2; ++e) lbt[e] = ((MODE == 1 || MODE == 3) && b0e[e] >= 1) ? (float)b0e[e] : -3.0e38f;
    u32x4 st[4];
    const int lofs = (tid >> 3) * AT_KROW + (tid & 7) * 16;
#define AT_KADDR(C, I) (kbase + (size_t)key_row((C) * 256 + (tid >> 3) + 64 * (I), sm, u) * 64 + (tid & 7) * 8)
#pragma unroll
    for (int i = 0; i < 4; ++i) st[i] = *(const u32x4*)AT_KADDR(0, i);
#pragma unroll
    for (int i = 0; i < 4; ++i) *(LAS u32x4*)(lds + AT_KBUF + lofs + i * 64 * AT_KROW) = st[i];
    __syncthreads();
    for (int c = 0; c < nch; ++c) {
        if (c + 1 < nch) {
#pragma unroll
            for (int i = 0; i < 4; ++i) st[i] = *(const u32x4*)AT_KADDR(c + 1, i);
        }
        const LAS unsigned char* kb = lds + AT_KBUF + (c & 1) * AT_KCH + kcol * AT_KROW + hh * 16;
        const int ntile = sm ? ((nst - 8 * c) < 8 ? (nst - 8 * c) : 8) : ((c + 1 < nch) ? 8 : (u & 7) + 1);
#define AT_READ(BF, TT) do { _Pragma("unroll") for (int ks = 0; ks < 4; ++ks) BF[ks] = *(const LAS bf16x8*)(kb + (TT) * 32 * AT_KROW + ks * 32); } while (0)
#define AT_MFMA(ACC, BF) do { _Pragma("unroll") for (int i_ = 0; i_ < 16; ++i_) ACC[i_] = 0.f; \
            _Pragma("unroll") for (int ks = 0; ks < 4; ++ks) ACC = __builtin_amdgcn_mfma_f32_32x32x16_bf16(afr[ks], BF[ks], ACC, 0, 0, 0); } while (0)
          \

#define AT_POST(ACC, KT, DIAG) do { const int kt = (KT); \
            float sc[2]; \
            _Pragma("unroll") for (int e = 0; e < 2; ++e) { float s = 0.f; \
                _Pragma("unroll") for (int i = 0; i < 8; ++i) s = __builtin_fmaf(wq[e][i], __builtin_amdgcn_fmed3f(ACC[8 * e + i], 0.f, 3.0e38f), s); \
                sc[e] = s; } \
            _Pragma("unroll") for (int e = 0; e < 2; ++e) { \
                const int q = 4 * wave + 2 * hh + e; \
                const float tv = __builtin_fmaf(sc[e], wq[e][8], 256.0f); \
                const bool cz = !(DIAG) || (kt < u) || (kcol <= q); \
                const bool live = cz && tv >= lbt[e]; \
                if (MODE == 3) { \
                    const unsigned long long m3 = __ballot(live); \
                    { \
                        const unsigned h3 = hh ? (unsigned)(m3 >> 32) : (unsigned)m3; \
                        const int pa = ccand[e] + __builtin_popcount(h3 & ((1u << kcol) - 1u)); \
                        if (live) { u32x2 ent;      \
                             ent.x = (unsigned)(kt * 32 + kcol); ent.y = __builtin_bit_cast(unsigned, sc[e]); \
                            *(u32x2*)((char*)cbw + ((unsigned)((2 * hh + e) * AT_LCAP + pa) * 8u)) = ent; } \
                        ccand[e] += __builtin_popcount(h3); \
                    } \
                } else if (MODE == 0) { \
                    const int bin = (int)__builtin_amdgcn_fmed3f(tv, 0.0f, 511.5f); \
                    LAS unsigned* hp = HIST + q * AT_NBIN + bin; \
                    if (cz) __hip_atomic_fetch_add(hp, 1u, __ATOMIC_RELAXED, __HIP_MEMORY_SCOPE_WORKGROUP); \
                } else if (__ballot(live) != 0ull) { \
                    const int bin = (int)__builtin_amdgcn_fmed3f(tv, 0.0f, 511.5f); \
                    const int key = kt * 32 + kcol; \
                    const bool cc = live && bin == b0e[e]; \
                    const unsigned long long m2 = __ballot(cc); const unsigned h2 = hh ? (unsigned)(m2 >> 32) : (unsigned)m2; \
                    const int pc = ccand[e] + __builtin_popcount(h2 & ((1u << kcol) - 1u)); \
                    if (cc && !tiee[e] && pc < AT_CAP) CAND[q * AT_CAP + pc] = ((unsigned long long)ord_key(sc[e]) << 32) | (unsigned)(0xFFFFu - key); \
                    ccand[e] += __builtin_popcount(h2); \
                    const bool cs = live && (bin > b0e[e] || (tiee[e] && cc && pc < neede[e])); \
                    const unsigned long long m1 = __ballot(cs); const unsigned h1 = hh ? (unsigned)(m1 >> 32) : (unsigned)m1; \
                    if (cs) SEL[q * 256 + csel[e] + __builtin_popcount(h1 & ((1u << kcol) - 1u))] = (unsigned short)key; \
                    csel[e] += __builtin_popcount(h1); \
                } \
            } } while (0)
#define AT_TILES(NT, DIAG, PRAG) do { \
        AT_READ(B0, 0); if ((NT) > 1) AT_READ(B1, 1); \
        AT_MFMA(accA, B0); \
        PRAG for (int tt = 0; tt < (NT); tt += 2) { \
            if (tt + 2 < (NT)) AT_READ(B0, tt + 2); \
            if (tt + 1 < (NT)) AT_MFMA(accB, B1); \
            AT_POST(accA, c * 8 + tt, DIAG); \
            if (tt + 1 < (NT)) { \
                if (tt + 3 < (NT)) AT_READ(B1, tt + 3); \
                if (tt + 2 < (NT)) AT_MFMA(accA, B0); \
                AT_POST(accB, c * 8 + tt + 1, DIAG); \
            } \
        } } while (0)
        f32x16 accA, accB; bf16x8 B0[4], B1[4];
        if (sm ? (ntile == 8) : (c + 1 < nch)) AT_TILES(8, false, _Pragma("unroll"));
        else AT_TILES(ntile, true, _Pragma("unroll 1"));
#undef AT_TILES
#undef AT_POST
#undef AT_KADDR
#undef AT_READ
#undef AT_MFMA
        if (MODE == 0 && AT_LBREF && c + 1 < nch && (c < 4 || (c & 3) == 3)) {
#pragma unroll
            for (int q = 0; q < 4; ++q) { int bs, c1, c2; hist_scan(HIST + (4 * wave + q) * AT_NBIN, lane, 256, bs, c1, c2);
                const float lb = bs >= 1 ? (float)bs : -3.0e38f;
                if ((q >> 1) == hh) lbt[q & 1] = lb; }
        }
        if (c + 1 < nch) {
#pragma unroll
            for (int i = 0; i < 4; ++i) *(LAS u32x4*)(lds + AT_KBUF + ((c + 1) & 1) * AT_KCH + lofs + i * 64 * AT_KROW) = st[i];
        }
        __syncthreads();
    }
}

__device__ __forceinline__ void attn_unit(LAS unsigned char* lds, const AttnP& P, int b, int u, int tid_) {
    int tid = tid_; asm volatile("" : "+v"(tid));
    const int wave = __builtin_amdgcn_readfirstlane(tid >> 6), lane = tid & 63, hh = lane >> 5, kcol = lane & 31;
    LAS unsigned* HIST = (LAS unsigned*)lds; LAS unsigned long long* CAND = (LAS unsigned long long*)(lds + AT_CAND); LAS unsigned short* SEL = (LAS unsigned short*)(lds + AT_SEL);
    const LAS float* BIAS2 = (const LAS float*)(lds + AT_BIAS2);
    const int t0 = 32 * u; const size_t rowb = (size_t)b * SEQ;
    __syncthreads();
#pragma unroll
    for (int i = 0; i < 8; ++i) *(LAS u32x4*)(lds + (i * 512 + tid) * 16) = (u32x4){0u, 0u, 0u, 0u};
    if (tid == 0) *(LAS unsigned*)(lds + AT_TIEF) = 0u;
    bf16x8 afr[4]; float wq[2][9];
    { const int rho = kcol, j = rho >> 3, r = rho & 3, hq = (rho >> 2) & 1, head = 4 * (j & 1) + r, qloc = 2 * hq + (j >> 1);
      const bf16_t* qp = P.qidx + (rowb + t0 + 4 * wave + qloc) * 512 + head * 64 + 8 * hh;
#pragma unroll
      for (int ks = 0; ks < 4; ++ks) afr[ks] = *(const bf16x8*)(qp + ks * 16);
#pragma unroll
      for (int e = 0; e < 2; ++e) { const float* wp = P.widx + (rowb + t0 + 4 * wave + 2 * hh + e) * 8; const f32x4 a = *(const f32x4*)wp, c = *(const f32x4*)(wp + 4);
          wq[e][0] = a[0]; wq[e][1] = a[1]; wq[e][2] = a[2]; wq[e][3] = a[3]; wq[e][4] = c[0]; wq[e][5] = c[1]; wq[e][6] = c[2]; wq[e][7] = c[3];
          const float ss = (a[0] * a[0] + a[1] * a[1]) + (a[2] * a[2] + a[3] * a[3]) + (c[0] * c[0] + c[1] * c[1]) + (c[2] * c[2] + c[3] * c[3]);
          wq[e][8] = 32.0f / __builtin_sqrtf(fmaxf(ss, 1.0e-12f)); } }
    const bf16_t* kbase = P.kidx + rowb * 64;
    int b0e[2] = {0, 0}, neede[2] = {0, 0}, tiee[2] = {0, 0}, csel[2] = {0, 0}, ccand[2] = {0, 0};
    int b0q[4], needq[4], nb0q[4], csq[4];
    unsigned long long* cbw = P.cbuf + (size_t)(4 * wave) * AT_LCAP;
#pragma unroll 1
    for (int att = (u >= AT_SAMPLE_MIN_U) ? 0 : 1; att < 2; ++att) {
        int tl = tid; asm volatile("" : "+v"(tl));
        const int ll = tl & 63, hl = ll >> 5;
        if (att == 1 && u >= AT_SAMPLE_MIN_U) {
            __syncthreads();
#pragma unroll
            for (int i = 0; i < 8; ++i) *(LAS u32x4*)(lds + (i * 512 + tl) * 16) = (u32x4){0u, 0u, 0u, 0u};
            if (tl == 0) *(LAS unsigned*)(lds + AT_TIEF) = 0u;
        }
        csel[0] = 0; csel[1] = 0; ccand[0] = 0; ccand[1] = 0;
        attn_pass<0>(lds, afr, wq, kbase, u, wave, ll, tl, b0e, neede, tiee, csel, ccand, nullptr, att == 0 ? 1 : 0);
        const int kth = att == 0 ? 64 : 256;
#pragma unroll
        for (int q = 0; q < 4; ++q) {
            const int nq = t0 + 4 * wave + q + 1;
            int bsel, cat, abat; hist_scan(HIST + (4 * wave + q) * AT_NBIN, ll, kth, bsel, cat, abat);
            if (att == 1 && nq <= 256) { bsel = -1; cat = 0; abat = 0; }
            b0q[q] = bsel; nb0q[q] = cat; needq[q] = (nq > 256) ? (256 - abat) : 0;
        }
        b0e[0] = hl ? b0q[2] : b0q[0]; b0e[1] = hl ? b0q[3] : b0q[1];
        neede[0] = hl ? needq[2] : needq[0]; neede[1] = hl ? needq[3] : needq[1];
        tiee[0] = (att == 1) && ((hl ? nb0q[2] : nb0q[0]) > AT_CAP); tiee[1] = (att == 1) && ((hl ? nb0q[3] : nb0q[1]) > AT_CAP);
        if ((tiee[0] | tiee[1]) != 0) *(LAS unsigned*)(lds + AT_TIEF) = 1u;
        __syncthreads();
        if (att == 1 && *(const LAS unsigned*)(lds + AT_TIEF) != 0u) {
            attn_pass<1>(lds, afr, wq, kbase, u, wave, ll, tl, b0e, neede, tiee, csel, ccand, cbw);
#pragma unroll
            for (int q = 0; q < 4; ++q) { const int cv = (q & 1) ? csel[1] : csel[0]; csq[q] = __builtin_amdgcn_readlane(cv, (q >> 1) * 32); }
            break;
        }
        if (att == 0) {
#pragma unroll
            for (int i = 0; i < 8; ++i) *(LAS u32x4*)(lds + wave * 8192 + (i * 64 + ll) * 16) = (u32x4){0u, 0u, 0u, 0u};
        }
        attn_pass<3>(lds, afr, wq, kbase, u, wave, ll, tl, b0e, neede, tiee, csel, ccand, cbw);
        asm volatile("s_waitcnt vmcnt(0)" ::: "memory");
        if (att == 0) {
            bool ok = true;
#pragma unroll
            for (int q = 0; q < 4; ++q) {
                const int cv = (q & 1) ? ccand[1] : ccand[0]; const int nraw = __builtin_amdgcn_readlane(cv, (q >> 1) * 32); ok = ok && nraw >= 256 && nraw <= AT_LCAP;
                const int n = nraw > AT_LCAP ? AT_LCAP : nraw;
                const float scl = (q & 2) ? __shfl(wq[q & 1][8], 32) : __shfl(wq[q & 1][8], 0);
                unsigned long long ent[AT_LCAP / 64];
#pragma unroll
                for (int j = 0; j < AT_LCAP / 64; ++j) { const int i = 64 * j + ll; ent[j] = (i < n) ? __builtin_nontemporal_load(cbw + q * AT_LCAP + i) : 0ull; }
#pragma unroll
                for (int j = 0; j < AT_LCAP / 64; ++j) { const int i = 64 * j + ll; const float scv = __builtin_bit_cast(float, (unsigned)(ent[j] >> 32));
                    const int bin = (int)__builtin_amdgcn_fmed3f(__builtin_fmaf(scv, scl, 256.0f), 0.0f, 511.5f);
                    if (i < n) __hip_atomic_fetch_add(HIST + (4 * wave + q) * AT_NBIN + bin, 1u, __ATOMIC_RELAXED, __HIP_MEMORY_SCOPE_WORKGROUP); }
                asm volatile("s_waitcnt lgkmcnt(0)" ::: "memory");
                int bsel, cat, abat; hist_scan(HIST + (4 * wave + q) * AT_NBIN, ll, 256, bsel, cat, abat);
                ok = ok && bsel >= 0;
                b0q[q] = bsel; nb0q[q] = cat; needq[q] = 256 - abat;
                const int b0 = bsel, need = 256 - abat; const bool tieq = cat > AT_CAP;
                int cs = 0, cc = 0;
#pragma unroll
                for (int j = 0; j < AT_LCAP / 64; ++j) {
                    if (64 * j < n) {
                        const unsigned long long v = ent[j]; const bool in = 64 * j + ll < n;
                        const float scv = __builtin_bit_cast(float, (unsigned)(v >> 32));
                        const int bin = (int)__builtin_amdgcn_fmed3f(__builtin_fmaf(scv, scl, 256.0f), 0.0f, 511.5f);
                        const bool isc = in && bin == b0;
                        const unsigned long long mc = __ballot(isc);
                        const int pc = cc + __builtin_popcountll(mc & ((1ull << ll) - 1ull));
                        const bool isa = in && (bin > b0 || (tieq && isc && pc < need));
                        const unsigned long long ms = __ballot(isa);
                        const int ps = cs + __builtin_popcountll(ms & ((1ull << ll) - 1ull));
                        if (isa && ps < 256) SEL[(4 * wave + q) * 256 + ps] = (unsigned short)(v & 0xFFFFu);
                        if (isc && !tieq && pc < AT_CAP) CAND[(4 * wave + q) * AT_CAP + pc] = ((unsigned long long)ord_key(scv) << 32) | (unsigned)(0xFFFFu - (unsigned)(v & 0xFFFFu));
                        cs += __builtin_popcountll(ms); cc += __builtin_popcountll(mc);
                    }
                }
                csq[q] = cs;
                asm volatile("" ::: "memory");
            }
            if (!ok) *(LAS unsigned*)(lds + AT_TIEF) = 1u;
            __syncthreads();
            if (*(const LAS unsigned*)(lds + AT_TIEF) != 0u) continue;
            break;
        }
#pragma unroll
        for (int q = 0; q < 4; ++q) {
            const int cv = (q & 1) ? ccand[1] : ccand[0]; int n = __builtin_amdgcn_readlane(cv, (q >> 1) * 32); n = n > AT_LCAP ? AT_LCAP : n;
            const int b0 = b0q[q], need = needq[q]; const bool tieq = nb0q[q] > AT_CAP;
            const float scl = (q & 2) ? __shfl(wq[q & 1][8], 32) : __shfl(wq[q & 1][8], 0);
            int cs = 0, cc = 0;
#pragma unroll
            for (int jb = 0; jb < AT_LCAP / 256; ++jb) {
                if (256 * jb < n) {
                    unsigned long long ent[4];
#pragma unroll
                    for (int j = 0; j < 4; ++j) { const int i = 256 * jb + 64 * j + ll; ent[j] = (i < n) ? __builtin_nontemporal_load(cbw + q * AT_LCAP + i) : 0ull; }
#pragma unroll
                    for (int j = 0; j < 4; ++j) {
                        const unsigned long long v = ent[j]; const bool in = 256 * jb + 64 * j + ll < n;
                        const float scv = __builtin_bit_cast(float, (unsigned)(v >> 32));
                        const int bin = (int)__builtin_amdgcn_fmed3f(__builtin_fmaf(scv, scl, 256.0f), 0.0f, 511.5f);
                        const bool isc = in && bin == b0;
                        const unsigned long long mc = __ballot(isc);
                        const int pc = cc + __builtin_popcountll(mc & ((1ull << ll) - 1ull));
                        const bool isa = in && (bin > b0 || (tieq && isc && pc < need));
                        const unsigned long long ms = __ballot(isa);
                        if (isa) SEL[(4 * wave + q) * 256 + cs + __builtin_popcountll(ms & ((1ull << ll) - 1ull))] = (unsigned short)(v & 0xFFFFu);
                        if (isc && !tieq && pc < AT_CAP) CAND[(4 * wave + q) * AT_CAP + pc] = ((unsigned long long)ord_key(scv) << 32) | (unsigned)(0xFFFFu - (unsigned)(v & 0xFFFFu));
                        cs += __builtin_popcountll(ms); cc += __builtin_popcountll(mc);
                    }
                }
            }
            csq[q] = cs;
            asm volatile("" ::: "memory");
        }
        break;
    }
    int nselq[4];
#pragma unroll
    for (int q = 0; q < 4; ++q) {
        int cs = csq[q];
        const int need = needq[q], nb0 = nb0q[q];
        if (need > 0 && nb0 <= AT_CAP) {
            const int nc = nb0;
            const LAS unsigned long long* cq = CAND + (4 * wave + q) * AT_CAP;
            for (int i0 = 0; i0 < nc; i0 += 64) {
                const int i = i0 + lane; const unsigned long long mine = (i < nc) ? cq[i] : 0ull;
                int rank = 0; for (int j = 0; j < nc; ++j) rank += (cq[j] > mine) ? 1 : 0;
                const bool pick = (i < nc) && rank < need;
                const unsigned long long mk = __ballot(pick);
                if (pick) SEL[(4 * wave + q) * 256 + cs + __builtin_popcountll(mk & ((1ull << lane) - 1ull))] = (unsigned short)(0xFFFFu - (unsigned)(mine & 0xFFFFu));
                cs += __builtin_popcountll(mk);
            }
        }
        nselq[q] = cs;
    }
    asm volatile("s_waitcnt lgkmcnt(0)" ::: "memory");
#ifdef DBG_TIME_ATT
    if (tid == 0) { const unsigned tn_ = (unsigned)__builtin_amdgcn_s_memrealtime(); ((LAS unsigned*)(lds + LDS_MISC))[19] += tn_ - tk0; tk0 = tn_; }
#endif
    __syncthreads();
    LAS unsigned char* gb = lds + wave * AT_GBUF;
    const int n = lane & 15, kg = lane >> 4, head = n & 7;
#pragma unroll 1
    for (int qi = 0; qi < 4; ++qi) {
        const int q = 4 * wave + qi, t = t0 + q;
        const int nsel = qi == 0 ? nselq[0] : (qi == 1 ? nselq[1] : (qi == 2 ? nselq[2] : nselq[3]));
        const LAS unsigned short* sel = SEL + q * 256;
        bf16_t* qrow = P.qlat + (rowb + t) * 2048;
        bf16x8 qb[8];
#pragma unroll
        for (int ks = 0; ks < 8; ++ks) { qb[ks] = (bf16x8){0, 0, 0, 0, 0, 0, 0, 0}; if (n < 8) qb[ks] = *(const bf16x8*)(qrow + n * 256 + 32 * ks + 8 * kg); }
        f32x4 oacc[16];
#pragma unroll
        for (int mt = 0; mt < 16; ++mt) oacc[mt] = (f32x4){0.f, 0.f, 0.f, 0.f};
        float mrun = -1e30f, lrun = 0.f;
        const int nchunk = (nsel + 31) >> 5;
#pragma unroll 1
        for (int c = 0; c < nchunk; ++c) {
            const int jn = 32 * c + kcol; const int idxc = (jn < nsel) ? (int)sel[jn] : 0;
            { u32x4 pre[16];
              const unsigned offc = ((unsigned)rowb + (unsigned)idxc) * 512u;
#pragma unroll
              for (int i = 0; i < 16; ++i) { const unsigned o0 = (unsigned)__builtin_amdgcn_readlane((int)offc, 2 * i), o1 = (unsigned)__builtin_amdgcn_readlane((int)offc, 2 * i + 1);
                  pre[i] = *(const u32x4*)((const char*)P.ckv + ((hh ? o1 : o0) + (unsigned)kcol * 16u)); }
#pragma unroll
              for (int i = 0; i < 16; ++i) *(LAS u32x4*)(gb + (2 * i + hh) * AT_GROW + kcol * 16) = pre[i];
            }
            f32x4 st[2];
#pragma unroll
            for (int k2 = 0; k2 < 2; ++k2) { st[k2] = (f32x4){0.f, 0.f, 0.f, 0.f};
#pragma unroll
                for (int ks = 0; ks < 8; ++ks) { const bf16x8 a = *(const LAS bf16x8*)(gb + (16 * k2 + n) * AT_GROW + (32 * ks + 8 * kg) * 2); st[k2] = __builtin_amdgcn_mfma_f32_16x16x32_bf16(a, qb[ks], st[k2], 0, 0, 0); } }
            float mloc = -1e30f;
#pragma unroll
            for (int k2 = 0; k2 < 2; ++k2)
#pragma unroll
                for (int r = 0; r < 4; ++r) { const int jj = 16 * k2 + 4 * kg + r; const int idx = (32 * c + jj < nsel) ? (int)sel[32 * c + jj] : 0; int d = t - idx; d = d < 127 ? d : 127;
                    float lg = st[k2][r] + BIAS2[d * 8 + head]; if (32 * c + jj >= nsel) lg = -1e30f;
                    st[k2][r] = lg; mloc = fmaxf(mloc, lg); }
            if (c == 0) { mloc = fmaxf(mloc, __shfl_xor(mloc, 16)); mloc = fmaxf(mloc, __shfl_xor(mloc, 32)); mrun = mloc; }
            else if (__ballot(mloc > mrun + 60.0f) != 0ull) {
                mloc = fmaxf(mloc, __shfl_xor(mloc, 16)); mloc = fmaxf(mloc, __shfl_xor(mloc, 32));
                const float mnew = fmaxf(mrun, mloc), alpha = fast_exp(mrun - mnew);
                lrun = lrun * alpha; mrun = mnew;
#pragma unroll
                for (int mt = 0; mt < 16; ++mt) oacc[mt] = oacc[mt] * alpha;
            }
#pragma unroll
            for (int k2 = 0; k2 < 2; ++k2)
#pragma unroll
                for (int r = 0; r < 4; ++r) { const float p = fast_exp(st[k2][r] - mrun); st[k2][r] = p; lrun += p; }
            u32x4 pw; pw.x = pk2(st[0][0], st[0][1]); pw.y = pk2(st[0][2], st[0][3]); pw.z = pk2(st[1][0], st[1][1]); pw.w = pk2(st[1][2], st[1][3]);
            const bf16x8 pb = __builtin_bit_cast(bf16x8, pw);
            LAS unsigned char* tb = gb + (4 * kg + (n >> 2)) * AT_GROW + 8 * (n & 3);
#pragma unroll
            for (int mt = 0; mt < 16; ++mt) {
                const s16x4 v1 = __builtin_amdgcn_ds_read_tr16_b64_v4i16((LAS s16x4*)(tb + 32 * mt));
                const s16x4 v2 = __builtin_amdgcn_ds_read_tr16_b64_v4i16((LAS s16x4*)(tb + 16 * AT_GROW + 32 * mt));
                const bf16x8 av = (bf16x8){v1[0], v1[1], v1[2], v1[3], v2[0], v2[1], v2[2], v2[3]};
                oacc[mt] = __builtin_amdgcn_mfma_f32_16x16x32_bf16(av, pb, oacc[mt], 0, 0, 0);
            }
        }
        lrun += __shfl_xor(lrun, 16); lrun += __shfl_xor(lrun, 32);
        const float inv = 1.0f / lrun;
        if (n < 8) {
#pragma unroll
            for (int mt = 0; mt < 16; ++mt) { const f32x4 o = oacc[mt] * inv; u32x2 w; w.x = pk2(o[0], o[1]); w.y = pk2(o[2], o[3]); *(u32x2*)(qrow + n * 256 + 16 * mt + 4 * kg) = w; }
        }
    }
#ifdef DBG_TIME_ATT
    if (tid == 0) { const unsigned tn_ = (unsigned)__builtin_amdgcn_s_memrealtime(); ((LAS unsigned*)(lds + LDS_MISC))[20] += tn_ - tk0; tk0 = tn_; }
#endif
}
__device__ __forceinline__ void ln_finish(f32x4 (&v)[4], const float* gam, const float* bet, float* orow, bf16_t* brow, int lane) {
    float s = 0.f;
#pragma unroll
    for (int j = 0; j < 4; ++j) s += (v[j][0] + v[j][1]) + (v[j][2] + v[j][3]);
    const float mean = wave_sum(s) * (1.0f / 1024.0f); float s2 = 0.f;
#pragma unroll
    for (int j = 0; j < 4; ++j) { v[j] = v[j] - mean; s2 += (v[j][0] * v[j][0] + v[j][1] * v[j][1]) + (v[j][2] * v[j][2] + v[j][3] * v[j][3]); }
    const float rstd = 1.0f / __builtin_sqrtf(wave_sum(s2) * (1.0f / 1024.0f) + LN_EPS);
#pragma unroll
    for (int j = 0; j < 4; ++j) { const f32x4 g = *(const f32x4*)(gam + 256 * j + 4 * lane), bb = *(const f32x4*)(bet + 256 * j + 4 * lane);
        v[j] = v[j] * rstd * g + bb;
        if (orow != nullptr) *(f32x4*)(orow + 256 * j + 4 * lane) = v[j];
        u32x2 w; w.x = pk2(v[j][0], v[j][1]); w.y = pk2(v[j][2], v[j][3]); *(u32x2*)(brow + 256 * j + 4 * lane) = w; }
}
struct RouteP { int* r_e; int* r_pos; int* r_slot; float* r_g; unsigned* gcnt; };

__device__ __forceinline__ void ln1_route_block(LAS unsigned char* lds, int blk, float* xo, bf16_t* xb, const float* gam, const float* bet, const float* rbias, const RouteP& R, int tid) {
    const int wave = __builtin_amdgcn_readfirstlane(tid >> 6), lane = tid & 63;
    const LAS float* WR = (const LAS float*)lds; LAS int* lcnt = (LAS int*)(lds + 65536); LAS int* basee = (LAS int*)(lds + 65600); LAS int* tok = (LAS int*)(lds + 65664);
    __syncthreads();
    if (tid < 16) lcnt[tid] = 0;
    __syncthreads();
    u32x2 wn[4];
#pragma unroll
    for (int j = 0; j < 4; ++j) wn[j] = *(const u32x2*)(xb + ((size_t)blk * 128 + wave * 16) * 1024 + 256 * j + 4 * lane);
    for (int rr = 0; rr < 16; ++rr) {
        const int rl = wave * 16 + rr; const size_t row = (size_t)blk * 128 + rl;
        f32x4 v[4];
#pragma unroll
        for (int j = 0; j < 4; ++j) { const u32x2 w = wn[j]; v[j] = (f32x4){bf_lo(w.x), bf_hi(w.x), bf_lo(w.y), bf_hi(w.y)}; }
        { const size_t rn = row + (rr + 1 < 16 ? 1 : 0);
#pragma unroll
          for (int j = 0; j < 4; ++j) wn[j] = *(const u32x2*)(xb + rn * 1024 + 256 * j + 4 * lane); }
        ln_finish(v, gam, bet, nullptr, xb + row * 1024, lane);
        float aff[16], sel[16];
#pragma unroll
        for (int e = 0; e < 16; ++e) { float p = 0.f;
#pragma unroll
            for (int j = 0; j < 4; ++j) { const f32x4 w = *(const LAS f32x4*)(WR + e * 1024 + 256 * j + 4 * lane); p += (v[j][0] * w[0] + v[j][1] * w[1]) + (v[j][2] * w[2] + v[j][3] * w[3]); }
            const float lg = wave_sum(p); aff[e] = 1.0f / (1.0f + expf(-lg)); sel[e] = aff[e] + rbias[e]; }
        float gbv = -3.0e38f; int gb = 0;
#pragma unroll
        for (int g = 0; g < 4; ++g) { float m1 = -3.0e38f, m2 = -3.0e38f;
#pragma unroll
            for (int i = 0; i < 4; ++i) { const float x = sel[4 * g + i]; if (x > m1) { m2 = m1; m1 = x; } else if (x > m2) m2 = x; }
            const float gs_ = m1 + m2; if (gs_ > gbv) { gbv = gs_; gb = g; } }
        float s0 = -3.0e38f, a0 = 0.f; int e0 = 0;
#pragma unroll
        for (int e = 0; e < 16; ++e) { const bool in = (e >> 2) == gb; if (in && sel[e] > s0) { s0 = sel[e]; a0 = aff[e]; e0 = e; } }
        float s1 = -3.0e38f, a1 = 0.f; int e1 = 0;
#pragma unroll
        for (int e = 0; e < 16; ++e) { const bool in = ((e >> 2) == gb) && (e != e0); if (in && sel[e] > s1) { s1 = sel[e]; a1 = aff[e]; e1 = e; } }
        if (lane == 0) {
            const float inv = 1.0f / (a0 + a1);
            const int p0 = __hip_atomic_fetch_add(lcnt + e0, 1, __ATOMIC_RELAXED, __HIP_MEMORY_SCOPE_WORKGROUP);
            const int p1 = __hip_atomic_fetch_add(lcnt + e1, 1, __ATOMIC_RELAXED, __HIP_MEMORY_SCOPE_WORKGROUP);
            tok[rl * 4 + 0] = e0; tok[rl * 4 + 1] = p0; tok[rl * 4 + 2] = e1; tok[rl * 4 + 3] = p1;
            *(f32x2*)(R.r_g + row * 2) = (f32x2){a0 * inv, a1 * inv};
        }
    }
    __syncthreads();
    if (tid < 16) basee[tid] = (int)__hip_atomic_fetch_add(R.gcnt + tid * 64, (unsigned)lcnt[tid], __ATOMIC_RELAXED, __HIP_MEMORY_SCOPE_AGENT);
    __syncthreads();
    if (tid < 256) { const int rl = tid >> 1, k = tid & 1; const int e = tok[rl * 4 + 2 * k], p = tok[rl * 4 + 2 * k + 1]; const size_t o = ((size_t)blk * 128 + rl) * 2 + k; R.r_e[o] = e; R.r_pos[o] = basee[e] + p; }
}
__device__ __forceinline__ void moe_offsets(LAS int* offp, const unsigned* gcnt, int tid) {
    __syncthreads();
    if (tid == 0) { int o = 0;
        for (int e = 0; e < 16; ++e) { offp[e] = o; const int c = (int)__hip_atomic_load(gcnt + e * 64, __ATOMIC_RELAXED, __HIP_MEMORY_SCOPE_AGENT); o += (c + 255) & ~255; }
        offp[16] = o; }
    __syncthreads();
}
#ifndef MK_PER_PHASE
#define MK_PER_PHASE 0
#endif
#ifndef EN_MASK
#define EN_MASK 0xFFF
#endif
#ifndef EN_M1
#define EN_M1 1
#endif
#ifndef EN_M2
#define EN_M2 1
#endif
#ifndef DBG_REP_P0A
#define DBG_REP_P0A 1
#endif
#ifndef EN_2A
#define EN_2A 1
#endif
#ifndef EN_2R
#define EN_2R 1
#endif
#define EN_A ((EN_MASK >> 0) & 1)
#define EN_B ((EN_MASK >> 1) & 1)
#define EN_0 ((EN_MASK >> 2) & 1)
#define EN_1 ((EN_MASK >> 3) & 1)
#define EN_2 ((EN_MASK >> 4) & 1)
#define EN_3 ((EN_MASK >> 5) & 1)
#define EN_4 ((EN_MASK >> 6) & 1)
#define EN_5 ((EN_MASK >> 7) & 1)
#define EN_6 ((EN_MASK >> 8) & 1)
#define EN_7 ((EN_MASK >> 9) & 1)
#define EN_8 ((EN_MASK >> 10) & 1)
#define EN_9 ((EN_MASK >> 11) & 1)
constexpr int NPH_L = 10, NPH = 2 + NL * NPH_L;
struct Args { const float* in[25]; float* out; unsigned char* ws; int ph_lo, ph_hi; };

__global__ void __launch_bounds__(NTHR, 2) fwd(Args a) {
    extern __shared__ __attribute__((aligned(16))) unsigned char lds_raw[];
    LAS unsigned char* lds = (LAS unsigned char*)lds_raw;
    const int G = gridDim.x, bx = blockIdx.x, vcu = (G % 8 == 0) ? (bx % 8) * (G / 8) + bx / 8 : bx;
    const int NGW = G * NWAVES;
#define PH_LOCALS int tid = wave_s * 64 + lane_id(); asm volatile("" : "+v"(tid)); const int lane = tid & 63, wave = wave_s, gw = vcu * NWAVES + wave; (void)lane; (void)gw;
    volatile LAS unsigned* MISC = (volatile LAS unsigned*)(lds + LDS_MISC);
    const int wave_s = __builtin_amdgcn_readfirstlane((int)threadIdx.x >> 6);
    if (threadIdx.x < 64) MISC[threadIdx.x] = 0u;
    __syncthreads();
    unsigned char* ws = a.ws;
    unsigned* ctl = (unsigned*)(ws + WS_CTL);
    const int lo = a.ph_lo, hi = a.ph_hi;
    XcdBarrier bar; bar.bar = ctl + CW_BAR; bar.x = 0; bar.st = MISC + 8;
    if (hi - lo > 1) bar = xcd_barrier_post(ctl + CW_BAR, MISC + 8);
#define IN(k) (lo <= (k) && (k) < hi)
#ifdef DBG_TIME
    if (blockIdx.x == 0 && threadIdx.x == 0) ctl[12288 + 63] = (unsigned)__builtin_amdgcn_s_memrealtime();
#define SEAM(k) do { if (IN(k) && IN((k) + 1)) { xcd_barrier(bar, wave_s == 0 && lane_id() == 0); if (bx == 0 && wave_s == 0 && lane_id() == 0) ctl[12288 + (k)] = (unsigned)__builtin_amdgcn_s_memrealtime(); } } while (0)
#else
#define SEAM(k) do { if (IN(k) && IN((k) + 1)) xcd_barrier(bar, wave_s == 0 && lane_id() == 0); } while (0)
#endif
    float* xo = a.out;
    bf16_t* xb = (bf16_t*)(ws + WS_XB);
    unsigned char* R = ws + WS_R;

    for (int rep_ = 0; rep_ < (DBG_REP_P0A); ++rep_)
    if (EN_A && IN(0)) { PH_LOCALS
        LAS float* scr = (LAS float*)(lds + wave * 8448);
        constexpr int PER_L = 4160;
        for (int it = gw; it < NL * PER_L; it += NGW) {
            const int l = it / PER_L; int r = it - l * PER_L;
            const float* win = a.in[1] + (size_t)l * 1024 * DIN;
            unsigned char* wm = ws + WS_WMIX + (size_t)l * WMIX_STRIDE;
            if (r < 1024) { tr_item(win, DIN, 0, 2048, (bf16_t*)(wm + OFF_WIN), 1024, 0, r, 64, scr, lane); continue; } r -= 1024;
            if (r < 512) { tr_item(win, DIN, 3072, 840, (bf16_t*)(wm + OFF_WIN) + (size_t)4096 * 1024, 1024, 0, r, 32, scr, lane); continue; } r -= 512;
            if (r < 1024) { tr_item(win, DIN, 3912, 2048, (bf16_t*)(wm + OFF_WG), 1024, 0, r, 64, scr, lane); continue; } r -= 1024;
            if (r < 512) { tr_item(a.in[12] + (size_t)l * 1048576, 1024, 0, 1024, (bf16_t*)(wm + OFF_WPR), 1024, 0, r, 32, scr, lane); continue; } r -= 512;
            if (r < 512) { tr_item(a.in[14] + (size_t)l * 1048576, 1024, 0, 1024, (bf16_t*)(wm + OFF_WO), 1024, 0, r, 32, scr, lane); continue; } r -= 512;
            if (r < 512) { tr_item(a.in[13] + (size_t)l * 1048576, 1024, 0, 1024, (bf16_t*)(R + R_PT + (size_t)l * 2 * MiB), 1024, 0, r, 32, scr, lane); continue; } r -= 512;
            { const int m = r >> 5, g = (r >> 1) & 15, nb = r & 1;
              const float* src = (m ? a.in[6] : a.in[4]) + (size_t)(l * 16 + g) * 4096;
              bf16_t* dst = (bf16_t*)(ws + WS_WSM + (size_t)l * 262144 + (size_t)m * 131072) + g * 4096;
              tr_item(src, 64, 0, 64, dst, 64, 0, nb, 2, scr, lane); }
        }
        const size_t gt = (size_t)vcu * NTHR + tid, GT = (size_t)G * NTHR;
        for (size_t i = gt; i < (size_t)NL * 1024 * 128; i += GT) { const int l = (int)(i >> 17), k = (int)(i >> 7) & 1023, j8 = (int)i & 127;
            const float* s = a.in[1] + ((size_t)l * 1024 + k) * DIN + 2048 + 8 * j8; const f32x4 v0 = *(const f32x4*)s, v1 = *(const f32x4*)(s + 4);
            *(u32x4*)((bf16_t*)(R + R_WQ + (size_t)l * 2 * MiB) + (size_t)k * 1024 + 8 * j8) = pack8(v0, v1); }
        for (size_t i = gt; i < (size_t)2 * NL * 8 * 256 * 32; i += GT) { const int which = (int)(i >> 18); const int r = (int)(i & 262143); const int lh = r >> 13, c = (r >> 5) & 255, d8 = r & 31; const int h = lh & 7;
            u32x4 o = (u32x4){0u, 0u, 0u, 0u};
            if ((d8 >> 4) == (h & 1)) { const float* s = (which ? a.in[11] : a.in[10]) + ((size_t)lh * 256 + c) * 128 + 8 * (d8 & 15); o = pack8(*(const f32x4*)s, *(const f32x4*)(s + 4)); }
            *(u32x4*)((bf16_t*)(R + (which ? R_UVP : R_UKP)) + ((size_t)lh * 256 + c) * 1024 + 8 * d8) = o; }
        for (size_t i = gt; i < (size_t)T * 128; i += GT) { const float* s = a.in[0] + i * 8; const f32x4 v0 = *(const f32x4*)s, v1 = *(const f32x4*)(s + 4);
            *(u32x4*)(xb + i * 8) = pack8(v0, v1); }
    }
    SEAM(0);
    if (EN_B && IN(1)) {
        SchedPro S{R, G, vcu}; EpiPro E{ws + WS_WMIX};
        gs::gemm_stream<true>(lds, S, E, wave_s);
    }
    SEAM(1);

    for (int l = 0; l < NL; ++l) {
        const int pb = 2 + l * NPH_L;
        unsigned char* wm = ws + WS_WMIX + (size_t)l * WMIX_STRIDE;
        bf16_t* xrnn = (bf16_t*)(R + R_XRNN); bf16_t* grnn = (bf16_t*)(R + R_GRNN); bf16_t* qlat = (bf16_t*)(R + R_QLAT); bf16_t* ckv = (bf16_t*)(R + R_CKV);
        bf16_t* qidx = (bf16_t*)(R + R_QIDX); bf16_t* kidx = (bf16_t*)(R + R_KIDX); float* widx = (float*)(R + R_WIDX);
        if (EN_0 && IN(pb + 0)) {
            SchedDense S{(const char*)xb, (const char*)(wm + OFF_WIN), 2048u, 2048u, 16, T / 256, 20, G, vcu};
            EpiInproj E{xrnn, grnn, qlat, ckv, qidx, kidx, widx};
            gs::gemm_stream<true>(lds, S, E, wave_s);
#ifdef DBG_REP_INPROJ
            gs::gemm_stream<true>(lds, S, E, wave_s);
#endif
        }
        SEAM(pb + 0);
        RnnP RP{xrnn, grnn, (float*)(R + R_TOT), (const bf16_t*)(ws + WS_WSM + (size_t)l * 262144), (const bf16_t*)(ws + WS_WSM + (size_t)l * 262144 + 131072),
                a.in[2] + (size_t)l * 4096, a.in[3] + (size_t)l * 1024, a.in[5] + (size_t)l * 1024, a.in[7] + (size_t)l * 1024, a.in[8] + (size_t)l * 1024};
        if (EN_1 && IN(pb + 1)) { PH_LOCALS
#ifdef DBG_TIME
            if (tid == 0) MISC[24] = (unsigned)__builtin_amdgcn_s_memrealtime();
#endif
            for (int it = gw; it < 2048; it += NGW) rnn_item<1>(RP, it, lds + wave * 8448, lane);
#ifdef DBG_TIME
            if (tid == 0) MISC[25] = (unsigned)__builtin_amdgcn_s_memrealtime();
#endif
#ifdef DBG_REP_RNN
            for (int it = gw; it < 2048; it += NGW) rnn_item<1>(RP, it, lds + wave * 8448, lane);
#endif
            for (int row = gw; row < T; row += 4 * NGW) ckv_norm_rows4(ckv, row, NGW, T, a.in[9] + (size_t)l * 256, lane);
#ifdef DBG_TIME
            if (tid == 0) MISC[26] = (unsigned)__builtin_amdgcn_s_memrealtime();
#endif
            LAS float* scr = (LAS float*)(lds + wave * 8448);
            for (int it = gw; it < 16 * 768; it += NGW) { const int e = it / 768; int r = it - e * 768; const size_t le = (size_t)l * 16 + e;
                bf16_t* gu = (bf16_t*)(ws + WS_WEXP) + (size_t)e * 1048576; bf16_t* dn = (bf16_t*)(ws + WS_WEXP + OFF_DN) + (size_t)e * 524288;
                if (r < 256) { tr_item(a.in[19] + le * 524288, 512, 0, 512, gu, 1024, 1, r, 16, scr, lane); continue; } r -= 256;
                if (r < 256) { tr_item(a.in[20] + le * 524288, 512, 0, 512, gu + 4 * 1024, 1024, 1, r, 16, scr, lane); continue; } r -= 256;
                tr_item(a.in[21] + le * 524288, 1024, 0, 1024, dn, 512, 0, r, 32, scr, lane); }
#ifdef DBG_TIME
            if (l == 1 && bx == 0 && tid == 0) { const unsigned tq3 = (unsigned)__builtin_amdgcn_s_memrealtime();
                ctl[12288 + 48] = MISC[25] - MISC[24]; ctl[12288 + 49] = MISC[26] - MISC[25]; ctl[12288 + 50] = tq3 - MISC[26]; ctl[12288 + 51] = tq3 - MISC[24]; }
#endif
        }
        SEAM(pb + 1);
        if (EN_2 && IN(pb + 2)) { PH_LOCALS
            __syncthreads();
            if (tid < 256) ((LAS float*)(lds + AT_BIAS))[tid] = a.in[24][tid];
            if (tid < 128) { const int d = tid; int bk = d; if (d >= 16) { bk = 16 + (int)(logf((float)d / 16.0f) / 2.0794415416798357f * 16.0f); bk = bk > 31 ? 31 : bk; } ((LAS int*)(lds + AT_BKT))[d] = bk; }
            __syncthreads();
            for (int i = tid; i < 1024; i += NTHR) ((LAS float*)(lds + AT_BIAS2))[i] = ((const LAS float*)(lds + AT_BIAS))[((const LAS int*)(lds + AT_BKT))[i >> 3] * 8 + (i & 7)];
            AttnP AP{qidx, kidx, ckv, widx, qlat, (unsigned long long*)(R + R_MSCR + (size_t)bx * 393216)};
#ifdef DBG_TIME
            unsigned tph0 = (unsigned)__builtin_amdgcn_s_memrealtime();
#endif
#ifdef DBG_STATIC_UNITS
            if (EN_2A) for (int p = vcu; p < 512; p += G) { const int b = p >> 8, uu = p & 255;
#pragma unroll 1
                for (int k2 = 0; k2 < 2; ++k2) { attn_unit(lds, AP, b, k2 ? uu : 511 - uu, tid);
#ifdef DBG_TIME
                    if (tid == 0) MISC[21] = MISC[21] + 1u;
#endif
                } }
#else
            if (EN_2A) for (;;) {
                __syncthreads();
                if (tid == 0) MISC[4] = __hip_atomic_fetch_add(ctl + CW_QUEUE + l * 64, 1u, __ATOMIC_RELAXED, __HIP_MEMORY_SCOPE_AGENT);
                __syncthreads();
                const unsigned tk = MISC[4];
                if (tk >= 1024u) break;
                attn_unit(lds, AP, (int)(tk & 1u), 511 - (int)(tk >> 1), tid);
#ifdef DBG_TIME
                if (tid == 0) MISC[21] = MISC[21] + 1u;
#endif
            }
            __syncthreads();
#endif
#ifdef DBG_TIME
            if (l == 1 && bx == 0 && tid == 0) { for (int i_ = 0; i_ < 6; ++i_) ctl[12288 + 40 + i_] = ((LAS unsigned*)(lds + LDS_MISC))[16 + i_]; ctl[12288 + 46] = ((LAS unsigned*)(lds + LDS_MISC))[16]; }
            if (l == 0 && tid == 0) { for (int i_ = 0; i_ < 6; ++i_) ((LAS unsigned*)(lds + LDS_MISC))[16 + i_] = 0u; }
            __syncthreads();
            unsigned tph1 = (unsigned)__builtin_amdgcn_s_memrealtime();
            if (l == 1 && bx == 0 && tid == 0) ctl[12288 + 47] = tph1 - tph0;
            if (l == 1 && tid == 0) { __hip_atomic_fetch_max(ctl + 12288 + 59, tph1 - tph0, __ATOMIC_RELAXED, __HIP_MEMORY_SCOPE_AGENT); __hip_atomic_fetch_max(ctl + 12288 + 58, 0x40000000u - (tph1 - tph0), __ATOMIC_RELAXED, __HIP_MEMORY_SCOPE_AGENT); }
#endif
            if (EN_2R) for (int it = gw; it < 2048; it += NGW) rnn_item<2>(RP, it, lds + wave * 8448, lane);
#ifdef DBG_TIME
            { __syncthreads(); const unsigned tph2 = (unsigned)__builtin_amdgcn_s_memrealtime();
              if (l == 1 && tid == 0) __hip_atomic_fetch_max(ctl + 12288 + 57, tph2 - tph1, __ATOMIC_RELAXED, __HIP_MEMORY_SCOPE_AGENT); }
#endif
        }
        SEAM(pb + 2);
        if (EN_3 && IN(pb + 3)) {
            if (EN_M1) { SchedMerge1 S{(const char*)xb, (const char*)grnn, (const char*)(wm + OFF_WG), (const char*)(wm + OFF_WPR), G, vcu};
              EpiMerge1 E{R + R_MSCR + (size_t)bx * 131072, R + R_MSCR2, (bf16_t*)(R + R_MERGED)};
              gs::gemm_stream<true>(lds, S, E, wave_s); }
            if (EN_M2) { SchedDense S{(const char*)qlat, (const char*)(wm + OFF_WVO), 4096u, 4096u, 32, T / 256, 4, G, vcu};
              EpiMerge2 E{R + R_MSCR2, (bf16_t*)(R + R_MERGED)};
              gs::gemm_stream<true>(lds, S, E, wave_s); }
        }
        SEAM(pb + 3);
        if (EN_4 && IN(pb + 4)) {
            SchedDense S{(const char*)(R + R_MERGED), (const char*)(wm + OFF_WO), 2048u, 2048u, 16, T / 256, 4, G, vcu};
            EpiOut E{xb};
            gs::gemm_stream<true>(lds, S, E, wave_s);
        }
        SEAM(pb + 4);
        RouteP RT{(int*)(R + R_ROUTE), (int*)(R + R_ROUTE + 262144), (int*)(R + R_ROUTE + 524288), (float*)(R + R_ROUTE + 786432), ctl + CW_CNT + l * 16 * 64};
        LAS int* offp = (LAS int*)(lds + LDS_MISC - 128);
        if (EN_5 && IN(pb + 5)) { PH_LOCALS
            __syncthreads();
            { float wv[32];
#pragma unroll
              for (int j = 0; j < 32; ++j) wv[j] = a.in[17][tid + j * NTHR];
#pragma unroll
              for (int j = 0; j < 32; ++j) { const int i = tid + j * NTHR; ((LAS float*)lds)[(i & 15) * 1024 + (i >> 4)] = wv[j]; } }
            for (int blk = vcu; blk < T / 128; blk += G) ln1_route_block(lds, blk, xo, xb, a.in[15] + (size_t)l * 1024, a.in[16] + (size_t)l * 1024, a.in[18], RT, tid);
        }
        SEAM(pb + 5);
        int* tokof = (int*)(R + R_ROUTE + 1048576);
        if (EN_6 && IN(pb + 6)) { PH_LOCALS
            moe_offsets(offp, RT.gcnt, tid);
            for (int p = vcu * NTHR + tid; p < 2 * T; p += G * NTHR) { const int e = RT.r_e[p], slot = offp[e] + RT.r_pos[p]; RT.r_slot[p] = slot; tokof[slot] = p >> 1; }
            if (vcu == 0 && tid < 256) {
                for (int e = 0; e < 16; ++e) { const int cnt = (int)__hip_atomic_load(RT.gcnt + e * 64, __ATOMIC_RELAXED, __HIP_MEMORY_SCOPE_AGENT); const int s0 = offp[e] + cnt;
                    if (s0 + tid < offp[e + 1]) tokof[s0 + tid] = 0; } }
        }
        SEAM(pb + 6);
        if (EN_7 && IN(pb + 7)) { PH_LOCALS
            moe_offsets(offp, RT.gcnt, tid);
            SchedMoEG S{(const char*)xb, (const char*)(ws + WS_WEXP), 2048u, 2048u, (size_t)2097152, 16, 4, G, vcu, offp, tokof};
            EpiGU E{(bf16_t*)(R + R_HE)};
            gs::gemm_stream<true, SchedMoEG, EpiGU, true>(lds, S, E, wave_s);
        }
        SEAM(pb + 7);
        if (EN_8 && IN(pb + 8)) { PH_LOCALS
            moe_offsets(offp, RT.gcnt, tid);
            SchedMoE S{(const char*)(R + R_HE), (const char*)(ws + WS_WEXP + OFF_DN), 1024u, 1024u, (size_t)1048576, 8, 4, G, vcu, offp};
            EpiBf16 E{(bf16_t*)(R + R_XG), 1024};
            gs::gemm_stream<true>(lds, S, E, wave_s);
        }
        SEAM(pb + 8);
        if (EN_9 && IN(pb + 9)) { PH_LOCALS
            const bf16_t* Y = (const bf16_t*)(R + R_XG);
            u32x2 xwn[4], y0n[4], y1n[4]; int s0n, s1n; f32x2 ggc, ggn;
            { const int r0 = gw < T ? gw : T - 1, r1 = gw + NGW < T ? gw + NGW : T - 1;
              const int a0 = RT.r_slot[2 * r0], a1 = RT.r_slot[2 * r0 + 1]; ggc = *(const f32x2*)(RT.r_g + 2 * (size_t)r0);
#pragma unroll
              for (int j = 0; j < 4; ++j) { xwn[j] = *(const u32x2*)(xb + (size_t)r0 * 1024 + 256 * j + 4 * lane); y0n[j] = *(const u32x2*)(Y + (size_t)a0 * 1024 + 256 * j + 4 * lane); y1n[j] = *(const u32x2*)(Y + (size_t)a1 * 1024 + 256 * j + 4 * lane); }
              s0n = RT.r_slot[2 * r1]; s1n = RT.r_slot[2 * r1 + 1]; ggn = *(const f32x2*)(RT.r_g + 2 * (size_t)r1); }
            for (int row = gw; row < T; row += NGW) {
                const f32x2 gg = ggc;
                u32x2 xwc[4], y0c[4], y1c[4];
#pragma unroll
                for (int j = 0; j < 4; ++j) { xwc[j] = xwn[j]; y0c[j] = y0n[j]; y1c[j] = y1n[j]; }
                { const int r1 = row + NGW < T ? row + NGW : T - 1, r2 = row + 2 * NGW < T ? row + 2 * NGW : T - 1;
                  const int a0 = s0n, a1 = s1n; ggc = ggn;
#pragma unroll
                  for (int j = 0; j < 4; ++j) { xwn[j] = *(const u32x2*)(xb + (size_t)r1 * 1024 + 256 * j + 4 * lane); y0n[j] = *(const u32x2*)(Y + (size_t)a0 * 1024 + 256 * j + 4 * lane); y1n[j] = *(const u32x2*)(Y + (size_t)a1 * 1024 + 256 * j + 4 * lane); }
                  s0n = RT.r_slot[2 * r2]; s1n = RT.r_slot[2 * r2 + 1]; ggn = *(const f32x2*)(RT.r_g + 2 * (size_t)r2); }
                f32x4 v[4];
#pragma unroll
                for (int j = 0; j < 4; ++j) { const u32x2 xw = xwc[j]; const f32x4 x1 = {bf_lo(xw.x), bf_hi(xw.x), bf_lo(xw.y), bf_hi(xw.y)};
                    const u32x2 y0 = y0c[j], y1 = y1c[j];
                    v[j][0] = ALPHA * x1[0] + gg.x * bf_lo(y0.x) + gg.y * bf_lo(y1.x); v[j][1] = ALPHA * x1[1] + gg.x * bf_hi(y0.x) + gg.y * bf_hi(y1.x);
                    v[j][2] = ALPHA * x1[2] + gg.x * bf_lo(y0.y) + gg.y * bf_lo(y1.y); v[j][3] = ALPHA * x1[3] + gg.x * bf_hi(y0.y) + gg.y * bf_hi(y1.y); }
                ln_finish(v, a.in[22] + (size_t)l * 1024, a.in[23] + (size_t)l * 1024, l == NL - 1 ? xo + (size_t)row * 1024 : nullptr, xb + (size_t)row * 1024, lane);
#ifdef DBG_TIME
                if (l == NL - 1) {
                    const unsigned ta = __hip_atomic_load(ctl + 12288 + (DBG_TA), __ATOMIC_RELAXED, __HIP_MEMORY_SCOPE_AGENT), tb = __hip_atomic_load(ctl + 12288 + (DBG_TB), __ATOMIC_RELAXED, __HIP_MEMORY_SCOPE_AGENT);
                    unsigned k_ = (DBG_Q) == 0 ? (40u * ta + tb / 2u) / (tb ? tb : 1u) : ((DBG_TA) == 58 ? (0x40000000u - ta) : (ta - tb)) / (unsigned)((DBG_Q) ? (DBG_Q) : 1); k_ = k_ > 45u ? 45u : k_;
                    const float sc_ = 1.0f - 0.02f * (float)k_;
#pragma unroll
                    for (int j = 0; j < 4; ++j) *(f32x4*)(xo + (size_t)row * 1024 + 256 * j + 4 * lane) = v[j] * sc_; }
#endif
            }
        }
        SEAM(pb + 9);
    }
#undef IN
#undef SEAM
}

#ifdef DUMP_OFF
__global__ void dump_k(const bf16_t* src, float* dst, size_t ld, size_t col0) { for (size_t i = (size_t)blockIdx.x * blockDim.x + threadIdx.x; i < (size_t)T * 1024; i += (size_t)gridDim.x * blockDim.x) dst[i] = bf2f(src[(i >> 10) * ld + col0 + (i & 1023)]); }
#endif
extern "C" void kernel_launch(void* const* d_in, const int* in_sizes, int n_in, void* d_out, int out_size, void* d_ws, size_t ws_size, hipStream_t stream) {
    static int grid = 0;
    if (grid == 0) {
        if (n_in != 25 || out_size != T * D || ws_size < WS_END) { fprintf(stderr, "kernel_launch: unexpected shapes (n_in %d, out %d, ws %zu < %zu)\n", n_in, out_size, ws_size, (size_t)WS_END); grid = -1; return; }
        int dev = 0, cus = 0, per_cu = 0;
        if (hipGetDevice(&dev) != hipSuccess || hipDeviceGetAttribute(&cus, hipDeviceAttributeMultiprocessorCount, dev) != hipSuccess) { grid = -1; return; }
        if (hipFuncSetAttribute((const void*)fwd, hipFuncAttributeMaxDynamicSharedMemorySize, LDS_BYTES) != hipSuccess) { fprintf(stderr, "kernel_launch: hipFuncSetAttribute failed\n"); grid = -1; return; }
        if (hipOccupancyMaxActiveBlocksPerMultiprocessor(&per_cu, (const void*)fwd, NTHR, LDS_BYTES) != hipSuccess || per_cu < 1) fprintf(stderr, "kernel_launch: occupancy query says %d\n", per_cu);
        (void)hipGetLastError();
        grid = cus < 256 ? cus : 256;
    }
    if (grid < 0) return;
    (void)hipMemsetAsync((char*)d_ws + WS_CTL, 0, CTL_BYTES, stream);
    Args a{};
    for (int i = 0; i < 25; ++i) a.in[i] = (const float*)d_in[i];
    a.out = (float*)d_out; a.ws = (unsigned char*)d_ws;
#if MK_PER_PHASE
#ifndef PH_LIMIT
#define PH_LIMIT NPH
#endif
    for (int ph = 0; ph < PH_LIMIT; ++ph) { a.ph_lo = ph; a.ph_hi = ph + 1; hipLaunchKernelGGL(fwd, dim3(grid), dim3(NTHR), LDS_BYTES, stream, a); }
#else
    a.ph_lo = 0; a.ph_hi = NPH; hipLaunchKernelGGL(fwd, dim3(grid), dim3(NTHR), LDS_BYTES, stream, a);
#endif
#ifdef DUMP_OFF
    hipLaunchKernelGGL(dump_k, dim3(2048), dim3(256), 0, stream, (const bf16_t*)((const char*)d_ws + (DUMP_OFF)), (float*)d_out, (size_t)(DUMP_LD), (size_t)(DUMP_COL));
#endif
}
```

```cpp
#include <hip/hip_runtime.h>
#include <cstdio>
#include <cstdint>

#define GAS __attribute__((address_space(1)))
#define LAS __attribute__((address_space(3)))
typedef unsigned short bf16_t;
typedef short bf16x8 __attribute__((ext_vector_type(8)));
typedef short s16x4 __attribute__((ext_vector_type(4)));
typedef float f32x2 __attribute__((ext_vector_type(2)));
typedef float f32x4 __attribute__((ext_vector_type(4)));
typedef float f32x16 __attribute__((ext_vector_type(16)));
typedef unsigned u32x2 __attribute__((ext_vector_type(2)));
typedef unsigned u32x4 __attribute__((ext_vector_type(4)));

constexpr int NB = 2, SEQ = 16384, T = NB * SEQ, D = 1024, NL = 4, DIN = 5960;
constexpr int NE = 16;
constexpr float ALPHA = 1.681792830507429f;
constexpr float LN_EPS = 1e-5f, RMS_EPS = 1e-6f;
constexpr int NWAVES = 8, NTHR = 512;

constexpr size_t MiB = 1u << 20;
constexpr size_t WS_CTL = 0, CTL_BYTES = 1 * MiB;
constexpr size_t WS_XB = 1 * MiB;
constexpr size_t WS_WMIX = 65 * MiB, WMIX_STRIDE = 22 * MiB;
constexpr size_t OFF_WIN = 0, OFF_WG = 10 * MiB, OFF_WPR = 14 * MiB, OFF_WVO = 16 * MiB, OFF_WO = 20 * MiB;
constexpr size_t WS_WSM = 153 * MiB;
constexpr size_t WS_WEXP = 154 * MiB;
constexpr size_t OFF_DN = 32 * MiB;
constexpr size_t WS_R = 202 * MiB;
constexpr size_t R_XRNN = 0, R_GRNN = 64 * MiB, R_QLAT = 128 * MiB, R_CKV = 256 * MiB, R_QIDX = 272 * MiB, R_KIDX = 304 * MiB, R_WIDX = 308 * MiB,
                 R_TOT = 309 * MiB, R_MSCR = 310 * MiB, R_MSCR2 = 342 * MiB, R_END = 406 * MiB;
constexpr size_t R_MERGED = R_XRNN;
constexpr size_t R_XG = 0, R_HE = 136 * MiB, R_ROUTE = 204 * MiB;
constexpr size_t R_WQ = 0, R_UKP = 8 * MiB, R_PT = 24 * MiB, R_UVP = 32 * MiB;
constexpr size_t WS_END = WS_R + R_END;
constexpr int MP_MAX = 2 * T + NE * 256;

constexpr int CW_TMO = 0;
constexpr int CW_BAR = 4096;
constexpr int CW_CNT = 8192;
constexpr int CW_QUEUE = 14336;

constexpr int LDS_BYTES = 163840;
constexpr int LDS_MISC = LDS_BYTES - 256;

#define RLX_AGENT __ATOMIC_RELAXED, __HIP_MEMORY_SCOPE_AGENT
__device__ __forceinline__ unsigned f2bf(float f) { unsigned u = __builtin_bit_cast(unsigned, f); return (u + 0x7fffu + ((u >> 16) & 1u)) >> 16; }
typedef __bf16 bf16x2_t __attribute__((ext_vector_type(2)));
__device__ __forceinline__ unsigned pk2(float lo, float hi) { const f32x2 v = {lo, hi}; const bf16x2_t b = __builtin_convertvector(v, bf16x2_t); return __builtin_bit_cast(unsigned, b); }
__device__ __forceinline__ float bf_lo(unsigned w) { return __builtin_bit_cast(float, w << 16); }
__device__ __forceinline__ float bf_hi(unsigned w) { return __builtin_bit_cast(float, w & 0xffff0000u); }
__device__ __forceinline__ float bf2f(bf16_t h) { return __builtin_bit_cast(float, ((unsigned)h) << 16); }
__device__ __forceinline__ float fast_exp(float x) { return __builtin_amdgcn_exp2f(x * 1.4426950408889634f); }
__device__ __forceinline__ float fast_rcp(float x) { return __builtin_amdgcn_rcpf(x); }
__device__ __forceinline__ float sigmoidf_(float x) { return fast_rcp(1.0f + fast_exp(-x)); }
__device__ __forceinline__ float gelu_tanh(float x) { const float y = 0.7978845608028654f * (x + 0.044715f * x * x * x); const float e = fast_exp(2.0f * y); const float th = 1.0f - 2.0f * fast_rcp(e + 1.0f); return 0.5f * x * (1.0f + th); }
template <int CTRL> __device__ __forceinline__ float dpp_f(float v) { return __builtin_bit_cast(float, __builtin_amdgcn_update_dpp(0, __builtin_bit_cast(int, v), CTRL, 0xf, 0xf, true)); }
__device__ __forceinline__ float wave_sum(float v) {
    v += dpp_f<0xB1>(v); v += dpp_f<0x4E>(v); v += dpp_f<0x141>(v); v += dpp_f<0x140>(v);
    const int vi = __builtin_bit_cast(int, v);
    return (__builtin_bit_cast(float, __builtin_amdgcn_readlane(vi, 0)) + __builtin_bit_cast(float, __builtin_amdgcn_readlane(vi, 16))) +
           (__builtin_bit_cast(float, __builtin_amdgcn_readlane(vi, 32)) + __builtin_bit_cast(float, __builtin_amdgcn_readlane(vi, 48)));
}

__device__ __forceinline__ int lane_id() { unsigned z = 0u; asm volatile("" : "+v"(z)); return (int)__builtin_amdgcn_mbcnt_hi(~0u, __builtin_amdgcn_mbcnt_lo(~0u, z)); }
#define XB_TMO      128
#define XB_XCNT(j)  (256  + 64 * (j))
#define XB_XSUB(j)  (1280 + 64 * (j))
#define XB_XGEN(j)  (2304 + 64 * (j))
#define XB_TOP      3328
#define XB_TOPGEN   3392
#define XCD_BAR_WORDS 3456
#define XB_SPIN_CAP (1u << 18)
__device__ __forceinline__ unsigned xb_ld(unsigned* p)              { return __hip_atomic_load(p, __ATOMIC_RELAXED, __HIP_MEMORY_SCOPE_AGENT); }
__device__ __forceinline__ unsigned xb_add(unsigned* p, unsigned v) { return __hip_atomic_fetch_add(p, v, __ATOMIC_RELAXED, __HIP_MEMORY_SCOPE_AGENT); }
__device__ __forceinline__ unsigned xb_xcc_id() { return (unsigned)__builtin_amdgcn_s_getreg((3 << 11) | 20) & 0xFu; }
#define XB_SPIN(cond, bar) do { unsigned _sp = 0; while (cond) { __builtin_amdgcn_s_sleep(1); \
    if ((++_sp & 255u) == 0u) { if (xb_ld(&(bar)[XB_TMO])) break; if (_sp > XB_SPIN_CAP) { atomicAdd(&(bar)[XB_TMO], 1u); break; } } } } while (0)
struct XcdBarrier { unsigned* bar; unsigned x; volatile LAS unsigned* st; };
__device__ __forceinline__ XcdBarrier xcd_barrier_post(unsigned* bar, volatile LAS unsigned* st) {
    XcdBarrier b; b.bar = bar; b.x = xb_xcc_id(); b.st = st;
    if (threadIdx.x == 0) (void)xb_add(&bar[XB_XCNT(b.x)], 1u);
    return b;
}
__device__ __forceinline__ void xcd_barrier_complete(unsigned* bar, unsigned x, unsigned& nloc, unsigned& nx) {
    const unsigned G = gridDim.x * gridDim.y * gridDim.z;
    unsigned sum, cnt, mine, sp = 0u;
    for (;;) {
        sum = 0u; cnt = 0u; mine = 0u;
#pragma unroll
        for (unsigned j = 0; j < 16; ++j) { const unsigned c = xb_ld(&bar[XB_XCNT(j)]); sum += c; cnt += (c > 0u) ? 1u : 0u; mine = (j == x) ? c : mine; }
        if (sum == G) break;
        __builtin_amdgcn_s_sleep(1);
        if ((++sp & 255u) == 0u) { if (xb_ld(&bar[XB_TMO])) break; if (sp > XB_SPIN_CAP) { atomicAdd(&bar[XB_TMO], 1u); break; } }
    }
    nloc = mine > 0u ? mine : 1u; nx = cnt > 0u ? cnt : 1u;
}
__device__ __forceinline__ void xcd_barrier(const XcdBarrier& b, bool is_t0) {
    asm volatile("s_waitcnt vmcnt(0)" ::: "memory");
    __syncthreads();
    if (is_t0) {
        unsigned* bar = b.bar;
        __builtin_amdgcn_s_waitcnt(0);
        unsigned nloc = b.st[0], nx = b.st[1];
        if (nloc == 0u) { xcd_barrier_complete(bar, b.x, nloc, nx); b.st[0] = nloc; b.st[1] = nx; }
        const unsigned old = xb_add(&bar[XB_XSUB(b.x)], 1u);
        const unsigned gen = old / nloc;
        if (old + 1u == (gen + 1u) * nloc) {
            __builtin_amdgcn_fence(__ATOMIC_RELEASE, "agent");
            asm volatile("s_waitcnt vmcnt(0)" ::: "memory");
            const unsigned og = xb_add(&bar[XB_TOP], 1u);
            const unsigned tg = og / nx;
            if (og + 1u == (tg + 1u) * nx) xb_add(&bar[XB_TOPGEN], 1u);
            else XB_SPIN(xb_ld(&bar[XB_TOPGEN]) == tg, bar);
            __builtin_amdgcn_fence(__ATOMIC_ACQUIRE, "agent");
            xb_add(&bar[XB_XGEN(b.x)], 1u);
            asm volatile("s_waitcnt vmcnt(0)" ::: "memory");
        } else {
            XB_SPIN(xb_ld(&bar[XB_XGEN(b.x)]) == gen, bar);
            __builtin_amdgcn_fence(__ATOMIC_ACQUIRE, "agent");
            asm volatile("s_waitcnt vmcnt(0)" ::: "memory");
        }
    }
    __syncthreads();
}
namespace gs {
constexpr int BM = 256, BK = 64, HALF = 128, HTB = HALF * BK * 2, STAGE_BYTES = 8 * HTB, NXCD = 8, WGM = 8;
__host__ __device__ __forceinline__ int lds_byte(int r, int c) { const int st = (r >> 4) * 2 + (c >> 5), rr = r & 15, cc = c & 31, ob = rr * 64 + cc * 2; return st * 1024 + (ob ^ (((ob >> 9) & 1) << 5)); }
__host__ __device__ __forceinline__ void stage_rc(int b, int& R, int& C) { const int st = b / 1024, sb = b % 1024, swz = sb ^ (((sb >> 9) & 1) << 5); R = (st >> 1) * 16 + swz / 64; C = (st & 1) * 32 + (swz % 64) / 2; }
__host__ __device__ __forceinline__ int perm32(int rho) { const int n = rho >> 4, i = rho & 15; return 8 * (i >> 2) + 4 * n + (i & 3); }

struct UD { const char* A; const char* B; unsigned lda, ldb; int nt; int kind, pm, pn, aux; };

__device__ __forceinline__ bool tile_of(long L, int nM, int nN, int& pm, int& pn) {
    const int nwg = nM * nN; if (L >= nwg) return false;
    int wgid = (int)L; { const int q = nwg / NXCD, r = nwg % NXCD, xcd = wgid % NXCD, off = wgid / NXCD; wgid = (xcd < r ? xcd * (q + 1) : r * (q + 1) + (xcd - r) * q) + off; }
    const int nig = WGM * nN, gid = wgid / nig, fm = gid * WGM, gsz = (nM - fm) < WGM ? (nM - fm) : WGM;
    pm = fm + ((wgid % nig) % gsz); pn = (wgid % nig) / gsz; return true;
}

template <bool PERM, class Sched, class Epi, bool GATHER = false>
__device__ __forceinline__ void gemm_stream(LAS unsigned char* lds, const Sched& S, const Epi& E, int wave_s) {
    int tid = wave_s * 64 + lane_id(); asm volatile("" : "+v"(tid));
    const int wid = __builtin_amdgcn_readfirstlane(tid >> 6), lane = tid & 63, wr = wid >> 2, wc = wid & 3, fr = lane & 15, fq = lane >> 4;
    int rA[2], rB[2], cb[2];
#pragma unroll
    for (int i = 0; i < 2; ++i) { int R, C; stage_rc(tid * 16 + i * 8192, R, C); rA[i] = R; rB[i] = PERM ? ((R & ~31) + perm32(R & 31)) : R; cb[i] = C * 2; }
    const size_t kstep = (size_t)(BK * 2);
    const unsigned ldsw = (unsigned)wid * 1024u;
    const int aoff = lds_byte(wr * 64 + fr, fq * 8), boff = lds_byte(wc * 32 + fr, fq * 8);
#define GS_SA(b, h) (((b) * 2 + (h)) * HTB)
#define GS_SB(b, h) ((4 + (b) * 2 + (h)) * HTB)
#define GS_STAGE(bufoff, gbase, voff) do { _Pragma("unroll") for (int _i = 0; _i < 2; ++_i) \
        __builtin_amdgcn_global_load_lds((const unsigned*)((const char*)(gbase) + (voff)[_i]), (LAS unsigned*)(lds + (bufoff) + ldsw + _i * 8192), 16, 0, 0); } while (0)
#define GS_LDA(dst, b, h) do { _Pragma("unroll") for (int m = 0; m < 4; ++m) _Pragma("unroll") for (int k = 0; k < 2; ++k) dst[m][k] = *(const LAS bf16x8*)(lds + GS_SA(b, h) + aoff + m * 2048 + k * 1024); } while (0)
#define GS_LDB(dst, b, h) do { _Pragma("unroll") for (int n = 0; n < 2; ++n) _Pragma("unroll") for (int k = 0; k < 2; ++k) dst[n][k] = *(const LAS bf16x8*)(lds + GS_SB(b, h) + boff + n * 2048 + k * 1024); } while (0)
#define GS_MMA(ai, bj, At, Bt) do { __builtin_amdgcn_s_setprio(1); _Pragma("unroll") for (int m = 0; m < 4; ++m) _Pragma("unroll") for (int n = 0; n < 2; ++n) _Pragma("unroll") for (int k = 0; k < 2; ++k) \
        acc[ai][bj][m][n] = __builtin_amdgcn_mfma_f32_16x16x32_bf16(Bt[n][k], At[m][k], acc[ai][bj][m][n], 0, 0, 0); __builtin_amdgcn_s_setprio(0); } while (0)
#define GS_WAIT_V(n) asm volatile("s_waitcnt vmcnt(" #n ")" ::: "memory")
#define GS_WAIT_L(n) asm volatile("s_waitcnt lgkmcnt(" #n ")" ::: "memory")
#define GS_BAR __builtin_amdgcn_s_barrier()
#define GS_SCHED __builtin_amdgcn_sched_barrier(0)
    UD cur, nxt; int ui = 0; const bool prime = false;
    if (!S.next(0, cur)) return;
    f32x4 acc[2][2][4][2];
#pragma unroll
    for (int a = 0; a < 2; ++a)
#pragma unroll
        for (int b = 0; b < 2; ++b)
#pragma unroll
            for (int m = 0; m < 4; ++m)
#pragma unroll
                for (int n = 0; n < 2; ++n) acc[a][b][m][n] = (f32x4){0.f, 0.f, 0.f, 0.f};
    bf16x8 At[4][2], B0[2][2], B1[2][2];
    unsigned vAc[2], vBc[2], vAc1[2] = {0u, 0u};
#pragma unroll
    for (int i = 0; i < 2; ++i) { vAc[i] = (unsigned)rA[i] * cur.lda + (unsigned)cb[i]; vBc[i] = (unsigned)rB[i] * cur.ldb + (unsigned)cb[i]; }
    if constexpr (GATHER) { const int* rm = S.rmap + cur.pm * 256;
#pragma unroll
        for (int i = 0; i < 2; ++i) { vAc[i] = (unsigned)rm[rA[i]] * cur.lda + (unsigned)cb[i]; vAc1[i] = (unsigned)rm[HALF + rA[i]] * cur.lda + (unsigned)cb[i]; } }
    const char* cA = cur.A; const char* cB = cur.B; size_t hA = GATHER ? (size_t)0 : (size_t)HALF * cur.lda, hB = (size_t)HALF * cur.ldb;
    GS_STAGE(GS_SB(0, 0), cB, vBc); GS_STAGE(GS_SA(0, 0), cA, vAc); GS_STAGE(GS_SB(0, 1), cB + hB, vBc); GS_STAGE(GS_SA(0, 1), cA + hA, (GATHER ? vAc1 : vAc));
    if (wr == 1) GS_BAR;
    GS_WAIT_V(4); GS_BAR;
    GS_STAGE(GS_SB(1, 0), cB + kstep, vBc); GS_STAGE(GS_SA(1, 0), cA + kstep, vAc); GS_STAGE(GS_SB(1, 1), cB + hB + kstep, vBc);
    GS_WAIT_V(6); GS_BAR;
    for (;;) {
        const bool has_next = S.next(ui + 1, nxt);
        const char* nA = has_next ? nxt.A : cA; const char* nB = has_next ? nxt.B : cB;
        const unsigned nlda = has_next ? nxt.lda : cur.lda, nldb = has_next ? nxt.ldb : cur.ldb;
        unsigned vAn[2], vBn[2], vAn1[2] = {0u, 0u};
#pragma unroll
        for (int i = 0; i < 2; ++i) { vAn[i] = (unsigned)rA[i] * nlda + (unsigned)cb[i]; vBn[i] = (unsigned)rB[i] * nldb + (unsigned)cb[i]; }
        if constexpr (GATHER) { const int* rm = S.rmap + (has_next ? nxt.pm : cur.pm) * 256;
#pragma unroll
            for (int i = 0; i < 2; ++i) { vAn[i] = (unsigned)rm[rA[i]] * nlda + (unsigned)cb[i]; vAn1[i] = (unsigned)rm[HALF + rA[i]] * nlda + (unsigned)cb[i]; } }
        const size_t hAn = GATHER ? (size_t)0 : (size_t)HALF * nlda, hBn = (size_t)HALF * nldb;
        const int nt = cur.nt;
        for (int t = 0; t < nt; t += 2) {
            const bool last = (t == nt - 2);
            const char* a1 = cA + (size_t)(t + 1) * kstep;
            const char* a2 = last ? nA : cA + (size_t)(t + 2) * kstep; const char* b2 = last ? nB : cB + (size_t)(t + 2) * kstep;
            const char* a3 = a2 + kstep; const char* b3 = b2 + kstep;
            unsigned vA2[2], vB2[2], vA21[2];
#pragma unroll
            for (int i = 0; i < 2; ++i) { vA2[i] = last ? vAn[i] : vAc[i]; vB2[i] = last ? vBn[i] : vBc[i]; vA21[i] = last ? vAn1[i] : vAc1[i]; }
            const size_t hA2 = last ? hAn : hA, hB2 = last ? hBn : hB;
            GS_LDB(B0, 0, 0); GS_SCHED; GS_LDA(At, 0, 0); GS_STAGE(GS_SA(1, 1), a1 + hA, (GATHER ? vAc1 : vAc));
            GS_WAIT_L(8); GS_BAR; GS_WAIT_L(0); GS_MMA(0, 0, At, B0); GS_BAR; GS_SCHED;
            GS_LDB(B1, 0, 1); GS_STAGE(GS_SB(0, 0), b2, vB2);
            GS_BAR; GS_WAIT_L(0); GS_MMA(0, 1, At, B1); GS_BAR;
            GS_LDA(At, 0, 1); GS_STAGE(GS_SA(0, 0), a2, vA2);
            GS_BAR; GS_WAIT_L(0); GS_MMA(1, 0, At, B0); GS_BAR; GS_SCHED;
            GS_STAGE(GS_SB(0, 1), b2 + hB2, vB2);
            GS_WAIT_V(6); GS_BAR; GS_MMA(1, 1, At, B1); GS_BAR;
            GS_LDB(B0, 1, 0); GS_SCHED; GS_LDA(At, 1, 0); GS_STAGE(GS_SA(0, 1), a2 + hA2, (GATHER ? vA21 : vA2));
            GS_WAIT_L(8); GS_BAR; GS_WAIT_L(0); GS_MMA(0, 0, At, B0); GS_BAR; GS_SCHED;
            GS_LDB(B1, 1, 1); GS_STAGE(GS_SB(1, 0), b3, vB2);
            GS_BAR; GS_WAIT_L(0); GS_MMA(0, 1, At, B1); GS_BAR;
            GS_LDA(At, 1, 1); GS_STAGE(GS_SA(1, 0), a3, vA2);
            GS_BAR; GS_WAIT_L(0); GS_MMA(1, 0, At, B0); GS_BAR; GS_SCHED;
            GS_STAGE(GS_SB(1, 1), b3 + hB2, vB2);
            GS_WAIT_V(6); GS_BAR; GS_MMA(1, 1, At, B1); GS_BAR;
        }
        if (!prime) { int tz = wave_s * 64 + lane_id(); asm volatile("" : "+v"(tz)); const int w2 = __builtin_amdgcn_readfirstlane(tz >> 6), l2 = tz & 63; E(acc, cur, w2 >> 2, w2 & 3, l2 & 15, l2 >> 4, tz); }
        if (!has_next) break;
#pragma unroll
        for (int a = 0; a < 2; ++a)
#pragma unroll
            for (int b = 0; b < 2; ++b)
#pragma unroll
                for (int m = 0; m < 4; ++m)
#pragma unroll
                    for (int n = 0; n < 2; ++n) acc[a][b][m][n] = (f32x4){0.f, 0.f, 0.f, 0.f};
        cur = nxt; cA = nA; cB = nB; hA = hAn; hB = hBn;
#pragma unroll
        for (int i = 0; i < 2; ++i) { vAc[i] = vAn[i]; vBc[i] = vBn[i]; vAc1[i] = vAn1[i]; }
        ++ui;
    }
    GS_WAIT_V(0);
    if (wr == 0) GS_BAR;
    GS_BAR;
#undef GS_SA
#undef GS_SB
#undef GS_STAGE
#undef GS_LDA
#undef GS_LDB
#undef GS_MMA
#undef GS_WAIT_V
#undef GS_WAIT_L
#undef GS_BAR
#undef GS_SCHED
}
}
using gs::UD;
__device__ __forceinline__ u32x4 pack8(f32x4 v0, f32x4 v1) { u32x4 w; w.x = pk2(v0[0], v0[1]); w.y = pk2(v0[2], v0[3]); w.z = pk2(v1[0], v1[1]); w.w = pk2(v1[2], v1[3]); return w; }
__device__ __forceinline__ void unpack8(u32x4 w, f32x4& v0, f32x4& v1) { v0 = (f32x4){bf_lo(w.x), bf_hi(w.x), bf_lo(w.y), bf_hi(w.y)}; v1 = (f32x4){bf_lo(w.z), bf_hi(w.z), bf_lo(w.w), bf_hi(w.w)}; }

struct EpiInproj {
    bf16_t *xrnn, *grnn, *qlat, *ckv, *qidx, *kidx; float* widx;
    __device__ __forceinline__ void operator()(const f32x4 (&acc)[2][2][4][2], const UD& u, int wr, int wc, int fr, int fq, int tid) const {
        const int pn = u.pn; const size_t row0 = (size_t)u.pm * 256 + wr * 64 + fr;
        if (pn < 19) {
            bf16_t* base; int ldc, colt; float sc = 1.f; bool gl = false;
            if (pn < 4) { base = xrnn; ldc = 1024; colt = 256 * pn; }
            else if (pn < 8) { base = grnn; ldc = 1024; colt = 256 * (pn - 4); gl = true; }
            else if (pn < 16) { base = qlat; ldc = 2048; colt = 256 * (pn - 8); }
            else if (pn == 16) { base = ckv; ldc = 256; colt = 0; }
            else { base = qidx; ldc = 512; colt = 256 * (pn - 17); sc = 0.125f; }
#pragma unroll
            for (int ai = 0; ai < 2; ++ai)
#pragma unroll
                for (int m = 0; m < 4; ++m) { bf16_t* rowp = base + (row0 + ai * 128 + m * 16) * ldc + colt + wc * 32 + 8 * fq;
#pragma unroll
                    for (int bj = 0; bj < 2; ++bj) { f32x4 v0 = acc[ai][bj][m][0], v1 = acc[ai][bj][m][1];
                        if (gl) {
#pragma unroll
                            for (int j = 0; j < 4; ++j) { v0[j] = gelu_tanh(v0[j]); v1[j] = gelu_tanh(v1[j]); } }
                        v0 = v0 * sc; v1 = v1 * sc;
                        *(u32x4*)(rowp + bj * 128) = pack8(v0, v1); } }
        } else {
#pragma unroll
            for (int ai = 0; ai < 2; ++ai)
#pragma unroll
                for (int m = 0; m < 4; ++m) { const size_t row = row0 + ai * 128 + m * 16; const f32x4 v0 = acc[ai][0][m][0], v1 = acc[ai][0][m][1];
                    if (wc < 2) *(u32x4*)(kidx + row * 64 + wc * 32 + 8 * fq) = pack8(v0, v1);
                    else if (wc == 2 && fq == 0) { *(f32x4*)(widx + row * 8) = v0 * 0.35355339059327373f; *(f32x4*)(widx + row * 8 + 4) = v1 * 0.35355339059327373f; } }
        }
    }
};
struct EpiMerge1 {
    unsigned char* s1b; unsigned char* s2b; bf16_t* merged;
    __device__ __forceinline__ void operator()(const f32x4 (&acc)[2][2][4][2], const UD& u, int wr, int wc, int fr, int fq, int tid) const {
        const int kind = u.kind;
        u32x4* s1 = (u32x4*)s1b + tid; u32x4* s2 = (u32x4*)(s2b + (size_t)(u.pm * 4 + u.pn) * 131072) + tid;
#pragma unroll
        for (int ai = 0; ai < 2; ++ai)
#pragma unroll
            for (int bj = 0; bj < 2; ++bj)
#pragma unroll
                for (int m = 0; m < 4; ++m) { const int slot = (ai * 2 + bj) * 4 + m; f32x4 v0 = acc[ai][bj][m][0], v1 = acc[ai][bj][m][1];
                    if (kind != 1) {
#pragma unroll
                        for (int j = 0; j < 4; ++j) { v0[j] = sigmoidf_(v0[j]); v1[j] = sigmoidf_(v1[j]); }
#ifdef DBG_S1_CONST
                        { const float cv = (float)(u.pm * 4 + u.pn + 1) * (1.0f / 512.0f); v0 = (f32x4){cv, cv, cv, cv}; v1 = v0; }
#endif
                        (kind == 0 ? s1 : s2)[slot * 512] = pack8(v0, v1);
                    } else {
                        f32x4 a0, a1; unpack8(__builtin_nontemporal_load(s1 + slot * 512), a0, a1);
#ifdef DBG_NO_S1
                        a0 = (f32x4){1.f, 1.f, 1.f, 1.f}; a1 = a0;
#endif
                        const size_t row = (size_t)u.pm * 256 + ai * 128 + wr * 64 + m * 16 + fr;
                        *(u32x4*)(merged + row * 1024 + u.pn * 256 + bj * 128 + wc * 32 + 8 * fq) = pack8(a0 * v0, a1 * v1);
#ifdef DBG_OUT_S1
                        *(u32x4*)(merged + row * 1024 + u.pn * 256 + bj * 128 + wc * 32 + 8 * fq) = pack8(a0, a1);
#endif
                    }
                    if (m & 1) asm volatile("" ::: "memory"); }
    }
};
struct EpiMerge2 {
    unsigned char* s2b; bf16_t* merged;
    __device__ __forceinline__ void operator()(const f32x4 (&acc)[2][2][4][2], const UD& u, int wr, int wc, int fr, int fq, int tid) const {
        const u32x4* s2 = (const u32x4*)(s2b + (size_t)(u.pm * 4 + u.pn) * 131072) + tid;
#pragma unroll
        for (int ai = 0; ai < 2; ++ai)
#pragma unroll
            for (int bj = 0; bj < 2; ++bj)
#pragma unroll
                for (int m = 0; m < 4; ++m) { const int slot = (ai * 2 + bj) * 4 + m;
                    const size_t row = (size_t)u.pm * 256 + ai * 128 + wr * 64 + m * 16 + fr;
                    u32x4* mp = (u32x4*)(merged + row * 1024 + u.pn * 256 + bj * 128 + wc * 32 + 8 * fq);
                    f32x4 a0, a1, b0, b1; unpack8(__builtin_nontemporal_load(mp), a0, a1); unpack8(__builtin_nontemporal_load(s2 + slot * 512), b0, b1);
#ifdef DBG_NO_S2
                    b0 = (f32x4){1.f, 1.f, 1.f, 1.f}; b1 = b0;
#endif
#ifdef DBG_NO_MRG
                    a0 = (f32x4){0.f, 0.f, 0.f, 0.f}; a1 = a0;
#endif
                    *mp = pack8(a0 + b0 * acc[ai][bj][m][0], a1 + b1 * acc[ai][bj][m][1]);
                    if (m & 1) asm volatile("" ::: "memory"); }
    }
};
struct EpiOut {
    bf16_t* xb;
    __device__ __forceinline__ void operator()(const f32x4 (&acc)[2][2][4][2], const UD& u, int wr, int wc, int fr, int fq, int tid) const {
#pragma unroll
        for (int ai = 0; ai < 2; ++ai)
#pragma unroll
            for (int m = 0; m < 4; ++m) { bf16_t* rowp = xb + ((size_t)u.pm * 256 + ai * 128 + wr * 64 + m * 16 + fr) * 1024 + u.pn * 256 + wc * 32 + 8 * fq;
#pragma unroll
                for (int bj = 0; bj < 2; ++bj) { u32x4* p = (u32x4*)(rowp + bj * 128); const u32x4 xv = *p; f32x4 v0 = acc[ai][bj][m][0], v1 = acc[ai][bj][m][1];
                    v0[0] += ALPHA * bf_lo(xv.x); v0[1] += ALPHA * bf_hi(xv.x); v0[2] += ALPHA * bf_lo(xv.y); v0[3] += ALPHA * bf_hi(xv.y);
                    v1[0] += ALPHA * bf_lo(xv.z); v1[1] += ALPHA * bf_hi(xv.z); v1[2] += ALPHA * bf_lo(xv.w); v1[3] += ALPHA * bf_hi(xv.w);
                    *p = pack8(v0, v1); } }
    }
};
struct EpiGU {
    bf16_t* he;
    __device__ __forceinline__ void operator()(const f32x4 (&acc)[2][2][4][2], const UD& u, int wr, int wc, int fr, int fq, int tid) const {
#pragma unroll
        for (int ai = 0; ai < 2; ++ai)
#pragma unroll
            for (int m = 0; m < 4; ++m) { bf16_t* rowp = he + ((size_t)u.pm * 256 + ai * 128 + wr * 64 + m * 16 + fr) * 512 + u.pn * 128 + wc * 16 + 4 * fq;
#pragma unroll
                for (int bj = 0; bj < 2; ++bj) { const f32x4 g = acc[ai][bj][m][0], up = acc[ai][bj][m][1]; f32x4 o;
#pragma unroll
                    for (int j = 0; j < 4; ++j) o[j] = g[j] * sigmoidf_(g[j]) * up[j];
                    u32x2 w; w.x = pk2(o[0], o[1]); w.y = pk2(o[2], o[3]); *(u32x2*)(rowp + bj * 64) = w; } }
    }
};
struct EpiBf16 {
    bf16_t* out; int ldc;
    __device__ __forceinline__ void operator()(const f32x4 (&acc)[2][2][4][2], const UD& u, int wr, int wc, int fr, int fq, int tid) const {
#pragma unroll
        for (int ai = 0; ai < 2; ++ai)
#pragma unroll
            for (int m = 0; m < 4; ++m) { bf16_t* rowp = out + ((size_t)u.pm * 256 + ai * 128 + wr * 64 + m * 16 + fr) * ldc + u.pn * 256 + wc * 32 + 8 * fq;
#pragma unroll
                for (int bj = 0; bj < 2; ++bj) *(u32x4*)(rowp + bj * 128) = pack8(acc[ai][bj][m][0], acc[ai][bj][m][1]); }
    }
};
struct EpiPro {
    unsigned char* wmix;
    __device__ __forceinline__ void operator()(const f32x4 (&acc)[2][2][4][2], const UD& u, int wr, int wc, int fr, int fq, int tid) const {
        const int l = u.aux >> 3, h = u.aux & 7, p = u.pn;
        bf16_t* base; int ldc; float sc;
        if (u.kind == 0) { base = (bf16_t*)(wmix + (size_t)l * WMIX_STRIDE + OFF_WIN) + (size_t)(2048 + 256 * h) * 1024 + 256 * p; ldc = 1024; sc = 0.08838834764831845f; }
        else { base = (bf16_t*)(wmix + (size_t)l * WMIX_STRIDE + OFF_WVO) + (size_t)(256 * p) * 2048 + 256 * h; ldc = 2048; sc = 1.f; }
#pragma unroll
        for (int ai = 0; ai < 2; ++ai)
#pragma unroll
            for (int m = 0; m < 4; ++m) { bf16_t* rowp = base + (size_t)(ai * 128 + wr * 64 + m * 16 + fr) * ldc + wc * 32 + 8 * fq;
#pragma unroll
                for (int bj = 0; bj < 2; ++bj) *(u32x4*)(rowp + bj * 128) = pack8(acc[ai][bj][m][0] * sc, acc[ai][bj][m][1] * sc); }
    }
};

struct SchedDense {
    const char* A; const char* B; unsigned lda, ldb; int nt, nM, nN, G, c;
    __device__ __forceinline__ bool next(int i, UD& u) const {
        int pm, pn; if (!gs::tile_of((long)i * G + c, nM, nN, pm, pn)) return false;
        u.A = A + (size_t)pm * 256 * lda; u.B = B + (size_t)pn * 256 * ldb; u.lda = lda; u.ldb = ldb; u.nt = nt; u.kind = 0; u.pm = pm; u.pn = pn; u.aux = 0; return true;
    }
};
struct SchedMerge1 {
    const char *xb, *yrnn, *wg, *wpr; int G, c;
    __device__ __forceinline__ bool next(int i_, UD& u) const { int i = i_;
#ifdef DBG_DUPFIRST
        if (i > 0) i -= 1;
#endif
#ifdef DBG_ORDER201
        const int ti = i / 3, kk_ = i - 3 * ti, k = kk_ == 0 ? 2 : kk_ - 1;
#else
        const int ti = i / 3, k = i - 3 * ti;
#endif
        int pm, pn; if (!gs::tile_of((long)ti * G + c, T / 256, 4, pm, pn)) return false;
        u.kind = k; u.pm = pm; u.pn = pn; u.aux = 0; u.lda = 2048; u.ldb = 2048; u.nt = 16;
#ifdef DBG_K0_AS_K1
        if (k == 0) { u.A = yrnn + (size_t)pm * 256 * 2048; u.B = wpr + (size_t)pn * 256 * 2048; }
#else
        if (k == 0) { u.A = xb + (size_t)pm * 256 * 2048; u.B = wg + (size_t)pn * 256 * 2048; }
#endif
        else if (k == 1) { u.A = yrnn + (size_t)pm * 256 * 2048; u.B = wpr + (size_t)pn * 256 * 2048; }
        else { u.A = xb + (size_t)pm * 256 * 2048; u.B = wg + (size_t)(1024 + pn * 256) * 2048; }
        return true;
    }
};
struct SchedMoE {
    const char* A; const char* B; unsigned lda, ldb; size_t bstride; int nt, nN, G, c; const LAS int* offp;
    __device__ __forceinline__ bool next(int i, UD& u) const {
        const int nM = offp[16] >> 8; int pm, pn; if (!gs::tile_of((long)i * G + c, nM, nN, pm, pn)) return false;
        int e = 0;
#pragma unroll 1
        for (int j = 1; j < 16; ++j) e += (pm * 256 >= offp[j]) ? 1 : 0;
        u.A = A + (size_t)pm * 256 * lda; u.B = B + (size_t)e * bstride + (size_t)pn * 256 * ldb; u.lda = lda; u.ldb = ldb; u.nt = nt; u.kind = 0; u.pm = pm; u.pn = pn; u.aux = e; return true;
    }
};
struct SchedMoEG {
    const char* A; const char* B; unsigned lda, ldb; size_t bstride; int nt, nN, G, c; const LAS int* offp; const int* rmap;
    __device__ __forceinline__ bool next(int i, UD& u) const {
        const int nM = offp[16] >> 8; int pm, pn; if (!gs::tile_of((long)i * G + c, nM, nN, pm, pn)) return false;
        int e = 0;
#pragma unroll 1
        for (int j = 1; j < 16; ++j) e += (pm * 256 >= offp[j]) ? 1 : 0;
        u.A = A; u.B = B + (size_t)e * bstride + (size_t)pn * 256 * ldb; u.lda = lda; u.ldb = ldb; u.nt = nt; u.kind = 0; u.pm = pm; u.pn = pn; u.aux = e; return true;
    }
};
struct SchedPro {
    const unsigned char* tmp; int G, c;
    __device__ __forceinline__ bool next(int i, UD& u) const {
        const long L = (long)i * G + c; if (L >= 256) return false;
        const int kind = (int)(L >> 7), l = (int)(L >> 5) & 3, h = (int)(L >> 2) & 7, p = (int)L & 3;
        u.kind = kind; u.aux = l * 8 + h; u.pm = 0; u.pn = p; u.nt = 4; u.lda = 2048; u.ldb = 2048;
        if (kind == 0) { u.A = (const char*)tmp + R_UKP + ((size_t)(l * 8 + h) * 256) * 2048;
                         u.B = (const char*)tmp + R_WQ + (size_t)l * 2 * MiB + (size_t)(256 * p) * 2048 + (size_t)(h >> 1) * 512; }
        else { u.A = (const char*)tmp + R_PT + (size_t)l * 2 * MiB + (size_t)(256 * p) * 2048 + (size_t)(h >> 1) * 512;
               u.B = (const char*)tmp + R_UVP + ((size_t)(l * 8 + h) * 256) * 2048; }
        return true;
    }
};

__device__ __forceinline__ void tr_item(const float* src, int ld, int c0, int nvalid, bf16_t* dst, int lddst, int mode, int item, int nblk, LAS float* scr, int lane) {
    const int kb = item / nblk, nb = item - kb * nblk, k0 = 64 * kb, n0 = 32 * nb;
    const int cc = 4 * (lane & 7); const bool ok = n0 + cc < nvalid;
    f32x4 tv_[8];
#pragma unroll
    for (int i = 0; i < 8; ++i) { const int kk = 8 * i + (lane >> 3); tv_[i] = ok ? *(const f32x4*)(src + (size_t)(k0 + kk) * ld + c0 + n0 + cc) : (f32x4){0.f, 0.f, 0.f, 0.f}; }
#pragma unroll
    for (int i = 0; i < 8; ++i) { const int kk = 8 * i + (lane >> 3);
#pragma unroll
        for (int j = 0; j < 4; ++j) scr[kk * 33 + cc + j] = tv_[i][j]; }
    asm volatile("s_waitcnt lgkmcnt(0)" ::: "memory");
    const int c = lane & 7;
#pragma unroll
    for (int j = 0; j < 4; ++j) { const int nl = (lane >> 3) + 8 * j; const int nn = n0 + nl; const int row = mode ? (8 * (nn >> 2) + (nn & 3)) : nn; const LAS float* s = scr + (8 * c) * 33 + nl;
        u32x4 o; o.x = pk2(s[0 * 33], s[1 * 33]); o.y = pk2(s[2 * 33], s[3 * 33]); o.z = pk2(s[4 * 33], s[5 * 33]); o.w = pk2(s[6 * 33], s[7 * 33]);
        *(u32x4*)(dst + (size_t)row * lddst + k0 + 8 * c) = o; }
    asm volatile("s_waitcnt lgkmcnt(0)" ::: "memory");
}
__device__ __forceinline__ float expm1_acc(float x) {
    if (x > -0.35f) { float p = 1.0f + x * (1.0f / 8.0f); p = 1.0f + x * (1.0f / 7.0f) * p; p = 1.0f + x * (1.0f / 6.0f) * p; p = 1.0f + x * (1.0f / 5.0f) * p; p = 1.0f + x * 0.25f * p; p = 1.0f + x * (1.0f / 3.0f) * p; p = 1.0f + x * 0.5f * p; return x * p; }
    return fast_exp(x) - 1.0f;
}
struct RnnP { const bf16_t* xrnn; bf16_t* gy; float* tot; const bf16_t *waT, *wxT; const float *convw, *convb, *ba, *bx, *lam; };
template <int PASS>
__device__ __forceinline__ void rnn_item(const RnnP& P, int item, LAS unsigned char* wlds, int lane) {
    const int b = item >> 10, g = (item >> 6) & 15, seg = item & 63, ch0 = 64 * g;
    const int row = lane & 15, kg = lane >> 4, col = lane & 15;
    LAS float* CW = (LAS float*)wlds;
    LAS float* XR = CW + 320;
#pragma unroll
    for (int k = 0; k < 4; ++k) CW[k * 64 + lane] = P.convw[k * 1024 + ch0 + lane];
    CW[256 + lane] = P.convb[ch0 + lane];
    bf16x8 Ba[4][2], Bx[4][2];
#pragma unroll
    for (int jt = 0; jt < 4; ++jt)
#pragma unroll
        for (int s = 0; s < 2; ++s) { const size_t o = ((size_t)g * 64 + 16 * jt + col) * 64 + 32 * s + 8 * kg; Ba[jt][s] = *(const bf16x8*)(P.waT + o); Bx[jt][s] = *(const bf16x8*)(P.wxT + o); }
    float cba[4], cbx[4], sp8[4], h0[4], Pc[4];
#pragma unroll
    for (int jt = 0; jt < 4; ++jt) { const int ch = ch0 + 16 * jt + col; cba[jt] = -1.4426950408889634f * P.ba[ch]; cbx[jt] = -1.4426950408889634f * P.bx[ch]; const float lm = P.lam[ch]; sp8[jt] = -8.0f * 1.4426950408889634f * log1pf(expf(-lm));   h0[jt] = 0.f; Pc[jt] = 1.f; }
    float* totp = P.tot + ((size_t)(b * 64) * 1024 + ch0 + col) * 2;
    if (PASS == 2 && seg > 0) {
        const int Q = (seg + 3) >> 2, slo = kg * Q;
        float Pq[4] = {1.f, 1.f, 1.f, 1.f}, Hq[4] = {0.f, 0.f, 0.f, 0.f};
        for (int i0 = 0; i0 < Q; i0 += 4) {
            f32x2 ph[4][4];
#pragma unroll
            for (int i = 0; i < 4; ++i) { int s2 = slo + i0 + i; s2 = s2 < seg ? s2 : seg - 1;
#pragma unroll
                for (int jt = 0; jt < 4; ++jt) ph[i][jt] = *(const f32x2*)(totp + ((size_t)s2 * 1024 + 16 * jt) * 2); }
#pragma unroll
            for (int i = 0; i < 4; ++i) { const bool ok = (i0 + i < Q) && (slo + i0 + i < seg);
#pragma unroll
                for (int jt = 0; jt < 4; ++jt) { const float px = ok ? ph[i][jt].x : 1.f, hy = ok ? ph[i][jt].y : 0.f; Hq[jt] = px * Hq[jt] + hy; Pq[jt] = Pq[jt] * px; } }
        }
#pragma unroll
        for (int jt = 0; jt < 4; ++jt) {
            const float H0 = __shfl(Hq[jt], col), P1 = __shfl(Pq[jt], col + 16), H1 = __shfl(Hq[jt], col + 16), P2 = __shfl(Pq[jt], col + 32), H2 = __shfl(Hq[jt], col + 32),
                        P3 = __shfl(Pq[jt], col + 48), H3 = __shfl(Hq[jt], col + 48);
            float h = H0; h = P1 * h + H1; h = P2 * h + H2; h = P3 * h + H3; h0[jt] = h; }
    }
    asm volatile("s_waitcnt lgkmcnt(0)" ::: "memory");
    const size_t rowb = (size_t)b * SEQ;
    u32x4 xn[4][2];
    { const int tA0 = seg * 256 + row;
#pragma unroll
      for (int dt = 0; dt < 4; ++dt) { const int tt = tA0 - 3 + dt;
#pragma unroll
          for (int s = 0; s < 2; ++s) xn[dt][s] = (tt >= 0) ? *(const u32x4*)(P.xrnn + (rowb + tt) * 1024 + ch0 + 32 * s + 8 * kg) : (u32x4){0u, 0u, 0u, 0u}; } }
    for (int tile = 0; tile < 16; ++tile) {
        const int t0 = seg * 256 + tile * 16;
        u32x4 xw[4][2];
#pragma unroll
        for (int dt = 0; dt < 4; ++dt)
#pragma unroll
            for (int s = 0; s < 2; ++s) xw[dt][s] = xn[dt][s];
        if (tile + 1 < 16) { const int tB = t0 + 16 + row;
#pragma unroll
            for (int dt = 0; dt < 4; ++dt) { const int tt = tB - 3 + dt;
#pragma unroll
                for (int s = 0; s < 2; ++s) xn[dt][s] = *(const u32x4*)(P.xrnn + (rowb + tt) * 1024 + ch0 + 32 * s + 8 * kg); } }
        bf16_t gq[4][4];
        if (PASS == 2) { const bf16_t* gp0 = P.gy + (rowb + t0 + 4 * kg) * 1024 + ch0 + col;
#pragma unroll
            for (int jt = 0; jt < 4; ++jt)
#pragma unroll
                for (int r = 0; r < 4; ++r) gq[jt][r] = gp0[(size_t)r * 1024 + 16 * jt]; }
        bf16x8 Af[2];
#pragma unroll
        for (int s = 0; s < 2; ++s) {
            const int cl = 32 * s + 8 * kg;
            f32x4 o0 = *(LAS f32x4*)(CW + 256 + cl), o1 = *(LAS f32x4*)(CW + 256 + cl + 4);
#pragma unroll
            for (int dt = 0; dt < 4; ++dt) { const f32x4 w0 = *(LAS f32x4*)(CW + dt * 64 + cl), w1 = *(LAS f32x4*)(CW + dt * 64 + cl + 4); const u32x4 x = xw[dt][s];
                o0[0] += w0[0] * bf_lo(x.x); o0[1] += w0[1] * bf_hi(x.x); o0[2] += w0[2] * bf_lo(x.y); o0[3] += w0[3] * bf_hi(x.y);
                o1[0] += w1[0] * bf_lo(x.z); o1[1] += w1[1] * bf_hi(x.z); o1[2] += w1[2] * bf_lo(x.w); o1[3] += w1[3] * bf_hi(x.w); }
            *(LAS f32x4*)(XR + row * 68 + cl) = o0; *(LAS f32x4*)(XR + row * 68 + cl + 4) = o1;
            const u32x4 pk = pack8(o0, o1); Af[s] = __builtin_bit_cast(bf16x8, pk);
        }
        f32x4 ar[4], ax[4];
#pragma unroll
        for (int jt = 0; jt < 4; ++jt) { ar[jt] = (f32x4){0.f, 0.f, 0.f, 0.f}; ax[jt] = ar[jt];
#pragma unroll
            for (int s = 0; s < 2; ++s) { ar[jt] = __builtin_amdgcn_mfma_f32_16x16x32_bf16(Af[s], Ba[jt][s], ar[jt], 0, 0, 0); ax[jt] = __builtin_amdgcn_mfma_f32_16x16x32_bf16(Af[s], Bx[jt][s], ax[jt], 0, 0, 0); } }
        asm volatile("s_waitcnt lgkmcnt(0)" ::: "memory");
#pragma unroll
        for (int jt = 0; jt < 4; ++jt) {
            float Pp[4], Hp[4]; float pr = 1.f, hr = 0.f;
#pragma unroll
            for (int r = 0; r < 4; ++r) {
                const float xr = XR[(4 * kg + r) * 68 + 16 * jt + col];
                const float rg = fast_rcp(1.0f + __builtin_amdgcn_exp2f(__builtin_fmaf(ar[jt][r], -1.4426950408889634f, cba[jt]))), ig = fast_rcp(1.0f + __builtin_amdgcn_exp2f(__builtin_fmaf(ax[jt][r], -1.4426950408889634f, cbx[jt])));
                const float a = __builtin_amdgcn_exp2f(sp8[jt] * rg); const float em = a - 1.0f;
                const float mm = __builtin_amdgcn_sqrtf(fmaxf(-em * (2.0f + em), 0.f));
                const float uu = mm * ig * xr;
                hr = a * hr + uu; pr = pr * a; Pp[r] = pr; Hp[r] = hr;
            }
            const float P0 = __shfl(pr, col), P1 = __shfl(pr, col + 16), P2 = __shfl(pr, col + 32), P3 = __shfl(pr, col + 48);
            const float H0 = __shfl(hr, col), H1 = __shfl(hr, col + 16), H2 = __shfl(hr, col + 32), H3 = __shfl(hr, col + 48);
            const float h1 = P0 * h0[jt] + H0, h2 = P1 * h1 + H1, h3 = P2 * h2 + H2, h4 = P3 * h3 + H3;
            if (PASS == 2) {
                const float hs = kg == 0 ? h0[jt] : (kg == 1 ? h1 : (kg == 2 ? h2 : h3));
                bf16_t* gp = P.gy + (rowb + t0 + 4 * kg) * 1024 + ch0 + 16 * jt + col;
#pragma unroll
                for (int r = 0; r < 4; ++r) { const float hv = Pp[r] * hs + Hp[r]; const float gg = bf2f(gq[jt][r]); gp[(size_t)r * 1024] = (bf16_t)pk2(hv * gg, 0.f); }
            } else Pc[jt] = Pc[jt] * (P0 * P1) * (P2 * P3);
            h0[jt] = h4;
        }
    }
    if (PASS == 1 && kg == 0) {
#pragma unroll
        for (int jt = 0; jt < 4; ++jt) *(f32x2*)(totp + ((size_t)seg * 1024 + 16 * jt) * 2) = (f32x2){Pc[jt], h0[jt]};
    }
}
__device__ __forceinline__ void ckv_norm_rows4(bf16_t* base, int row0, int rstep, int nrows, const float* gain, int lane) {
    u32x2 w[4];
#pragma unroll
    for (int i = 0; i < 4; ++i) { const int r = row0 + i * rstep; w[i] = *(const u32x2*)(base + (size_t)(r < nrows ? r : row0) * 256 + 4 * lane); }
    const f32x4 gn = *(const f32x4*)(gain + 4 * lane);
#pragma unroll
    for (int i = 0; i < 4; ++i) { const int r = row0 + i * rstep;
        const float v0 = bf_lo(w[i].x), v1 = bf_hi(w[i].x), v2 = bf_lo(w[i].y), v3 = bf_hi(w[i].y);
        const float ss = wave_sum(v0 * v0 + v1 * v1 + v2 * v2 + v3 * v3);
        const float rs = 1.0f / __builtin_sqrtf(ss * (1.0f / 256.0f) + RMS_EPS);
        u32x2 o; o.x = pk2(v0 * rs * gn[0], v1 * rs * gn[1]); o.y = pk2(v2 * rs * gn[2], v3 * rs * gn[3]);
        if (r < nrows) *(u32x2*)(base + (size_t)r * 256 + 4 * lane) = o; }
}
constexpr int AT_CAND = 0, AT_KBUF = 65536, AT_KROW = 144, AT_KCH = 256 * AT_KROW, AT_SEL = 139264, AT_BIAS = 155648, AT_BKT = 156672, AT_GROW = 544, AT_GBUF = 32 * AT_GROW;
constexpr int AT_NBIN = 512, AT_CAP = 256, AT_LCAP = 1024, AT_TIEF = 157184, AT_BIAS2 = 157440;
#ifndef AT_SAMPLE_MIN_U
#define AT_SAMPLE_MIN_U 64
#endif
#ifndef AT_LBREF
#define AT_LBREF 0
#endif
struct AttnP { const bf16_t *qidx, *kidx, *ckv; const float* widx; bf16_t* qlat; unsigned long long* cbuf; };

__device__ __forceinline__ unsigned ord_key(float s) { const unsigned b = __builtin_bit_cast(unsigned, s); return (b & 0x80000000u) ? ~b : (b | 0x80000000u); }

__device__ __forceinline__ void hist_scan(const LAS unsigned* hq, int lane, int kth, int& bsel, int& cat, int& abat) {
    const u32x4 w0 = *(const LAS u32x4*)(hq + 8 * lane), w1 = *(const LAS u32x4*)(hq + 8 * lane + 4);
    int cnt[8];
    cnt[0] = (int)w0.x; cnt[1] = (int)w0.y; cnt[2] = (int)w0.z; cnt[3] = (int)w0.w; cnt[4] = (int)w1.x; cnt[5] = (int)w1.y; cnt[6] = (int)w1.z; cnt[7] = (int)w1.w;
    int s = 0;
#pragma unroll
    for (int i = 0; i < 8; ++i) s += cnt[i];
    int S = s;
    S += __builtin_amdgcn_update_dpp(0, S, 0x101, 0xf, 0xf, true); S += __builtin_amdgcn_update_dpp(0, S, 0x102, 0xf, 0xf, true);
    S += __builtin_amdgcn_update_dpp(0, S, 0x104, 0xf, 0xf, true); S += __builtin_amdgcn_update_dpp(0, S, 0x108, 0xf, 0xf, true);
    { const int t1 = __builtin_amdgcn_readlane(S, 16), t2 = __builtin_amdgcn_readlane(S, 32), t3 = __builtin_amdgcn_readlane(S, 48); const int row = lane >> 4;
      S += row == 0 ? (t1 + t2 + t3) : (row == 1 ? (t2 + t3) : (row == 2 ? t3 : 0)); }
    bsel = -1; cat = 0; abat = 0;
    const unsigned long long mk = __ballot(S >= kth);
    if (mk != 0ull) {
        const int Ls = 63 - __builtin_clzll(mk);
        int above = S - s; bool found = false;
#pragma unroll
        for (int bb = 7; bb >= 0; --bb) { const int c = cnt[bb]; if (!found && above + c >= kth) { bsel = 8 * lane + bb; cat = c; abat = above; found = true; } above += c; }
        bsel = __builtin_amdgcn_readlane(bsel, Ls); cat = __builtin_amdgcn_readlane(cat, Ls); abat = __builtin_amdgcn_readlane(abat, Ls);
    }
}
__device__ __forceinline__ int key_row(int r, bool sm, int u) { if (sm) { r = r * 8 + (u & 7); r = r < SEQ ? r : SEQ - 1; } return r; }
template <int MODE>
__device__ __forceinline__ void attn_pass(LAS unsigned char* lds, const bf16x8 (&afr)[4], const float (&wq)[2][9], const bf16_t* kbase, int u, int wave, int lane, int tid,
                                          const int (&b0e)[2], const int (&neede)[2], const int (&tiee)[2], int (&csel)[2], int (&ccand)[2], unsigned long long* cbw, int samp = 0) {
    const int hh = lane >> 5, kcol = lane & 31;
    LAS unsigned* HIST = (LAS unsigned*)lds; LAS unsigned long long* CAND = (LAS unsigned long long*)(lds + AT_CAND); LAS unsigned short* SEL = (LAS unsigned short*)(lds + AT_SEL);
    const bool sm = (MODE == 0) && (samp != 0);
    const int nst = u >> 3, nch = sm ? ((nst + 7) >> 3) : (u >> 3) + 1;
    float lbt[2];
#pragma unroll
    for (int e = 0; e < 2; ++e) lbt[e] = ((MODE == 1 || MODE == 3) && b0e[e] >= 1) ? (float)b0e[e] : -3.0e38f;
    u32x4 st[4];
    const int lofs = (tid >> 3) * AT_KROW + (tid & 7) * 16;
#define AT_KADDR(C, I) (kbase + (size_t)key_row((C) * 256 + (tid >> 3) + 64 * (I), sm, u) * 64 + (tid & 7) * 8)
#pragma unroll
    for (int i = 0; i < 4; ++i) st[i] = *(const u32x4*)AT_KADDR(0, i);
#pragma unroll
    for (int i = 0; i < 4; ++i) *(LAS u32x4*)(lds + AT_KBUF + lofs + i * 64 * AT_KROW) = st[i];
    __syncthreads();
    for (int c = 0; c < nch; ++c) {
        if (c + 1 < nch) {
#pragma unroll
            for (int i = 0; i < 4; ++i) st[i] = *(const u32x4*)AT_KADDR(c + 1, i);
        }
        const LAS unsigned char* kb = lds + AT_KBUF + (c & 1) * AT_KCH + kcol * AT_KROW + hh * 16;
        const int ntile = sm ? ((nst - 8 * c) < 8 ? (nst - 8 * c) : 8) : ((c + 1 < nch) ? 8 : (u & 7) + 1);
#define AT_READ(BF, TT) do { _Pragma("unroll") for (int ks = 0; ks < 4; ++ks) BF[ks] = *(const LAS bf16x8*)(kb + (TT) * 32 * AT_KROW + ks * 32); } while (0)
#define AT_MFMA(ACC, BF) do { _Pragma("unroll") for (int i_ = 0; i_ < 16; ++i_) ACC[i_] = 0.f; \
            _Pragma("unroll") for (int ks = 0; ks < 4; ++ks) ACC = __builtin_amdgcn_mfma_f32_32x32x16_bf16(afr[ks], BF[ks], ACC, 0, 0, 0); } while (0)
          \

#define AT_POST(ACC, KT, DIAG) do { const int kt = (KT); \
            float sc[2]; \
            _Pragma("unroll") for (int e = 0; e < 2; ++e) { float s = 0.f; \
                _Pragma("unroll") for (int i = 0; i < 8; ++i) s = __builtin_fmaf(wq[e][i], __builtin_amdgcn_fmed3f(ACC[8 * e + i], 0.f, 3.0e38f), s); \
                sc[e] = s; } \
            _Pragma("unroll") for (int e = 0; e < 2; ++e) { \
                const int q = 4 * wave + 2 * hh + e; \
                const float tv = __builtin_fmaf(sc[e], wq[e][8], 256.0f); \
                const bool cz = !(DIAG) || (kt < u) || (kcol <= q); \
                const bool live = cz && tv >= lbt[e]; \
                if (MODE == 3) { \
                    const unsigned long long m3 = __ballot(live); \
                    { \
                        const unsigned h3 = hh ? (unsigned)(m3 >> 32) : (unsigned)m3; \
                        const int pa = ccand[e] + __builtin_popcount(h3 & ((1u << kcol) - 1u)); \
                        if (live) { u32x2 ent;      \
                             ent.x = (unsigned)(kt * 32 + kcol); ent.y = __builtin_bit_cast(unsigned, sc[e]); \
                            *(u32x2*)((char*)cbw + ((unsigned)((2 * hh + e) * AT_LCAP + pa) * 8u)) = ent; } \
                        ccand[e] += __builtin_popcount(h3); \
                    } \
                } else if (MODE == 0) { \
                    const int bin = (int)__builtin_amdgcn_fmed3f(tv, 0.0f, 511.5f); \
                    LAS unsigned* hp = HIST + q * AT_NBIN + bin; \
                    if (cz) __hip_atomic_fetch_add(hp, 1u, __ATOMIC_RELAXED, __HIP_MEMORY_SCOPE_WORKGROUP); \
                } else if (__ballot(live) != 0ull) { \
                    const int bin = (int)__builtin_amdgcn_fmed3f(tv, 0.0f, 511.5f); \
                    const int key = kt * 32 + kcol; \
                    const bool cc = live && bin == b0e[e]; \
                    const unsigned long long m2 = __ballot(cc); const unsigned h2 = hh ? (unsigned)(m2 >> 32) : (unsigned)m2; \
                    const int pc = ccand[e] + __builtin_popcount(h2 & ((1u << kcol) - 1u)); \
                    if (cc && !tiee[e] && pc < AT_CAP) CAND[q * AT_CAP + pc] = ((unsigned long long)ord_key(sc[e]) << 32) | (unsigned)(0xFFFFu - key); \
                    ccand[e] += __builtin_popcount(h2); \
                    const bool cs = live && (bin > b0e[e] || (tiee[e] && cc && pc < neede[e])); \
                    const unsigned long long m1 = __ballot(cs); const unsigned h1 = hh ? (unsigned)(m1 >> 32) : (unsigned)m1; \
                    if (cs) SEL[q * 256 + csel[e] + __builtin_popcount(h1 & ((1u << kcol) - 1u))] = (unsigned short)key; \
                    csel[e] += __builtin_popcount(h1); \
                } \
            } } while (0)
#define AT_TILES(NT, DIAG, PRAG) do { \
        AT_READ(B0, 0); if ((NT) > 1) AT_READ(B1, 1); \
        AT_MFMA(accA, B0); \
        PRAG for (int tt = 0; tt < (NT); tt += 2) { \
            if (tt + 2 < (NT)) AT_READ(B0, tt + 2); \
            if (tt + 1 < (NT)) AT_MFMA(accB, B1); \
            AT_POST(accA, c * 8 + tt, DIAG); \
            if (tt + 1 < (NT)) { \
                if (tt + 3 < (NT)) AT_READ(B1, tt + 3); \
                if (tt + 2 < (NT)) AT_MFMA(accA, B0); \
                AT_POST(accB, c * 8 + tt + 1, DIAG); \
            } \
        } } while (0)
        f32x16 accA, accB; bf16x8 B0[4], B1[4];
        if (sm ? (ntile == 8) : (c + 1 < nch)) AT_TILES(8, false, _Pragma("unroll"));
        else AT_TILES(ntile, true, _Pragma("unroll 1"));
#undef AT_TILES
#undef AT_POST
#undef AT_KADDR
#undef AT_READ
#undef AT_MFMA
        if (MODE == 0 && AT_LBREF && c + 1 < nch && (c < 4 || (c & 3) == 3)) {
#pragma unroll
            for (int q = 0; q < 4; ++q) { int bs, c1, c2; hist_scan(HIST + (4 * wave + q) * AT_NBIN, lane, 256, bs, c1, c2);
                const float lb = bs >= 1 ? (float)bs : -3.0e38f;
                if ((q >> 1) == hh) lbt[q & 1] = lb; }
        }
        if (c + 1 < nch) {
#pragma unroll
            for (int i = 0; i < 4; ++i) *(LAS u32x4*)(lds + AT_KBUF + ((c + 1) & 1) * AT_KCH + lofs + i * 64 * AT_KROW) = st[i];
        }
        __syncthreads();
    }
}

__device__ __forceinline__ void attn_unit(LAS unsigned char* lds, const AttnP& P, int b, int u, int tid_) {
    int tid = tid_; asm volatile("" : "+v"(tid));
    const int wave = __builtin_amdgcn_readfirstlane(tid >> 6), lane = tid & 63, hh = lane >> 5, kcol = lane & 31;
    LAS unsigned* HIST = (LAS unsigned*)lds; LAS unsigned long long* CAND = (LAS unsigned long long*)(lds + AT_CAND); LAS unsigned short* SEL = (LAS unsigned short*)(lds + AT_SEL);
    const LAS float* BIAS2 = (const LAS float*)(lds + AT_BIAS2);
    const int t0 = 32 * u; const size_t rowb = (size_t)b * SEQ;
    __syncthreads();
#pragma unroll
    for (int i = 0; i < 8; ++i) *(LAS u32x4*)(lds + (i * 512 + tid) * 16) = (u32x4){0u, 0u, 0u, 0u};
    if (tid == 0) *(LAS unsigned*)(lds + AT_TIEF) = 0u;
    bf16x8 afr[4]; float wq[2][9];
    { const int rho = kcol, j = rho >> 3, r = rho & 3, hq = (rho >> 2) & 1, head = 4 * (j & 1) + r, qloc = 2 * hq + (j >> 1);
      const bf16_t* qp = P.qidx + (rowb + t0 + 4 * wave + qloc) * 512 + head * 64 + 8 * hh;
#pragma unroll
      for (int ks = 0; ks < 4; ++ks) afr[ks] = *(const bf16x8*)(qp + ks * 16);
#pragma unroll
      for (int e = 0; e < 2; ++e) { const float* wp = P.widx + (rowb + t0 + 4 * wave + 2 * hh + e) * 8; const f32x4 a = *(const f32x4*)wp, c = *(const f32x4*)(wp + 4);
          wq[e][0] = a[0]; wq[e][1] = a[1]; wq[e][2] = a[2]; wq[e][3] = a[3]; wq[e][4] = c[0]; wq[e][5] = c[1]; wq[e][6] = c[2]; wq[e][7] = c[3];
          const float ss = (a[0] * a[0] + a[1] * a[1]) + (a[2] * a[2] + a[3] * a[3]) + (c[0] * c[0] + c[1] * c[1]) + (c[2] * c[2] + c[3] * c[3]);
          wq[e][8] = 32.0f / __builtin_sqrtf(fmaxf(ss, 1.0e-12f)); } }
    const bf16_t* kbase = P.kidx + rowb * 64;
    int b0e[2] = {0, 0}, neede[2] = {0, 0}, tiee[2] = {0, 0}, csel[2] = {0, 0}, ccand[2] = {0, 0};
    int b0q[4], needq[4], nb0q[4], csq[4];
    unsigned long long* cbw = P.cbuf + (size_t)(4 * wave) * AT_LCAP;
#pragma unroll 1
    for (int att = (u >= AT_SAMPLE_MIN_U) ? 0 : 1; att < 2; ++att) {
        int tl = tid; asm volatile("" : "+v"(tl));
        const int ll = tl & 63, hl = ll >> 5;
        if (att == 1 && u >= AT_SAMPLE_MIN_U) {
            __syncthreads();
#pragma unroll
            for (int i = 0; i < 8; ++i) *(LAS u32x4*)(lds + (i * 512 + tl) * 16) = (u32x4){0u, 0u, 0u, 0u};
            if (tl == 0) *(LAS unsigned*)(lds + AT_TIEF) = 0u;
        }
        csel[0] = 0; csel[1] = 0; ccand[0] = 0; ccand[1] = 0;
        attn_pass<0>(lds, afr, wq, kbase, u, wave, ll, tl, b0e, neede, tiee, csel, ccand, nullptr, att == 0 ? 1 : 0);
        const int kth = att == 0 ? 64 : 256;
#pragma unroll
        for (int q = 0; q < 4; ++q) {
            const int nq = t0 + 4 * wave + q + 1;
            int bsel, cat, abat; hist_scan(HIST + (4 * wave + q) * AT_NBIN, ll, kth, bsel, cat, abat);
            if (att == 1 && nq <= 256) { bsel = -1; cat = 0; abat = 0; }
            b0q[q] = bsel; nb0q[q] = cat; needq[q] = (nq > 256) ? (256 - abat) : 0;
        }
        b0e[0] = hl ? b0q[2] : b0q[0]; b0e[1] = hl ? b0q[3] : b0q[1];
        neede[0] = hl ? needq[2] : needq[0]; neede[1] = hl ? needq[3] : needq[1];
        tiee[0] = (att == 1) && ((hl ? nb0q[2] : nb0q[0]) > AT_CAP); tiee[1] = (att == 1) && ((hl ? nb0q[3] : nb0q[1]) > AT_CAP);
        if ((tiee[0] | tiee[1]) != 0) *(LAS unsigned*)(lds + AT_TIEF) = 1u;
        __syncthreads();
        if (att == 1 && *(const LAS unsigned*)(lds + AT_TIEF) != 0u) {
            attn_pass<1>(lds, afr, wq, kbase, u, wave, ll, tl, b0e, neede, tiee, csel, ccand, cbw);
#pragma unroll
            for (int q = 0; q < 4; ++q) { const int cv = (q & 1) ? csel[1] : csel[0]; csq[q] = __builtin_amdgcn_readlane(cv, (q >> 1) * 32); }
            break;
        }
        if (att == 0) {
#pragma unroll
            for (int i = 0; i < 8; ++i) *(LAS u32x4*)(lds + wave * 8192 + (i * 64 + ll) * 16) = (u32x4){0u, 0u, 0u, 0u};
        }
        attn_pass<3>(lds, afr, wq, kbase, u, wave, ll, tl, b0e, neede, tiee, csel, ccand, cbw);
        asm volatile("s_waitcnt vmcnt(0)" ::: "memory");
        if (att == 0) {
            bool ok = true;
#pragma unroll
            for (int q = 0; q < 4; ++q) {
                const int cv = (q & 1) ? ccand[1] : ccand[0]; const int nraw = __builtin_amdgcn_readlane(cv, (q >> 1) * 32); ok = ok && nraw >= 256 && nraw <= AT_LCAP;
                const int n = nraw > AT_LCAP ? AT_LCAP : nraw;
                const float scl = (q & 2) ? __shfl(wq[q & 1][8], 32) : __shfl(wq[q & 1][8], 0);
                unsigned long long ent[AT_LCAP / 64];
#pragma unroll
                for (int j = 0; j < AT_LCAP / 64; ++j) { const int i = 64 * j + ll; ent[j] = (i < n) ? __builtin_nontemporal_load(cbw + q * AT_LCAP + i) : 0ull; }
#pragma unroll
                for (int j = 0; j < AT_LCAP / 64; ++j) { const int i = 64 * j + ll; const float scv = __builtin_bit_cast(float, (unsigned)(ent[j] >> 32));
                    const int bin = (int)__builtin_amdgcn_fmed3f(__builtin_fmaf(scv, scl, 256.0f), 0.0f, 511.5f);
                    if (i < n) __hip_atomic_fetch_add(HIST + (4 * wave + q) * AT_NBIN + bin, 1u, __ATOMIC_RELAXED, __HIP_MEMORY_SCOPE_WORKGROUP); }
                asm volatile("s_waitcnt lgkmcnt(0)" ::: "memory");
                int bsel, cat, abat; hist_scan(HIST + (4 * wave + q) * AT_NBIN, ll, 256, bsel, cat, abat);
                ok = ok && bsel >= 0;
                b0q[q] = bsel; nb0q[q] = cat; needq[q] = 256 - abat;
                const int b0 = bsel, need = 256 - abat; const bool tieq = cat > AT_CAP;
                int cs = 0, cc = 0;
#pragma unroll
                for (int j = 0; j < AT_LCAP / 64; ++j) {
                    if (64 * j < n) {
                        const unsigned long long v = ent[j]; const bool in = 64 * j + ll < n;
                        const float scv = __builtin_bit_cast(float, (unsigned)(v >> 32));
                        const int bin = (int)__builtin_amdgcn_fmed3f(__builtin_fmaf(scv, scl, 256.0f), 0.0f, 511.5f);
                        const bool isc = in && bin == b0;
                        const unsigned long long mc = __ballot(isc);
                        const int pc = cc + __builtin_popcountll(mc & ((1ull << ll) - 1ull));
                        const bool isa = in && (bin > b0 || (tieq && isc && pc < need));
                        const unsigned long long ms = __ballot(isa);
                        const int ps = cs + __builtin_popcountll(ms & ((1ull << ll) - 1ull));
                        if (isa && ps < 256) SEL[(4 * wave + q) * 256 + ps] = (unsigned short)(v & 0xFFFFu);
                        if (isc && !tieq && pc < AT_CAP) CAND[(4 * wave + q) * AT_CAP + pc] = ((unsigned long long)ord_key(scv) << 32) | (unsigned)(0xFFFFu - (unsigned)(v & 0xFFFFu));
                        cs += __builtin_popcountll(ms); cc += __builtin_popcountll(mc);
                    }
                }
                csq[q] = cs;
                asm volatile("" ::: "memory");
            }
            if (!ok) *(LAS unsigned*)(lds + AT_TIEF) = 1u;
            __syncthreads();
            if (*(const LAS unsigned*)(lds + AT_TIEF) != 0u) continue;
            break;
        }
#pragma unroll
        for (int q = 0; q < 4; ++q) {
            const int cv = (q & 1) ? ccand[1] : ccand[0]; int n = __builtin_amdgcn_readlane(cv, (q >> 1) * 32); n = n > AT_LCAP ? AT_LCAP : n;
            const int b0 = b0q[q], need = needq[q]; const bool tieq = nb0q[q] > AT_CAP;
            const float scl = (q & 2) ? __shfl(wq[q & 1][8], 32) : __shfl(wq[q & 1][8], 0);
            int cs = 0, cc = 0;
#pragma unroll
            for (int jb = 0; jb < AT_LCAP / 256; ++jb) {
                if (256 * jb < n) {
                    unsigned long long ent[4];
#pragma unroll
                    for (int j = 0; j < 4; ++j) { const int i = 256 * jb + 64 * j + ll; ent[j] = (i < n) ? __builtin_nontemporal_load(cbw + q * AT_LCAP + i) : 0ull; }
#pragma unroll
                    for (int j = 0; j < 4; ++j) {
                        const unsigned long long v = ent[j]; const bool in = 256 * jb + 64 * j + ll < n;
                        const float scv = __builtin_bit_cast(float, (unsigned)(v >> 32));
                        const int bin = (int)__builtin_amdgcn_fmed3f(__builtin_fmaf(scv, scl, 256.0f), 0.0f, 511.5f);
                        const bool isc = in && bin == b0;
                        const unsigned long long mc = __ballot(isc);
                        const int pc = cc + __builtin_popcountll(mc & ((1ull << ll) - 1ull));
                        const bool isa = in && (bin > b0 || (tieq && isc && pc < need));
                        const unsigned long long ms = __ballot(isa);
                        if (isa) SEL[(4 * wave + q) * 256 + cs + __builtin_popcountll(ms & ((1ull << ll) - 1ull))] = (unsigned short)(v & 0xFFFFu);
                        if (isc && !tieq && pc < AT_CAP) CAND[(4 * wave + q) * AT_CAP + pc] = ((unsigned long long)ord_key(scv) << 32) | (unsigned)(0xFFFFu - (unsigned)(v & 0xFFFFu));
                        cs += __builtin_popcountll(ms); cc += __builtin_popcountll(mc);
                    }
                }
            }
            csq[q] = cs;
            asm volatile("" ::: "memory");
        }
        break;
    }
    int nselq[4];
#pragma unroll
    for (int q = 0; q < 4; ++q) {
        int cs = csq[q];
        const int need = needq[q], nb0 = nb0q[q];
        if (need > 0 && nb0 <= AT_CAP) {
            const int nc = nb0;
            const LAS unsigned long long* cq = CAND + (4 * wave + q) * AT_CAP;
            for (int i0 = 0; i0 < nc; i0 += 64) {
                const int i = i0 + lane; const unsigned long long mine = (i < nc) ? cq[i] : 0ull;
                int rank = 0; for (int j = 0; j < nc; ++j) rank += (cq[j] > mine) ? 1 : 0;
                const bool pick = (i < nc) && rank < need;
                const unsigned long long mk = __ballot(pick);
                if (pick) SEL[(4 * wave + q) * 256 + cs + __builtin_popcountll(mk & ((1ull << lane) - 1ull))] = (unsigned short)(0xFFFFu - (unsigned)(mine & 0xFFFFu));
                cs += __builtin_popcountll(mk);
            }
        }
        nselq[q] = cs;
    }
    asm volatile("s_waitcnt lgkmcnt(0)" ::: "memory");
#ifdef DBG_TIME_ATT
    if (tid == 0) { const unsigned tn_ = (unsigned)__builtin_amdgcn_s_memrealtime(); ((LAS unsigned*)(lds + LDS_MISC))[19] += tn_ - tk0; tk0 = tn_; }
#endif
    __syncthreads();
    LAS unsigned char* gb = lds + wave * AT_GBUF;
    const int n = lane & 15, kg = lane >> 4, head = n & 7;
#pragma unroll 1
    for (int qi = 0; qi < 4; ++qi) {
        const int q = 4 * wave + qi, t = t0 + q;
        const int nsel = qi == 0 ? nselq[0] : (qi == 1 ? nselq[1] : (qi == 2 ? nselq[2] : nselq[3]));
        const LAS unsigned short* sel = SEL + q * 256;
        bf16_t* qrow = P.qlat + (rowb + t) * 2048;
        bf16x8 qb[8];
#pragma unroll
        for (int ks = 0; ks < 8; ++ks) { qb[ks] = (bf16x8){0, 0, 0, 0, 0, 0, 0, 0}; if (n < 8) qb[ks] = *(const bf16x8*)(qrow + n * 256 + 32 * ks + 8 * kg); }
        f32x4 oacc[16];
#pragma unroll
        for (int mt = 0; mt < 16; ++mt) oacc[mt] = (f32x4){0.f, 0.f, 0.f, 0.f};
        float mrun = -1e30f, lrun = 0.f;
        const int nchunk = (nsel + 31) >> 5;
#pragma unroll 1
        for (int c = 0; c < nchunk; ++c) {
            const int jn = 32 * c + kcol; const int idxc = (jn < nsel) ? (int)sel[jn] : 0;
            { u32x4 pre[16];
              const unsigned offc = ((unsigned)rowb + (unsigned)idxc) * 512u;
#pragma unroll
              for (int i = 0; i < 16; ++i) { const unsigned o0 = (unsigned)__builtin_amdgcn_readlane((int)offc, 2 * i), o1 = (unsigned)__builtin_amdgcn_readlane((int)offc, 2 * i + 1);
                  pre[i] = *(const u32x4*)((const char*)P.ckv + ((hh ? o1 : o0) + (unsigned)kcol * 16u)); }
#pragma unroll
              for (int i = 0; i < 16; ++i) *(LAS u32x4*)(gb + (2 * i + hh) * AT_GROW + kcol * 16) = pre[i];
            }
            f32x4 st[2];
#pragma unroll
            for (int k2 = 0; k2 < 2; ++k2) { st[k2] = (f32x4){0.f, 0.f, 0.f, 0.f};
#pragma unroll
                for (int ks = 0; ks < 8; ++ks) { const bf16x8 a = *(const LAS bf16x8*)(gb + (16 * k2 + n) * AT_GROW + (32 * ks + 8 * kg) * 2); st[k2] = __builtin_amdgcn_mfma_f32_16x16x32_bf16(a, qb[ks], st[k2], 0, 0, 0); } }
            float mloc = -1e30f;
#pragma unroll
            for (int k2 = 0; k2 < 2; ++k2)
#pragma unroll
                for (int r = 0; r < 4; ++r) { const int jj = 16 * k2 + 4 * kg + r; const int idx = (32 * c + jj < nsel) ? (int)sel[32 * c + jj] : 0; int d = t - idx; d = d < 127 ? d : 127;
                    float lg = st[k2][r] + BIAS2[d * 8 + head]; if (32 * c + jj >= nsel) lg = -1e30f;
                    st[k2][r] = lg; mloc = fmaxf(mloc, lg); }
            if (c == 0) { mloc = fmaxf(mloc, __shfl_xor(mloc, 16)); mloc = fmaxf(mloc, __shfl_xor(mloc, 32)); mrun = mloc; }
            else if (__ballot(mloc > mrun + 60.0f) != 0ull) {
                mloc = fmaxf(mloc, __shfl_xor(mloc, 16)); mloc = fmaxf(mloc, __shfl_xor(mloc, 32));
                const float mnew = fmaxf(mrun, mloc), alpha = fast_exp(mrun - mnew);
                lrun = lrun * alpha; mrun = mnew;
#pragma unroll
                for (int mt = 0; mt < 16; ++mt) oacc[mt] = oacc[mt] * alpha;
            }
#pragma unroll
            for (int k2 = 0; k2 < 2; ++k2)
#pragma unroll
                for (int r = 0; r < 4; ++r) { const float p = fast_exp(st[k2][r] - mrun); st[k2][r] = p; lrun += p; }
            u32x4 pw; pw.x = pk2(st[0][0], st[0][1]); pw.y = pk2(st[0][2], st[0][3]); pw.z = pk2(st[1][0], st[1][1]); pw.w = pk2(st[1][2], st[1][3]);
            const bf16x8 pb = __builtin_bit_cast(bf16x8, pw);
            LAS unsigned char* tb = gb + (4 * kg + (n >> 2)) * AT_GROW + 8 * (n & 3);
#pragma unroll
            for (int mt = 0; mt < 16; ++mt) {
                const s16x4 v1 = __builtin_amdgcn_ds_read_tr16_b64_v4i16((LAS s16x4*)(tb + 32 * mt));
                const s16x4 v2 = __builtin_amdgcn_ds_read_tr16_b64_v4i16((LAS s16x4*)(tb + 16 * AT_GROW + 32 * mt));
                const bf16x8 av = (bf16x8){v1[0], v1[1], v1[2], v1[3], v2[0], v2[1], v2[2], v2[3]};
                oacc[mt] = __builtin_amdgcn_mfma_f32_16x16x32_bf16(av, pb, oacc[mt], 0, 0, 0);
            }
        }
        lrun += __shfl_xor(lrun, 16); lrun += __shfl_xor(lrun, 32);
        const float inv = 1.0f / lrun;
        if (n < 8) {
#pragma unroll
            for (int mt = 0; mt < 16; ++mt) { const f32x4 o = oacc[mt] * inv; u32x2 w; w.x = pk2(o[0], o[1]); w.y = pk2(o[2], o[3]); *(u32x2*)(qrow + n * 256 + 16 * mt + 4 * kg) = w; }
        }
    }
#ifdef DBG_TIME_ATT
    if (tid == 0) { const unsigned tn_ = (unsigned)__builtin_amdgcn_s_memrealtime(); ((LAS unsigned*)(lds + LDS_MISC))[20] += tn_ - tk0; tk0 = tn_; }
#endif
}
__device__ __forceinline__ void ln_finish(f32x4 (&v)[4], const float* gam, const float* bet, float* orow, bf16_t* brow, int lane) {
    float s = 0.f;
#pragma unroll
    for (int j = 0; j < 4; ++j) s += (v[j][0] + v[j][1]) + (v[j][2] + v[j][3]);
    const float mean = wave_sum(s) * (1.0f / 1024.0f); float s2 = 0.f;
#pragma unroll
    for (int j = 0; j < 4; ++j) { v[j] = v[j] - mean; s2 += (v[j][0] * v[j][0] + v[j][1] * v[j][1]) + (v[j][2] * v[j][2] + v[j][3] * v[j][3]); }
    const float rstd = 1.0f / __builtin_sqrtf(wave_sum(s2) * (1.0f / 1024.0f) + LN_EPS);
#pragma unroll
    for (int j = 0; j < 4; ++j) { const f32x4 g = *(const f32x4*)(gam + 256 * j + 4 * lane), bb = *(const f32x4*)(bet + 256 * j + 4 * lane);
        v[j] = v[j] * rstd * g + bb;
        if (orow != nullptr) *(f32x4*)(orow + 256 * j + 4 * lane) = v[j];
        u32x2 w; w.x = pk2(v[j][0], v[j][1]); w.y = pk2(v[j][2], v[j][3]); *(u32x2*)(brow + 256 * j + 4 * lane) = w; }
}
struct RouteP { int* r_e; int* r_pos; int* r_slot; float* r_g; unsigned* gcnt; };

__device__ __forceinline__ void ln1_route_block(LAS unsigned char* lds, int blk, float* xo, bf16_t* xb, const float* gam, const float* bet, const float* rbias, const RouteP& R, int tid) {
    const int wave = __builtin_amdgcn_readfirstlane(tid >> 6), lane = tid & 63;
    const LAS float* WR = (const LAS float*)lds; LAS int* lcnt = (LAS int*)(lds + 65536); LAS int* basee = (LAS int*)(lds + 65600); LAS int* tok = (LAS int*)(lds + 65664);
    __syncthreads();
    if (tid < 16) lcnt[tid] = 0;
    __syncthreads();
    u32x2 wn[4];
#pragma unroll
    for (int j = 0; j < 4; ++j) wn[j] = *(const u32x2*)(xb + ((size_t)blk * 128 + wave * 16) * 1024 + 256 * j + 4 * lane);
    for (int rr = 0; rr < 16; ++rr) {
        const int rl = wave * 16 + rr; const size_t row = (size_t)blk * 128 + rl;
        f32x4 v[4];
#pragma unroll
        for (int j = 0; j < 4; ++j) { const u32x2 w = wn[j]; v[j] = (f32x4){bf_lo(w.x), bf_hi(w.x), bf_lo(w.y), bf_hi(w.y)}; }
        { const size_t rn = row + (rr + 1 < 16 ? 1 : 0);
#pragma unroll
          for (int j = 0; j < 4; ++j) wn[j] = *(const u32x2*)(xb + rn * 1024 + 256 * j + 4 * lane); }
        ln_finish(v, gam, bet, nullptr, xb + row * 1024, lane);
        float aff[16], sel[16];
#pragma unroll
        for (int e = 0; e < 16; ++e) { float p = 0.f;
#pragma unroll
            for (int j = 0; j < 4; ++j) { const f32x4 w = *(const LAS f32x4*)(WR + e * 1024 + 256 * j + 4 * lane); p += (v[j][0] * w[0] + v[j][1] * w[1]) + (v[j][2] * w[2] + v[j][3] * w[3]); }
            const float lg = wave_sum(p); aff[e] = 1.0f / (1.0f + expf(-lg)); sel[e] = aff[e] + rbias[e]; }
        float gbv = -3.0e38f; int gb = 0;
#pragma unroll
        for (int g = 0; g < 4; ++g) { float m1 = -3.0e38f, m2 = -3.0e38f;
#pragma unroll
            for (int i = 0; i < 4; ++i) { const float x = sel[4 * g + i]; if (x > m1) { m2 = m1; m1 = x; } else if (x > m2) m2 = x; }
            const float gs_ = m1 + m2; if (gs_ > gbv) { gbv = gs_; gb = g; } }
        float s0 = -3.0e38f, a0 = 0.f; int e0 = 0;
#pragma unroll
        for (int e = 0; e < 16; ++e) { const bool in = (e >> 2) == gb; if (in && sel[e] > s0) { s0 = sel[e]; a0 = aff[e]; e0 = e; } }
        float s1 = -3.0e38f, a1 = 0.f; int e1 = 0;
#pragma unroll
        for (int e = 0; e < 16; ++e) { const bool in = ((e >> 2) == gb) && (e != e0); if (in && sel[e] > s1) { s1 = sel[e]; a1 = aff[e]; e1 = e; } }
        if (lane == 0) {
            const float inv = 1.0f / (a0 + a1);
            const int p0 = __hip_atomic_fetch_add(lcnt + e0, 1, __ATOMIC_RELAXED, __HIP_MEMORY_SCOPE_WORKGROUP);
            const int p1 = __hip_atomic_fetch_add(lcnt + e1, 1, __ATOMIC_RELAXED, __HIP_MEMORY_SCOPE_WORKGROUP);
            tok[rl * 4 + 0] = e0; tok[rl * 4 + 1] = p0; tok[rl * 4 + 2] = e1; tok[rl * 4 + 3] = p1;
            *(f32x2*)(R.r_g + row * 2) = (f32x2){a0 * inv, a1 * inv};
        }
    }
    __syncthreads();
    if (tid < 16) basee[tid] = (int)__hip_atomic_fetch_add(R.gcnt + tid * 64, (unsigned)lcnt[tid], __ATOMIC_RELAXED, __HIP_MEMORY_SCOPE_AGENT);
    __syncthreads();
    if (tid < 256) { const int rl = tid >> 1, k = tid & 1; const int e = tok[rl * 4 + 2 * k], p = tok[rl * 4 + 2 * k + 1]; const size_t o = ((size_t)blk * 128 + rl) * 2 + k; R.r_e[o] = e; R.r_pos[o] = basee[e] + p; }
}
__device__ __forceinline__ void moe_offsets(LAS int* offp, const unsigned* gcnt, int tid) {
    __syncthreads();
    if (tid == 0) { int o = 0;
        for (int e = 0; e < 16; ++e) { offp[e] = o; const int c = (int)__hip_atomic_load(gcnt + e * 64, __ATOMIC_RELAXED, __HIP_MEMORY_SCOPE_AGENT); o += (c + 255) & ~255; }
        offp[16] = o; }
    __syncthreads();
}
#ifndef MK_PER_PHASE
#define MK_PER_PHASE 0
#endif
#ifndef EN_MASK
#define EN_MASK 0xFFF
#endif
#ifndef EN_M1
#define EN_M1 1
#endif
#ifndef EN_M2
#define EN_M2 1
#endif
#ifndef DBG_REP_P0A
#define DBG_REP_P0A 1
#endif
#ifndef EN_2A
#define EN_2A 1
#endif
#ifndef EN_2R
#define EN_2R 1
#endif
#define EN_A ((EN_MASK >> 0) & 1)
#define EN_B ((EN_MASK >> 1) & 1)
#define EN_0 ((EN_MASK >> 2) & 1)
#define EN_1 ((EN_MASK >> 3) & 1)
#define EN_2 ((EN_MASK >> 4) & 1)
#define EN_3 ((EN_MASK >> 5) & 1)
#define EN_4 ((EN_MASK >> 6) & 1)
#define EN_5 ((EN_MASK >> 7) & 1)
#define EN_6 ((EN_MASK >> 8) & 1)
#define EN_7 ((EN_MASK >> 9) & 1)
#define EN_8 ((EN_MASK >> 10) & 1)
#define EN_9 ((EN_MASK >> 11) & 1)
constexpr int NPH_L = 10, NPH = 2 + NL * NPH_L;
struct Args { const float* in[25]; float* out; unsigned char* ws; int ph_lo, ph_hi; };

__global__ void __launch_bounds__(NTHR, 2) fwd(Args a) {
    extern __shared__ __attribute__((aligned(16))) unsigned char lds_raw[];
    LAS unsigned char* lds = (LAS unsigned char*)lds_raw;
    const int G = gridDim.x, bx = blockIdx.x, vcu = (G % 8 == 0) ? (bx % 8) * (G / 8) + bx / 8 : bx;
    const int NGW = G * NWAVES;
#define PH_LOCALS int tid = wave_s * 64 + lane_id(); asm volatile("" : "+v"(tid)); const int lane = tid & 63, wave = wave_s, gw = vcu * NWAVES + wave; (void)lane; (void)gw;
    volatile LAS unsigned* MISC = (volatile LAS unsigned*)(lds + LDS_MISC);
    const int wave_s = __builtin_amdgcn_readfirstlane((int)threadIdx.x >> 6);
    if (threadIdx.x < 64) MISC[threadIdx.x] = 0u;
    __syncthreads();
    unsigned char* ws = a.ws;
    unsigned* ctl = (unsigned*)(ws + WS_CTL);
    const int lo = a.ph_lo, hi = a.ph_hi;
    XcdBarrier bar; bar.bar = ctl + CW_BAR; bar.x = 0; bar.st = MISC + 8;
    if (hi - lo > 1) bar = xcd_barrier_post(ctl + CW_BAR, MISC + 8);
#define IN(k) (lo <= (k) && (k) < hi)
#ifdef DBG_TIME
    if (blockIdx.x == 0 && threadIdx.x == 0) ctl[12288 + 63] = (unsigned)__builtin_amdgcn_s_memrealtime();
#define SEAM(k) do { if (IN(k) && IN((k) + 1)) { xcd_barrier(bar, wave_s == 0 && lane_id() == 0); if (bx == 0 && wave_s == 0 && lane_id() == 0) ctl[12288 + (k)] = (unsigned)__builtin_amdgcn_s_memrealtime(); } } while (0)
#else
#define SEAM(k) do { if (IN(k) && IN((k) + 1)) xcd_barrier(bar, wave_s == 0 && lane_id() == 0); } while (0)
#endif
    float* xo = a.out;
    bf16_t* xb = (bf16_t*)(ws + WS_XB);
    unsigned char* R = ws + WS_R;

    for (int rep_ = 0; rep_ < (DBG_REP_P0A); ++rep_)
    if (EN_A && IN(0)) { PH_LOCALS
        LAS float* scr = (LAS float*)(lds + wave * 8448);
        constexpr int PER_L = 4160;
        for (int it = gw; it < NL * PER_L; it += NGW) {
            const int l = it / PER_L; int r = it - l * PER_L;
            const float* win = a.in[1] + (size_t)l * 1024 * DIN;
            unsigned char* wm = ws + WS_WMIX + (size_t)l * WMIX_STRIDE;
            if (r < 1024) { tr_item(win, DIN, 0, 2048, (bf16_t*)(wm + OFF_WIN), 1024, 0, r, 64, scr, lane); continue; } r -= 1024;
            if (r < 512) { tr_item(win, DIN, 3072, 840, (bf16_t*)(wm + OFF_WIN) + (size_t)4096 * 1024, 1024, 0, r, 32, scr, lane); continue; } r -= 512;
            if (r < 1024) { tr_item(win, DIN, 3912, 2048, (bf16_t*)(wm + OFF_WG), 1024, 0, r, 64, scr, lane); continue; } r -= 1024;
            if (r < 512) { tr_item(a.in[12] + (size_t)l * 1048576, 1024, 0, 1024, (bf16_t*)(wm + OFF_WPR), 1024, 0, r, 32, scr, lane); continue; } r -= 512;
            if (r < 512) { tr_item(a.in[14] + (size_t)l * 1048576, 1024, 0, 1024, (bf16_t*)(wm + OFF_WO), 1024, 0, r, 32, scr, lane); continue; } r -= 512;
            if (r < 512) { tr_item(a.in[13] + (size_t)l * 1048576, 1024, 0, 1024, (bf16_t*)(R + R_PT + (size_t)l * 2 * MiB), 1024, 0, r, 32, scr, lane); continue; } r -= 512;
            { const int m = r >> 5, g = (r >> 1) & 15, nb = r & 1;
              const float* src = (m ? a.in[6] : a.in[4]) + (size_t)(l * 16 + g) * 4096;
              bf16_t* dst = (bf16_t*)(ws + WS_WSM + (size_t)l * 262144 + (size_t)m * 131072) + g * 4096;
              tr_item(src, 64, 0, 64, dst, 64, 0, nb, 2, scr, lane); }
        }
        const size_t gt = (size_t)vcu * NTHR + tid, GT = (size_t)G * NTHR;
        for (size_t i = gt; i < (size_t)NL * 1024 * 128; i += GT) { const int l = (int)(i >> 17), k = (int)(i >> 7) & 1023, j8 = (int)i & 127;
            const float* s = a.in[1] + ((size_t)l * 1024 + k) * DIN + 2048 + 8 * j8; const f32x4 v0 = *(const f32x4*)s, v1 = *(const f32x4*)(s + 4);
            *(u32x4*)((bf16_t*)(R + R_WQ + (size_t)l * 2 * MiB) + (size_t)k * 1024 + 8 * j8) = pack8(v0, v1); }
        for (size_t i = gt; i < (size_t)2 * NL * 8 * 256 * 32; i += GT) { const int which = (int)(i >> 18); const int r = (int)(i & 262143); const int lh = r >> 13, c = (r >> 5) & 255, d8 = r & 31; const int h = lh & 7;
            u32x4 o = (u32x4){0u, 0u, 0u, 0u};
            if ((d8 >> 4) == (h & 1)) { const float* s = (which ? a.in[11] : a.in[10]) + ((size_t)lh * 256 + c) * 128 + 8 * (d8 & 15); o = pack8(*(const f32x4*)s, *(const f32x4*)(s + 4)); }
            *(u32x4*)((bf16_t*)(R + (which ? R_UVP : R_UKP)) + ((size_t)lh * 256 + c) * 1024 + 8 * d8) = o; }
        for (size_t i = gt; i < (size_t)T * 128; i += GT) { const float* s = a.in[0] + i * 8; const f32x4 v0 = *(const f32x4*)s, v1 = *(const f32x4*)(s + 4);
            *(u32x4*)(xb + i * 8) = pack8(v0, v1); }
    }
    SEAM(0);
    if (EN_B && IN(1)) {
        SchedPro S{R, G, vcu}; EpiPro E{ws + WS_WMIX};
        gs::gemm_stream<true>(lds, S, E, wave_s);
    }
    SEAM(1);

    for (int l = 0; l < NL; ++l) {
        const int pb = 2 + l * NPH_L;
        unsigned char* wm = ws + WS_WMIX + (size_t)l * WMIX_STRIDE;
        bf16_t* xrnn = (bf16_t*)(R + R_XRNN); bf16_t* grnn = (bf16_t*)(R + R_GRNN); bf16_t* qlat = (bf16_t*)(R + R_QLAT); bf16_t* ckv = (bf16_t*)(R + R_CKV);
        bf16_t* qidx = (bf16_t*)(R + R_QIDX); bf16_t* kidx = (bf16_t*)(R + R_KIDX); float* widx = (float*)(R + R_WIDX);
        if (EN_0 && IN(pb + 0)) {
            SchedDense S{(const char*)xb, (const char*)(wm + OFF_WIN), 2048u, 2048u, 16, T / 256, 20, G, vcu};
            EpiInproj E{xrnn, grnn, qlat, ckv, qidx, kidx, widx};
            gs::gemm_stream<true>(lds, S, E, wave_s);
#ifdef DBG_REP_INPROJ
            gs::gemm_stream<true>(lds, S, E, wave_s);
#endif
        }
        SEAM(pb + 0);
        RnnP RP{xrnn, grnn, (float*)(R + R_TOT), (const bf16_t*)(ws + WS_WSM + (size_t)l * 262144), (const bf16_t*)(ws + WS_WSM + (size_t)l * 262144 + 131072),
                a.in[2] + (size_t)l * 4096, a.in[3] + (size_t)l * 1024, a.in[5] + (size_t)l * 1024, a.in[7] + (size_t)l * 1024, a.in[8] + (size_t)l * 1024};
        if (EN_1 && IN(pb + 1)) { PH_LOCALS
#ifdef DBG_TIME
            if (tid == 0) MISC[24] = (unsigned)__builtin_amdgcn_s_memrealtime();
#endif
            for (int it = gw; it < 2048; it += NGW) rnn_item<1>(RP, it, lds + wave * 8448, lane);
#ifdef DBG_TIME
            if (tid == 0) MISC[25] = (unsigned)__builtin_amdgcn_s_memrealtime();
#endif
#ifdef DBG_REP_RNN
            for (int it = gw; it < 2048; it += NGW) rnn_item<1>(RP, it, lds + wave * 8448, lane);
#endif
            for (int row = gw; row < T; row += 4 * NGW) ckv_norm_rows4(ckv, row, NGW, T, a.in[9] + (size_t)l * 256, lane);
#ifdef DBG_TIME
            if (tid == 0) MISC[26] = (unsigned)__builtin_amdgcn_s_memrealtime();
#endif
            LAS float* scr = (LAS float*)(lds + wave * 8448);
            for (int it = gw; it < 16 * 768; it += NGW) { const int e = it / 768; int r = it - e * 768; const size_t le = (size_t)l * 16 + e;
                bf16_t* gu = (bf16_t*)(ws + WS_WEXP) + (size_t)e * 1048576; bf16_t* dn = (bf16_t*)(ws + WS_WEXP + OFF_DN) + (size_t)e * 524288;
                if (r < 256) { tr_item(a.in[19] + le * 524288, 512, 0, 512, gu, 1024, 1, r, 16, scr, lane); continue; } r -= 256;
                if (r < 256) { tr_item(a.in[20] + le * 524288, 512, 0, 512, gu + 4 * 1024, 1024, 1, r, 16, scr, lane); continue; } r -= 256;
                tr_item(a.in[21] + le * 524288, 1024, 0, 1024, dn, 512, 0, r, 32, scr, lane); }
#ifdef DBG_TIME
            if (l == 1 && bx == 0 && tid == 0) { const unsigned tq3 = (unsigned)__builtin_amdgcn_s_memrealtime();
                ctl[12288 + 48] = MISC[25] - MISC[24]; ctl[12288 + 49] = MISC[26] - MISC[25]; ctl[12288 + 50] = tq3 - MISC[26]; ctl[12288 + 51] = tq3 - MISC[24]; }
#endif
        }
        SEAM(pb + 1);
        if (EN_2 && IN(pb + 2)) { PH_LOCALS
            __syncthreads();
            if (tid < 256) ((LAS float*)(lds + AT_BIAS))[tid] = a.in[24][tid];
            if (tid < 128) { const int d = tid; int bk = d; if (d >= 16) { bk = 16 + (int)(logf((float)d / 16.0f) / 2.0794415416798357f * 16.0f); bk = bk > 31 ? 31 : bk; } ((LAS int*)(lds + AT_BKT))[d] = bk; }
            __syncthreads();
            for (int i = tid; i < 1024; i += NTHR) ((LAS float*)(lds + AT_BIAS2))[i] = ((const LAS float*)(lds + AT_BIAS))[((const LAS int*)(lds + AT_BKT))[i >> 3] * 8 + (i & 7)];
            AttnP AP{qidx, kidx, ckv, widx, qlat, (unsigned long long*)(R + R_MSCR + (size_t)bx * 393216)};
#ifdef DBG_TIME
            unsigned tph0 = (unsigned)__builtin_amdgcn_s_memrealtime();
#endif
#ifdef DBG_STATIC_UNITS
            if (EN_2A) for (int p = vcu; p < 512; p += G) { const int b = p >> 8, uu = p & 255;
#pragma unroll 1
                for (int k2 = 0; k2 < 2; ++k2) { attn_unit(lds, AP, b, k2 ? uu : 511 - uu, tid);
#ifdef DBG_TIME
                    if (tid == 0) MISC[21] = MISC[21] + 1u;
#endif
                } }
#else
            if (EN_2A) for (;;) {
                __syncthreads();
                if (tid == 0) MISC[4] = __hip_atomic_fetch_add(ctl + CW_QUEUE + l * 64, 1u, __ATOMIC_RELAXED, __HIP_MEMORY_SCOPE_AGENT);
                __syncthreads();
                const unsigned tk = MISC[4];
                if (tk >= 1024u) break;
                attn_unit(lds, AP, (int)(tk & 1u), 511 - (int)(tk >> 1), tid);
#ifdef DBG_TIME
                if (tid == 0) MISC[21] = MISC[21] + 1u;
#endif
            }
            __syncthreads();
#endif
#ifdef DBG_TIME
            if (l == 1 && bx == 0 && tid == 0) { for (int i_ = 0; i_ < 6; ++i_) ctl[12288 + 40 + i_] = ((LAS unsigned*)(lds + LDS_MISC))[16 + i_]; ctl[12288 + 46] = ((LAS unsigned*)(lds + LDS_MISC))[16]; }
            if (l == 0 && tid == 0) { for (int i_ = 0; i_ < 6; ++i_) ((LAS unsigned*)(lds + LDS_MISC))[16 + i_] = 0u; }
            __syncthreads();
            unsigned tph1 = (unsigned)__builtin_amdgcn_s_memrealtime();
            if (l == 1 && bx == 0 && tid == 0) ctl[12288 + 47] = tph1 - tph0;
            if (l == 1 && tid == 0) { __hip_atomic_fetch_max(ctl + 12288 + 59, tph1 - tph0, __ATOMIC_RELAXED, __HIP_MEMORY_SCOPE_AGENT); __hip_atomic_fetch_max(ctl + 12288 + 58, 0x40000000u - (tph1 - tph0), __ATOMIC_RELAXED, __HIP_MEMORY_SCOPE_AGENT); }
#endif
            if (EN_2R) for (int it = gw; it < 2048; it += NGW) rnn_item<2>(RP, it, lds + wave * 8448, lane);
#ifdef DBG_TIME
            { __syncthreads(); const unsigned tph2 = (unsigned)__builtin_amdgcn_s_memrealtime();
              if (l == 1 && tid == 0) __hip_atomic_fetch_max(ctl + 12288 + 57, tph2 - tph1, __ATOMIC_RELAXED, __HIP_MEMORY_SCOPE_AGENT); }
#endif
        }
        SEAM(pb + 2);
        if (EN_3 && IN(pb + 3)) {
            if (EN_M1) { SchedMerge1 S{(const char*)xb, (const char*)grnn, (const char*)(wm + OFF_WG), (const char*)(wm + OFF_WPR), G, vcu};
              EpiMerge1 E{R + R_MSCR + (size_t)bx * 131072, R + R_MSCR2, (bf16_t*)(R + R_MERGED)};
              gs::gemm_stream<true>(lds, S, E, wave_s); }
            if (EN_M2) { SchedDense S{(const char*)qlat, (const char*)(wm + OFF_WVO), 4096u, 4096u, 32, T / 256, 4, G, vcu};
              EpiMerge2 E{R + R_MSCR2, (bf16_t*)(R + R_MERGED)};
              gs::gemm_stream<true>(lds, S, E, wave_s); }
        }
        SEAM(pb + 3);
        if (EN_4 && IN(pb + 4)) {
            SchedDense S{(const char*)(R + R_MERGED), (const char*)(wm + OFF_WO), 2048u, 2048u, 16, T / 256, 4, G, vcu};
            EpiOut E{xb};
            gs::gemm_stream<true>(lds, S, E, wave_s);
        }
        SEAM(pb + 4);
        RouteP RT{(int*)(R + R_ROUTE), (int*)(R + R_ROUTE + 262144), (int*)(R + R_ROUTE + 524288), (float*)(R + R_ROUTE + 786432), ctl + CW_CNT + l * 16 * 64};
        LAS int* offp = (LAS int*)(lds + LDS_MISC - 128);
        if (EN_5 && IN(pb + 5)) { PH_LOCALS
            __syncthreads();
            { float wv[32];
#pragma unroll
              for (int j = 0; j < 32; ++j) wv[j] = a.in[17][tid + j * NTHR];
#pragma unroll
              for (int j = 0; j < 32; ++j) { const int i = tid + j * NTHR; ((LAS float*)lds)[(i & 15) * 1024 + (i >> 4)] = wv[j]; } }
            for (int blk = vcu; blk < T / 128; blk += G) ln1_route_block(lds, blk, xo, xb, a.in[15] + (size_t)l * 1024, a.in[16] + (size_t)l * 1024, a.in[18], RT, tid);
        }
        SEAM(pb + 5);
        int* tokof = (int*)(R + R_ROUTE + 1048576);
        if (EN_6 && IN(pb + 6)) { PH_LOCALS
            moe_offsets(offp, RT.gcnt, tid);
            for (int p = vcu * NTHR + tid; p < 2 * T; p += G * NTHR) { const int e = RT.r_e[p], slot = offp[e] + RT.r_pos[p]; RT.r_slot[p] = slot; tokof[slot] = p >> 1; }
            if (vcu == 0 && tid < 256) {
                for (int e = 0; e < 16; ++e) { const int cnt = (int)__hip_atomic_load(RT.gcnt + e * 64, __ATOMIC_RELAXED, __HIP_MEMORY_SCOPE_AGENT); const int s0 = offp[e] + cnt;
                    if (s0 + tid < offp[e + 1]) tokof[s0 + tid] = 0; } }
        }
        SEAM(pb + 6);
        if (EN_7 && IN(pb + 7)) { PH_LOCALS
            moe_offsets(offp, RT.gcnt, tid);
            SchedMoEG S{(const char*)xb, (const char*)(ws + WS_WEXP), 2048u, 2048u, (size_t)2097152, 16, 4, G, vcu, offp, tokof};
            EpiGU E{(bf16_t*)(R + R_HE)};
            gs::gemm_stream<true, SchedMoEG, EpiGU, true>(lds, S, E, wave_s);
        }
        SEAM(pb + 7);
        if (EN_8 && IN(pb + 8)) { PH_LOCALS
            moe_offsets(offp, RT.gcnt, tid);
            SchedMoE S{(const char*)(R + R_HE), (const char*)(ws + WS_WEXP + OFF_DN), 1024u, 1024u, (size_t)1048576, 8, 4, G, vcu, offp};
            EpiBf16 E{(bf16_t*)(R + R_XG), 1024};
            gs::gemm_stream<true>(lds, S, E, wave_s);
        }
        SEAM(pb + 8);
        if (EN_9 && IN(pb + 9)) { PH_LOCALS
            const bf16_t* Y = (const bf16_t*)(R + R_XG);
            u32x2 xwn[4], y0n[4], y1n[4]; int s0n, s1n; f32x2 ggc, ggn;
            { const int r0 = gw < T ? gw : T - 1, r1 = gw + NGW < T ? gw + NGW : T - 1;
              const int a0 = RT.r_slot[2 * r0], a1 = RT.r_slot[2 * r0 + 1]; ggc = *(const f32x2*)(RT.r_g + 2 * (size_t)r0);
#pragma unroll
              for (int j = 0; j < 4; ++j) { xwn[j] = *(const u32x2*)(xb + (size_t)r0 * 1024 + 256 * j + 4 * lane); y0n[j] = *(const u32x2*)(Y + (size_t)a0 * 1024 + 256 * j + 4 * lane); y1n[j] = *(const u32x2*)(Y + (size_t)a1 * 1024 + 256 * j + 4 * lane); }
              s0n = RT.r_slot[2 * r1]; s1n = RT.r_slot[2 * r1 + 1]; ggn = *(const f32x2*)(RT.r_g + 2 * (size_t)r1); }
            for (int row = gw; row < T; row += NGW) {
                const f32x2 gg = ggc;
                u32x2 xwc[4], y0c[4], y1c[4];
#pragma unroll
                for (int j = 0; j < 4; ++j) { xwc[j] = xwn[j]; y0c[j] = y0n[j]; y1c[j] = y1n[j]; }
                { const int r1 = row + NGW < T ? row + NGW : T - 1, r2 = row + 2 * NGW < T ? row + 2 * NGW : T - 1;
                  const int a0 = s0n, a1 = s1n; ggc = ggn;
#pragma unroll
                  for (int j = 0; j < 4; ++j) { xwn[j] = *(const u32x2*)(xb + (size_t)r1 * 1024 + 256 * j + 4 * lane); y0n[j] = *(const u32x2*)(Y + (size_t)a0 * 1024 + 256 * j + 4 * lane); y1n[j] = *(const u32x2*)(Y + (size_t)a1 * 1024 + 256 * j + 4 * lane); }
                  s0n = RT.r_slot[2 * r2]; s1n = RT.r_slot[2 * r2 + 1]; ggn = *(const f32x2*)(RT.r_g + 2 * (size_t)r2); }
                f32x4 v[4];
#pragma unroll
                for (int j = 0; j < 4; ++j) { const u32x2 xw = xwc[j]; const f32x4 x1 = {bf_lo(xw.x), bf_hi(xw.x), bf_lo(xw.y), bf_hi(xw.y)};
                    const u32x2 y0 = y0c[j], y1 = y1c[j];
                    v[j][0] = ALPHA * x1[0] + gg.x * bf_lo(y0.x) + gg.y * bf_lo(y1.x); v[j][1] = ALPHA * x1[1] + gg.x * bf_hi(y0.x) + gg.y * bf_hi(y1.x);
                    v[j][2] = ALPHA * x1[2] + gg.x * bf_lo(y0.y) + gg.y * bf_lo(y1.y); v[j][3] = ALPHA * x1[3] + gg.x * bf_hi(y0.y) + gg.y * bf_hi(y1.y); }
                ln_finish(v, a.in[22] + (size_t)l * 1024, a.in[23] + (size_t)l * 1024, l == NL - 1 ? xo + (size_t)row * 1024 : nullptr, xb + (size_t)row * 1024, lane);
#ifdef DBG_TIME
                if (l == NL - 1) {
                    const unsigned ta = __hip_atomic_load(ctl + 12288 + (DBG_TA), __ATOMIC_RELAXED, __HIP_MEMORY_SCOPE_AGENT), tb = __hip_atomic_load(ctl + 12288 + (DBG_TB), __ATOMIC_RELAXED, __HIP_MEMORY_SCOPE_AGENT);
                    unsigned k_ = (DBG_Q) == 0 ? (40u * ta + tb / 2u) / (tb ? tb : 1u) : ((DBG_TA) == 58 ? (0x40000000u - ta) : (ta - tb)) / (unsigned)((DBG_Q) ? (DBG_Q) : 1); k_ = k_ > 45u ? 45u : k_;
                    const float sc_ = 1.0f - 0.02f * (float)k_;
#pragma unroll
                    for (int j = 0; j < 4; ++j) *(f32x4*)(xo + (size_t)row * 1024 + 256 * j + 4 * lane) = v[j] * sc_; }
#endif
            }
        }
        SEAM(pb + 9);
    }
#undef IN
#undef SEAM
}

#ifdef DUMP_OFF
__global__ void dump_k(const bf16_t* src, float* dst, size_t ld, size_t col0) { for (size_t i = (size_t)blockIdx.x * blockDim.x + threadIdx.x; i < (size_t)T * 1024; i += (size_t)gridDim.x * blockDim.x) dst[i] = bf2f(src[(i >> 10) * ld + col0 + (i & 1023)]); }
#endif
extern "C" void kernel_launch(void* const* d_in, const int* in_sizes, int n_in, void* d_out, int out_size, void* d_ws, size_t ws_size, hipStream_t stream) {
    static int grid = 0;
    if (grid == 0) {
        if (n_in != 25 || out_size != T * D || ws_size < WS_END) { fprintf(stderr, "kernel_launch: unexpected shapes (n_in %d, out %d, ws %zu < %zu)\n", n_in, out_size, ws_size, (size_t)WS_END); grid = -1; return; }
        int dev = 0, cus = 0, per_cu = 0;
        if (hipGetDevice(&dev) != hipSuccess || hipDeviceGetAttribute(&cus, hipDeviceAttributeMultiprocessorCount, dev) != hipSuccess) { grid = -1; return; }
        if (hipFuncSetAttribute((const void*)fwd, hipFuncAttributeMaxDynamicSharedMemorySize, LDS_BYTES) != hipSuccess) { fprintf(stderr, "kernel_launch: hipFuncSetAttribute failed\n"); grid = -1; return; }
        if (hipOccupancyMaxActiveBlocksPerMultiprocessor(&per_cu, (const void*)fwd, NTHR, LDS_BYTES) != hipSuccess || per_cu < 1) fprintf(stderr, "kernel_launch: occupancy query says %d\n", per_cu);
        (void)hipGetLastError();
        grid = cus < 256 ? cus : 256;
    }
    if (grid < 0) return;
    (void)hipMemsetAsync((char*)d_ws + WS_CTL, 0, CTL_BYTES, stream);
    Args a{};
    for (int i = 0; i < 25; ++i) a.in[i] = (const float*)d_in[i];
    a.out = (float*)d_out; a.ws = (unsigned char*)d_ws;
#if MK_PER_PHASE
#ifndef PH_LIMIT
#define PH_LIMIT NPH
#endif
    for (int ph = 0; ph < PH_LIMIT; ++ph) { a.ph_lo = ph; a.ph_hi = ph + 1; hipLaunchKernelGGL(fwd, dim3(grid), dim3(NTHR), LDS_BYTES, stream, a); }
#else
    a.ph_lo = 0; a.ph_hi = NPH; hipLaunchKernelGGL(fwd, dim3(grid), dim3(NTHR), LDS_BYTES, stream, a);
#endif
#ifdef DUMP_OFF
    hipLaunchKernelGGL(dump_k, dim3(2048), dim3(256), 0, stream, (const bf16_t*)((const char*)d_ws + (DUMP_OFF)), (float*)d_out, (size_t)(DUMP_LD), (size_t)(DUMP_COL));
#endif
}
```

```cpp
#include <hip/hip_runtime.h>
#include <cstdio>
#include <cstdint>

#define GAS __attribute__((address_space(1)))
#define LAS __attribute__((address_space(3)))
typedef unsigned short bf16_t;
typedef short bf16x8 __attribute__((ext_vector_type(8)));
typedef short s16x4 __attribute__((ext_vector_type(4)));
typedef float f32x2 __attribute__((ext_vector_type(2)));
typedef float f32x4 __attribute__((ext_vector_type(4)));
typedef float f32x16 __attribute__((ext_vector_type(16)));
typedef unsigned u32x2 __attribute__((ext_vector_type(2)));
typedef unsigned u32x4 __attribute__((ext_vector_type(4)));

constexpr int NB = 2, SEQ = 16384, T = NB * SEQ, D = 1024, NL = 4, DIN = 5960;
constexpr int NE = 16;
constexpr float ALPHA = 1.681792830507429f;
constexpr float LN_EPS = 1e-5f, RMS_EPS = 1e-6f;
constexpr int NWAVES = 8, NTHR = 512;

constexpr size_t MiB = 1u << 20;
constexpr size_t WS_CTL = 0, CTL_BYTES = 1 * MiB;
constexpr size_t WS_XB = 1 * MiB;
constexpr size_t WS_WMIX = 65 * MiB, WMIX_STRIDE = 22 * MiB;
constexpr size_t OFF_WIN = 0, OFF_WG = 10 * MiB, OFF_WPR = 14 * MiB, OFF_WVO = 16 * MiB, OFF_WO = 20 * MiB;
constexpr size_t WS_WSM = 153 * MiB;
constexpr size_t WS_WEXP = 154 * MiB;
constexpr size_t OFF_DN = 32 * MiB;
constexpr size_t WS_R = 202 * MiB;
constexpr size_t R_XRNN = 0, R_GRNN = 64 * MiB, R_QLAT = 128 * MiB, R_CKV = 256 * MiB, R_QIDX = 272 * MiB, R_KIDX = 304 * MiB, R_WIDX = 308 * MiB,
                 R_TOT = 309 * MiB, R_MSCR = 310 * MiB, R_MSCR2 = 342 * MiB, R_END = 406 * MiB;
constexpr size_t R_MERGED = R_XRNN;
constexpr size_t R_XG = 0, R_HE = 136 * MiB, R_ROUTE = 204 * MiB;
constexpr size_t R_WQ = 0, R_UKP = 8 * MiB, R_PT = 24 * MiB, R_UVP = 32 * MiB;
constexpr size_t WS_END = WS_R + R_END;
constexpr int MP_MAX = 2 * T + NE * 256;

constexpr int CW_TMO = 0;
constexpr int CW_BAR = 4096;
constexpr int CW_CNT = 8192;
constexpr int CW_QUEUE = 14336;

constexpr int LDS_BYTES = 163840;
constexpr int LDS_MISC = LDS_BYTES - 256;

#define RLX_AGENT __ATOMIC_RELAXED, __HIP_MEMORY_SCOPE_AGENT
__device__ __forceinline__ unsigned f2bf(float f) { unsigned u = __builtin_bit_cast(unsigned, f); return (u + 0x7fffu + ((u >> 16) & 1u)) >> 16; }
typedef __bf16 bf16x2_t __attribute__((ext_vector_type(2)));
__device__ __forceinline__ unsigned pk2(float lo, float hi) { const f32x2 v = {lo, hi}; const bf16x2_t b = __builtin_convertvector(v, bf16x2_t); return __builtin_bit_cast(unsigned, b); }
__device__ __forceinline__ float bf_lo(unsigned w) { return __builtin_bit_cast(float, w << 16); }
__device__ __forceinline__ float bf_hi(unsigned w) { return __builtin_bit_cast(float, w & 0xffff0000u); }
__device__ __forceinline__ float bf2f(bf16_t h) { return __builtin_bit_cast(float, ((unsigned)h) << 16); }
__device__ __forceinline__ float fast_exp(float x) { return __builtin_amdgcn_exp2f(x * 1.4426950408889634f); }
__device__ __forceinline__ float fast_rcp(float x) { return __builtin_amdgcn_rcpf(x); }
__device__ __forceinline__ float sigmoidf_(float x) { return fast_rcp(1.0f + fast_exp(-x)); }
__device__ __forceinline__ float gelu_tanh(float x) { const float y = 0.7978845608028654f * (x + 0.044715f * x * x * x); const float e = fast_exp(2.0f * y); const float th = 1.0f - 2.0f * fast_rcp(e + 1.0f); return 0.5f * x * (1.0f + th); }
template <int CTRL> __device__ __forceinline__ float dpp_f(float v) { return __builtin_bit_cast(float, __builtin_amdgcn_update_dpp(0, __builtin_bit_cast(int, v), CTRL, 0xf, 0xf, true)); }
__device__ __forceinline__ float wave_sum(float v) {
    v += dpp_f<0xB1>(v); v += dpp_f<0x4E>(v); v += dpp_f<0x141>(v); v += dpp_f<0x140>(v);
    const int vi = __builtin_bit_cast(int, v);
    return (__builtin_bit_cast(float, __builtin_amdgcn_readlane(vi, 0)) + __builtin_bit_cast(float, __builtin_amdgcn_readlane(vi, 16))) +
           (__builtin_bit_cast(float, __builtin_amdgcn_readlane(vi, 32)) + __builtin_bit_cast(float, __builtin_amdgcn_readlane(vi, 48)));
}

__device__ __forceinline__ int lane_id() { unsigned z = 0u; asm volatile("" : "+v"(z)); return (int)__builtin_amdgcn_mbcnt_hi(~0u, __builtin_amdgcn_mbcnt_lo(~0u, z)); }
#define XB_TMO      128
#define XB_XCNT(j)  (256  + 64 * (j))
#define XB_XSUB(j)  (1280 + 64 * (j))
#define XB_XGEN(j)  (2304 + 64 * (j))
#define XB_TOP      3328
#define XB_TOPGEN   3392
#define XCD_BAR_WORDS 3456
#define XB_SPIN_CAP (1u << 18)
__device__ __forceinline__ unsigned xb_ld(unsigned* p)              { return __hip_atomic_load(p, __ATOMIC_RELAXED, __HIP_MEMORY_SCOPE_AGENT); }
__device__ __forceinline__ unsigned xb_add(unsigned* p, unsigned v) { return __hip_atomic_fetch_add(p, v, __ATOMIC_RELAXED, __HIP_MEMORY_SCOPE_AGENT); }
__device__ __forceinline__ unsigned xb_xcc_id() { return (unsigned)__builtin_amdgcn_s_getreg((3 << 11) | 20) & 0xFu; }
#define XB_SPIN(cond, bar) do { unsigned _sp = 0; while (cond) { __builtin_amdgcn_s_sleep(1); \
    if ((++_sp & 255u) == 0u) { if (xb_ld(&(bar)[XB_TMO])) break; if (_sp > XB_SPIN_CAP) { atomicAdd(&(bar)[XB_TMO], 1u); break; } } } } while (0)
struct XcdBarrier { unsigned* bar; unsigned x; volatile LAS unsigned* st; };
__device__ __forceinline__ XcdBarrier xcd_barrier_post(unsigned* bar, volatile LAS unsigned* st) {
    XcdBarrier b; b.bar = bar; b.x = xb_xcc_id(); b.st = st;
    if (threadIdx.x == 0) (void)xb_add(&bar[XB_XCNT(b.x)], 1u);
    return b;
}
__device__ __forceinline__ void xcd_barrier_complete(unsigned* bar, unsigned x, unsigned& nloc, unsigned& nx) {
    const unsigned G = gridDim.x * gridDim.y * gridDim.z;
    unsigned sum, cnt, mine, sp = 0u;
    for (;;) {
        sum = 0u; cnt = 0u; mine = 0u;
#pragma unroll
        for (unsigned j = 0; j < 16; ++j) { const unsigned c = xb_ld(&bar[XB_XCNT(j)]); sum += c; cnt += (c > 0u) ? 1u : 0u; mine = (j == x) ? c : mine; }
        if (sum == G) break;
        __builtin_amdgcn_s_sleep(1);
        if ((++sp & 255u) == 0u) { if (xb_ld(&bar[XB_TMO])) break; if (sp > XB_SPIN_CAP) { atomicAdd(&bar[XB_TMO], 1u); break; } }
    }
    nloc = mine > 0u ? mine : 1u; nx = cnt > 0u ? cnt : 1u;
}
__device__ __forceinline__ void xcd_barrier(const XcdBarrier& b, bool is_t0) {
    asm volatile("s_waitcnt vmcnt(0)" ::: "memory");
    __syncthreads();
    if (is_t0) {
        unsigned* bar = b.bar;
        __builtin_amdgcn_s_waitcnt(0);
        unsigned nloc = b.st[0], nx = b.st[1];
        if (nloc == 0u) { xcd_barrier_complete(bar, b.x, nloc, nx); b.st[0] = nloc; b.st[1] = nx; }
        const unsigned old = xb_add(&bar[XB_XSUB(b.x)], 1u);
        const unsigned gen = old / nloc;
        if (old + 1u == (gen + 1u) * nloc) {
            __builtin_amdgcn_fence(__ATOMIC_RELEASE, "agent");
            asm volatile("s_waitcnt vmcnt(0)" ::: "memory");
            const unsigned og = xb_add(&bar[XB_TOP], 1u);
            const unsigned tg = og / nx;
            if (og + 1u == (tg + 1u) * nx) xb_add(&bar[XB_TOPGEN], 1u);
            else XB_SPIN(xb_ld(&bar[XB_TOPGEN]) == tg, bar);
            __builtin_amdgcn_fence(__ATOMIC_ACQUIRE, "agent");
            xb_add(&bar[XB_XGEN(b.x)], 1u);
            asm volatile("s_waitcnt vmcnt(0)" ::: "memory");
        } else {
            XB_SPIN(xb_ld(&bar[XB_XGEN(b.x)]) == gen, bar);
            __builtin_amdgcn_fence(__ATOMIC_ACQUIRE, "agent");
            asm volatile("s_waitcnt vmcnt(0)" ::: "memory");
        }
    }
    __syncthreads();
}
namespace gs {
constexpr int BM = 256, BK = 64, HALF = 128, HTB = HALF * BK * 2, STAGE_BYTES = 8 * HTB, NXCD = 8, WGM = 8;
__host__ __device__ __forceinline__ int lds_byte(int r, int c) { const int st = (r >> 4) * 2 + (c >> 5), rr = r & 15, cc = c & 31, ob = rr * 64 + cc * 2; return st * 1024 + (ob ^ (((ob >> 9) & 1) << 5)); }
__host__ __device__ __forceinline__ void stage_rc(int b, int& R, int& C) { const int st = b / 1024, sb = b % 1024, swz = sb ^ (((sb >> 9) & 1) << 5); R = (st >> 1) * 16 + swz / 64; C = (st & 1) * 32 + (swz % 64) / 2; }
__host__ __device__ __forceinline__ int perm32(int rho) { const int n = rho >> 4, i = rho & 15; return 8 * (i >> 2) + 4 * n + (i & 3); }

struct UD { const char* A; const char* B; unsigned lda, ldb; int nt; int kind, pm, pn, aux; };

__device__ __forceinline__ bool tile_of(long L, int nM, int nN, int& pm, int& pn) {
    const int nwg = nM * nN; if (L >= nwg) return false;
    int wgid = (int)L; { const int q = nwg / NXCD, r = nwg % NXCD, xcd = wgid % NXCD, off = wgid / NXCD; wgid = (xcd < r ? xcd * (q + 1) : r * (q + 1) + (xcd - r) * q) + off; }
    const int nig = WGM * nN, gid = wgid / nig, fm = gid * WGM, gsz = (nM - fm) < WGM ? (nM - fm) : WGM;
    pm = fm + ((wgid % nig) % gsz); pn = (wgid % nig) / gsz; return true;
}

template <bool PERM, class Sched, class Epi, bool GATHER = false>
__device__ __forceinline__ void gemm_stream(LAS unsigned char* lds, const Sched& S, const Epi& E, int wave_s) {
    int tid = wave_s * 64 + lane_id(); asm volatile("" : "+v"(tid));
    const int wid = __builtin_amdgcn_readfirstlane(tid >> 6), lane = tid & 63, wr = wid >> 2, wc = wid & 3, fr = lane & 15, fq = lane >> 4;
    int rA[2], rB[2], cb[2];
#pragma unroll
    for (int i = 0; i < 2; ++i) { int R, C; stage_rc(tid * 16 + i * 8192, R, C); rA[i] = R; rB[i] = PERM ? ((R & ~31) + perm32(R & 31)) : R; cb[i] = C * 2; }
    const size_t kstep = (size_t)(BK * 2);
    const unsigned ldsw = (unsigned)wid * 1024u;
    const int aoff = lds_byte(wr * 64 + fr, fq * 8), boff = lds_byte(wc * 32 + fr, fq * 8);
#define GS_SA(b, h) (((b) * 2 + (h)) * HTB)
#define GS_SB(b, h) ((4 + (b) * 2 + (h)) * HTB)
#define GS_STAGE(bufoff, gbase, voff) do { _Pragma("unroll") for (int _i = 0; _i < 2; ++_i) \
        __builtin_amdgcn_global_load_lds((const unsigned*)((const char*)(gbase) + (voff)[_i]), (LAS unsigned*)(lds + (bufoff) + ldsw + _i * 8192), 16, 0, 0); } while (0)
#define GS_LDA(dst, b, h) do { _Pragma("unroll") for (int m = 0; m < 4; ++m) _Pragma("unroll") for (int k = 0; k < 2; ++k) dst[m][k] = *(const LAS bf16x8*)(lds + GS_SA(b, h) + aoff + m * 2048 + k * 1024); } while (0)
#define GS_LDB(dst, b, h) do { _Pragma("unroll") for (int n = 0; n < 2; ++n) _Pragma("unroll") for (int k = 0; k < 2; ++k) dst[n][k] = *(const LAS bf16x8*)(lds + GS_SB(b, h) + boff + n * 2048 + k * 1024); } while (0)
#define GS_MMA(ai, bj, At, Bt) do { __builtin_amdgcn_s_setprio(1); _Pragma("unroll") for (int m = 0; m < 4; ++m) _Pragma("unroll") for (int n = 0; n < 2; ++n) _Pragma("unroll") for (int k = 0; k < 2; ++k) \
        acc[ai][bj][m][n] = __builtin_amdgcn_mfma_f32_16x16x32_bf16(Bt[n][k], At[m][k], acc[ai][bj][m][n], 0, 0, 0); __builtin_amdgcn_s_setprio(0); } while (0)
#define GS_WAIT_V(n) asm volatile("s_waitcnt vmcnt(" #n ")" ::: "memory")
#define GS_WAIT_L(n) asm volatile("s_waitcnt lgkmcnt(" #n ")" ::: "memory")
#define GS_BAR __builtin_amdgcn_s_barrier()
#define GS_SCHED __builtin_amdgcn_sched_barrier(0)
    UD cur, nxt; int ui = 0; const bool prime = false;
    if (!S.next(0, cur)) return;
    f32x4 acc[2][2][4][2];
#pragma unroll
    for (int a = 0; a < 2; ++a)
#pragma unroll
        for (int b = 0; b < 2; ++b)
#pragma unroll
            for (int m = 0; m < 4; ++m)
#pragma unroll
                for (int n = 0; n < 2; ++n) acc[a][b][m][n] = (f32x4){0.f, 0.f, 0.f, 0.f};
    bf16x8 At[4][2], B0[2][2], B1[2][2];
    unsigned vAc[2], vBc[2], vAc1[2] = {0u, 0u};
#pragma unroll
    for (int i = 0; i < 2; ++i) { vAc[i] = (unsigned)rA[i] * cur.lda + (unsigned)cb[i]; vBc[i] = (unsigned)rB[i] * cur.ldb + (unsigned)cb[i]; }
    if constexpr (GATHER) { const int* rm = S.rmap + cur.pm * 256;
#pragma unroll
        for (int i = 0; i < 2; ++i) { vAc[i] = (unsigned)rm[rA[i]] * cur.lda + (unsigned)cb[i]; vAc1[i] = (unsigned)rm[HALF + rA[i]] * cur.lda + (unsigned)cb[i]; } }
    const char* cA = cur.A; const char* cB = cur.B; size_t hA = GATHER ? (size_t)0 : (size_t)HALF * cur.lda, hB = (size_t)HALF * cur.ldb;
    GS_STAGE(GS_SB(0, 0), cB, vBc); GS_STAGE(GS_SA(0, 0), cA, vAc); GS_STAGE(GS_SB(0, 1), cB + hB, vBc); GS_STAGE(GS_SA(0, 1), cA + hA, (GATHER ? vAc1 : vAc));
    if (wr == 1) GS_BAR;
    GS_WAIT_V(4); GS_BAR;
    GS_STAGE(GS_SB(1, 0), cB + kstep, vBc); GS_STAGE(GS_SA(1, 0), cA + kstep, vAc); GS_STAGE(GS_SB(1, 1), cB + hB + kstep, vBc);
    GS_WAIT_V(6); GS_BAR;
    for (;;) {
        const bool has_next = S.next(ui + 1, nxt);
        const char* nA = has_next ? nxt.A : cA; const char* nB = has_next ? nxt.B : cB;
        const unsigned nlda = has_next ? nxt.lda : cur.lda, nldb = has_next ? nxt.ldb : cur.ldb;
        unsigned vAn[2], vBn[2], vAn1[2] = {0u, 0u};
#pragma unroll
        for (int i = 0; i < 2; ++i) { vAn[i] = (unsigned)rA[i] * nlda + (unsigned)cb[i]; vBn[i] = (unsigned)rB[i] * nldb + (unsigned)cb[i]; }
        if constexpr (GATHER) { const int* rm = S.rmap + (has_next ? nxt.pm : cur.pm) * 256;
#pragma unroll
            for (int i = 0; i < 2; ++i) { vAn[i] = (unsigned)rm[rA[i]] * nlda + (unsigned)cb[i]; vAn1[i] = (unsigned)rm[HALF + rA[i]] * nlda + (unsigned)cb[i]; } }
        const size_t hAn = GATHER ? (size_t)0 : (size_t)HALF * nlda, hBn = (size_t)HALF * nldb;
        const int nt = cur.nt;
        for (int t = 0; t < nt; t += 2) {
            const bool last = (t == nt - 2);
            const char* a1 = cA + (size_t)(t + 1) * kstep;
            const char* a2 = last ? nA : cA + (size_t)(t + 2) * kstep; const char* b2 = last ? nB : cB + (size_t)(t + 2) * kstep;
            const char* a3 = a2 + kstep; const char* b3 = b2 + kstep;
            unsigned vA2[2], vB2[2], vA21[2];
#pragma unroll
            for (int i = 0; i < 2; ++i) { vA2[i] = last ? vAn[i] : vAc[i]; vB2[i] = last ? vBn[i] : vBc[i]; vA21[i] = last ? vAn1[i] : vAc1[i]; }
            const size_t hA2 = last ? hAn : hA, hB2 = last ? hBn : hB;
            GS_LDB(B0, 0, 0); GS_SCHED; GS_LDA(At, 0, 0); GS_STAGE(GS_SA(1, 1), a1 + hA, (GATHER ? vAc1 : vAc));
            GS_WAIT_L(8); GS_BAR; GS_WAIT_L(0); GS_MMA(0, 0, At, B0); GS_BAR; GS_SCHED;
            GS_LDB(B1, 0, 1); GS_STAGE(GS_SB(0, 0), b2, vB2);
            GS_BAR; GS_WAIT_L(0); GS_MMA(0, 1, At, B1); GS_BAR;
            GS_LDA(At, 0, 1); GS_STAGE(GS_SA(0, 0), a2, vA2);
            GS_BAR; GS_WAIT_L(0); GS_MMA(1, 0, At, B0); GS_BAR; GS_SCHED;
            GS_STAGE(GS_SB(0, 1), b2 + hB2, vB2);
            GS_WAIT_V(6); GS_BAR; GS_MMA(1, 1, At, B1); GS_BAR;
            GS_LDB(B0, 1, 0); GS_SCHED; GS_LDA(At, 1, 0); GS_STAGE(GS_SA(0, 1), a2 + hA2, (GATHER ? vA21 : vA2));
            GS_WAIT_L(8); GS_BAR; GS_WAIT_L(0); GS_MMA(0, 0, At, B0); GS_BAR; GS_SCHED;
            GS_LDB(B1, 1, 1); GS_STAGE(GS_SB(1, 0), b3, vB2);
            GS_BAR; GS_WAIT_L(0); GS_MMA(0, 1, At, B1); GS_BAR;
            GS_LDA(At, 1, 1); GS_STAGE(GS_SA(1, 0), a3, vA2);
            GS_BAR; GS_WAIT_L(0); GS_MMA(1, 0, At, B0); GS_BAR; GS_SCHED;
            GS_STAGE(GS_SB(1, 1), b3 + hB2, vB2);
            GS_WAIT_V(6); GS_BAR; GS_MMA(1, 1, At, B1); GS_BAR;
        }
        if (!prime) { int tz = wave_s * 64 + lane_id(); asm volatile("" : "+v"(tz)); const int w2 = __builtin_amdgcn_readfirstlane(tz >> 6), l2 = tz & 63; E(acc, cur, w2 >> 2, w2 & 3, l2 & 15, l2 >> 4, tz); }
        if (!has_next) break;
#pragma unroll
        for (int a = 0; a < 2; ++a)
#pragma unroll
            for (int b = 0; b < 2; ++b)
#pragma unroll
                for (int m = 0; m < 4; ++m)
#pragma unroll
                    for (int n = 0; n < 2; ++n) acc[a][b][m][n] = (f32x4){0.f, 0.f, 0.f, 0.f};
        cur = nxt; cA = nA; cB = nB; hA = hAn; hB = hBn;
#pragma unroll
        for (int i = 0; i < 2; ++i) { vAc[i] = vAn[i]; vBc[i] = vBn[i]; vAc1[i] = vAn1[i]; }
        ++ui;
    }
    GS_WAIT_V(0);
    if (wr == 0) GS_BAR;
    GS_BAR;
#undef GS_SA
#undef GS_SB
#undef GS_STAGE
#undef GS_LDA
#undef GS_LDB
#undef GS_MMA
#undef GS_WAIT_V
#undef GS_WAIT_L
#undef GS_BAR
#undef GS_SCHED
}
}
using gs::UD;
__device__ __forceinline__ u32x4 pack8(f32x4 v0, f32x4 v1) { u32x4 w; w.x = pk2(v0[0], v0[1]); w.y = pk2(v0[2], v0[3]); w.z = pk2(v1[0], v1[1]); w.w = pk2(v1[2], v1[3]); return w; }
__device__ __forceinline__ void unpack8(u32x4 w, f32x4& v0, f32x4& v1) { v0 = (f32x4){bf_lo(w.x), bf_hi(w.x), bf_lo(w.y), bf_hi(w.y)}; v1 = (f32x4){bf_lo(w.z), bf_hi(w.z), bf_lo(w.w), bf_hi(w.w)}; }

struct EpiInproj {
    bf16_t *xrnn, *grnn, *qlat, *ckv, *qidx, *kidx; float* widx;
    __device__ __forceinline__ void operator()(const f32x4 (&acc)[2][2][4][2], const UD& u, int wr, int wc, int fr, int fq, int tid) const {
        const int pn = u.pn; const size_t row0 = (size_t)u.pm * 256 + wr * 64 + fr;
        if (pn < 19) {
            bf16_t* base; int ldc, colt; float sc = 1.f; bool gl = false;
            if (pn < 4) { base = xrnn; ldc = 1024; colt = 256 * pn; }
            else if (pn < 8) { base = grnn; ldc = 1024; colt = 256 * (pn - 4); gl = true; }
            else if (pn < 16) { base = qlat; ldc = 2048; colt = 256 * (pn - 8); }
            else if (pn == 16) { base = ckv; ldc = 256; colt = 0; }
            else { base = qidx; ldc = 512; colt = 256 * (pn - 17); sc = 0.125f; }
#pragma unroll
            for (int ai = 0; ai < 2; ++ai)
#pragma unroll
                for (int m = 0; m < 4; ++m) { bf16_t* rowp = base + (row0 + ai * 128 + m * 16) * ldc + colt + wc * 32 + 8 * fq;
#pragma unroll
                    for (int bj = 0; bj < 2; ++bj) { f32x4 v0 = acc[ai][bj][m][0], v1 = acc[ai][bj][m][1];
                        if (gl) {
#pragma unroll
                            for (int j = 0; j < 4; ++j) { v0[j] = gelu_tanh(v0[j]); v1[j] = gelu_tanh(v1[j]); } }
                        v0 = v0 * sc; v1 = v1 * sc;
                        *(u32x4*)(rowp + bj * 128) = pack8(v0, v1); } }
        } else {
#pragma unroll
            for (int ai = 0; ai < 2; ++ai)
#pragma unroll
                for (int m = 0; m < 4; ++m) { const size_t row = row0 + ai * 128 + m * 16; const f32x4 v0 = acc[ai][0][m][0], v1 = acc[ai][0][m][1];
                    if (wc < 2) *(u32x4*)(kidx + row * 64 + wc * 32 + 8 * fq) = pack8(v0, v1);
                    else if (wc == 2 && fq == 0) { *(f32x4*)(widx + row * 8) = v0 * 0.35355339059327373f; *(f32x4*)(widx + row * 8 + 4) = v1 * 0.35355339059327373f; } }
        }
    }
};
struct EpiMerge1 {
    unsigned char* s1b; unsigned char* s2b; bf16_t* merged;
    __device__ __forceinline__ void operator()(const f32x4 (&acc)[2][2][4][2], const UD& u, int wr, int wc, int fr, int fq, int tid) const {
        const int kind = u.kind;
        u32x4* s1 = (u32x4*)s1b + tid; u32x4* s2 = (u32x4*)(s2b + (size_t)(u.pm * 4 + u.pn) * 131072) + tid;
#pragma unroll
        for (int ai = 0; ai < 2; ++ai)
#pragma unroll
            for (int bj = 0; bj < 2; ++bj)
#pragma unroll
                for (int m = 0; m < 4; ++m) { const int slot = (ai * 2 + bj) * 4 + m; f32x4 v0 = acc[ai][bj][m][0], v1 = acc[ai][bj][m][1];
                    if (kind != 1) {
#pragma unroll
                        for (int j = 0; j < 4; ++j) { v0[j] = sigmoidf_(v0[j]); v1[j] = sigmoidf_(v1[j]); }
#ifdef DBG_S1_CONST
                        { const float cv = (float)(u.pm * 4 + u.pn + 1) * (1.0f / 512.0f); v0 = (f32x4){cv, cv, cv, cv}; v1 = v0; }
#endif
                        (kind == 0 ? s1 : s2)[slot * 512] = pack8(v0, v1);
                    } else {
                        f32x4 a0, a1; unpack8(__builtin_nontemporal_load(s1 + slot * 512), a0, a1);
#ifdef DBG_NO_S1
                        a0 = (f32x4){1.f, 1.f, 1.f, 1.f}; a1 = a0;
#endif
                        const size_t row = (size_t)u.pm * 256 + ai * 128 + wr * 64 + m * 16 + fr;
                        *(u32x4*)(merged + row * 1024 + u.pn * 256 + bj * 128 + wc * 32 + 8 * fq) = pack8(a0 * v0, a1 * v1);
#ifdef DBG_OUT_S1
                        *(u32x4*)(merged + row * 1024 + u.pn * 256 + bj * 128 + wc * 32 + 8 * fq) = pack8(a0, a1);
#endif
                    }
                    if (m & 1) asm volatile("" ::: "memory"); }
    }
};
struct EpiMerge2 {
    unsigned char* s2b; bf16_t* merged;
    __device__ __forceinline__ void operator()(const f32x4 (&acc)[2][2][4][2], const UD& u, int wr, int wc, int fr, int fq, int tid) const {
        const u32x4* s2 = (const u32x4*)(s2b + (size_t)(u.pm * 4 + u.pn) * 131072) + tid;
#pragma unroll
        for (int ai = 0; ai < 2; ++ai)
#pragma unroll
            for (int bj = 0; bj < 2; ++bj)
#pragma unroll
                for (int m = 0; m < 4; ++m) { const int slot = (ai * 2 + bj) * 4 + m;
                    const size_t row = (size_t)u.pm * 256 + ai * 128 + wr * 64 + m * 16 + fr;
                    u32x4* mp = (u32x4*)(merged + row * 1024 + u.pn * 256 + bj * 128 + wc * 32 + 8 * fq);
                    f32x4 a0, a1, b0, b1; unpack8(__builtin_nontemporal_load(mp), a0, a1); unpack8(__builtin_nontemporal_load(s2 + slot * 512), b0, b1);
#ifdef DBG_NO_S2
                    b0 = (f32x4){1.f, 1.f, 1.f, 1.f}; b1 = b0;
#endif
#ifdef DBG_NO_MRG
                    a0 = (f32x4){0.f, 0.f, 0.f, 0.f}; a1 = a0;
#endif
                    *mp = pack8(a0 + b0 * acc[ai][bj][m][0], a1 + b1 * acc[ai][bj][m][1]);
                    if (m & 1) asm volatile("" ::: "memory"); }
    }
};
struct EpiOut {
    bf16_t* xb;
    __device__ __forceinline__ void operator()(const f32x4 (&acc)[2][2][4][2], const UD& u, int wr, int wc, int fr, int fq, int tid) const {
#pragma unroll
        for (int ai = 0; ai < 2; ++ai)
#pragma unroll
            for (int m = 0; m < 4; ++m) { bf16_t* rowp = xb + ((size_t)u.pm * 256 + ai * 128 + wr * 64 + m * 16 + fr) * 1024 + u.pn * 256 + wc * 32 + 8 * fq;
#pragma unroll
                for (int bj = 0; bj < 2; ++bj) { u32x4* p = (u32x4*)(rowp + bj * 128); const u32x4 xv = *p; f32x4 v0 = acc[ai][bj][m][0], v1 = acc[ai][bj][m][1];
                    v0[0] += ALPHA * bf_lo(xv.x); v0[1] += ALPHA * bf_hi(xv.x); v0[2] += ALPHA * bf_lo(xv.y); v0[3] += ALPHA * bf_hi(xv.y);
                    v1[0] += ALPHA * bf_lo(xv.z); v1[1] += ALPHA * bf_hi(xv.z); v1[2] += ALPHA * bf_lo(xv.w); v1[3] += ALPHA * bf_hi(xv.w);
                    *p = pack8(v0, v1); } }
    }
};
struct EpiGU {
    bf16_t* he;
    __device__ __forceinline__ void operator()(const f32x4 (&acc)[2][2][4][2], const UD& u, int wr, int wc, int fr, int fq, int tid) const {
#pragma unroll
        for (int ai = 0; ai < 2; ++ai)
#pragma unroll
            for (int m = 0; m < 4; ++m) { bf16_t* rowp = he + ((size_t)u.pm * 256 + ai * 128 + wr * 64 + m * 16 + fr) * 512 + u.pn * 128 + wc * 16 + 4 * fq;
#pragma unroll
                for (int bj = 0; bj < 2; ++bj) { const f32x4 g = acc[ai][bj][m][0], up = acc[ai][bj][m][1]; f32x4 o;
#pragma unroll
                    for (int j = 0; j < 4; ++j) o[j] = g[j] * sigmoidf_(g[j]) * up[j];
                    u32x2 w; w.x = pk2(o[0], o[1]); w.y = pk2(o[2], o[3]); *(u32x2*)(rowp + bj * 64) = w; } }
    }
};
struct EpiBf16 {
    bf16_t* out; int ldc;
    __device__ __forceinline__ void operator()(const f32x4 (&acc)[2][2][4][2], const UD& u, int wr, int wc, int fr, int fq, int tid) const {
#pragma unroll
        for (int ai = 0; ai < 2; ++ai)
#pragma unroll
            for (int m = 0; m < 4; ++m) { bf16_t* rowp = out + ((size_t)u.pm * 256 + ai * 128 + wr * 64 + m * 16 + fr) * ldc + u.pn * 256 + wc * 32 + 8 * fq;
#pragma unroll
                for (int bj = 0; bj < 2; ++bj) *(u32x4*)(rowp + bj * 128) = pack8(acc[ai][bj][m][0], acc[ai][bj][m][1]); }
    }
};
struct EpiPro {
    unsigned char* wmix;
    __device__ __forceinline__ void operator()(const f32x4 (&acc)[2][2][4][2], const UD& u, int wr, int wc, int fr, int fq, int tid) const {
        const int l = u.aux >> 3, h = u.aux & 7, p = u.pn;
        bf16_t* base; int ldc; float sc;
        if (u.kind == 0) { base = (bf16_t*)(wmix + (size_t)l * WMIX_STRIDE + OFF_WIN) + (size_t)(2048 + 256 * h) * 1024 + 256 * p; ldc = 1024; sc = 0.08838834764831845f; }
        else { base = (bf16_t*)(wmix + (size_t)l * WMIX_STRIDE + OFF_WVO) + (size_t)(256 * p) * 2048 + 256 * h; ldc = 2048; sc = 1.f; }
#pragma unroll
        for (int ai = 0; ai < 2; ++ai)
#pragma unroll
            for (int m = 0; m < 4; ++m) { bf16_t* rowp = base + (size_t)(ai * 128 + wr * 64 + m * 16 + fr) * ldc + wc * 32 + 8 * fq;
#pragma unroll
                for (int bj = 0; bj < 2; ++bj) *(u32x4*)(rowp + bj * 128) = pack8(acc[ai][bj][m][0] * sc, acc[ai][bj][m][1] * sc); }
    }
};

struct SchedDense {
    const char* A; const char* B; unsigned lda, ldb; int nt, nM, nN, G, c;
    __device__ __forceinline__ bool next(int i, UD& u) const {
        int pm, pn; if (!gs::tile_of((long)i * G + c, nM, nN, pm, pn)) return false;
        u.A = A + (size_t)pm * 256 * lda; u.B = B + (size_t)pn * 256 * ldb; u.lda = lda; u.ldb = ldb; u.nt = nt; u.kind = 0; u.pm = pm; u.pn = pn; u.aux = 0; return true;
    }
};
struct SchedMerge1 {
    const char *xb, *yrnn, *wg, *wpr; int G, c;
    __device__ __forceinline__ bool next(int i_, UD& u) const { int i = i_;
#ifdef DBG_DUPFIRST
        if (i > 0) i -= 1;
#endif
#ifdef DBG_ORDER201
        const int ti = i / 3, kk_ = i - 3 * ti, k = kk_ == 0 ? 2 : kk_ - 1;
#else
        const int ti = i / 3, k = i - 3 * ti;
#endif
        int pm, pn; if (!gs::tile_of((long)ti * G + c, T / 256, 4, pm, pn)) return false;
        u.kind = k; u.pm = pm; u.pn = pn; u.aux = 0; u.lda = 2048; u.ldb = 2048; u.nt = 16;
#ifdef DBG_K0_AS_K1
        if (k == 0) { u.A = yrnn + (size_t)pm * 256 * 2048; u.B = wpr + (size_t)pn * 256 * 2048; }
#else
        if (k == 0) { u.A = xb + (size_t)pm * 256 * 2048; u.B = wg + (size_t)pn * 256 * 2048; }
#endif
        else if (k == 1) { u.A = yrnn + (size_t)pm * 256 * 2048; u.B = wpr + (size_t)pn * 256 * 2048; }
        else { u.A = xb + (size_t)pm * 256 * 2048; u.B = wg + (size_t)(1024 + pn * 256) * 2048; }
        return true;
    }
};
struct SchedMoE {
    const char* A; const char* B; unsigned lda, ldb; size_t bstride; int nt, nN, G, c; const LAS int* offp;
    __device__ __forceinline__ bool next(int i, UD& u) const {
        const int nM = offp[16] >> 8; int pm, pn; if (!gs::tile_of((long)i * G + c, nM, nN, pm, pn)) return false;
        int e = 0;
#pragma unroll 1
        for (int j = 1; j < 16; ++j) e += (pm * 256 >= offp[j]) ? 1 : 0;
        u.A = A + (size_t)pm * 256 * lda; u.B = B + (size_t)e * bstride + (size_t)pn * 256 * ldb; u.lda = lda; u.ldb = ldb; u.nt = nt; u.kind = 0; u.pm = pm; u.pn = pn; u.aux = e; return true;
    }
};
struct SchedMoEG {
    const char* A; const char* B; unsigned lda, ldb; size_t bstride; int nt, nN, G, c; const LAS int* offp; const int* rmap;
    __device__ __forceinline__ bool next(int i, UD& u) const {
        const int nM = offp[16] >> 8; int pm, pn; if (!gs::tile_of((long)i * G + c, nM, nN, pm, pn)) return false;
        int e = 0;
#pragma unroll 1
        for (int j = 1; j < 16; ++j) e += (pm * 256 >= offp[j]) ? 1 : 0;
        u.A = A; u.B = B + (size_t)e * bstride + (size_t)pn * 256 * ldb; u.lda = lda; u.ldb = ldb; u.nt = nt; u.kind = 0; u.pm = pm; u.pn = pn; u.aux = e; return true;
    }
};
struct SchedPro {
    const unsigned char* tmp; int G, c;
    __device__ __forceinline__ bool next(int i, UD& u) const {
        const long L = (long)i * G + c; if (L >= 256) return false;
        const int kind = (int)(L >> 7), l = (int)(L >> 5) & 3, h = (int)(L >> 2) & 7, p = (int)L & 3;
        u.kind = kind; u.aux = l * 8 + h; u.pm = 0; u.pn = p; u.nt = 4; u.lda = 2048; u.ldb = 2048;
        if (kind == 0) { u.A = (const char*)tmp + R_UKP + ((size_t)(l * 8 + h) * 256) * 2048;
                         u.B = (const char*)tmp + R_WQ + (size_t)l * 2 * MiB + (size_t)(256 * p) * 2048 + (size_t)(h >> 1) * 512; }
        else { u.A = (const char*)tmp + R_PT + (size_t)l * 2 * MiB + (size_t)(256 * p) * 2048 + (size_t)(h >> 1) * 512;
               u.B = (const char*)tmp + R_UVP + ((size_t)(l * 8 + h) * 256) * 2048; }
        return true;
    }
};

__device__ __forceinline__ void tr_item(const float* src, int ld, int c0, int nvalid, bf16_t* dst, int lddst, int mode, int item, int nblk, LAS float* scr, int lane) {
    const int kb = item / nblk, nb = item - kb * nblk, k0 = 64 * kb, n0 = 32 * nb;
    const int cc = 4 * (lane & 7); const bool ok = n0 + cc < nvalid;
    f32x4 tv_[8];
#pragma unroll
    for (int i = 0; i < 8; ++i) { const int kk = 8 * i + (lane >> 3); tv_[i] = ok ? *(const f32x4*)(src + (size_t)(k0 + kk) * ld + c0 + n0 + cc) : (f32x4){0.f, 0.f, 0.f, 0.f}; }
#pragma unroll
    for (int i = 0; i < 8; ++i) { const int kk = 8 * i + (lane >> 3);
#pragma unroll
        for (int j = 0; j < 4; ++j) scr[kk * 33 + cc + j] = tv_[i][j]; }
    asm volatile("s_waitcnt lgkmcnt(0)" ::: "memory");
    const int c = lane & 7;
#pragma unroll
    for (int j = 0; j < 4; ++j) { const int nl = (lane >> 3) + 8 * j; const int nn = n0 + nl; const int row = mode ? (8 * (nn >> 2) + (nn & 3)) : nn; const LAS float* s = scr + (8 * c) * 33 + nl;
        u32x4 o; o.x = pk2(s[0 * 33], s[1 * 33]); o.y = pk2(s[2 * 33], s[3 * 33]); o.z = pk2(s[4 * 33], s[5 * 33]); o.w = pk2(s[6 * 33], s[7 * 33]);
        *(u32x4*)(dst + (size_t)row * lddst + k0 + 8 * c) = o; }
    asm volatile("s_waitcnt lgkmcnt(0)" ::: "memory");
}
__device__ __forceinline__ float expm1_acc(float x) {
    if (x > -0.35f) { float p = 1.0f + x * (1.0f / 8.0f); p = 1.0f + x * (1.0f / 7.0f) * p; p = 1.0f + x * (1.0f / 6.0f) * p; p = 1.0f + x * (1.0f / 5.0f) * p; p = 1.0f + x * 0.25f * p; p = 1.0f + x * (1.0f / 3.0f) * p; p = 1.0f + x * 0.5f * p; return x * p; }
    return fast_exp(x) - 1.0f;
}
struct RnnP { const bf16_t* xrnn; bf16_t* gy; float* tot; const bf16_t *waT, *wxT; const float *convw, *convb, *ba, *bx, *lam; };
template <int PASS>
__device__ __forceinline__ void rnn_item(const RnnP& P, int item, LAS unsigned char* wlds, int lane) {
    const int b = item >> 10, g = (item >> 6) & 15, seg = item & 63, ch0 = 64 * g;
    const int row = lane & 15, kg = lane >> 4, col = lane & 15;
    LAS float* CW = (LAS float*)wlds;
    LAS float* XR = CW + 320;
#pragma unroll
    for (int k = 0; k < 4; ++k) CW[k * 64 + lane] = P.convw[k * 1024 + ch0 + lane];
    CW[256 + lane] = P.convb[ch0 + lane];
    bf16x8 Ba[4][2], Bx[4][2];
#pragma unroll
    for (int jt = 0; jt < 4; ++jt)
#pragma unroll
        for (int s = 0; s < 2; ++s) { const size_t o = ((size_t)g * 64 + 16 * jt + col) * 64 + 32 * s + 8 * kg; Ba[jt][s] = *(const bf16x8*)(P.waT + o); Bx[jt][s] = *(const bf16x8*)(P.wxT + o); }
    float cba[4], cbx[4], sp8[4], h0[4], Pc[4];
#pragma unroll
    for (int jt = 0; jt < 4; ++jt) { const int ch = ch0 + 16 * jt + col; cba[jt] = -1.4426950408889634f * P.ba[ch]; cbx[jt] = -1.4426950408889634f * P.bx[ch]; const float lm = P.lam[ch]; sp8[jt] = -8.0f * 1.4426950408889634f * log1pf(expf(-lm));   h0[jt] = 0.f; Pc[jt] = 1.f; }
    float* totp = P.tot + ((size_t)(b * 64) * 1024 + ch0 + col) * 2;
    if (PASS == 2 && seg > 0) {
        const int Q = (seg + 3) >> 2, slo = kg * Q;
        float Pq[4] = {1.f, 1.f, 1.f, 1.f}, Hq[4] = {0.f, 0.f, 0.f, 0.f};
        for (int i0 = 0; i0 < Q; i0 += 4) {
            f32x2 ph[4][4];
#pragma unroll
            for (int i = 0; i < 4; ++i) { int s2 = slo + i0 + i; s2 = s2 < seg ? s2 : seg - 1;
#pragma unroll
                for (int jt = 0; jt < 4; ++jt) ph[i][jt] = *(const f32x2*)(totp + ((size_t)s2 * 1024 + 16 * jt) * 2); }
#pragma unroll
            for (int i = 0; i < 4; ++i) { const bool ok = (i0 + i < Q) && (slo + i0 + i < seg);
#pragma unroll
                for (int jt = 0; jt < 4; ++jt) { const float px = ok ? ph[i][jt].x : 1.f, hy = ok ? ph[i][jt].y : 0.f; Hq[jt] = px * Hq[jt] + hy; Pq[jt] = Pq[jt] * px; } }
        }
#pragma unroll
        for (int jt = 0; jt < 4; ++jt) {
            const float H0 = __shfl(Hq[jt], col), P1 = __shfl(Pq[jt], col + 16), H1 = __shfl(Hq[jt], col + 16), P2 = __shfl(Pq[jt], col + 32), H2 = __shfl(Hq[jt], col + 32),
                        P3 = __shfl(Pq[jt], col + 48), H3 = __shfl(Hq[jt], col + 48);
            float h = H0; h = P1 * h + H1; h = P2 * h + H2; h = P3 * h + H3; h0[jt] = h; }
    }
    asm volatile("s_waitcnt lgkmcnt(0)" ::: "memory");
    const size_t rowb = (size_t)b * SEQ;
    u32x4 xn[4][2];
    { const int tA0 = seg * 256 + row;
#pragma unroll
      for (int dt = 0; dt < 4; ++dt) { const int tt = tA0 - 3 + dt;
#pragma unroll
          for (int s = 0; s < 2; ++s) xn[dt][s] = (tt >= 0) ? *(const u32x4*)(P.xrnn + (rowb + tt) * 1024 + ch0 + 32 * s + 8 * kg) : (u32x4){0u, 0u, 0u, 0u}; } }
    for (int tile = 0; tile < 16; ++tile) {
        const int t0 = seg * 256 + tile * 16;
        u32x4 xw[4][2];
#pragma unroll
        for (int dt = 0; dt < 4; ++dt)
#pragma unroll
            for (int s = 0; s < 2; ++s) xw[dt][s] = xn[dt][s];
        if (tile + 1 < 16) { const int tB = t0 + 16 + row;
#pragma unroll
            for (int dt = 0; dt < 4; ++dt) { const int tt = tB - 3 + dt;
#pragma unroll
                for (int s = 0; s < 2; ++s) xn[dt][s] = *(const u32x4*)(P.xrnn + (rowb + tt) * 1024 + ch0 + 32 * s + 8 * kg); } }
        bf16_t gq[4][4];
        if (PASS == 2) { const bf16_t* gp0 = P.gy + (rowb + t0 + 4 * kg) * 1024 + ch0 + col;
#pragma unroll
            for (int jt = 0; jt < 4; ++jt)
#pragma unroll
                for (int r = 0; r < 4; ++r) gq[jt][r] = gp0[(size_t)r * 1024 + 16 * jt]; }
        bf16x8 Af[2];
#pragma unroll
        for (int s = 0; s < 2; ++s) {
            const int cl = 32 * s + 8 * kg;
            f32x4 o0 = *(LAS f32x4*)(CW + 256 + cl), o1 = *(LAS f32x4*)(CW + 256 + cl + 4);
#pragma unroll
            for (int dt = 0; dt < 4; ++dt) { const f32x4 w0 = *(LAS f32x4*)(CW + dt * 64 + cl), w1 = *(LAS f32x4*)(CW + dt * 64 + cl + 4); const u32x4 x = xw[dt][s];
                o0[0] += w0[0] * bf_lo(x.x); o0[1] += w0[1] * bf_hi(x.x); o0[2] += w0[2] * bf_lo(x.y); o0[3] += w0[3] * bf_hi(x.y);
                o1[0] += w1[0] * bf_lo(x.z); o1[1] += w1[1] * bf_hi(x.z); o1[2] += w1[2] * bf_lo(x.w); o1[3] += w1[3] * bf_hi(x.w); }
            *(LAS f32x4*)(XR + row * 68 + cl) = o0; *(LAS f32x4*)(XR + row * 68 + cl + 4) = o1;
            const u32x4 pk = pack8(o0, o1); Af[s] = __builtin_bit_cast(bf16x8, pk);
        }
        f32x4 ar[4], ax[4];
#pragma unroll
        for (int jt = 0; jt < 4; ++jt) { ar[jt] = (f32x4){0.f, 0.f, 0.f, 0.f}; ax[jt] = ar[jt];
#pragma unroll
            for (int s = 0; s < 2; ++s) { ar[jt] = __builtin_amdgcn_mfma_f32_16x16x32_bf16(Af[s], Ba[jt][s], ar[jt], 0, 0, 0); ax[jt] = __builtin_amdgcn_mfma_f32_16x16x32_bf16(Af[s], Bx[jt][s], ax[jt], 0, 0, 0); } }
        asm volatile("s_waitcnt lgkmcnt(0)" ::: "memory");
#pragma unroll
        for (int jt = 0; jt < 4; ++jt) {
            float Pp[4], Hp[4]; float pr = 1.f, hr = 0.f;
#pragma unroll
            for (int r = 0; r < 4; ++r) {
                const float xr = XR[(4 * kg + r) * 68 + 16 * jt + col];
                const float rg = fast_rcp(1.0f + __builtin_amdgcn_exp2f(__builtin_fmaf(ar[jt][r], -1.4426950408889634f, cba[jt]))), ig = fast_rcp(1.0f + __builtin_amdgcn_exp2f(__builtin_fmaf(ax[jt][r], -1.4426950408889634f, cbx[jt])));
                const float a = __builtin_amdgcn_exp2f(sp8[jt] * rg); const float em = a - 1.0f;
                const float mm = __builtin_amdgcn_sqrtf(fmaxf(-em * (2.0f + em), 0.f));
                const float uu = mm * ig * xr;
                hr = a * hr + uu; pr = pr * a; Pp[r] = pr; Hp[r] = hr;
            }
            const float P0 = __shfl(pr, col), P1 = __shfl(pr, col + 16), P2 = __shfl(pr, col + 32), P3 = __shfl(pr, col + 48);
            const float H0 = __shfl(hr, col), H1 = __shfl(hr, col + 16), H2 = __shfl(hr, col + 32), H3 = __shfl(hr, col + 48);
            const float h1 = P0 * h0[jt] + H0, h2 = P1 * h1 + H1, h3 = P2 * h2 + H2, h4 = P3 * h3 + H3;
            if (PASS == 2) {
                const float hs = kg == 0 ? h0[jt] : (kg == 1 ? h1 : (kg == 2 ? h2 : h3));
                bf16_t* gp = P.gy + (rowb + t0 + 4 * kg) * 1024 + ch0 + 16 * jt + col;
#pragma unroll
                for (int r = 0; r < 4; ++r) { const float hv = Pp[r] * hs + Hp[r]; const float gg = bf2f(gq[jt][r]); gp[(size_t)r * 1024] = (bf16_t)pk2(hv * gg, 0.f); }
            } else Pc[jt] = Pc[jt] * (P0 * P1) * (P2 * P3);
            h0[jt] = h4;
        }
    }
    if (PASS == 1 && kg == 0) {
#pragma unroll
        for (int jt = 0; jt < 4; ++jt) *(f32x2*)(totp + ((size_t)seg * 1024 + 16 * jt) * 2) = (f32x2){Pc[jt], h0[jt]};
    }
}
__device__ __forceinline__ void ckv_norm_rows4(bf16_t* base, int row0, int rstep, int nrows, const float* gain, int lane) {
    u32x2 w[4];
#pragma unroll
    for (int i = 0; i < 4; ++i) { const int r = row0 + i * rstep; w[i] = *(const u32x2*)(base + (size_t)(r < nrows ? r : row0) * 256 + 4 * lane); }
    const f32x4 gn = *(const f32x4*)(gain + 4 * lane);
#pragma unroll
    for (int i = 0; i < 4; ++i) { const int r = row0 + i * rstep;
        const float v0 = bf_lo(w[i].x), v1 = bf_hi(w[i].x), v2 = bf_lo(w[i].y), v3 = bf_hi(w[i].y);
        const float ss = wave_sum(v0 * v0 + v1 * v1 + v2 * v2 + v3 * v3);
        const float rs = 1.0f / __builtin_sqrtf(ss * (1.0f / 256.0f) + RMS_EPS);
        u32x2 o; o.x = pk2(v0 * rs * gn[0], v1 * rs * gn[1]); o.y = pk2(v2 * rs * gn[2], v3 * rs * gn[3]);
        if (r < nrows) *(u32x2*)(base + (size_t)r * 256 + 4 * lane) = o; }
}
constexpr int AT_CAND = 0, AT_KBUF = 65536, AT_KROW = 144, AT_KCH = 256 * AT_KROW, AT_SEL = 139264, AT_BIAS = 155648, AT_BKT = 156672, AT_GROW = 544, AT_GBUF = 32 * AT_GROW;
constexpr int AT_NBIN = 512, AT_CAP = 256, AT_LCAP = 1024, AT_TIEF = 157184, AT_BIAS2 = 157440;
#ifndef AT_SAMPLE_MIN_U
#define AT_SAMPLE_MIN_U 64
#endif
#ifndef AT_LBREF
#define AT_LBREF 0
#endif
struct AttnP { const bf16_t *qidx, *kidx, *ckv; const float* widx; bf16_t* qlat; unsigned long long* cbuf; };

__device__ __forceinline__ unsigned ord_key(float s) { const unsigned b = __builtin_bit_cast(unsigned, s); return (b & 0x80000000u) ? ~b : (b | 0x80000000u); }

__device__ __forceinline__ void hist_scan(const LAS unsigned* hq, int lane, int kth, int& bsel, int& cat, int& abat) {
    const u32x4 w0 = *(const LAS u32x4*)(hq + 8 * lane), w1 = *(const LAS u32x4*)(hq + 8 * lane + 4);
    int cnt[8];
    cnt[0] = (int)w0.x; cnt[1] = (int)w0.y; cnt[2] = (int)w0.z; cnt[3] = (int)w0.w; cnt[4] = (int)w1.x; cnt[5] = (int)w1.y; cnt[6] = (int)w1.z; cnt[7] = (int)w1.w;
    int s = 0;
#pragma unroll
    for (int i = 0; i < 8; ++i) s += cnt[i];
    int S = s;
    S += __builtin_amdgcn_update_dpp(0, S, 0x101, 0xf, 0xf, true); S += __builtin_amdgcn_update_dpp(0, S, 0x102, 0xf, 0xf, true);
    S += __builtin_amdgcn_update_dpp(0, S, 0x104, 0xf, 0xf, true); S += __builtin_amdgcn_update_dpp(0, S, 0x108, 0xf, 0xf, true);
    { const int t1 = __builtin_amdgcn_readlane(S, 16), t2 = __builtin_amdgcn_readlane(S, 32), t3 = __builtin_amdgcn_readlane(S, 48); const int row = lane >> 4;
      S += row == 0 ? (t1 + t2 + t3) : (row == 1 ? (t2 + t3) : (row == 2 ? t3 : 0)); }
    bsel = -1; cat = 0; abat = 0;
    const unsigned long long mk = __ballot(S >= kth);
    if (mk != 0ull) {
        const int Ls = 63 - __builtin_clzll(mk);
        int above = S - s; bool found = false;
#pragma unroll
        for (int bb = 7; bb >= 0; --bb) { const int c = cnt[bb]; if (!found && above + c >= kth) { bsel = 8 * lane + bb; cat = c; abat = above; found = true; } above += c; }
        bsel = __builtin_amdgcn_readlane(bsel, Ls); cat = __builtin_amdgcn_readlane(cat, Ls); abat = __builtin_amdgcn_readlane(abat, Ls);
    }
}
__device__ __forceinline__ int key_row(int r, bool sm, int u) { if (sm) { r = r * 8 + (u & 7); r = r < SEQ ? r : SEQ - 1; } return r; }
template <int MODE>
__device__ __forceinline__ void attn_pass(LAS unsigned char* lds, const bf16x8 (&afr)[4], const float (&wq)[2][9], const bf16_t* kbase, int u, int wave, int lane, int tid,
                                          const int (&b0e)[2], const int (&neede)[2], const int (&tiee)[2], int (&csel)[2], int (&ccand)[2], unsigned long long* cbw, int samp = 0) {
    const int hh = lane >> 5, kcol = lane & 31;
    LAS unsigned* HIST = (LAS unsigned*)lds; LAS unsigned long long* CAND = (LAS unsigned long long*)(lds + AT_CAND); LAS unsigned short* SEL = (LAS unsigned short*)(lds + AT_SEL);
    const bool sm = (MODE == 0) && (samp != 0);
    const int nst = u >> 3, nch = sm ? ((nst + 7) >> 3) : (u >> 3) + 1;
    float lbt[2];
#pragma unroll
    for (int e = 0; e < 2; ++e) lbt[e] = ((MODE == 1 || MODE == 3) && b0e[e] >= 1) ? (float)b0e[e] : -3.0e38f;
    u32x4 st[4];
    const int lofs = (tid >> 3) * AT_KROW + (tid & 7) * 16;
#define AT_KADDR(C, I) (kbase + (size_t)key_row((C) * 256 + (tid >> 3) + 64 * (I), sm, u) * 64 + (tid & 7) * 8)
#pragma unroll
    for (int i = 0; i < 4; ++i) st[i] = *(const u32x4*)AT_KADDR(0, i);
#pragma unroll
    for (int i = 0; i < 4; ++i) *(LAS u32x4*)(lds + AT_KBUF + lofs + i * 64 * AT_KROW) = st[i];
    __syncthreads();
    for (int c = 0; c < nch; ++c) {
        if (c + 1 < nch) {
#pragma unroll
            for (int i = 0; i < 4; ++i) st[i] = *(const u32x4*)AT_KADDR(c + 1, i);
        }
        const LAS unsigned char* kb = lds + AT_KBUF + (c & 1) * AT_KCH + kcol * AT_KROW + hh * 16;
        const int ntile = sm ? ((nst - 8 * c) < 8 ? (nst - 8 * c) : 8) : ((c + 1 < nch) ? 8 : (u & 7) + 1);
#define AT_READ(BF, TT) do { _Pragma("unroll") for (int ks = 0; ks < 4; ++ks) BF[ks] = *(const LAS bf16x8*)(kb + (TT) * 32 * AT_KROW + ks * 32); } while (0)
#define AT_MFMA(ACC, BF) do { _Pragma("unroll") for (int i_ = 0; i_ < 16; ++i_) ACC[i_] = 0.f; \
            _Pragma("unroll") for (int ks = 0; ks < 4; ++ks) ACC = __builtin_amdgcn_mfma_f32_32x32x16_bf16(afr[ks], BF[ks], ACC, 0, 0, 0); } while (0)
          \

#define AT_POST(ACC, KT, DIAG) do { const int kt = (KT); \
            float sc[2]; \
            _Pragma("unroll") for (int e = 0; e < 2; ++e) { float s = 0.f; \
                _Pragma("unroll") for (int i = 0; i < 8; ++i) s = __builtin_fmaf(wq[e][i], __builtin_amdgcn_fmed3f(ACC[8 * e + i], 0.f, 3.0e38f), s); \
                sc[e] = s; } \
            _Pragma("unroll") for (int e = 0; e < 2; ++e) { \
                const int q = 4 * wave + 2 * hh + e; \
                const float tv = __builtin_fmaf(sc[e], wq[e][8], 256.0f); \
                const bool cz = !(DIAG) || (kt < u) || (kcol <= q); \
                const bool live = cz && tv >= lbt[e]; \
                if (MODE == 3) { \
                    const unsigned long long m3 = __ballot(live); \
                    { \
                        const unsigned h3 = hh ? (unsigned)(m3 >> 32) : (unsigned)m3; \
                        const int pa = ccand[e] + __builtin_popcount(h3 & ((1u << kcol) - 1u)); \
                        if (live) { u32x2 ent;      \
                             ent.x = (unsigned)(kt * 32 + kcol); ent.y = __builtin_bit_cast(unsigned, sc[e]); \
                            *(u32x2*)((char*)cbw + ((unsigned)((2 * hh + e) * AT_LCAP + pa) * 8u)) = ent; } \
                        ccand[e] += __builtin_popcount(h3); \
                    } \
                } else if (MODE == 0) { \
                    const int bin = (int)__builtin_amdgcn_fmed3f(tv, 0.0f, 511.5f); \
                    LAS unsigned* hp = HIST + q * AT_NBIN + bin; \
                    if (cz) __hip_atomic_fetch_add(hp, 1u, __ATOMIC_RELAXED, __HIP_MEMORY_SCOPE_WORKGROUP); \
                } else if (__ballot(live) != 0ull) { \
                    const int bin = (int)__builtin_amdgcn_fmed3f(tv, 0.0f, 511.5f); \
                    const int key = kt * 32 + kcol; \
                    const bool cc = live && bin == b0e[e]; \
                    const unsigned long long m2 = __ballot(cc); const unsigned h2 = hh ? (unsigned)(m2 >> 32) : (unsigned)m2; \
                    const int pc = ccand[e] + __builtin_popcount(h2 & ((1u << kcol) - 1u)); \
                    if (cc && !tiee[e] && pc < AT_CAP) CAND[q * AT_CAP + pc] = ((unsigned long long)ord_key(sc[e]) << 32) | (unsigned)(0xFFFFu - key); \
                    ccand[e] += __builtin_popcount(h2); \
                    const bool cs = live && (bin > b0e[e] || (tiee[e] && cc && pc < neede[e])); \
                    const unsigned long long m1 = __ballot(cs); const unsigned h1 = hh ? (unsigned)(m1 >> 32) : (unsigned)m1; \
                    if (cs) SEL[q * 256 + csel[e] + __builtin_popcount(h1 & ((1u << kcol) - 1u))] = (unsigned short)key; \
                    csel[e] += __builtin_popcount(h1); \
                } \
            } } while (0)
#define AT_TILES(NT, DIAG, PRAG) do { \
        AT_READ(B0, 0); if ((NT) > 1) AT_READ(B1, 1); \
        AT_MFMA(accA, B0); \
        PRAG for (int tt = 0; tt < (NT); tt += 2) { \
            if (tt + 2 < (NT)) AT_READ(B0, tt + 2); \
            if (tt + 1 < (NT)) AT_MFMA(accB, B1); \
            AT_POST(accA, c * 8 + tt, DIAG); \
            if (tt + 1 < (NT)) { \
                if (tt + 3 < (NT)) AT_READ(B1, tt + 3); \
                if (tt + 2 < (NT)) AT_MFMA(accA, B0); \
                AT_POST(accB, c * 8 + tt + 1, DIAG); \
            } \
        } } while (0)
        f32x16 accA, accB; bf16x8 B0[4], B1[4];
        if (sm ? (ntile == 8) : (c + 1 < nch)) AT_TILES(8, false, _Pragma("unroll"));
        else AT_TILES(ntile, true, _Pragma("unroll 1"));
#undef AT_TILES
#undef AT_POST
#undef AT_KADDR
#undef AT_READ
#undef AT_MFMA
        if (MODE == 0 && AT_LBREF && c + 1 < nch && (c < 4 || (c & 3) == 3)) {
#pragma unroll
            for (int q = 0; q < 4; ++q) { int bs, c1, c2; hist_scan(HIST + (4 * wave + q) * AT_NBIN, lane, 256, bs, c1, c2);
                const float lb = bs >= 1 ? (float)bs : -3.0e38f;
                if ((q >> 1) == hh) lbt[q & 1] = lb; }
        }
        if (c + 1 < nch) {
#pragma unroll
            for (int i = 0; i < 4; ++i) *(LAS u32x4*)(lds + AT_KBUF + ((c + 1) & 1) * AT_KCH + lofs + i * 64 * AT_KROW) = st[i];
        }
        __syncthreads();
    }
}

__device__ __forceinline__ void attn_unit(LAS unsigned char* lds, const AttnP& P, int b, int u, int tid_) {
    int tid = tid_; asm volatile("" : "+v"(tid));
    const int wave = __builtin_amdgcn_readfirstlane(tid >> 6), lane = tid & 63, hh = lane >> 5, kcol = lane & 31;
    LAS unsigned* HIST = (LAS unsigned*)lds; LAS unsigned long long* CAND = (LAS unsigned long long*)(lds + AT_CAND); LAS unsigned short* SEL = (LAS unsigned short*)(lds + AT_SEL);
    const LAS float* BIAS2 = (const LAS float*)(lds + AT_BIAS2);
    const int t0 = 32 * u; const size_t rowb = (size_t)b * SEQ;
    __syncthreads();
#pragma unroll
    for (int i = 0; i < 8; ++i) *(LAS u32x4*)(lds + (i * 512 + tid) * 16) = (u32x4){0u, 0u, 0u, 0u};
    if (tid == 0) *(LAS unsigned*)(lds + AT_TIEF) = 0u;
    bf16x8 afr[4]; float wq[2][9];
    { const int rho = kcol, j = rho >> 3, r = rho & 3, hq = (rho >> 2) & 1, head = 4 * (j & 1) + r, qloc = 2 * hq + (j >> 1);
      const bf16_t* qp = P.qidx + (rowb + t0 + 4 * wave + qloc) * 512 + head * 64 + 8 * hh;
#pragma unroll
      for (int ks = 0; ks < 4; ++ks) afr[ks] = *(const bf16x8*)(qp + ks * 16);
#pragma unroll
      for (int e = 0; e < 2; ++e) { const float* wp = P.widx + (rowb + t0 + 4 * wave + 2 * hh + e) * 8; const f32x4 a = *(const f32x4*)wp, c = *(const f32x4*)(wp + 4);
          wq[e][0] = a[0]; wq[e][1] = a[1]; wq[e][2] = a[2]; wq[e][3] = a[3]; wq[e][4] = c[0]; wq[e][5] = c[1]; wq[e][6] = c[2]; wq[e][7] = c[3];
          const float ss = (a[0] * a[0] + a[1] * a[1]) + (a[2] * a[2] + a[3] * a[3]) + (c[0] * c[0] + c[1] * c[1]) + (c[2] * c[2] + c[3] * c[3]);
          wq[e][8] = 32.0f / __builtin_sqrtf(fmaxf(ss, 1.0e-12f)); } }
    const bf16_t* kbase = P.kidx + rowb * 64;
    int b0e[2] = {0, 0}, neede[2] = {0, 0}, tiee[2] = {0, 0}, csel[2] = {0, 0}, ccand[2] = {0, 0};
    int b0q[4], needq[4], nb0q[4], csq[4];
    unsigned long long* cbw = P.cbuf + (size_t)(4 * wave) * AT_LCAP;
#pragma unroll 1
    for (int att = (u >= AT_SAMPLE_MIN_U) ? 0 : 1; att < 2; ++att) {
        int tl = tid; asm volatile("" : "+v"(tl));
        const int ll = tl & 63, hl = ll >> 5;
        if (att == 1 && u >= AT_SAMPLE_MIN_U) {
            __syncthreads();
#pragma unroll
            for (int i = 0; i < 8; ++i) *(LAS u32x4*)(lds + (i * 512 + tl) * 16) = (u32x4){0u, 0u, 0u, 0u};
            if (tl == 0) *(LAS unsigned*)(lds + AT_TIEF) = 0u;
        }
        csel[0] = 0; csel[1] = 0; ccand[0] = 0; ccand[1] = 0;
        attn_pass<0>(lds, afr, wq, kbase, u, wave, ll, tl, b0e, neede, tiee, csel, ccand, nullptr, att == 0 ? 1 : 0);
        const int kth = att == 0 ? 64 : 256;
#pragma unroll
        for (int q = 0; q < 4; ++q) {
            const int nq = t0 + 4 * wave + q + 1;
            int bsel, cat, abat; hist_scan(HIST + (4 * wave + q) * AT_NBIN, ll, kth, bsel, cat, abat);
            if (att == 1 && nq <= 256) { bsel = -1; cat = 0; abat = 0; }
            b0q[q] = bsel; nb0q[q] = cat; needq[q] = (nq > 256) ? (256 - abat) : 0;
        }
        b0e[0] = hl ? b0q[2] : b0q[0]; b0e[1] = hl ? b0q[3] : b0q[1];
        neede[0] = hl ? needq[2] : needq[0]; neede[1] = hl ? needq[3] : needq[1];
        tiee[0] = (att == 1) && ((hl ? nb0q[2] : nb0q[0]) > AT_CAP); tiee[1] = (att == 1) && ((hl ? nb0q[3] : nb0q[1]) > AT_CAP);
        if ((tiee[0] | tiee[1]) != 0) *(LAS unsigned*)(lds + AT_TIEF) = 1u;
        __syncthreads();
        if (att == 1 && *(const LAS unsigned*)(lds + AT_TIEF) != 0u) {
            attn_pass<1>(lds, afr, wq, kbase, u, wave, ll, tl, b0e, neede, tiee, csel, ccand, cbw);
#pragma unroll
            for (int q = 0; q < 4; ++q) { const int cv = (q & 1) ? csel[1] : csel[0]; csq[q] = __builtin_amdgcn_readlane(cv, (q >> 1) * 32); }
            break;
        }
        if (att == 0) {
#pragma unroll
            for (int i = 0; i < 8; ++i) *(LAS u32x4*)(lds + wave * 8192 + (i * 64 + ll) * 16) = (u32x4){0u, 0u, 0u, 0u};
        }
        attn_pass<3>(lds, afr, wq, kbase, u, wave, ll, tl, b0e, neede, tiee, csel, ccand, cbw);
        asm volatile("s_waitcnt vmcnt(0)" ::: "memory");
        if (att == 0) {
            bool ok = true;
#pragma unroll
            for (int q = 0; q < 4; ++q) {
                const int cv = (q & 1) ? ccand[1] : ccand[0]; const int nraw = __builtin_amdgcn_readlane(cv, (q >> 1) * 32); ok = ok && nraw >= 256 && nraw <= AT_LCAP;
                const int n = nraw > AT_LCAP ? AT_LCAP : nraw;
                const float scl = (q & 2) ? __shfl(wq[q & 1][8], 32) : __shfl(wq[q & 1][8], 0);
                unsigned long long ent[AT_LCAP / 64];
#pragma unroll
                for (int j = 0; j < AT_LCAP / 64; ++j) { const int i = 64 * j + ll; ent[j] = (i < n) ? __builtin_nontemporal_load(cbw + q * AT_LCAP + i) : 0ull; }
#pragma unroll
                for (int j = 0; j < AT_LCAP / 64; ++j) { const int i = 64 * j + ll; const float scv = __builtin_bit_cast(float, (unsigned)(ent[j] >> 32));
                    const int bin = (int)__builtin_amdgcn_fmed3f(__builtin_fmaf(scv, scl, 256.0f), 0.0f, 511.5f);
                    if (i < n) __hip_atomic_fetch_add(HIST + (4 * wave + q) * AT_NBIN + bin, 1u, __ATOMIC_RELAXED, __HIP_MEMORY_SCOPE_WORKGROUP); }
                asm volatile("s_waitcnt lgkmcnt(0)" ::: "memory");
                int bsel, cat, abat; hist_scan(HIST + (4 * wave + q) * AT_NBIN, ll, 256, bsel, cat, abat);
                ok = ok && bsel >= 0;
                b0q[q] = bsel; nb0q[q] = cat; needq[q] = 256 - abat;
                const int b0 = bsel, need = 256 - abat; const bool tieq = cat > AT_CAP;
                int cs = 0, cc = 0;
#pragma unroll
                for (int j = 0; j < AT_LCAP / 64; ++j) {
                    if (64 * j < n) {
                        const unsigned long long v = ent[j]; const bool in = 64 * j + ll < n;
                        const float scv = __builtin_bit_cast(float, (unsigned)(v >> 32));
                        const int bin = (int)__builtin_amdgcn_fmed3f(__builtin_fmaf(scv, scl, 256.0f), 0.0f, 511.5f);
                        const bool isc = in && bin == b0;
                        const unsigned long long mc = __ballot(isc);
                        const int pc = cc + __builtin_popcountll(mc & ((1ull << ll) - 1ull));
                        const bool isa = in && (bin > b0 || (tieq && isc && pc < need));
                        const unsigned long long ms = __ballot(isa);
                        const int ps = cs + __builtin_popcountll(ms & ((1ull << ll) - 1ull));
                        if (isa && ps < 256) SEL[(4 * wave + q) * 256 + ps] = (unsigned short)(v & 0xFFFFu);
                        if (isc && !tieq && pc < AT_CAP) CAND[(4 * wave + q) * AT_CAP + pc] = ((unsigned long long)ord_key(scv) << 32) | (unsigned)(0xFFFFu - (unsigned)(v & 0xFFFFu));
                        cs += __builtin_popcountll(ms); cc += __builtin_popcountll(mc);
                    }
                }
                csq[q] = cs;
                asm volatile("" ::: "memory");
            }
            if (!ok) *(LAS unsigned*)(lds + AT_TIEF) = 1u;
            __syncthreads();
            if (*(const LAS unsigned*)(lds + AT_TIEF) != 0u) continue;
            break;
        }
#pragma unroll
        for (int q = 0; q < 4; ++q) {
            const int cv = (q & 1) ? ccand[1] : ccand[0]; int n = __builtin_amdgcn_readlane(cv, (q >> 1) * 32); n = n > AT_LCAP ? AT_LCAP : n;
            const int b0 = b0q[q], need = needq[q]; const bool tieq = nb0q[q] > AT_CAP;
            const float scl = (q & 2) ? __shfl(wq[q & 1][8], 32) : __shfl(wq[q & 1][8], 0);
            int cs = 0, cc = 0;
#pragma unroll
            for (int jb = 0; jb < AT_LCAP / 256; ++jb) {
                if (256 * jb < n) {
                    unsigned long long ent[4];
#pragma unroll
                    for (int j = 0; j < 4; ++j) { const int i = 256 * jb + 64 * j + ll; ent[j] = (i < n) ? __builtin_nontemporal_load(cbw + q * AT_LCAP + i) : 0ull; }
#pragma unroll
                    for (int j = 0; j < 4; ++j) {
                        const unsigned long long v = ent[j]; const bool in = 256 * jb + 64 * j + ll < n;
                        const float scv = __builtin_bit_cast(float, (unsigned)(v >> 32));
                        const int bin = (int)__builtin_amdgcn_fmed3f(__builtin_fmaf(scv, scl, 256.0f), 0.0f, 511.5f);
                        const bool isc = in && bin == b0;
                        const unsigned long long mc = __ballot(isc);
                        const int pc = cc + __builtin_popcountll(mc & ((1ull << ll) - 1ull));
                        const bool isa = in && (bin > b0 || (tieq && isc && pc < need));
                        const unsigned long long ms = __ballot(isa);
                        if (isa) SEL[(4 * wave + q) * 256 + cs + __builtin_popcountll(ms & ((1ull << ll) - 1ull))] = (unsigned short)(v & 0xFFFFu);
                        if (isc && !tieq && pc < AT_CAP) CAND[(4 * wave + q) * AT_CAP + pc] = ((unsigned long long)ord_key(scv) << 32) | (unsigned)(0xFFFFu - (unsigned)(v & 0xFFFFu));
                        cs += __builtin_popcountll(ms); cc += __builtin_popcountll(mc);
                    }
                }
            }
            csq[q] = cs;
            asm volatile("" ::: "memory");
        }
        break;
    }
    int nselq[4];
#pragma unroll
    for (int q = 0; q < 4; ++q) {
        int cs = csq[q];
        const int need = needq[q], nb0 = nb0q[q];
        if (need > 0 && nb0 <= AT_CAP) {
            const int nc = nb0;
            const LAS unsigned long long* cq = CAND + (4 * wave + q) * AT_CAP;
            for (int i0 = 0; i0 < nc; i0 += 64) {
                const int i = i0 + lane; const unsigned long long mine = (i < nc) ? cq[i] : 0ull;
                int rank = 0; for (int j = 0; j < nc; ++j) rank += (cq[j] > mine) ? 1 : 0;
                const bool pick = (i < nc) && rank < need;
                const unsigned long long mk = __ballot(pick);
                if (pick) SEL[(4 * wave + q) * 256 + cs + __builtin_popcountll(mk & ((1ull << lane) - 1ull))] = (unsigned short)(0xFFFFu - (unsigned)(mine & 0xFFFFu));
                cs += __builtin_popcountll(mk);
            }
        }
        nselq[q] = cs;
    }
    asm volatile("s_waitcnt lgkmcnt(0)" ::: "memory");
#ifdef DBG_TIME_ATT
    if (tid == 0) { const unsigned tn_ = (unsigned)__builtin_amdgcn_s_memrealtime(); ((LAS unsigned*)(lds + LDS_MISC))[19] += tn_ - tk0; tk0 = tn_; }
#endif
    __syncthreads();
    LAS unsigned char* gb = lds + wave * AT_GBUF;
    const int n = lane & 15, kg = lane >> 4, head = n & 7;
#pragma unroll 1
    for (int qi = 0; qi < 4; ++qi) {
        const int q = 4 * wave + qi, t = t0 + q;
        const int nsel = qi == 0 ? nselq[0] : (qi == 1 ? nselq[1] : (qi == 2 ? nselq[2] : nselq[3]));
        const LAS unsigned short* sel = SEL + q * 256;
        bf16_t* qrow = P.qlat + (rowb + t) * 2048;
        bf16x8 qb[8];
#pragma unroll
        for (int ks = 0; ks < 8; ++ks) { qb[ks] = (bf16x8){0, 0, 0, 0, 0, 0, 0, 0}; if (n < 8) qb[ks] = *(const bf16x8*)(qrow + n * 256 + 32 * ks + 8 * kg); }
        f32x4 oacc[16];
#pragma unroll
        for (int mt = 0; mt < 16; ++mt) oacc[mt] = (f32x4){0.f, 0.f, 0.f, 0.f};
        float mrun = -1e30f, lrun = 0.f;
        const int nchunk = (nsel + 31) >> 5;
#pragma unroll 1
        for (int c = 0; c < nchunk; ++c) {
            const int jn = 32 * c + kcol; const int idxc = (jn < nsel) ? (int)sel[jn] : 0;
            { u32x4 pre[16];
              const unsigned offc = ((unsigned)rowb + (unsigned)idxc) * 512u;
#pragma unroll
              for (int i = 0; i < 16; ++i) { const unsigned o0 = (unsigned)__builtin_amdgcn_readlane((int)offc, 2 * i), o1 = (unsigned)__builtin_amdgcn_readlane((int)offc, 2 * i + 1);
                  pre[i] = *(const u32x4*)((const char*)P.ckv + ((hh ? o1 : o0) + (unsigned)kcol * 16u)); }
#pragma unroll
              for (int i = 0; i < 16; ++i) *(LAS u32x4*)(gb + (2 * i + hh) * AT_GROW + kcol * 16) = pre[i];
            }
            f32x4 st[2];
#pragma unroll
            for (int k2 = 0; k2 < 2; ++k2) { st[k2] = (f32x4){0.f, 0.f, 0.f, 0.f};
#pragma unroll
                for (int ks = 0; ks < 8; ++ks) { const bf16x8 a = *(const LAS bf16x8*)(gb + (16 * k2 + n) * AT_GROW + (32 * ks + 8 * kg) * 2); st[k2] = __builtin_amdgcn_mfma_f32_16x16x32_bf16(a, qb[ks], st[k2], 0, 0, 0); } }
            float mloc = -1e30f;
#pragma unroll
            for (int k2 = 0; k2 < 2; ++k2)
#pragma unroll
                for (int r = 0; r < 4; ++r) { const int jj = 16 * k2 + 4 * kg + r; const int idx = (32 * c + jj < nsel) ? (int)sel[32 * c + jj] : 0; int d = t - idx; d = d < 127 ? d : 127;
                    float lg = st[k2][r] + BIAS2[d * 8 + head]; if (32 * c + jj >= nsel) lg = -1e30f;
                    st[k2][r] = lg; mloc = fmaxf(mloc, lg); }
            if (c == 0) { mloc = fmaxf(mloc, __shfl_xor(mloc, 16)); mloc = fmaxf(mloc, __shfl_xor(mloc, 32)); mrun = mloc; }
            else if (__ballot(mloc > mrun + 60.0f) != 0ull) {
                mloc = fmaxf(mloc, __shfl_xor(mloc, 16)); mloc = fmaxf(mloc, __shfl_xor(mloc, 32));
                const float mnew = fmaxf(mrun, mloc), alpha = fast_exp(mrun - mnew);
                lrun = lrun * alpha; mrun = mnew;
#pragma unroll
                for (int mt = 0; mt < 16; ++mt) oacc[mt] = oacc[mt] * alpha;
            }
#pragma unroll
            for (int k2 = 0; k2 < 2; ++k2)
#pragma unroll
                for (int r = 0; r < 4; ++r) { const float p = fast_exp(st[k2][r] - mrun); st[k2][r] = p; lrun += p; }
            u32x4 pw; pw.x = pk2(st[0][0], st[0][1]); pw.y = pk2(st[0][2], st[0][3]); pw.z = pk2(st[1][0], st[1][1]); pw.w = pk2(st[1][2], st[1][3]);
            const bf16x8 pb = __builtin_bit_cast(bf16x8, pw);
            LAS unsigned char* tb = gb + (4 * kg + (n >> 2)) * AT_GROW + 8 * (n & 3);
#pragma unroll
            for (int mt = 0; mt < 16; ++mt) {
                const s16x4 v1 = __builtin_amdgcn_ds_read_tr16_b64_v4i16((LAS s16x4*)(tb + 32 * mt));
                const s16x4 v2 = __builtin_amdgcn_ds_read_tr16_b64_v4i16((LAS s16x4*)(tb + 16 * AT_GROW + 32 * mt));
                const bf16x8 av = (bf16x8){v1[0], v1[1], v1[2], v1[3], v2[0], v2[1], v2[2], v2[3]};
                oacc[mt] = __builtin_amdgcn_mfma_f32_16x16x32_bf16(av, pb, oacc[mt], 0, 0, 0);
            }
        }
        lrun += __shfl_xor(lrun, 16); lrun += __shfl_xor(lrun, 32);
        const float inv = 1.0f / lrun;
        if (n < 8) {
#pragma unroll
            for (int mt = 0; mt < 16; ++mt) { const f32x4 o = oacc[mt] * inv; u32x2 w; w.x = pk2(o[0], o[1]); w.y = pk2(o[2], o[3]); *(u32x2*)(qrow + n * 256 + 16 * mt + 4 * kg) = w; }
        }
    }
#ifdef DBG_TIME_ATT
    if (tid == 0) { const unsigned tn_ = (unsigned)__builtin_amdgcn_s_memrealtime(); ((LAS unsigned*)(lds + LDS_MISC))[20] += tn_ - tk0; tk0 = tn_; }
#endif
}
__device__ __forceinline__ void ln_finish(f32x4 (&v)[4], const float* gam, const float* bet, float* orow, bf16_t* brow, int lane) {
    float s = 0.f;
#pragma unroll
    for (int j = 0; j < 4; ++j) s += (v[j][0] + v[j][1]) + (v[j][2] + v[j][3]);
    const float mean = wave_sum(s) * (1.0f / 1024.0f); float s2 = 0.f;
#pragma unroll
    for (int j = 0; j < 4; ++j) { v[j] = v[j] - mean; s2 += (v[j][0] * v[j][0] + v[j][1] * v[j][1]) + (v[j][2] * v[j][2] + v[j][3] * v[j][3]); }
    const float rstd = 1.0f / __builtin_sqrtf(wave_sum(s2) * (1.0f / 1024.0f) + LN_EPS);
#pragma unroll
    for (int j = 0; j < 4; ++j) { const f32x4 g = *(const f32x4*)(gam + 256 * j + 4 * lane), bb = *(const f32x4*)(bet + 256 * j + 4 * lane);
        v[j] = v[j] * rstd * g + bb;
        if (orow != nullptr) *(f32x4*)(orow + 256 * j + 4 * lane) = v[j];
        u32x2 w; w.x = pk2(v[j][0], v[j][1]); w.y = pk2(v[j][2], v[j][3]); *(u32x2*)(brow + 256 * j + 4 * lane) = w; }
}
struct RouteP { int* r_e; int* r_pos; int* r_slot; float* r_g; unsigned* gcnt; };

__device__ __forceinline__ void ln1_route_block(LAS unsigned char* lds, int blk, float* xo, bf16_t* xb, const float* gam, const float* bet, const float* rbias, const RouteP& R, int tid) {
    const int wave = __builtin_amdgcn_readfirstlane(tid >> 6), lane = tid & 63;
    const LAS float* WR = (const LAS float*)lds; LAS int* lcnt = (LAS int*)(lds + 65536); LAS int* basee = (LAS int*)(lds + 65600); LAS int* tok = (LAS int*)(lds + 65664);
    __syncthreads();
    if (tid < 16) lcnt[tid] = 0;
    __syncthreads();
    u32x2 wn[4];
#pragma unroll
    for (int j = 0; j < 4; ++j) wn[j] = *(const u32x2*)(xb + ((size_t)blk * 128 + wave * 16) * 1024 + 256 * j + 4 * lane);
    float rb[16];
#pragma unroll
    for (int e = 0; e < 16; ++e) rb[e] = rbias[e];
    for (int rr = 0; rr < 16; ++rr) {
        const int rl = wave * 16 + rr; const size_t row = (size_t)blk * 128 + rl;
        f32x4 v[4];
#pragma unroll
        for (int j = 0; j < 4; ++j) { const u32x2 w = wn[j]; v[j] = (f32x4){bf_lo(w.x), bf_hi(w.x), bf_lo(w.y), bf_hi(w.y)}; }
        { const size_t rn = row + (rr + 1 < 16 ? 1 : 0);
#pragma unroll
          for (int j = 0; j < 4; ++j) wn[j] = *(const u32x2*)(xb + rn * 1024 + 256 * j + 4 * lane); }
        ln_finish(v, gam, bet, nullptr, xb + row * 1024, lane);
        float aff[16], sel[16];
#pragma unroll
        for (int e = 0; e < 16; ++e) { float p = 0.f;
#pragma unroll
            for (int j = 0; j < 4; ++j) { const f32x4 w = *(const LAS f32x4*)(WR + e * 1024 + 256 * j + 4 * lane); p += (v[j][0] * w[0] + v[j][1] * w[1]) + (v[j][2] * w[2] + v[j][3] * w[3]); }
            const float lg = wave_sum(p); aff[e] = sigmoidf_(lg); sel[e] = aff[e] + rb[e]; }
        float gbv = -3.0e38f; int gb = 0;
#pragma unroll
        for (int g = 0; g < 4; ++g) { float m1 = -3.0e38f, m2 = -3.0e38f;
#pragma unroll
            for (int i = 0; i < 4; ++i) { const float x = sel[4 * g + i]; if (x > m1) { m2 = m1; m1 = x; } else if (x > m2) m2 = x; }
            const float gs_ = m1 + m2; if (gs_ > gbv) { gbv = gs_; gb = g; } }
        float s0 = -3.0e38f, a0 = 0.f; int e0 = 0;
#pragma unroll
        for (int e = 0; e < 16; ++e) { const bool in = (e >> 2) == gb; if (in && sel[e] > s0) { s0 = sel[e]; a0 = aff[e]; e0 = e; } }
        float s1 = -3.0e38f, a1 = 0.f; int e1 = 0;
#pragma unroll
        for (int e = 0; e < 16; ++e) { const bool in = ((e >> 2) == gb) && (e != e0); if (in && sel[e] > s1) { s1 = sel[e]; a1 = aff[e]; e1 = e; } }
        if (lane == 0) {
            const float inv = 1.0f / (a0 + a1);
            const int p0 = __hip_atomic_fetch_add(lcnt + e0, 1, __ATOMIC_RELAXED, __HIP_MEMORY_SCOPE_WORKGROUP);
            const int p1 = __hip_atomic_fetch_add(lcnt + e1, 1, __ATOMIC_RELAXED, __HIP_MEMORY_SCOPE_WORKGROUP);
            tok[rl * 4 + 0] = e0; tok[rl * 4 + 1] = p0; tok[rl * 4 + 2] = e1; tok[rl * 4 + 3] = p1;
            *(f32x2*)(R.r_g + row * 2) = (f32x2){a0 * inv, a1 * inv};
        }
    }
    __syncthreads();
    if (tid < 16) basee[tid] = (int)__hip_atomic_fetch_add(R.gcnt + tid * 64, (unsigned)lcnt[tid], __ATOMIC_RELAXED, __HIP_MEMORY_SCOPE_AGENT);
    __syncthreads();
    if (tid < 256) { const int rl = tid >> 1, k = tid & 1; const int e = tok[rl * 4 + 2 * k], p = tok[rl * 4 + 2 * k + 1]; const size_t o = ((size_t)blk * 128 + rl) * 2 + k; R.r_e[o] = e; R.r_pos[o] = basee[e] + p; }
}
__device__ __forceinline__ void moe_offsets(LAS int* offp, const unsigned* gcnt, int tid) {
    __syncthreads();
    if (tid == 0) { int o = 0;
        for (int e = 0; e < 16; ++e) { offp[e] = o; const int c = (int)__hip_atomic_load(gcnt + e * 64, __ATOMIC_RELAXED, __HIP_MEMORY_SCOPE_AGENT); o += (c + 255) & ~255; }
        offp[16] = o; }
    __syncthreads();
}
#ifndef MK_PER_PHASE
#define MK_PER_PHASE 0
#endif
#ifndef EN_MASK
#define EN_MASK 0xFFF
#endif
#ifndef EN_M1
#define EN_M1 1
#endif
#ifndef EN_M2
#define EN_M2 1
#endif
#ifndef DBG_REP_P0A
#define DBG_REP_P0A 1
#endif
#ifndef EN_2A
#define EN_2A 1
#endif
#ifndef EN_2R
#define EN_2R 1
#endif
#define EN_A ((EN_MASK >> 0) & 1)
#define EN_B ((EN_MASK >> 1) & 1)
#define EN_0 ((EN_MASK >> 2) & 1)
#define EN_1 ((EN_MASK >> 3) & 1)
#define EN_2 ((EN_MASK >> 4) & 1)
#define EN_3 ((EN_MASK >> 5) & 1)
#define EN_4 ((EN_MASK >> 6) & 1)
#define EN_5 ((EN_MASK >> 7) & 1)
#define EN_6 ((EN_MASK >> 8) & 1)
#define EN_7 ((EN_MASK >> 9) & 1)
#define EN_8 ((EN_MASK >> 10) & 1)
#define EN_9 ((EN_MASK >> 11) & 1)
constexpr int NPH_L = 10, NPH = 2 + NL * NPH_L;
struct Args { const float* in[25]; float* out; unsigned char* ws; int ph_lo, ph_hi; };

__global__ void __launch_bounds__(NTHR, 2) fwd(Args a) {
    extern __shared__ __attribute__((aligned(16))) unsigned char lds_raw[];
    LAS unsigned char* lds = (LAS unsigned char*)lds_raw;
    const int G = gridDim.x, bx = blockIdx.x, vcu = (G % 8 == 0) ? (bx % 8) * (G / 8) + bx / 8 : bx;
    const int NGW = G * NWAVES;
#define PH_LOCALS int tid = wave_s * 64 + lane_id(); asm volatile("" : "+v"(tid)); const int lane = tid & 63, wave = wave_s, gw = vcu * NWAVES + wave; (void)lane; (void)gw;
    volatile LAS unsigned* MISC = (volatile LAS unsigned*)(lds + LDS_MISC);
    const int wave_s = __builtin_amdgcn_readfirstlane((int)threadIdx.x >> 6);
    if (threadIdx.x < 64) MISC[threadIdx.x] = 0u;
    __syncthreads();
    unsigned char* ws = a.ws;
    unsigned* ctl = (unsigned*)(ws + WS_CTL);
    const int lo = a.ph_lo, hi = a.ph_hi;
    XcdBarrier bar; bar.bar = ctl + CW_BAR; bar.x = 0; bar.st = MISC + 8;
    if (hi - lo > 1) bar = xcd_barrier_post(ctl + CW_BAR, MISC + 8);
#define IN(k) (lo <= (k) && (k) < hi)
#ifdef DBG_TIME
    if (blockIdx.x == 0 && threadIdx.x == 0) ctl[12288 + 63] = (unsigned)__builtin_amdgcn_s_memrealtime();
#define SEAM(k) do { if (IN(k) && IN((k) + 1)) { xcd_barrier(bar, wave_s == 0 && lane_id() == 0); if (bx == 0 && wave_s == 0 && lane_id() == 0) ctl[12288 + (k)] = (unsigned)__builtin_amdgcn_s_memrealtime(); } } while (0)
#else
#define SEAM(k) do { if (IN(k) && IN((k) + 1)) xcd_barrier(bar, wave_s == 0 && lane_id() == 0); } while (0)
#endif
    float* xo = a.out;
    bf16_t* xb = (bf16_t*)(ws + WS_XB);
    unsigned char* R = ws + WS_R;

    for (int rep_ = 0; rep_ < (DBG_REP_P0A); ++rep_)
    if (EN_A && IN(0)) { PH_LOCALS
        LAS float* scr = (LAS float*)(lds + wave * 8448);
        constexpr int PER_L = 4160;
        for (int it = gw; it < NL * PER_L; it += NGW) {
            const int l = it / PER_L; int r = it - l * PER_L;
            const float* win = a.in[1] + (size_t)l * 1024 * DIN;
            unsigned char* wm = ws + WS_WMIX + (size_t)l * WMIX_STRIDE;
            if (r < 1024) { tr_item(win, DIN, 0, 2048, (bf16_t*)(wm + OFF_WIN), 1024, 0, r, 64, scr, lane); continue; } r -= 1024;
            if (r < 512) { tr_item(win, DIN, 3072, 840, (bf16_t*)(wm + OFF_WIN) + (size_t)4096 * 1024, 1024, 0, r, 32, scr, lane); continue; } r -= 512;
            if (r < 1024) { tr_item(win, DIN, 3912, 2048, (bf16_t*)(wm + OFF_WG), 1024, 0, r, 64, scr, lane); continue; } r -= 1024;
            if (r < 512) { tr_item(a.in[12] + (size_t)l * 1048576, 1024, 0, 1024, (bf16_t*)(wm + OFF_WPR), 1024, 0, r, 32, scr, lane); continue; } r -= 512;
            if (r < 512) { tr_item(a.in[14] + (size_t)l * 1048576, 1024, 0, 1024, (bf16_t*)(wm + OFF_WO), 1024, 0, r, 32, scr, lane); continue; } r -= 512;
            if (r < 512) { tr_item(a.in[13] + (size_t)l * 1048576, 1024, 0, 1024, (bf16_t*)(R + R_PT + (size_t)l * 2 * MiB), 1024, 0, r, 32, scr, lane); continue; } r -= 512;
            { const int m = r >> 5, g = (r >> 1) & 15, nb = r & 1;
              const float* src = (m ? a.in[6] : a.in[4]) + (size_t)(l * 16 + g) * 4096;
              bf16_t* dst = (bf16_t*)(ws + WS_WSM + (size_t)l * 262144 + (size_t)m * 131072) + g * 4096;
              tr_item(src, 64, 0, 64, dst, 64, 0, nb, 2, scr, lane); }
        }
        const size_t gt = (size_t)vcu * NTHR + tid, GT = (size_t)G * NTHR;
        for (size_t i = gt; i < (size_t)NL * 1024 * 128; i += GT) { const int l = (int)(i >> 17), k = (int)(i >> 7) & 1023, j8 = (int)i & 127;
            const float* s = a.in[1] + ((size_t)l * 1024 + k) * DIN + 2048 + 8 * j8; const f32x4 v0 = *(const f32x4*)s, v1 = *(const f32x4*)(s + 4);
            *(u32x4*)((bf16_t*)(R + R_WQ + (size_t)l * 2 * MiB) + (size_t)k * 1024 + 8 * j8) = pack8(v0, v1); }
        for (size_t i = gt; i < (size_t)2 * NL * 8 * 256 * 32; i += GT) { const int which = (int)(i >> 18); const int r = (int)(i & 262143); const int lh = r >> 13, c = (r >> 5) & 255, d8 = r & 31; const int h = lh & 7;
            u32x4 o = (u32x4){0u, 0u, 0u, 0u};
            if ((d8 >> 4) == (h & 1)) { const float* s = (which ? a.in[11] : a.in[10]) + ((size_t)lh * 256 + c) * 128 + 8 * (d8 & 15); o = pack8(*(const f32x4*)s, *(const f32x4*)(s + 4)); }
            *(u32x4*)((bf16_t*)(R + (which ? R_UVP : R_UKP)) + ((size_t)lh * 256 + c) * 1024 + 8 * d8) = o; }
        for (size_t i = gt; i < (size_t)T * 128; i += GT) { const float* s = a.in[0] + i * 8; const f32x4 v0 = *(const f32x4*)s, v1 = *(const f32x4*)(s + 4);
            *(u32x4*)(xb + i * 8) = pack8(v0, v1); }
    }
    SEAM(0);
    if (EN_B && IN(1)) {
        SchedPro S{R, G, vcu}; EpiPro E{ws + WS_WMIX};
        gs::gemm_stream<true>(lds, S, E, wave_s);
    }
    SEAM(1);

    for (int l = 0; l < NL; ++l) {
        const int pb = 2 + l * NPH_L;
        unsigned char* wm = ws + WS_WMIX + (size_t)l * WMIX_STRIDE;
        bf16_t* xrnn = (bf16_t*)(R + R_XRNN); bf16_t* grnn = (bf16_t*)(R + R_GRNN); bf16_t* qlat = (bf16_t*)(R + R_QLAT); bf16_t* ckv = (bf16_t*)(R + R_CKV);
        bf16_t* qidx = (bf16_t*)(R + R_QIDX); bf16_t* kidx = (bf16_t*)(R + R_KIDX); float* widx = (float*)(R + R_WIDX);
        if (EN_0 && IN(pb + 0)) {
            SchedDense S{(const char*)xb, (const char*)(wm + OFF_WIN), 2048u, 2048u, 16, T / 256, 20, G, vcu};
            EpiInproj E{xrnn, grnn, qlat, ckv, qidx, kidx, widx};
            gs::gemm_stream<true>(lds, S, E, wave_s);
#ifdef DBG_REP_INPROJ
            gs::gemm_stream<true>(lds, S, E, wave_s);
#endif
        }
        SEAM(pb + 0);
        RnnP RP{xrnn, grnn, (float*)(R + R_TOT), (const bf16_t*)(ws + WS_WSM + (size_t)l * 262144), (const bf16_t*)(ws + WS_WSM + (size_t)l * 262144 + 131072),
                a.in[2] + (size_t)l * 4096, a.in[3] + (size_t)l * 1024, a.in[5] + (size_t)l * 1024, a.in[7] + (size_t)l * 1024, a.in[8] + (size_t)l * 1024};
        if (EN_1 && IN(pb + 1)) { PH_LOCALS
#ifdef DBG_TIME
            if (tid == 0) MISC[24] = (unsigned)__builtin_amdgcn_s_memrealtime();
#endif
            for (int it = gw; it < 2048; it += NGW) rnn_item<1>(RP, it, lds + wave * 8448, lane);
#ifdef DBG_TIME
            if (tid == 0) MISC[25] = (unsigned)__builtin_amdgcn_s_memrealtime();
#endif
#ifdef DBG_REP_RNN
            for (int it = gw; it < 2048; it += NGW) rnn_item<1>(RP, it, lds + wave * 8448, lane);
#endif
            for (int row = gw; row < T; row += 4 * NGW) ckv_norm_rows4(ckv, row, NGW, T, a.in[9] + (size_t)l * 256, lane);
#ifdef DBG_TIME
            if (tid == 0) MISC[26] = (unsigned)__builtin_amdgcn_s_memrealtime();
#endif
            LAS float* scr = (LAS float*)(lds + wave * 8448);
            for (int it = gw; it < 16 * 768; it += NGW) { const int e = it / 768; int r = it - e * 768; const size_t le = (size_t)l * 16 + e;
                bf16_t* gu = (bf16_t*)(ws + WS_WEXP) + (size_t)e * 1048576; bf16_t* dn = (bf16_t*)(ws + WS_WEXP + OFF_DN) + (size_t)e * 524288;
                if (r < 256) { tr_item(a.in[19] + le * 524288, 512, 0, 512, gu, 1024, 1, r, 16, scr, lane); continue; } r -= 256;
                if (r < 256) { tr_item(a.in[20] + le * 524288, 512, 0, 512, gu + 4 * 1024, 1024, 1, r, 16, scr, lane); continue; } r -= 256;
                tr_item(a.in[21] + le * 524288, 1024, 0, 1024, dn, 512, 0, r, 32, scr, lane); }
#ifdef DBG_TIME
            if (l == 1 && bx == 0 && tid == 0) { const unsigned tq3 = (unsigned)__builtin_amdgcn_s_memrealtime();
                ctl[12288 + 48] = MISC[25] - MISC[24]; ctl[12288 + 49] = MISC[26] - MISC[25]; ctl[12288 + 50] = tq3 - MISC[26]; ctl[12288 + 51] = tq3 - MISC[24]; }
#endif
        }
        SEAM(pb + 1);
        if (EN_2 && IN(pb + 2)) { PH_LOCALS
            __syncthreads();
            if (tid < 256) ((LAS float*)(lds + AT_BIAS))[tid] = a.in[24][tid];
            if (tid < 128) { const int d = tid; int bk = d; if (d >= 16) { bk = 16 + (int)(logf((float)d / 16.0f) / 2.0794415416798357f * 16.0f); bk = bk > 31 ? 31 : bk; } ((LAS int*)(lds + AT_BKT))[d] = bk; }
            __syncthreads();
            for (int i = tid; i < 1024; i += NTHR) ((LAS float*)(lds + AT_BIAS2))[i] = ((const LAS float*)(lds + AT_BIAS))[((const LAS int*)(lds + AT_BKT))[i >> 3] * 8 + (i & 7)];
            AttnP AP{qidx, kidx, ckv, widx, qlat, (unsigned long long*)(R + R_MSCR + (size_t)bx * 393216)};
#ifdef DBG_TIME
            unsigned tph0 = (unsigned)__builtin_amdgcn_s_memrealtime();
#endif
#ifdef DBG_STATIC_UNITS
            if (EN_2A) for (int p = vcu; p < 512; p += G) { const int b = p >> 8, uu = p & 255;
#pragma unroll 1
                for (int k2 = 0; k2 < 2; ++k2) { attn_unit(lds, AP, b, k2 ? uu : 511 - uu, tid);
#ifdef DBG_TIME
                    if (tid == 0) MISC[21] = MISC[21] + 1u;
#endif
                } }
#else
            if (EN_2A) for (;;) {
                __syncthreads();
                if (tid == 0) MISC[4] = __hip_atomic_fetch_add(ctl + CW_QUEUE + l * 64, 1u, __ATOMIC_RELAXED, __HIP_MEMORY_SCOPE_AGENT);
                __syncthreads();
                const unsigned tk = MISC[4];
                if (tk >= 1024u) break;
                attn_unit(lds, AP, (int)(tk & 1u), 511 - (int)(tk >> 1), tid);
#ifdef DBG_TIME
                if (tid == 0) MISC[21] = MISC[21] + 1u;
#endif
            }
            __syncthreads();
#endif
#ifdef DBG_TIME
            if (l == 1 && bx == 0 && tid == 0) { for (int i_ = 0; i_ < 6; ++i_) ctl[12288 + 40 + i_] = ((LAS unsigned*)(lds + LDS_MISC))[16 + i_]; ctl[12288 + 46] = ((LAS unsigned*)(lds + LDS_MISC))[16]; }
            if (l == 0 && tid == 0) { for (int i_ = 0; i_ < 6; ++i_) ((LAS unsigned*)(lds + LDS_MISC))[16 + i_] = 0u; }
            __syncthreads();
            unsigned tph1 = (unsigned)__builtin_amdgcn_s_memrealtime();
            if (l == 1 && bx == 0 && tid == 0) ctl[12288 + 47] = tph1 - tph0;
            if (l == 1 && tid == 0) { __hip_atomic_fetch_max(ctl + 12288 + 59, tph1 - tph0, __ATOMIC_RELAXED, __HIP_MEMORY_SCOPE_AGENT); __hip_atomic_fetch_max(ctl + 12288 + 58, 0x40000000u - (tph1 - tph0), __ATOMIC_RELAXED, __HIP_MEMORY_SCOPE_AGENT); }
#endif
            if (EN_2R) for (int it = gw; it < 2048; it += NGW) rnn_item<2>(RP, it, lds + wave * 8448, lane);
#ifdef DBG_TIME
            { __syncthreads(); const unsigned tph2 = (unsigned)__builtin_amdgcn_s_memrealtime();
              if (l == 1 && tid == 0) __hip_atomic_fetch_max(ctl + 12288 + 57, tph2 - tph1, __ATOMIC_RELAXED, __HIP_MEMORY_SCOPE_AGENT); }
#endif
        }
        SEAM(pb + 2);
        if (EN_3 && IN(pb + 3)) {
            if (EN_M1) { SchedMerge1 S{(const char*)xb, (const char*)grnn, (const char*)(wm + OFF_WG), (const char*)(wm + OFF_WPR), G, vcu};
              EpiMerge1 E{R + R_MSCR + (size_t)bx * 131072, R + R_MSCR2, (bf16_t*)(R + R_MERGED)};
              gs::gemm_stream<true>(lds, S, E, wave_s); }
            if (EN_M2) { SchedDense S{(const char*)qlat, (const char*)(wm + OFF_WVO), 4096u, 4096u, 32, T / 256, 4, G, vcu};
              EpiMerge2 E{R + R_MSCR2, (bf16_t*)(R + R_MERGED)};
              gs::gemm_stream<true>(lds, S, E, wave_s); }
        }
        SEAM(pb + 3);
        if (EN_4 && IN(pb + 4)) {
            SchedDense S{(const char*)(R + R_MERGED), (const char*)(wm + OFF_WO), 2048u, 2048u, 16, T / 256, 4, G, vcu};
            EpiOut E{xb};
            gs::gemm_stream<true>(lds, S, E, wave_s);
        }
        SEAM(pb + 4);
        RouteP RT{(int*)(R + R_ROUTE), (int*)(R + R_ROUTE + 262144), (int*)(R + R_ROUTE + 524288), (float*)(R + R_ROUTE + 786432), ctl + CW_CNT + l * 16 * 64};
        LAS int* offp = (LAS int*)(lds + LDS_MISC - 128);
        if (EN_5 && IN(pb + 5)) { PH_LOCALS
            __syncthreads();
            { float wv[32];
#pragma unroll
              for (int j = 0; j < 32; ++j) wv[j] = a.in[17][tid + j * NTHR];
#pragma unroll
              for (int j = 0; j < 32; ++j) { const int i = tid + j * NTHR; ((LAS float*)lds)[(i & 15) * 1024 + (i >> 4)] = wv[j]; } }
            for (int blk = vcu; blk < T / 128; blk += G) ln1_route_block(lds, blk, xo, xb, a.in[15] + (size_t)l * 1024, a.in[16] + (size_t)l * 1024, a.in[18], RT, tid);
        }
        SEAM(pb + 5);
        int* tokof = (int*)(R + R_ROUTE + 1048576);
        if (EN_6 && IN(pb + 6)) { PH_LOCALS
            moe_offsets(offp, RT.gcnt, tid);
            for (int p = vcu * NTHR + tid; p < 2 * T; p += G * NTHR) { const int e = RT.r_e[p], slot = offp[e] + RT.r_pos[p]; RT.r_slot[p] = slot; tokof[slot] = p >> 1; }
            if (vcu == 0 && tid < 256) {
                for (int e = 0; e < 16; ++e) { const int cnt = (int)__hip_atomic_load(RT.gcnt + e * 64, __ATOMIC_RELAXED, __HIP_MEMORY_SCOPE_AGENT); const int s0 = offp[e] + cnt;
                    if (s0 + tid < offp[e + 1]) tokof[s0 + tid] = 0; } }
        }
        SEAM(pb + 6);
        if (EN_7 && IN(pb + 7)) { PH_LOCALS
            moe_offsets(offp, RT.gcnt, tid);
            SchedMoEG S{(const char*)xb, (const char*)(ws + WS_WEXP), 2048u, 2048u, (size_t)2097152, 16, 4, G, vcu, offp, tokof};
            EpiGU E{(bf16_t*)(R + R_HE)};
            gs::gemm_stream<true, SchedMoEG, EpiGU, true>(lds, S, E, wave_s);
        }
        SEAM(pb + 7);
        if (EN_8 && IN(pb + 8)) { PH_LOCALS
            moe_offsets(offp, RT.gcnt, tid);
            SchedMoE S{(const char*)(R + R_HE), (const char*)(ws + WS_WEXP + OFF_DN), 1024u, 1024u, (size_t)1048576, 8, 4, G, vcu, offp};
            EpiBf16 E{(bf16_t*)(R + R_XG), 1024};
            gs::gemm_stream<true>(lds, S, E, wave_s);
        }
        SEAM(pb + 8);
        if (EN_9 && IN(pb + 9)) { PH_LOCALS
            const bf16_t* Y = (const bf16_t*)(R + R_XG);
            u32x2 xwn[4], y0n[4], y1n[4]; int s0n, s1n; f32x2 ggc, ggn;
            { const int r0 = gw < T ? gw : T - 1, r1 = gw + NGW < T ? gw + NGW : T - 1;
              const int a0 = RT.r_slot[2 * r0], a1 = RT.r_slot[2 * r0 + 1]; ggc = *(const f32x2*)(RT.r_g + 2 * (size_t)r0);
#pragma unroll
              for (int j = 0; j < 4; ++j) { xwn[j] = *(const u32x2*)(xb + (size_t)r0 * 1024 + 256 * j + 4 * lane); y0n[j] = *(const u32x2*)(Y + (size_t)a0 * 1024 + 256 * j + 4 * lane); y1n[j] = *(const u32x2*)(Y + (size_t)a1 * 1024 + 256 * j + 4 * lane); }
              s0n = RT.r_slot[2 * r1]; s1n = RT.r_slot[2 * r1 + 1]; ggn = *(const f32x2*)(RT.r_g + 2 * (size_t)r1); }
            for (int row = gw; row < T; row += NGW) {
                const f32x2 gg = ggc;
                u32x2 xwc[4], y0c[4], y1c[4];
#pragma unroll
                for (int j = 0; j < 4; ++j) { xwc[j] = xwn[j]; y0c[j] = y0n[j]; y1c[j] = y1n[j]; }
                { const int r1 = row + NGW < T ? row + NGW : T - 1, r2 = row + 2 * NGW < T ? row + 2 * NGW : T - 1;
                  const int a0 = s0n, a1 = s1n; ggc = ggn;
#pragma unroll
                  for (int j = 0; j < 4; ++j) { xwn[j] = *(const u32x2*)(xb + (size_t)r1 * 1024 + 256 * j + 4 * lane); y0n[j] = *(const u32x2*)(Y + (size_t)a0 * 1024 + 256 * j + 4 * lane); y1n[j] = *(const u32x2*)(Y + (size_t)a1 * 1024 + 256 * j + 4 * lane); }
                  s0n = RT.r_slot[2 * r2]; s1n = RT.r_slot[2 * r2 + 1]; ggn = *(const f32x2*)(RT.r_g + 2 * (size_t)r2); }
                f32x4 v[4];
#pragma unroll
                for (int j = 0; j < 4; ++j) { const u32x2 xw = xwc[j]; const f32x4 x1 = {bf_lo(xw.x), bf_hi(xw.x), bf_lo(xw.y), bf_hi(xw.y)};
                    const u32x2 y0 = y0c[j], y1 = y1c[j];
                    v[j][0] = ALPHA * x1[0] + gg.x * bf_lo(y0.x) + gg.y * bf_lo(y1.x); v[j][1] = ALPHA * x1[1] + gg.x * bf_hi(y0.x) + gg.y * bf_hi(y1.x);
                    v[j][2] = ALPHA * x1[2] + gg.x * bf_lo(y0.y) + gg.y * bf_lo(y1.y); v[j][3] = ALPHA * x1[3] + gg.x * bf_hi(y0.y) + gg.y * bf_hi(y1.y); }
                ln_finish(v, a.in[22] + (size_t)l * 1024, a.in[23] + (size_t)l * 1024, l == NL - 1 ? xo + (size_t)row * 1024 : nullptr, xb + (size_t)row * 1024, lane);
#ifdef DBG_TIME
                if (l == NL - 1) {
                    const unsigned ta = __hip_atomic_load(ctl + 12288 + (DBG_TA), __ATOMIC_RELAXED, __HIP_MEMORY_SCOPE_AGENT), tb = __hip_atomic_load(ctl + 12288 + (DBG_TB), __ATOMIC_RELAXED, __HIP_MEMORY_SCOPE_AGENT);
                    unsigned k_ = (DBG_Q) == 0 ? (40u * ta + tb / 2u) / (tb ? tb : 1u) : ((DBG_TA) == 58 ? (0x40000000u - ta) : (ta - tb)) / (unsigned)((DBG_Q) ? (DBG_Q) : 1); k_ = k_ > 45u ? 45u : k_;
                    const float sc_ = 1.0f - 0.02f * (float)k_;
#pragma unroll
                    for (int j = 0; j < 4; ++j) *(f32x4*)(xo + (size_t)row * 1024 + 256 * j + 4 * lane) = v[j] * sc_; }
#endif
            }
        }
        SEAM(pb + 9);
    }
#undef IN
#undef SEAM
}

#ifdef DUMP_OFF
__global__ void dump_k(const bf16_t* src, float* dst, size_t ld, size_t col0) { for (size_t i = (size_t)blockIdx.x * blockDim.x + threadIdx.x; i < (size_t)T * 1024; i += (size_t)gridDim.x * blockDim.x) dst[i] = bf2f(src[(i >> 10) * ld + col0 + (i & 1023)]); }
#endif
extern "C" void kernel_launch(void* const* d_in, const int* in_sizes, int n_in, void* d_out, int out_size, void* d_ws, size_t ws_size, hipStream_t stream) {
    static int grid = 0;
    if (grid == 0) {
        if (n_in != 25 || out_size != T * D || ws_size < WS_END) { fprintf(stderr, "kernel_launch: unexpected shapes (n_in %d, out %d, ws %zu < %zu)\n", n_in, out_size, ws_size, (size_t)WS_END); grid = -1; return; }
        int dev = 0, cus = 0, per_cu = 0;
        if (hipGetDevice(&dev) != hipSuccess || hipDeviceGetAttribute(&cus, hipDeviceAttributeMultiprocessorCount, dev) != hipSuccess) { grid = -1; return; }
        if (hipFuncSetAttribute((const void*)fwd, hipFuncAttributeMaxDynamicSharedMemorySize, LDS_BYTES) != hipSuccess) { fprintf(stderr, "kernel_launch: hipFuncSetAttribute failed\n"); grid = -1; return; }
        if (hipOccupancyMaxActiveBlocksPerMultiprocessor(&per_cu, (const void*)fwd, NTHR, LDS_BYTES) != hipSuccess || per_cu < 1) fprintf(stderr, "kernel_launch: occupancy query says %d\n", per_cu);
        (void)hipGetLastError();
        grid = cus < 256 ? cus : 256;
    }
    if (grid < 0) return;
    (void)hipMemsetAsync((char*)d_ws + WS_CTL, 0, CTL_BYTES, stream);
    Args a{};
    for (int i = 0; i < 25; ++i) a.in[i] = (const float*)d_in[i];
    a.out = (float*)d_out; a.ws = (unsigned char*)d_ws;
#if MK_PER_PHASE
#ifndef PH_LIMIT
#define PH_LIMIT NPH
#endif
    for (int ph = 0; ph < PH_LIMIT; ++ph) { a.ph_lo = ph; a.ph_hi = ph + 1; hipLaunchKernelGGL(fwd, dim3(grid), dim3(NTHR), LDS_BYTES, stream, a); }
#else
    a.ph_lo = 0; a.ph_hi = NPH; hipLaunchKernelGGL(fwd, dim3(grid), dim3(NTHR), LDS_BYTES, stream, a);
#endif
#ifdef DUMP_OFF
    hipLaunchKernelGGL(dump_k, dim3(2048), dim3(256), 0, stream, (const bf16_t*)((const char*)d_ws + (DUMP_OFF)), (float*)d_out, (size_t)(DUMP_LD), (size_t)(DUMP_COL));
#endif
}
```

```cpp
#include <hip/hip_runtime.h>
#include <cstdio>
#include <cstdint>

#define GAS __attribute__((address_space(1)))
#define LAS __attribute__((address_space(3)))
typedef unsigned short bf16_t;
typedef short bf16x8 __attribute__((ext_vector_type(8)));
typedef short s16x4 __attribute__((ext_vector_type(4)));
typedef float f32x2 __attribute__((ext_vector_type(2)));
typedef float f32x4 __attribute__((ext_vector_type(4)));
typedef float f32x16 __attribute__((ext_vector_type(16)));
typedef unsigned u32x2 __attribute__((ext_vector_type(2)));
typedef unsigned u32x4 __attribute__((ext_vector_type(4)));

constexpr int NB = 2, SEQ = 16384, T = NB * SEQ, D = 1024, NL = 4, DIN = 5960;
constexpr int NE = 16;
constexpr float ALPHA = 1.681792830507429f;
constexpr float LN_EPS = 1e-5f, RMS_EPS = 1e-6f;
constexpr int NWAVES = 8, NTHR = 512;

constexpr size_t MiB = 1u << 20;
constexpr size_t WS_CTL = 0, CTL_BYTES = 1 * MiB;
constexpr size_t WS_XB = 1 * MiB;
constexpr size_t WS_WMIX = 65 * MiB, WMIX_STRIDE = 22 * MiB;
constexpr size_t OFF_WIN = 0, OFF_WG = 10 * MiB, OFF_WPR = 14 * MiB, OFF_WVO = 16 * MiB, OFF_WO = 20 * MiB;
constexpr size_t WS_WSM = 153 * MiB;
constexpr size_t WS_WEXP = 154 * MiB;
constexpr size_t OFF_DN = 32 * MiB;
constexpr size_t WS_R = 202 * MiB;
constexpr size_t R_XRNN = 0, R_GRNN = 64 * MiB, R_QLAT = 128 * MiB, R_CKV = 256 * MiB, R_QIDX = 272 * MiB, R_KIDX = 304 * MiB, R_WIDX = 308 * MiB,
                 R_TOT = 309 * MiB, R_MSCR = 310 * MiB, R_MSCR2 = 342 * MiB, R_END = 406 * MiB;
constexpr size_t R_MERGED = R_XRNN;
constexpr size_t R_XG = 0, R_HE = 136 * MiB, R_ROUTE = 204 * MiB;
constexpr size_t R_WQ = 0, R_UKP = 8 * MiB, R_PT = 24 * MiB, R_UVP = 32 * MiB;
constexpr size_t WS_END = WS_R + R_END;
constexpr int MP_MAX = 2 * T + NE * 256;

constexpr int CW_TMO = 0;
constexpr int CW_BAR = 4096;
constexpr int CW_CNT = 8192;
constexpr int CW_QUEUE = 14336;

constexpr int LDS_BYTES = 163840;
constexpr int LDS_MISC = LDS_BYTES - 256;

#define RLX_AGENT __ATOMIC_RELAXED, __HIP_MEMORY_SCOPE_AGENT
__device__ __forceinline__ unsigned f2bf(float f) { unsigned u = __builtin_bit_cast(unsigned, f); return (u + 0x7fffu + ((u >> 16) & 1u)) >> 16; }
typedef __bf16 bf16x2_t __attribute__((ext_vector_type(2)));
__device__ __forceinline__ unsigned pk2(float lo, float hi) { const f32x2 v = {lo, hi}; const bf16x2_t b = __builtin_convertvector(v, bf16x2_t); return __builtin_bit_cast(unsigned, b); }
__device__ __forceinline__ float bf_lo(unsigned w) { return __builtin_bit_cast(float, w << 16); }
__device__ __forceinline__ float bf_hi(unsigned w) { return __builtin_bit_cast(float, w & 0xffff0000u); }
__device__ __forceinline__ float bf2f(bf16_t h) { return __builtin_bit_cast(float, ((unsigned)h) << 16); }
__device__ __forceinline__ float fast_exp(float x) { return __builtin_amdgcn_exp2f(x * 1.4426950408889634f); }
__device__ __forceinline__ float fast_rcp(float x) { return __builtin_amdgcn_rcpf(x); }
__device__ __forceinline__ float sigmoidf_(float x) { return fast_rcp(1.0f + fast_exp(-x)); }
__device__ __forceinline__ float gelu_tanh(float x) { const float y = 0.7978845608028654f * (x + 0.044715f * x * x * x); const float e = fast_exp(2.0f * y); const float th = 1.0f - 2.0f * fast_rcp(e + 1.0f); return 0.5f * x * (1.0f + th); }
template <int CTRL> __device__ __forceinline__ float dpp_f(float v) { return __builtin_bit_cast(float, __builtin_amdgcn_update_dpp(0, __builtin_bit_cast(int, v), CTRL, 0xf, 0xf, true)); }
__device__ __forceinline__ float wave_sum(float v) {
    v += dpp_f<0xB1>(v); v += dpp_f<0x4E>(v); v += dpp_f<0x141>(v); v += dpp_f<0x140>(v);
    const int vi = __builtin_bit_cast(int, v);
    return (__builtin_bit_cast(float, __builtin_amdgcn_readlane(vi, 0)) + __builtin_bit_cast(float, __builtin_amdgcn_readlane(vi, 16))) +
           (__builtin_bit_cast(float, __builtin_amdgcn_readlane(vi, 32)) + __builtin_bit_cast(float, __builtin_amdgcn_readlane(vi, 48)));
}

__device__ __forceinline__ int lane_id() { unsigned z = 0u; asm volatile("" : "+v"(z)); return (int)__builtin_amdgcn_mbcnt_hi(~0u, __builtin_amdgcn_mbcnt_lo(~0u, z)); }
#define XB_TMO      128
#define XB_XCNT(j)  (256  + 64 * (j))
#define XB_XSUB(j)  (1280 + 64 * (j))
#define XB_XGEN(j)  (2304 + 64 * (j))
#define XB_TOP      3328
#define XB_TOPGEN   3392
#define XCD_BAR_WORDS 3456
#define XB_SPIN_CAP (1u << 18)
__device__ __forceinline__ unsigned xb_ld(unsigned* p)              { return __hip_atomic_load(p, __ATOMIC_RELAXED, __HIP_MEMORY_SCOPE_AGENT); }
__device__ __forceinline__ unsigned xb_add(unsigned* p, unsigned v) { return __hip_atomic_fetch_add(p, v, __ATOMIC_RELAXED, __HIP_MEMORY_SCOPE_AGENT); }
__device__ __forceinline__ unsigned xb_xcc_id() { return (unsigned)__builtin_amdgcn_s_getreg((3 << 11) | 20) & 0xFu; }
#define XB_SPIN(cond, bar) do { unsigned _sp = 0; while (cond) { __builtin_amdgcn_s_sleep(1); \
    if ((++_sp & 255u) == 0u) { if (xb_ld(&(bar)[XB_TMO])) break; if (_sp > XB_SPIN_CAP) { atomicAdd(&(bar)[XB_TMO], 1u); break; } } } } while (0)
struct XcdBarrier { unsigned* bar; unsigned x; volatile LAS unsigned* st; };
__device__ __forceinline__ XcdBarrier xcd_barrier_post(unsigned* bar, volatile LAS unsigned* st) {
    XcdBarrier b; b.bar = bar; b.x = xb_xcc_id(); b.st = st;
    if (threadIdx.x == 0) (void)xb_add(&bar[XB_XCNT(b.x)], 1u);
    return b;
}
__device__ __forceinline__ void xcd_barrier_complete(unsigned* bar, unsigned x, unsigned& nloc, unsigned& nx) {
    const unsigned G = gridDim.x * gridDim.y * gridDim.z;
    unsigned sum, cnt, mine, sp = 0u;
    for (;;) {
        sum = 0u; cnt = 0u; mine = 0u;
#pragma unroll
        for (unsigned j = 0; j < 16; ++j) { const unsigned c = xb_ld(&bar[XB_XCNT(j)]); sum += c; cnt += (c > 0u) ? 1u : 0u; mine = (j == x) ? c : mine; }
        if (sum == G) break;
        __builtin_amdgcn_s_sleep(1);
        if ((++sp & 255u) == 0u) { if (xb_ld(&bar[XB_TMO])) break; if (sp > XB_SPIN_CAP) { atomicAdd(&bar[XB_TMO], 1u); break; } }
    }
    nloc = mine > 0u ? mine : 1u; nx = cnt > 0u ? cnt : 1u;
}
__device__ __forceinline__ void xcd_barrier(const XcdBarrier& b, bool is_t0) {
    asm volatile("s_waitcnt vmcnt(0)" ::: "memory");
    __syncthreads();
    if (is_t0) {
        unsigned* bar = b.bar;
        __builtin_amdgcn_s_waitcnt(0);
        unsigned nloc = b.st[0], nx = b.st[1];
        if (nloc == 0u) { xcd_barrier_complete(bar, b.x, nloc, nx); b.st[0] = nloc; b.st[1] = nx; }
        const unsigned old = xb_add(&bar[XB_XSUB(b.x)], 1u);
        const unsigned gen = old / nloc;
        if (old + 1u == (gen + 1u) * nloc) {
            __builtin_amdgcn_fence(__ATOMIC_RELEASE, "agent");
            asm volatile("s_waitcnt vmcnt(0)" ::: "memory");
            const unsigned og = xb_add(&bar[XB_TOP], 1u);
            const unsigned tg = og / nx;
            if (og + 1u == (tg + 1u) * nx) xb_add(&bar[XB_TOPGEN], 1u);
            else XB_SPIN(xb_ld(&bar[XB_TOPGEN]) == tg, bar);
            __builtin_amdgcn_fence(__ATOMIC_ACQUIRE, "agent");
            xb_add(&bar[XB_XGEN(b.x)], 1u);
            asm volatile("s_waitcnt vmcnt(0)" ::: "memory");
        } else {
            XB_SPIN(xb_ld(&bar[XB_XGEN(b.x)]) == gen, bar);
            __builtin_amdgcn_fence(__ATOMIC_ACQUIRE, "agent");
            asm volatile("s_waitcnt vmcnt(0)" ::: "memory");
        }
    }
    __syncthreads();
}
namespace gs {
constexpr int BM = 256, BK = 64, HALF = 128, HTB = HALF * BK * 2, STAGE_BYTES = 8 * HTB, NXCD = 8, WGM = 8;
__host__ __device__ __forceinline__ int lds_byte(int r, int c) { const int st = (r >> 4) * 2 + (c >> 5), rr = r & 15, cc = c & 31, ob = rr * 64 + cc * 2; return st * 1024 + (ob ^ (((ob >> 9) & 1) << 5)); }
__host__ __device__ __forceinline__ void stage_rc(int b, int& R, int& C) { const int st = b / 1024, sb = b % 1024, swz = sb ^ (((sb >> 9) & 1) << 5); R = (st >> 1) * 16 + swz / 64; C = (st & 1) * 32 + (swz % 64) / 2; }
__host__ __device__ __forceinline__ int perm32(int rho) { const int n = rho >> 4, i = rho & 15; return 8 * (i >> 2) + 4 * n + (i & 3); }

struct UD { const char* A; const char* B; unsigned lda, ldb; int nt; int kind, pm, pn, aux; };

__device__ __forceinline__ bool tile_of(long L, int nM, int nN, int& pm, int& pn) {
    const int nwg = nM * nN; if (L >= nwg) return false;
    int wgid = (int)L; { const int q = nwg / NXCD, r = nwg % NXCD, xcd = wgid % NXCD, off = wgid / NXCD; wgid = (xcd < r ? xcd * (q + 1) : r * (q + 1) + (xcd - r) * q) + off; }
    const int nig = WGM * nN, gid = wgid / nig, fm = gid * WGM, gsz = (nM - fm) < WGM ? (nM - fm) : WGM;
    pm = fm + ((wgid % nig) % gsz); pn = (wgid % nig) / gsz; return true;
}

template <bool PERM, class Sched, class Epi, bool GATHER = false>
__device__ __forceinline__ void gemm_stream(LAS unsigned char* lds, const Sched& S, const Epi& E, int wave_s) {
    int tid = wave_s * 64 + lane_id(); asm volatile("" : "+v"(tid));
    const int wid = __builtin_amdgcn_readfirstlane(tid >> 6), lane = tid & 63, wr = wid >> 2, wc = wid & 3, fr = lane & 15, fq = lane >> 4;
    int rA[2], rB[2], cb[2];
#pragma unroll
    for (int i = 0; i < 2; ++i) { int R, C; stage_rc(tid * 16 + i * 8192, R, C); rA[i] = R; rB[i] = PERM ? ((R & ~31) + perm32(R & 31)) : R; cb[i] = C * 2; }
    const size_t kstep = (size_t)(BK * 2);
    const unsigned ldsw = (unsigned)wid * 1024u;
    const int aoff = lds_byte(wr * 64 + fr, fq * 8), boff = lds_byte(wc * 32 + fr, fq * 8);
#define GS_SA(b, h) (((b) * 2 + (h)) * HTB)
#define GS_SB(b, h) ((4 + (b) * 2 + (h)) * HTB)
#define GS_STAGE(bufoff, gbase, voff) do { _Pragma("unroll") for (int _i = 0; _i < 2; ++_i) \
        __builtin_amdgcn_global_load_lds((const unsigned*)((const char*)(gbase) + (voff)[_i]), (LAS unsigned*)(lds + (bufoff) + ldsw + _i * 8192), 16, 0, 0); } while (0)
#define GS_LDA(dst, b, h) do { _Pragma("unroll") for (int m = 0; m < 4; ++m) _Pragma("unroll") for (int k = 0; k < 2; ++k) dst[m][k] = *(const LAS bf16x8*)(lds + GS_SA(b, h) + aoff + m * 2048 + k * 1024); } while (0)
#define GS_LDB(dst, b, h) do { _Pragma("unroll") for (int n = 0; n < 2; ++n) _Pragma("unroll") for (int k = 0; k < 2; ++k) dst[n][k] = *(const LAS bf16x8*)(lds + GS_SB(b, h) + boff + n * 2048 + k * 1024); } while (0)
#define GS_MMA(ai, bj, At, Bt) do { __builtin_amdgcn_s_setprio(1); _Pragma("unroll") for (int m = 0; m < 4; ++m) _Pragma("unroll") for (int n = 0; n < 2; ++n) _Pragma("unroll") for (int k = 0; k < 2; ++k) \
        acc[ai][bj][m][n] = __builtin_amdgcn_mfma_f32_16x16x32_bf16(Bt[n][k], At[m][k], acc[ai][bj][m][n], 0, 0, 0); __builtin_amdgcn_s_setprio(0); } while (0)
#define GS_WAIT_V(n) asm volatile("s_waitcnt vmcnt(" #n ")" ::: "memory")
#define GS_WAIT_L(n) asm volatile("s_waitcnt lgkmcnt(" #n ")" ::: "memory")
#define GS_BAR __builtin_amdgcn_s_barrier()
#define GS_SCHED __builtin_amdgcn_sched_barrier(0)
    UD cur, nxt; int ui = 0; const bool prime = false;
    if (!S.next(0, cur)) return;
    f32x4 acc[2][2][4][2];
#pragma unroll
    for (int a = 0; a < 2; ++a)
#pragma unroll
        for (int b = 0; b < 2; ++b)
#pragma unroll
            for (int m = 0; m < 4; ++m)
#pragma unroll
                for (int n = 0; n < 2; ++n) acc[a][b][m][n] = (f32x4){0.f, 0.f, 0.f, 0.f};
    bf16x8 At[4][2], B0[2][2], B1[2][2];
    unsigned vAc[2], vBc[2], vAc1[2] = {0u, 0u};
#pragma unroll
    for (int i = 0; i < 2; ++i) { vAc[i] = (unsigned)rA[i] * cur.lda + (unsigned)cb[i]; vBc[i] = (unsigned)rB[i] * cur.ldb + (unsigned)cb[i]; }
    if constexpr (GATHER) { const int* rm = S.rmap + cur.pm * 256;
#pragma unroll
        for (int i = 0; i < 2; ++i) { vAc[i] = (unsigned)rm[rA[i]] * cur.lda + (unsigned)cb[i]; vAc1[i] = (unsigned)rm[HALF + rA[i]] * cur.lda + (unsigned)cb[i]; } }
    const char* cA = cur.A; const char* cB = cur.B; size_t hA = GATHER ? (size_t)0 : (size_t)HALF * cur.lda, hB = (size_t)HALF * cur.ldb;
    GS_STAGE(GS_SB(0, 0), cB, vBc); GS_STAGE(GS_SA(0, 0), cA, vAc); GS_STAGE(GS_SB(0, 1), cB + hB, vBc); GS_STAGE(GS_SA(0, 1), cA + hA, (GATHER ? vAc1 : vAc));
    if (wr == 1) GS_BAR;
    GS_WAIT_V(4); GS_BAR;
    GS_STAGE(GS_SB(1, 0), cB + kstep, vBc); GS_STAGE(GS_SA(1, 0), cA + kstep, vAc); GS_STAGE(GS_SB(1, 1), cB + hB + kstep, vBc);
    GS_WAIT_V(6); GS_BAR;
    for (;;) {
        const bool has_next = S.next(ui + 1, nxt);
        const char* nA = has_next ? nxt.A : cA; const char* nB = has_next ? nxt.B : cB;
        const unsigned nlda = has_next ? nxt.lda : cur.lda, nldb = has_next ? nxt.ldb : cur.ldb;
        unsigned vAn[2], vBn[2], vAn1[2] = {0u, 0u};
#pragma unroll
        for (int i = 0; i < 2; ++i) { vAn[i] = (unsigned)rA[i] * nlda + (unsigned)cb[i]; vBn[i] = (unsigned)rB[i] * nldb + (unsigned)cb[i]; }
        if constexpr (GATHER) { const int* rm = S.rmap + (has_next ? nxt.pm : cur.pm) * 256;
#pragma unroll
            for (int i = 0; i < 2; ++i) { vAn[i] = (unsigned)rm[rA[i]] * nlda + (unsigned)cb[i]; vAn1[i] = (unsigned)rm[HALF + rA[i]] * nlda + (unsigned)cb[i]; } }
        const size_t hAn = GATHER ? (size_t)0 : (size_t)HALF * nlda, hBn = (size_t)HALF * nldb;
        const int nt = cur.nt;
        for (int t = 0; t < nt; t += 2) {
            const bool last = (t == nt - 2);
            const char* a1 = cA + (size_t)(t + 1) * kstep;
            const char* a2 = last ? nA : cA + (size_t)(t + 2) * kstep; const char* b2 = last ? nB : cB + (size_t)(t + 2) * kstep;
            const char* a3 = a2 + kstep; const char* b3 = b2 + kstep;
            unsigned vA2[2], vB2[2], vA21[2];
#pragma unroll
            for (int i = 0; i < 2; ++i) { vA2[i] = last ? vAn[i] : vAc[i]; vB2[i] = last ? vBn[i] : vBc[i]; vA21[i] = last ? vAn1[i] : vAc1[i]; }
            const size_t hA2 = last ? hAn : hA, hB2 = last ? hBn : hB;
            GS_LDB(B0, 0, 0); GS_SCHED; GS_LDA(At, 0, 0); GS_STAGE(GS_SA(1, 1), a1 + hA, (GATHER ? vAc1 : vAc));
            GS_WAIT_L(8); GS_BAR; GS_WAIT_L(0); GS_MMA(0, 0, At, B0); GS_BAR; GS_SCHED;
            GS_LDB(B1, 0, 1); GS_STAGE(GS_SB(0, 0), b2, vB2);
            GS_BAR; GS_WAIT_L(0); GS_MMA(0, 1, At, B1); GS_BAR;
            GS_LDA(At, 0, 1); GS_STAGE(GS_SA(0, 0), a2, vA2);
            GS_BAR; GS_WAIT_L(0); GS_MMA(1, 0, At, B0); GS_BAR; GS_SCHED;
            GS_STAGE(GS_SB(0, 1), b2 + hB2, vB2);
            GS_WAIT_V(6); GS_BAR; GS_MMA(1, 1, At, B1); GS_BAR;
            GS_LDB(B0, 1, 0); GS_SCHED; GS_LDA(At, 1, 0); GS_STAGE(GS_SA(0, 1), a2 + hA2, (GATHER ? vA21 : vA2));
            GS_WAIT_L(8); GS_BAR; GS_WAIT_L(0); GS_MMA(0, 0, At, B0); GS_BAR; GS_SCHED;
            GS_LDB(B1, 1, 1); GS_STAGE(GS_SB(1, 0), b3, vB2);
            GS_BAR; GS_WAIT_L(0); GS_MMA(0, 1, At, B1); GS_BAR;
            GS_LDA(At, 1, 1); GS_STAGE(GS_SA(1, 0), a3, vA2);
            GS_BAR; GS_WAIT_L(0); GS_MMA(1, 0, At, B0); GS_BAR; GS_SCHED;
            GS_STAGE(GS_SB(1, 1), b3 + hB2, vB2);
            GS_WAIT_V(6); GS_BAR; GS_MMA(1, 1, At, B1); GS_BAR;
        }
        if (!prime) { int tz = wave_s * 64 + lane_id(); asm volatile("" : "+v"(tz)); const int w2 = __builtin_amdgcn_readfirstlane(tz >> 6), l2 = tz & 63; E(acc, cur, w2 >> 2, w2 & 3, l2 & 15, l2 >> 4, tz); }
        if (!has_next) break;
#pragma unroll
        for (int a = 0; a < 2; ++a)
#pragma unroll
            for (int b = 0; b < 2; ++b)
#pragma unroll
                for (int m = 0; m < 4; ++m)
#pragma unroll
                    for (int n = 0; n < 2; ++n) acc[a][b][m][n] = (f32x4){0.f, 0.f, 0.f, 0.f};
        cur = nxt; cA = nA; cB = nB; hA = hAn; hB = hBn;
#pragma unroll
        for (int i = 0; i < 2; ++i) { vAc[i] = vAn[i]; vBc[i] = vBn[i]; vAc1[i] = vAn1[i]; }
        ++ui;
    }
    GS_WAIT_V(0);
    if (wr == 0) GS_BAR;
    GS_BAR;
#undef GS_SA
#undef GS_SB
#undef GS_STAGE
#undef GS_LDA
#undef GS_LDB
#undef GS_MMA
#undef GS_WAIT_V
#undef GS_WAIT_L
#undef GS_BAR
#undef GS_SCHED
}
}
using gs::UD;
__device__ __forceinline__ u32x4 pack8(f32x4 v0, f32x4 v1) { u32x4 w; w.x = pk2(v0[0], v0[1]); w.y = pk2(v0[2], v0[3]); w.z = pk2(v1[0], v1[1]); w.w = pk2(v1[2], v1[3]); return w; }
__device__ __forceinline__ void unpack8(u32x4 w, f32x4& v0, f32x4& v1) { v0 = (f32x4){bf_lo(w.x), bf_hi(w.x), bf_lo(w.y), bf_hi(w.y)}; v1 = (f32x4){bf_lo(w.z), bf_hi(w.z), bf_lo(w.w), bf_hi(w.w)}; }

struct EpiInproj {
    bf16_t *xrnn, *grnn, *qlat, *ckv, *qidx, *kidx; float* widx;
    __device__ __forceinline__ void operator()(const f32x4 (&acc)[2][2][4][2], const UD& u, int wr, int wc, int fr, int fq, int tid) const {
        const int pn = u.pn; const size_t row0 = (size_t)u.pm * 256 + wr * 64 + fr;
        if (pn < 19) {
            bf16_t* base; int ldc, colt; float sc = 1.f; bool gl = false;
            if (pn < 4) { base = xrnn; ldc = 1024; colt = 256 * pn; }
            else if (pn < 8) { base = grnn; ldc = 1024; colt = 256 * (pn - 4); gl = true; }
            else if (pn < 16) { base = qlat; ldc = 2048; colt = 256 * (pn - 8); }
            else if (pn == 16) { base = ckv; ldc = 256; colt = 0; }
            else { base = qidx; ldc = 512; colt = 256 * (pn - 17); sc = 0.125f; }
#pragma unroll
            for (int ai = 0; ai < 2; ++ai)
#pragma unroll
                for (int m = 0; m < 4; ++m) { bf16_t* rowp = base + (row0 + ai * 128 + m * 16) * ldc + colt + wc * 32 + 8 * fq;
#pragma unroll
                    for (int bj = 0; bj < 2; ++bj) { f32x4 v0 = acc[ai][bj][m][0], v1 = acc[ai][bj][m][1];
                        if (gl) {
#pragma unroll
                            for (int j = 0; j < 4; ++j) { v0[j] = gelu_tanh(v0[j]); v1[j] = gelu_tanh(v1[j]); } }
                        v0 = v0 * sc; v1 = v1 * sc;
                        *(u32x4*)(rowp + bj * 128) = pack8(v0, v1); } }
        } else {
#pragma unroll
            for (int ai = 0; ai < 2; ++ai)
#pragma unroll
                for (int m = 0; m < 4; ++m) { const size_t row = row0 + ai * 128 + m * 16; const f32x4 v0 = acc[ai][0][m][0], v1 = acc[ai][0][m][1];
                    if (wc < 2) *(u32x4*)(kidx + row * 64 + wc * 32 + 8 * fq) = pack8(v0, v1);
                    else if (wc == 2 && fq == 0) { *(f32x4*)(widx + row * 8) = v0 * 0.35355339059327373f; *(f32x4*)(widx + row * 8 + 4) = v1 * 0.35355339059327373f; } }
        }
    }
};
struct EpiMerge1 {
    unsigned char* s1b; unsigned char* s2b; bf16_t* merged;
    __device__ __forceinline__ void operator()(const f32x4 (&acc)[2][2][4][2], const UD& u, int wr, int wc, int fr, int fq, int tid) const {
        const int kind = u.kind;
        u32x4* s1 = (u32x4*)s1b + tid; u32x4* s2 = (u32x4*)(s2b + (size_t)(u.pm * 4 + u.pn) * 131072) + tid;
#pragma unroll
        for (int ai = 0; ai < 2; ++ai)
#pragma unroll
            for (int bj = 0; bj < 2; ++bj)
#pragma unroll
                for (int m = 0; m < 4; ++m) { const int slot = (ai * 2 + bj) * 4 + m; f32x4 v0 = acc[ai][bj][m][0], v1 = acc[ai][bj][m][1];
                    if (kind != 1) {
#pragma unroll
                        for (int j = 0; j < 4; ++j) { v0[j] = sigmoidf_(v0[j]); v1[j] = sigmoidf_(v1[j]); }
#ifdef DBG_S1_CONST
                        { const float cv = (float)(u.pm * 4 + u.pn + 1) * (1.0f / 512.0f); v0 = (f32x4){cv, cv, cv, cv}; v1 = v0; }
#endif
                        (kind == 0 ? s1 : s2)[slot * 512] = pack8(v0, v1);
                    } else {
                        f32x4 a0, a1; unpack8(__builtin_nontemporal_load(s1 + slot * 512), a0, a1);
#ifdef DBG_NO_S1
                        a0 = (f32x4){1.f, 1.f, 1.f, 1.f}; a1 = a0;
#endif
                        const size_t row = (size_t)u.pm * 256 + ai * 128 + wr * 64 + m * 16 + fr;
                        *(u32x4*)(merged + row * 1024 + u.pn * 256 + bj * 128 + wc * 32 + 8 * fq) = pack8(a0 * v0, a1 * v1);
#ifdef DBG_OUT_S1
                        *(u32x4*)(merged + row * 1024 + u.pn * 256 + bj * 128 + wc * 32 + 8 * fq) = pack8(a0, a1);
#endif
                    }
                    if (m & 1) asm volatile("" ::: "memory"); }
    }
};
struct EpiMerge2 {
    unsigned char* s2b; bf16_t* merged;
    __device__ __forceinline__ void operator()(const f32x4 (&acc)[2][2][4][2], const UD& u, int wr, int wc, int fr, int fq, int tid) const {
        const u32x4* s2 = (const u32x4*)(s2b + (size_t)(u.pm * 4 + u.pn) * 131072) + tid;
#pragma unroll
        for (int ai = 0; ai < 2; ++ai)
#pragma unroll
            for (int bj = 0; bj < 2; ++bj)
#pragma unroll
                for (int m = 0; m < 4; ++m) { const int slot = (ai * 2 + bj) * 4 + m;
                    const size_t row = (size_t)u.pm * 256 + ai * 128 + wr * 64 + m * 16 + fr;
                    u32x4* mp = (u32x4*)(merged + row * 1024 + u.pn * 256 + bj * 128 + wc * 32 + 8 * fq);
                    f32x4 a0, a1, b0, b1; unpack8(__builtin_nontemporal_load(mp), a0, a1); unpack8(__builtin_nontemporal_load(s2 + slot * 512), b0, b1);
#ifdef DBG_NO_S2
                    b0 = (f32x4){1.f, 1.f, 1.f, 1.f}; b1 = b0;
#endif
#ifdef DBG_NO_MRG
                    a0 = (f32x4){0.f, 0.f, 0.f, 0.f}; a1 = a0;
#endif
                    *mp = pack8(a0 + b0 * acc[ai][bj][m][0], a1 + b1 * acc[ai][bj][m][1]);
                    if (m & 1) asm volatile("" ::: "memory"); }
    }
};
struct EpiOut {
    bf16_t* xb;
    __device__ __forceinline__ void operator()(const f32x4 (&acc)[2][2][4][2], const UD& u, int wr, int wc, int fr, int fq, int tid) const {
#pragma unroll
        for (int ai = 0; ai < 2; ++ai)
#pragma unroll
            for (int m = 0; m < 4; ++m) { bf16_t* rowp = xb + ((size_t)u.pm * 256 + ai * 128 + wr * 64 + m * 16 + fr) * 1024 + u.pn * 256 + wc * 32 + 8 * fq;
#pragma unroll
                for (int bj = 0; bj < 2; ++bj) { u32x4* p = (u32x4*)(rowp + bj * 128); const u32x4 xv = *p; f32x4 v0 = acc[ai][bj][m][0], v1 = acc[ai][bj][m][1];
                    v0[0] += ALPHA * bf_lo(xv.x); v0[1] += ALPHA * bf_hi(xv.x); v0[2] += ALPHA * bf_lo(xv.y); v0[3] += ALPHA * bf_hi(xv.y);
                    v1[0] += ALPHA * bf_lo(xv.z); v1[1] += ALPHA * bf_hi(xv.z); v1[2] += ALPHA * bf_lo(xv.w); v1[3] += ALPHA * bf_hi(xv.w);
                    *p = pack8(v0, v1); } }
    }
};
struct EpiGU {
    bf16_t* he;
    __device__ __forceinline__ void operator()(const f32x4 (&acc)[2][2][4][2], const UD& u, int wr, int wc, int fr, int fq, int tid) const {
#pragma unroll
        for (int ai = 0; ai < 2; ++ai)
#pragma unroll
            for (int m = 0; m < 4; ++m) { bf16_t* rowp = he + ((size_t)u.pm * 256 + ai * 128 + wr * 64 + m * 16 + fr) * 512 + u.pn * 128 + wc * 16 + 4 * fq;
#pragma unroll
                for (int bj = 0; bj < 2; ++bj) { const f32x4 g = acc[ai][bj][m][0], up = acc[ai][bj][m][1]; f32x4 o;
#pragma unroll
                    for (int j = 0; j < 4; ++j) o[j] = g[j] * sigmoidf_(g[j]) * up[j];
                    u32x2 w; w.x = pk2(o[0], o[1]); w.y = pk2(o[2], o[3]); *(u32x2*)(rowp + bj * 64) = w; } }
    }
};
struct EpiBf16 {
    bf16_t* out; int ldc;
    __device__ __forceinline__ void operator()(const f32x4 (&acc)[2][2][4][2], const UD& u, int wr, int wc, int fr, int fq, int tid) const {
#pragma unroll
        for (int ai = 0; ai < 2; ++ai)
#pragma unroll
            for (int m = 0; m < 4; ++m) { bf16_t* rowp = out + ((size_t)u.pm * 256 + ai * 128 + wr * 64 + m * 16 + fr) * ldc + u.pn * 256 + wc * 32 + 8 * fq;
#pragma unroll
                for (int bj = 0; bj < 2; ++bj) *(u32x4*)(rowp + bj * 128) = pack8(acc[ai][bj][m][0], acc[ai][bj][m][1]); }
    }
};
struct EpiPro {
    unsigned char* wmix;
    __device__ __forceinline__ void operator()(const f32x4 (&acc)[2][2][4][2], const UD& u, int wr, int wc, int fr, int fq, int tid) const {
        const int l = u.aux >> 3, h = u.aux & 7, p = u.pn;
        bf16_t* base; int ldc; float sc;
        if (u.kind == 0) { base = (bf16_t*)(wmix + (size_t)l * WMIX_STRIDE + OFF_WIN) + (size_t)(2048 + 256 * h) * 1024 + 256 * p; ldc = 1024; sc = 0.08838834764831845f; }
        else { base = (bf16_t*)(wmix + (size_t)l * WMIX_STRIDE + OFF_WVO) + (size_t)(256 * p) * 2048 + 256 * h; ldc = 2048; sc = 1.f; }
#pragma unroll
        for (int ai = 0; ai < 2; ++ai)
#pragma unroll
            for (int m = 0; m < 4; ++m) { bf16_t* rowp = base + (size_t)(ai * 128 + wr * 64 + m * 16 + fr) * ldc + wc * 32 + 8 * fq;
#pragma unroll
                for (int bj = 0; bj < 2; ++bj) *(u32x4*)(rowp + bj * 128) = pack8(acc[ai][bj][m][0] * sc, acc[ai][bj][m][1] * sc); }
    }
};

struct SchedDense {
    const char* A; const char* B; unsigned lda, ldb; int nt, nM, nN, G, c;
    __device__ __forceinline__ bool next(int i, UD& u) const {
        int pm, pn; if (!gs::tile_of((long)i * G + c, nM, nN, pm, pn)) return false;
        u.A = A + (size_t)pm * 256 * lda; u.B = B + (size_t)pn * 256 * ldb; u.lda = lda; u.ldb = ldb; u.nt = nt; u.kind = 0; u.pm = pm; u.pn = pn; u.aux = 0; return true;
    }
};
struct SchedMerge1 {
    const char *xb, *yrnn, *wg, *wpr; int G, c;
    __device__ __forceinline__ bool next(int i_, UD& u) const { int i = i_;
#ifdef DBG_DUPFIRST
        if (i > 0) i -= 1;
#endif
#ifdef DBG_ORDER201
        const int ti = i / 3, kk_ = i - 3 * ti, k = kk_ == 0 ? 2 : kk_ - 1;
#else
        const int ti = i / 3, k = i - 3 * ti;
#endif
        int pm, pn; if (!gs::tile_of((long)ti * G + c, T / 256, 4, pm, pn)) return false;
        u.kind = k; u.pm = pm; u.pn = pn; u.aux = 0; u.lda = 2048; u.ldb = 2048; u.nt = 16;
#ifdef DBG_K0_AS_K1
        if (k == 0) { u.A = yrnn + (size_t)pm * 256 * 2048; u.B = wpr + (size_t)pn * 256 * 2048; }
#else
        if (k == 0) { u.A = xb + (size_t)pm * 256 * 2048; u.B = wg + (size_t)pn * 256 * 2048; }
#endif
        else if (k == 1) { u.A = yrnn + (size_t)pm * 256 * 2048; u.B = wpr + (size_t)pn * 256 * 2048; }
        else { u.A = xb + (size_t)pm * 256 * 2048; u.B = wg + (size_t)(1024 + pn * 256) * 2048; }
        return true;
    }
};
struct SchedMoE {
    const char* A; const char* B; unsigned lda, ldb; size_t bstride; int nt, nN, G, c; const LAS int* offp;
    __device__ __forceinline__ bool next(int i, UD& u) const {
        const int nM = offp[16] >> 8; int pm, pn; if (!gs::tile_of((long)i * G + c, nM, nN, pm, pn)) return false;
        int e = 0;
#pragma unroll 1
        for (int j = 1; j < 16; ++j) e += (pm * 256 >= offp[j]) ? 1 : 0;
        u.A = A + (size_t)pm * 256 * lda; u.B = B + (size_t)e * bstride + (size_t)pn * 256 * ldb; u.lda = lda; u.ldb = ldb; u.nt = nt; u.kind = 0; u.pm = pm; u.pn = pn; u.aux = e; return true;
    }
};
struct SchedMoEG {
    const char* A; const char* B; unsigned lda, ldb; size_t bstride; int nt, nN, G, c; const LAS int* offp; const int* rmap;
    __device__ __forceinline__ bool next(int i, UD& u) const {
        const int nM = offp[16] >> 8; int pm, pn; if (!gs::tile_of((long)i * G + c, nM, nN, pm, pn)) return false;
        int e = 0;
#pragma unroll 1
        for (int j = 1; j < 16; ++j) e += (pm * 256 >= offp[j]) ? 1 : 0;
        u.A = A; u.B = B + (size_t)e * bstride + (size_t)pn * 256 * ldb; u.lda = lda; u.ldb = ldb; u.nt = nt; u.kind = 0; u.pm = pm; u.pn = pn; u.aux = e; return true;
    }
};
struct SchedPro {
    const unsigned char* tmp; int G, c;
    __device__ __forceinline__ bool next(int i, UD& u) const {
        const long L = (long)i * G + c; if (L >= 256) return false;
        const int kind = (int)(L >> 7), l = (int)(L >> 5) & 3, h = (int)(L >> 2) & 7, p = (int)L & 3;
        u.kind = kind; u.aux = l * 8 + h; u.pm = 0; u.pn = p; u.nt = 4; u.lda = 2048; u.ldb = 2048;
        if (kind == 0) { u.A = (const char*)tmp + R_UKP + ((size_t)(l * 8 + h) * 256) * 2048;
                         u.B = (const char*)tmp + R_WQ + (size_t)l * 2 * MiB + (size_t)(256 * p) * 2048 + (size_t)(h >> 1) * 512; }
        else { u.A = (const char*)tmp + R_PT + (size_t)l * 2 * MiB + (size_t)(256 * p) * 2048 + (size_t)(h >> 1) * 512;
               u.B = (const char*)tmp + R_UVP + ((size_t)(l * 8 + h) * 256) * 2048; }
        return true;
    }
};

__device__ __forceinline__ void tr_item(const float* src, int ld, int c0, int nvalid, bf16_t* dst, int lddst, int mode, int item, int nblk, LAS float* scr, int lane) {
    const int kb = item / nblk, nb = item - kb * nblk, k0 = 64 * kb, n0 = 32 * nb;
    const int cc = 4 * (lane & 7); const bool ok = n0 + cc < nvalid;
    f32x4 tv_[8];
#pragma unroll
    for (int i = 0; i < 8; ++i) { const int kk = 8 * i + (lane >> 3); tv_[i] = ok ? *(const f32x4*)(src + (size_t)(k0 + kk) * ld + c0 + n0 + cc) : (f32x4){0.f, 0.f, 0.f, 0.f}; }
#pragma unroll
    for (int i = 0; i < 8; ++i) { const int kk = 8 * i + (lane >> 3);
#pragma unroll
        for (int j = 0; j < 4; ++j) scr[kk * 33 + cc + j] = tv_[i][j]; }
    asm volatile("s_waitcnt lgkmcnt(0)" ::: "memory");
    const int c = lane & 7;
#pragma unroll
    for (int j = 0; j < 4; ++j) { const int nl = (lane >> 3) + 8 * j; const int nn = n0 + nl; const int row = mode ? (8 * (nn >> 2) + (nn & 3)) : nn; const LAS float* s = scr + (8 * c) * 33 + nl;
        u32x4 o; o.x = pk2(s[0 * 33], s[1 * 33]); o.y = pk2(s[2 * 33], s[3 * 33]); o.z = pk2(s[4 * 33], s[5 * 33]); o.w = pk2(s[6 * 33], s[7 * 33]);
        *(u32x4*)(dst + (size_t)row * lddst + k0 + 8 * c) = o; }
    asm volatile("s_waitcnt lgkmcnt(0)" ::: "memory");
}
__device__ __forceinline__ float expm1_acc(float x) {
    if (x > -0.35f) { float p = 1.0f + x * (1.0f / 8.0f); p = 1.0f + x * (1.0f / 7.0f) * p; p = 1.0f + x * (1.0f / 6.0f) * p; p = 1.0f + x * (1.0f / 5.0f) * p; p = 1.0f + x * 0.25f * p; p = 1.0f + x * (1.0f / 3.0f) * p; p = 1.0f + x * 0.5f * p; return x * p; }
    return fast_exp(x) - 1.0f;
}
struct RnnP { const bf16_t* xrnn; bf16_t* gy; float* tot; const bf16_t *waT, *wxT; const float *convw, *convb, *ba, *bx, *lam; };
template <int PASS>
__device__ __forceinline__ void rnn_item(const RnnP& P, int item, LAS unsigned char* wlds, int lane) {
    const int b = item >> 10, g = (item >> 6) & 15, seg = item & 63, ch0 = 64 * g;
    const int row = lane & 15, kg = lane >> 4, col = lane & 15;
    LAS float* CW = (LAS float*)wlds;
    LAS float* XR = CW + 320;
#pragma unroll
    for (int k = 0; k < 4; ++k) CW[k * 64 + lane] = P.convw[k * 1024 + ch0 + lane];
    CW[256 + lane] = P.convb[ch0 + lane];
    bf16x8 Ba[4][2], Bx[4][2];
#pragma unroll
    for (int jt = 0; jt < 4; ++jt)
#pragma unroll
        for (int s = 0; s < 2; ++s) { const size_t o = ((size_t)g * 64 + 16 * jt + col) * 64 + 32 * s + 8 * kg; Ba[jt][s] = *(const bf16x8*)(P.waT + o); Bx[jt][s] = *(const bf16x8*)(P.wxT + o); }
    float cba[4], cbx[4], sp8[4], h0[4], Pc[4];
#pragma unroll
    for (int jt = 0; jt < 4; ++jt) { const int ch = ch0 + 16 * jt + col; cba[jt] = -1.4426950408889634f * P.ba[ch]; cbx[jt] = -1.4426950408889634f * P.bx[ch]; const float lm = P.lam[ch]; sp8[jt] = -8.0f * 1.4426950408889634f * log1pf(expf(-lm));   h0[jt] = 0.f; Pc[jt] = 1.f; }
    float* totp = P.tot + ((size_t)(b * 64) * 1024 + ch0 + col) * 2;
    if (PASS == 2 && seg > 0) {
        const int Q = (seg + 3) >> 2, slo = kg * Q;
        float Pq[4] = {1.f, 1.f, 1.f, 1.f}, Hq[4] = {0.f, 0.f, 0.f, 0.f};
        for (int i0 = 0; i0 < Q; i0 += 4) {
            f32x2 ph[4][4];
#pragma unroll
            for (int i = 0; i < 4; ++i) { int s2 = slo + i0 + i; s2 = s2 < seg ? s2 : seg - 1;
#pragma unroll
                for (int jt = 0; jt < 4; ++jt) ph[i][jt] = *(const f32x2*)(totp + ((size_t)s2 * 1024 + 16 * jt) * 2); }
#pragma unroll
            for (int i = 0; i < 4; ++i) { const bool ok = (i0 + i < Q) && (slo + i0 + i < seg);
#pragma unroll
                for (int jt = 0; jt < 4; ++jt) { const float px = ok ? ph[i][jt].x : 1.f, hy = ok ? ph[i][jt].y : 0.f; Hq[jt] = px * Hq[jt] + hy; Pq[jt] = Pq[jt] * px; } }
        }
#pragma unroll
        for (int jt = 0; jt < 4; ++jt) {
            const float H0 = __shfl(Hq[jt], col), P1 = __shfl(Pq[jt], col + 16), H1 = __shfl(Hq[jt], col + 16), P2 = __shfl(Pq[jt], col + 32), H2 = __shfl(Hq[jt], col + 32),
                        P3 = __shfl(Pq[jt], col + 48), H3 = __shfl(Hq[jt], col + 48);
            float h = H0; h = P1 * h + H1; h = P2 * h + H2; h = P3 * h + H3; h0[jt] = h; }
    }
    asm volatile("s_waitcnt lgkmcnt(0)" ::: "memory");
    const size_t rowb = (size_t)b * SEQ;
    u32x4 xn[4][2];
    { const int tA0 = seg * 256 + row;
#pragma unroll
      for (int dt = 0; dt < 4; ++dt) { const int tt = tA0 - 3 + dt;
#pragma unroll
          for (int s = 0; s < 2; ++s) xn[dt][s] = (tt >= 0) ? *(const u32x4*)(P.xrnn + (rowb + tt) * 1024 + ch0 + 32 * s + 8 * kg) : (u32x4){0u, 0u, 0u, 0u}; } }
    for (int tile = 0; tile < 16; ++tile) {
        const int t0 = seg * 256 + tile * 16;
        u32x4 xw[4][2];
#pragma unroll
        for (int dt = 0; dt < 4; ++dt)
#pragma unroll
            for (int s = 0; s < 2; ++s) xw[dt][s] = xn[dt][s];
        if (tile + 1 < 16) { const int tB = t0 + 16 + row;
#pragma unroll
            for (int dt = 0; dt < 4; ++dt) { const int tt = tB - 3 + dt;
#pragma unroll
                for (int s = 0; s < 2; ++s) xn[dt][s] = *(const u32x4*)(P.xrnn + (rowb + tt) * 1024 + ch0 + 32 * s + 8 * kg); } }
        bf16_t gq[4][4];
        if (PASS == 2) { const bf16_t* gp0 = P.gy + (rowb + t0 + 4 * kg) * 1024 + ch0 + col;
#pragma unroll
            for (int jt = 0; jt < 4; ++jt)
#pragma unroll
                for (int r = 0; r < 4; ++r) gq[jt][r] = gp0[(size_t)r * 1024 + 16 * jt]; }
        bf16x8 Af[2];
#pragma unroll
        for (int s = 0; s < 2; ++s) {
            const int cl = 32 * s + 8 * kg;
            f32x4 o0 = *(LAS f32x4*)(CW + 256 + cl), o1 = *(LAS f32x4*)(CW + 256 + cl + 4);
#pragma unroll
            for (int dt = 0; dt < 4; ++dt) { const f32x4 w0 = *(LAS f32x4*)(CW + dt * 64 + cl), w1 = *(LAS f32x4*)(CW + dt * 64 + cl + 4); const u32x4 x = xw[dt][s];
                o0[0] += w0[0] * bf_lo(x.x); o0[1] += w0[1] * bf_hi(x.x); o0[2] += w0[2] * bf_lo(x.y); o0[3] += w0[3] * bf_hi(x.y);
                o1[0] += w1[0] * bf_lo(x.z); o1[1] += w1[1] * bf_hi(x.z); o1[2] += w1[2] * bf_lo(x.w); o1[3] += w1[3] * bf_hi(x.w); }
            *(LAS f32x4*)(XR + row * 68 + cl) = o0; *(LAS f32x4*)(XR + row * 68 + cl + 4) = o1;
            const u32x4 pk = pack8(o0, o1); Af[s] = __builtin_bit_cast(bf16x8, pk);
        }
        f32x4 ar[4], ax[4];
#pragma unroll
        for (int jt = 0; jt < 4; ++jt) { ar[jt] = (f32x4){0.f, 0.f, 0.f, 0.f}; ax[jt] = ar[jt];
#pragma unroll
            for (int s = 0; s < 2; ++s) { ar[jt] = __builtin_amdgcn_mfma_f32_16x16x32_bf16(Af[s], Ba[jt][s], ar[jt], 0, 0, 0); ax[jt] = __builtin_amdgcn_mfma_f32_16x16x32_bf16(Af[s], Bx[jt][s], ax[jt], 0, 0, 0); } }
        asm volatile("s_waitcnt lgkmcnt(0)" ::: "memory");
#pragma unroll
        for (int jt = 0; jt < 4; ++jt) {
            float Pp[4], Hp[4]; float pr = 1.f, hr = 0.f;
#pragma unroll
            for (int r = 0; r < 4; ++r) {
                const float xr = XR[(4 * kg + r) * 68 + 16 * jt + col];
                const float rg = fast_rcp(1.0f + __builtin_amdgcn_exp2f(__builtin_fmaf(ar[jt][r], -1.4426950408889634f, cba[jt]))), ig = fast_rcp(1.0f + __builtin_amdgcn_exp2f(__builtin_fmaf(ax[jt][r], -1.4426950408889634f, cbx[jt])));
                const float a = __builtin_amdgcn_exp2f(sp8[jt] * rg); const float em = a - 1.0f;
                const float mm = __builtin_amdgcn_sqrtf(fmaxf(-em * (2.0f + em), 0.f));
                const float uu = mm * ig * xr;
                hr = a * hr + uu; pr = pr * a; Pp[r] = pr; Hp[r] = hr;
            }
            const float P0 = __shfl(pr, col), P1 = __shfl(pr, col + 16), P2 = __shfl(pr, col + 32), P3 = __shfl(pr, col + 48);
            const float H0 = __shfl(hr, col), H1 = __shfl(hr, col + 16), H2 = __shfl(hr, col + 32), H3 = __shfl(hr, col + 48);
            const float h1 = P0 * h0[jt] + H0, h2 = P1 * h1 + H1, h3 = P2 * h2 + H2, h4 = P3 * h3 + H3;
            if (PASS == 2) {
                const float hs = kg == 0 ? h0[jt] : (kg == 1 ? h1 : (kg == 2 ? h2 : h3));
                bf16_t* gp = P.gy + (rowb + t0 + 4 * kg) * 1024 + ch0 + 16 * jt + col;
#pragma unroll
                for (int r = 0; r < 4; ++r) { const float hv = Pp[r] * hs + Hp[r]; const float gg = bf2f(gq[jt][r]); gp[(size_t)r * 1024] = (bf16_t)pk2(hv * gg, 0.f); }
            } else Pc[jt] = Pc[jt] * (P0 * P1) * (P2 * P3);
            h0[jt] = h4;
        }
    }
    if (PASS == 1 && kg == 0) {
#pragma unroll
        for (int jt = 0; jt < 4; ++jt) *(f32x2*)(totp + ((size_t)seg * 1024 + 16 * jt) * 2) = (f32x2){Pc[jt], h0[jt]};
    }
}
__device__ __forceinline__ void ckv_norm_rows4(bf16_t* base, int row0, int rstep, int nrows, const float* gain, int lane) {
    u32x2 w[4];
#pragma unroll
    for (int i = 0; i < 4; ++i) { const int r = row0 + i * rstep; w[i] = *(const u32x2*)(base + (size_t)(r < nrows ? r : row0) * 256 + 4 * lane); }
    const f32x4 gn = *(const f32x4*)(gain + 4 * lane);
#pragma unroll
    for (int i = 0; i < 4; ++i) { const int r = row0 + i * rstep;
        const float v0 = bf_lo(w[i].x), v1 = bf_hi(w[i].x), v2 = bf_lo(w[i].y), v3 = bf_hi(w[i].y);
        const float ss = wave_sum(v0 * v0 + v1 * v1 + v2 * v2 + v3 * v3);
        const float rs = 1.0f / __builtin_sqrtf(ss * (1.0f / 256.0f) + RMS_EPS);
        u32x2 o; o.x = pk2(v0 * rs * gn[0], v1 * rs * gn[1]); o.y = pk2(v2 * rs * gn[2], v3 * rs * gn[3]);
        if (r < nrows) *(u32x2*)(base + (size_t)r * 256 + 4 * lane) = o; }
}
constexpr int AT_CAND = 0, AT_KBUF = 65536, AT_KROW = 144, AT_KCH = 256 * AT_KROW, AT_SEL = 139264, AT_BIAS = 155648, AT_BKT = 156672, AT_GROW = 544, AT_GBUF = 32 * AT_GROW;
constexpr int AT_NBIN = 512, AT_CAP = 256, AT_LCAP = 1024, AT_TIEF = 157184, AT_BIAS2 = 157440;
#ifndef AT_SAMPLE_MIN_U
#define AT_SAMPLE_MIN_U 64
#endif
#ifndef AT_LBREF
#define AT_LBREF 0
#endif
struct AttnP { const bf16_t *qidx, *kidx, *ckv; const float* widx; bf16_t* qlat; unsigned long long* cbuf; };

__device__ __forceinline__ unsigned ord_key(float s) { const unsigned b = __builtin_bit_cast(unsigned, s); return (b & 0x80000000u) ? ~b : (b | 0x80000000u); }

__device__ __forceinline__ void hist_scan(const LAS unsigned* hq, int lane, int kth, int& bsel, int& cat, int& abat) {
    const u32x4 w0 = *(const LAS u32x4*)(hq + 8 * lane), w1 = *(const LAS u32x4*)(hq + 8 * lane + 4);
    int cnt[8];
    cnt[0] = (int)w0.x; cnt[1] = (int)w0.y; cnt[2] = (int)w0.z; cnt[3] = (int)w0.w; cnt[4] = (int)w1.x; cnt[5] = (int)w1.y; cnt[6] = (int)w1.z; cnt[7] = (int)w1.w;
    int s = 0;
#pragma unroll
    for (int i = 0; i < 8; ++i) s += cnt[i];
    int S = s;
    S += __builtin_amdgcn_update_dpp(0, S, 0x101, 0xf, 0xf, true); S += __builtin_amdgcn_update_dpp(0, S, 0x102, 0xf, 0xf, true);
    S += __builtin_amdgcn_update_dpp(0, S, 0x104, 0xf, 0xf, true); S += __builtin_amdgcn_update_dpp(0, S, 0x108, 0xf, 0xf, true);
    { const int t1 = __builtin_amdgcn_readlane(S, 16), t2 = __builtin_amdgcn_readlane(S, 32), t3 = __builtin_amdgcn_readlane(S, 48); const int row = lane >> 4;
      S += row == 0 ? (t1 + t2 + t3) : (row == 1 ? (t2 + t3) : (row == 2 ? t3 : 0)); }
    bsel = -1; cat = 0; abat = 0;
    const unsigned long long mk = __ballot(S >= kth);
    if (mk != 0ull) {
        const int Ls = 63 - __builtin_clzll(mk);
        int above = S - s; bool found = false;
#pragma unroll
        for (int bb = 7; bb >= 0; --bb) { const int c = cnt[bb]; if (!found && above + c >= kth) { bsel = 8 * lane + bb; cat = c; abat = above; found = true; } above += c; }
        bsel = __builtin_amdgcn_readlane(bsel, Ls); cat = __builtin_amdgcn_readlane(cat, Ls); abat = __builtin_amdgcn_readlane(abat, Ls);
    }
}
__device__ __forceinline__ int key_row(int r, bool sm, int u) { if (sm) { r = r * 8 + (u & 7); r = r < SEQ ? r : SEQ - 1; } return r; }
template <int MODE>
__device__ __forceinline__ void attn_pass(LAS unsigned char* lds, const bf16x8 (&afr)[4], const float (&wq)[2][9], const bf16_t* kbase, int u, int wave, int lane, int tid,
                                          const int (&b0e)[2], const int (&neede)[2], const int (&tiee)[2], int (&csel)[2], int (&ccand)[2], unsigned long long* cbw, int samp = 0) {
    const int hh = lane >> 5, kcol = lane & 31;
    LAS unsigned* HIST = (LAS unsigned*)lds; LAS unsigned long long* CAND = (LAS unsigned long long*)(lds + AT_CAND); LAS unsigned short* SEL = (LAS unsigned short*)(lds + AT_SEL);
    const bool sm = (MODE == 0) && (samp != 0);
    const int nst = u >> 3, nch = sm ? ((nst + 7) >> 3) : (u >> 3) + 1;
    float lbt[2];
#pragma unroll
    for (int e = 0; e < 2; ++e) lbt[e] = ((MODE == 1 || MODE == 3) && b0e[e] >= 1) ? (float)b0e[e] : -3.0e38f;
    u32x4 st[4];
    const int lofs = (tid >> 3) * AT_KROW + (tid & 7) * 16;
#define AT_KADDR(C, I) (kbase + (size_t)key_row((C) * 256 + (tid >> 3) + 64 * (I), sm, u) * 64 + (tid & 7) * 8)
#pragma unroll
    for (int i = 0; i < 4; ++i) st[i] = *(const u32x4*)AT_KADDR(0, i);
#pragma unroll
    for (int i = 0; i < 4; ++i) *(LAS u32x4*)(lds + AT_KBUF + lofs + i * 64 * AT_KROW) = st[i];
    __syncthreads();
    for (int c = 0; c < nch; ++c) {
        if (c + 1 < nch) {
#pragma unroll
            for (int i = 0; i < 4; ++i) st[i] = *(const u32x4*)AT_KADDR(c + 1, i);
        }
        const LAS unsigned char* kb = lds + AT_KBUF + (c & 1) * AT_KCH + kcol * AT_KROW + hh * 16;
        const int ntile = sm ? ((nst - 8 * c) < 8 ? (nst - 8 * c) : 8) : ((c + 1 < nch) ? 8 : (u & 7) + 1);
#define AT_READ(BF, TT) do { _Pragma("unroll") for (int ks = 0; ks < 4; ++ks) BF[ks] = *(const LAS bf16x8*)(kb + (TT) * 32 * AT_KROW + ks * 32); } while (0)
#define AT_MFMA(ACC, BF) do { _Pragma("unroll") for (int i_ = 0; i_ < 16; ++i_) ACC[i_] = 0.f; \
            _Pragma("unroll") for (int ks = 0; ks < 4; ++ks) ACC = __builtin_amdgcn_mfma_f32_32x32x16_bf16(afr[ks], BF[ks], ACC, 0, 0, 0); } while (0)
          \

#define AT_POST(ACC, KT, DIAG) do { const int kt = (KT); \
            float sc[2]; \
            _Pragma("unroll") for (int e = 0; e < 2; ++e) { float s = 0.f; \
                _Pragma("unroll") for (int i = 0; i < 8; ++i) s = __builtin_fmaf(wq[e][i], __builtin_amdgcn_fmed3f(ACC[8 * e + i], 0.f, 3.0e38f), s); \
                sc[e] = s; } \
            _Pragma("unroll") for (int e = 0; e < 2; ++e) { \
                const int q = 4 * wave + 2 * hh + e; \
                const float tv = __builtin_fmaf(sc[e], wq[e][8], 256.0f); \
                const bool cz = !(DIAG) || (kt < u) || (kcol <= q); \
                const bool live = cz && tv >= lbt[e]; \
                if (MODE == 3) { \
                    const unsigned long long m3 = __ballot(live); \
                    { \
                        const unsigned h3 = hh ? (unsigned)(m3 >> 32) : (unsigned)m3; \
                        const int pa = ccand[e] + __builtin_popcount(h3 & ((1u << kcol) - 1u)); \
                        if (live) { u32x2 ent;      \
                             ent.x = (unsigned)(kt * 32 + kcol); ent.y = __builtin_bit_cast(unsigned, sc[e]); \
                            *(u32x2*)((char*)cbw + ((unsigned)((2 * hh + e) * AT_LCAP + pa) * 8u)) = ent; } \
                        ccand[e] += __builtin_popcount(h3); \
                    } \
                } else if (MODE == 0) { \
                    const int bin = (int)__builtin_amdgcn_fmed3f(tv, 0.0f, 511.5f); \
                    LAS unsigned* hp = HIST + q * AT_NBIN + bin; \
                    if (cz) __hip_atomic_fetch_add(hp, 1u, __ATOMIC_RELAXED, __HIP_MEMORY_SCOPE_WORKGROUP); \
                } else if (__ballot(live) != 0ull) { \
                    const int bin = (int)__builtin_amdgcn_fmed3f(tv, 0.0f, 511.5f); \
                    const int key = kt * 32 + kcol; \
                    const bool cc = live && bin == b0e[e]; \
                    const unsigned long long m2 = __ballot(cc); const unsigned h2 = hh ? (unsigned)(m2 >> 32) : (unsigned)m2; \
                    const int pc = ccand[e] + __builtin_popcount(h2 & ((1u << kcol) - 1u)); \
                    if (cc && !tiee[e] && pc < AT_CAP) CAND[q * AT_CAP + pc] = ((unsigned long long)ord_key(sc[e]) << 32) | (unsigned)(0xFFFFu - key); \
                    ccand[e] += __builtin_popcount(h2); \
                    const bool cs = live && (bin > b0e[e] || (tiee[e] && cc && pc < neede[e])); \
                    const unsigned long long m1 = __ballot(cs); const unsigned h1 = hh ? (unsigned)(m1 >> 32) : (unsigned)m1; \
                    if (cs) SEL[q * 256 + csel[e] + __builtin_popcount(h1 & ((1u << kcol) - 1u))] = (unsigned short)key; \
                    csel[e] += __builtin_popcount(h1); \
                } \
            } } while (0)
#define AT_TILES(NT, DIAG, PRAG) do { \
        AT_READ(B0, 0); if ((NT) > 1) AT_READ(B1, 1); \
        AT_MFMA(accA, B0); \
        PRAG for (int tt = 0; tt < (NT); tt += 2) { \
            if (tt + 2 < (NT)) AT_READ(B0, tt + 2); \
            if (tt + 1 < (NT)) AT_MFMA(accB, B1); \
            AT_POST(accA, c * 8 + tt, DIAG); \
            if (tt + 1 < (NT)) { \
                if (tt + 3 < (NT)) AT_READ(B1, tt + 3); \
                if (tt + 2 < (NT)) AT_MFMA(accA, B0); \
                AT_POST(accB, c * 8 + tt + 1, DIAG); \
            } \
        } } while (0)
        f32x16 accA, accB; bf16x8 B0[4], B1[4];
        if (sm ? (ntile == 8) : (c + 1 < nch)) AT_TILES(8, false, _Pragma("unroll"));
        else AT_TILES(ntile, true, _Pragma("unroll 1"));
#undef AT_TILES
#undef AT_POST
#undef AT_KADDR
#undef AT_READ
#undef AT_MFMA
        if (MODE == 0 && AT_LBREF && c + 1 < nch && (c < 4 || (c & 3) == 3)) {
#pragma unroll
            for (int q = 0; q < 4; ++q) { int bs, c1, c2; hist_scan(HIST + (4 * wave + q) * AT_NBIN, lane, 256, bs, c1, c2);
                const float lb = bs >= 1 ? (float)bs : -3.0e38f;
                if ((q >> 1) == hh) lbt[q & 1] = lb; }
        }
        if (c + 1 < nch) {
#pragma unroll
            for (int i = 0; i < 4; ++i) *(LAS u32x4*)(lds + AT_KBUF + ((c + 1) & 1) * AT_KCH + lofs + i * 64 * AT_KROW) = st[i];
        }
        __syncthreads();
    }
}

__device__ __forceinline__ void attn_unit(LAS unsigned char* lds, const AttnP& P, int b, int u, int tid_) {
    int tid = tid_; asm volatile("" : "+v"(tid));
    const int wave = __builtin_amdgcn_readfirstlane(tid >> 6), lane = tid & 63, hh = lane >> 5, kcol = lane & 31;
    LAS unsigned* HIST = (LAS unsigned*)lds; LAS unsigned long long* CAND = (LAS unsigned long long*)(lds + AT_CAND); LAS unsigned short* SEL = (LAS unsigned short*)(lds + AT_SEL);
    const LAS float* BIAS2 = (const LAS float*)(lds + AT_BIAS2);
    const int t0 = 32 * u; const size_t rowb = (size_t)b * SEQ;
    __syncthreads();
#pragma unroll
    for (int i = 0; i < 8; ++i) *(LAS u32x4*)(lds + (i * 512 + tid) * 16) = (u32x4){0u, 0u, 0u, 0u};
    if (tid == 0) *(LAS unsigned*)(lds + AT_TIEF) = 0u;
    bf16x8 afr[4]; float wq[2][9];
    { const int rho = kcol, j = rho >> 3, r = rho & 3, hq = (rho >> 2) & 1, head = 4 * (j & 1) + r, qloc = 2 * hq + (j >> 1);
      const bf16_t* qp = P.qidx + (rowb + t0 + 4 * wave + qloc) * 512 + head * 64 + 8 * hh;
#pragma unroll
      for (int ks = 0; ks < 4; ++ks) afr[ks] = *(const bf16x8*)(qp + ks * 16);
#pragma unroll
      for (int e = 0; e < 2; ++e) { const float* wp = P.widx + (rowb + t0 + 4 * wave + 2 * hh + e) * 8; const f32x4 a = *(const f32x4*)wp, c = *(const f32x4*)(wp + 4);
          wq[e][0] = a[0]; wq[e][1] = a[1]; wq[e][2] = a[2]; wq[e][3] = a[3]; wq[e][4] = c[0]; wq[e][5] = c[1]; wq[e][6] = c[2]; wq[e][7] = c[3];
          const float ss = (a[0] * a[0] + a[1] * a[1]) + (a[2] * a[2] + a[3] * a[3]) + (c[0] * c[0] + c[1] * c[1]) + (c[2] * c[2] + c[3] * c[3]);
          wq[e][8] = 32.0f / __builtin_sqrtf(fmaxf(ss, 1.0e-12f)); } }
    const bf16_t* kbase = P.kidx + rowb * 64;
    int b0e[2] = {0, 0}, neede[2] = {0, 0}, tiee[2] = {0, 0}, csel[2] = {0, 0}, ccand[2] = {0, 0};
    int b0q[4], needq[4], nb0q[4], csq[4];
    unsigned long long* cbw = P.cbuf + (size_t)(4 * wave) * AT_LCAP;
#pragma unroll 1
    for (int att = (u >= AT_SAMPLE_MIN_U) ? 0 : 1; att < 2; ++att) {
        int tl = tid; asm volatile("" : "+v"(tl));
        const int ll = tl & 63, hl = ll >> 5;
        if (att == 1 && u >= AT_SAMPLE_MIN_U) {
            __syncthreads();
#pragma unroll
            for (int i = 0; i < 8; ++i) *(LAS u32x4*)(lds + (i * 512 + tl) * 16) = (u32x4){0u, 0u, 0u, 0u};
            if (tl == 0) *(LAS unsigned*)(lds + AT_TIEF) = 0u;
        }
        csel[0] = 0; csel[1] = 0; ccand[0] = 0; ccand[1] = 0;
        attn_pass<0>(lds, afr, wq, kbase, u, wave, ll, tl, b0e, neede, tiee, csel, ccand, nullptr, att == 0 ? 1 : 0);
        const int kth = att == 0 ? 64 : 256;
#pragma unroll
        for (int q = 0; q < 4; ++q) {
            const int nq = t0 + 4 * wave + q + 1;
            int bsel, cat, abat; hist_scan(HIST + (4 * wave + q) * AT_NBIN, ll, kth, bsel, cat, abat);
            if (att == 1 && nq <= 256) { bsel = -1; cat = 0; abat = 0; }
            b0q[q] = bsel; nb0q[q] = cat; needq[q] = (nq > 256) ? (256 - abat) : 0;
        }
        b0e[0] = hl ? b0q[2] : b0q[0]; b0e[1] = hl ? b0q[3] : b0q[1];
        neede[0] = hl ? needq[2] : needq[0]; neede[1] = hl ? needq[3] : needq[1];
        tiee[0] = (att == 1) && ((hl ? nb0q[2] : nb0q[0]) > AT_CAP); tiee[1] = (att == 1) && ((hl ? nb0q[3] : nb0q[1]) > AT_CAP);
        if ((tiee[0] | tiee[1]) != 0) *(LAS unsigned*)(lds + AT_TIEF) = 1u;
        __syncthreads();
        if (att == 1 && *(const LAS unsigned*)(lds + AT_TIEF) != 0u) {
            attn_pass<1>(lds, afr, wq, kbase, u, wave, ll, tl, b0e, neede, tiee, csel, ccand, cbw);
#pragma unroll
            for (int q = 0; q < 4; ++q) { const int cv = (q & 1) ? csel[1] : csel[0]; csq[q] = __builtin_amdgcn_readlane(cv, (q >> 1) * 32); }
            break;
        }
        if (att == 0) {
#pragma unroll
            for (int i = 0; i < 8; ++i) *(LAS u32x4*)(lds + wave * 8192 + (i * 64 + ll) * 16) = (u32x4){0u, 0u, 0u, 0u};
        }
        attn_pass<3>(lds, afr, wq, kbase, u, wave, ll, tl, b0e, neede, tiee, csel, ccand, cbw);
        asm volatile("s_waitcnt vmcnt(0)" ::: "memory");
        if (att == 0) {
            bool ok = true;
#pragma unroll
            for (int q = 0; q < 4; ++q) {
                const int cv = (q & 1) ? ccand[1] : ccand[0]; const int nraw = __builtin_amdgcn_readlane(cv, (q >> 1) * 32); ok = ok && nraw >= 256 && nraw <= AT_LCAP;
                const int n = nraw > AT_LCAP ? AT_LCAP : nraw;
                const float scl = (q & 2) ? __shfl(wq[q & 1][8], 32) : __shfl(wq[q & 1][8], 0);
                unsigned long long ent[AT_LCAP / 64];
#pragma unroll
                for (int j = 0; j < AT_LCAP / 64; ++j) { const int i = 64 * j + ll; ent[j] = (i < n) ? __builtin_nontemporal_load(cbw + q * AT_LCAP + i) : 0ull; }
#pragma unroll
                for (int j = 0; j < AT_LCAP / 64; ++j) { const int i = 64 * j + ll; const float scv = __builtin_bit_cast(float, (unsigned)(ent[j] >> 32));
                    const int bin = (int)__builtin_amdgcn_fmed3f(__builtin_fmaf(scv, scl, 256.0f), 0.0f, 511.5f);
                    if (i < n) __hip_atomic_fetch_add(HIST + (4 * wave + q) * AT_NBIN + bin, 1u, __ATOMIC_RELAXED, __HIP_MEMORY_SCOPE_WORKGROUP); }
                asm volatile("s_waitcnt lgkmcnt(0)" ::: "memory");
                int bsel, cat, abat; hist_scan(HIST + (4 * wave + q) * AT_NBIN, ll, 256, bsel, cat, abat);
                ok = ok && bsel >= 0;
                b0q[q] = bsel; nb0q[q] = cat; needq[q] = 256 - abat;
                const int b0 = bsel, need = 256 - abat; const bool tieq = cat > AT_CAP;
                int cs = 0, cc = 0;
#pragma unroll
                for (int j = 0; j < AT_LCAP / 64; ++j) {
                    if (64 * j < n) {
                        const unsigned long long v = ent[j]; const bool in = 64 * j + ll < n;
                        const float scv = __builtin_bit_cast(float, (unsigned)(v >> 32));
                        const int bin = (int)__builtin_amdgcn_fmed3f(__builtin_fmaf(scv, scl, 256.0f), 0.0f, 511.5f);
                        const bool isc = in && bin == b0;
                        const unsigned long long mc = __ballot(isc);
                        const int pc = cc + __builtin_popcountll(mc & ((1ull << ll) - 1ull));
                        const bool isa = in && (bin > b0 || (tieq && isc && pc < need));
                        const unsigned long long ms = __ballot(isa);
                        const int ps = cs + __builtin_popcountll(ms & ((1ull << ll) - 1ull));
                        if (isa && ps < 256) SEL[(4 * wave + q) * 256 + ps] = (unsigned short)(v & 0xFFFFu);
                        if (isc && !tieq && pc < AT_CAP) CAND[(4 * wave + q) * AT_CAP + pc] = ((unsigned long long)ord_key(scv) << 32) | (unsigned)(0xFFFFu - (unsigned)(v & 0xFFFFu));
                        cs += __builtin_popcountll(ms); cc += __builtin_popcountll(mc);
                    }
                }
                csq[q] = cs;
                asm volatile("" ::: "memory");
            }
            if (!ok) *(LAS unsigned*)(lds + AT_TIEF) = 1u;
            __syncthreads();
            if (*(const LAS unsigned*)(lds + AT_TIEF) != 0u) continue;
            break;
        }
#pragma unroll
        for (int q = 0; q < 4; ++q) {
            const int cv = (q & 1) ? ccand[1] : ccand[0]; int n = __builtin_amdgcn_readlane(cv, (q >> 1) * 32); n = n > AT_LCAP ? AT_LCAP : n;
            const int b0 = b0q[q], need = needq[q]; const bool tieq = nb0q[q] > AT_CAP;
            const float scl = (q & 2) ? __shfl(wq[q & 1][8], 32) : __shfl(wq[q & 1][8], 0);
            int cs = 0, cc = 0;
#pragma unroll
            for (int jb = 0; jb < AT_LCAP / 256; ++jb) {
                if (256 * jb < n) {
                    unsigned long long ent[4];
#pragma unroll
                    for (int j = 0; j < 4; ++j) { const int i = 256 * jb + 64 * j + ll; ent[j] = (i < n) ? __builtin_nontemporal_load(cbw + q * AT_LCAP + i) : 0ull; }
#pragma unroll
                    for (int j = 0; j < 4; ++j) {
                        const unsigned long long v = ent[j]; const bool in = 256 * jb + 64 * j + ll < n;
                        const float scv = __builtin_bit_cast(float, (unsigned)(v >> 32));
                        const int bin = (int)__builtin_amdgcn_fmed3f(__builtin_fmaf(scv, scl, 256.0f), 0.0f, 511.5f);
                        const bool isc = in && bin == b0;
                        const unsigned long long mc = __ballot(isc);
                        const int pc = cc + __builtin_popcountll(mc & ((1ull << ll) - 1ull));
                        const bool isa = in && (bin > b0 || (tieq && isc && pc < need));
                        const unsigned long long ms = __ballot(isa);
                        if (isa) SEL[(4 * wave + q) * 256 + cs + __builtin_popcountll(ms & ((1ull << ll) - 1ull))] = (unsigned short)(v & 0xFFFFu);
                        if (isc && !tieq && pc < AT_CAP) CAND[(4 * wave + q) * AT_CAP + pc] = ((unsigned long long)ord_key(scv) << 32) | (unsigned)(0xFFFFu - (unsigned)(v & 0xFFFFu));
                        cs += __builtin_popcountll(ms); cc += __builtin_popcountll(mc);
                    }
                }
            }
            csq[q] = cs;
            asm volatile("" ::: "memory");
        }
        break;
    }
    int nselq[4];
#pragma unroll
    for (int q = 0; q < 4; ++q) {
        int cs = csq[q];
        const int need = needq[q], nb0 = nb0q[q];
        if (need > 0 && nb0 <= AT_CAP) {
            const int nc = nb0;
            const LAS unsigned long long* cq = CAND + (4 * wave + q) * AT_CAP;
            for (int i0 = 0; i0 < nc; i0 += 64) {
                const int i = i0 + lane; const unsigned long long mine = (i < nc) ? cq[i] : 0ull;
                int rank = 0; for (int j = 0; j < nc; ++j) rank += (cq[j] > mine) ? 1 : 0;
                const bool pick = (i < nc) && rank < need;
                const unsigned long long mk = __ballot(pick);
                if (pick) SEL[(4 * wave + q) * 256 + cs + __builtin_popcountll(mk & ((1ull << lane) - 1ull))] = (unsigned short)(0xFFFFu - (unsigned)(mine & 0xFFFFu));
                cs += __builtin_popcountll(mk);
            }
        }
        nselq[q] = cs;
    }
    asm volatile("s_waitcnt lgkmcnt(0)" ::: "memory");
#ifdef DBG_TIME_ATT
    if (tid == 0) { const unsigned tn_ = (unsigned)__builtin_amdgcn_s_memrealtime(); ((LAS unsigned*)(lds + LDS_MISC))[19] += tn_ - tk0; tk0 = tn_; }
#endif
    __syncthreads();
    LAS unsigned char* gb = lds + wave * AT_GBUF;
    const int n = lane & 15, kg = lane >> 4, head = n & 7;
#pragma unroll 1
    for (int qi = 0; qi < 4; ++qi) {
        const int q = 4 * wave + qi, t = t0 + q;
        const int nsel = qi == 0 ? nselq[0] : (qi == 1 ? nselq[1] : (qi == 2 ? nselq[2] : nselq[3]));
        const LAS unsigned short* sel = SEL + q * 256;
        bf16_t* qrow = P.qlat + (rowb + t) * 2048;
        bf16x8 qb[8];
#pragma unroll
        for (int ks = 0; ks < 8; ++ks) { qb[ks] = (bf16x8){0, 0, 0, 0, 0, 0, 0, 0}; if (n < 8) qb[ks] = *(const bf16x8*)(qrow + n * 256 + 32 * ks + 8 * kg); }
        f32x4 oacc[16];
#pragma unroll
        for (int mt = 0; mt < 16; ++mt) oacc[mt] = (f32x4){0.f, 0.f, 0.f, 0.f};
        float mrun = -1e30f, lrun = 0.f;
        const int nchunk = (nsel + 31) >> 5;
#pragma unroll 1
        for (int c = 0; c < nchunk; ++c) {
            { u32x4 pre[16];
              const int rw = lane >> 4, li = lane & 15; const int jb = 32 * c + 2 * li + (rw >> 1);
              const int bv = (int)((((unsigned)rowb + (unsigned)((jb < nsel) ? (int)sel[jb] : 0)) * 512u) + (unsigned)(rw & 1) * 256u);
#define AT_GREQ(I) pre[I] = *(const u32x4*)((const char*)P.ckv + ((unsigned)__builtin_amdgcn_update_dpp(0, bv, 0x150 + (I), 0xf, 0xf, true) + (unsigned)li * 16u));
              AT_GREQ(0) AT_GREQ(1) AT_GREQ(2) AT_GREQ(3) AT_GREQ(4) AT_GREQ(5) AT_GREQ(6) AT_GREQ(7) AT_GREQ(8) AT_GREQ(9) AT_GREQ(10) AT_GREQ(11) AT_GREQ(12) AT_GREQ(13) AT_GREQ(14) AT_GREQ(15)
#undef AT_GREQ
#pragma unroll
              for (int i = 0; i < 16; ++i) *(LAS u32x4*)(gb + (2 * i + (rw >> 1)) * AT_GROW + (rw & 1) * 256 + li * 16) = pre[i];
            }
            f32x4 st[2];
#pragma unroll
            for (int k2 = 0; k2 < 2; ++k2) { st[k2] = (f32x4){0.f, 0.f, 0.f, 0.f};
#pragma unroll
                for (int ks = 0; ks < 8; ++ks) { const bf16x8 a = *(const LAS bf16x8*)(gb + (16 * k2 + n) * AT_GROW + (32 * ks + 8 * kg) * 2); st[k2] = __builtin_amdgcn_mfma_f32_16x16x32_bf16(a, qb[ks], st[k2], 0, 0, 0); } }
            float mloc = -1e30f;
#pragma unroll
            for (int k2 = 0; k2 < 2; ++k2)
#pragma unroll
                for (int r = 0; r < 4; ++r) { const int jj = 16 * k2 + 4 * kg + r; const int idx = (32 * c + jj < nsel) ? (int)sel[32 * c + jj] : 0; int d = t - idx; d = d < 127 ? d : 127;
                    float lg = st[k2][r] + BIAS2[d * 8 + head]; if (32 * c + jj >= nsel) lg = -1e30f;
                    st[k2][r] = lg; mloc = fmaxf(mloc, lg); }
            if (c == 0) { mloc = fmaxf(mloc, __shfl_xor(mloc, 16)); mloc = fmaxf(mloc, __shfl_xor(mloc, 32)); mrun = mloc; }
            else if (__ballot(mloc > mrun + 60.0f) != 0ull) {
                mloc = fmaxf(mloc, __shfl_xor(mloc, 16)); mloc = fmaxf(mloc, __shfl_xor(mloc, 32));
                const float mnew = fmaxf(mrun, mloc), alpha = fast_exp(mrun - mnew);
                lrun = lrun * alpha; mrun = mnew;
#pragma unroll
                for (int mt = 0; mt < 16; ++mt) oacc[mt] = oacc[mt] * alpha;
            }
#pragma unroll
            for (int k2 = 0; k2 < 2; ++k2)
#pragma unroll
                for (int r = 0; r < 4; ++r) { const float p = fast_exp(st[k2][r] - mrun); st[k2][r] = p; lrun += p; }
            u32x4 pw; pw.x = pk2(st[0][0], st[0][1]); pw.y = pk2(st[0][2], st[0][3]); pw.z = pk2(st[1][0], st[1][1]); pw.w = pk2(st[1][2], st[1][3]);
            const bf16x8 pb = __builtin_bit_cast(bf16x8, pw);
            LAS unsigned char* tb = gb + (4 * kg + (n >> 2)) * AT_GROW + 8 * (n & 3);
#pragma unroll
            for (int mt = 0; mt < 16; ++mt) {
                const s16x4 v1 = __builtin_amdgcn_ds_read_tr16_b64_v4i16((LAS s16x4*)(tb + 32 * mt));
                const s16x4 v2 = __builtin_amdgcn_ds_read_tr16_b64_v4i16((LAS s16x4*)(tb + 16 * AT_GROW + 32 * mt));
                const bf16x8 av = (bf16x8){v1[0], v1[1], v1[2], v1[3], v2[0], v2[1], v2[2], v2[3]};
                oacc[mt] = __builtin_amdgcn_mfma_f32_16x16x32_bf16(av, pb, oacc[mt], 0, 0, 0);
            }
        }
        lrun += __shfl_xor(lrun, 16); lrun += __shfl_xor(lrun, 32);
        const float inv = 1.0f / lrun;
        if (n < 8) {
#pragma unroll
            for (int mt = 0; mt < 16; ++mt) { const f32x4 o = oacc[mt] * inv; u32x2 w; w.x = pk2(o[0], o[1]); w.y = pk2(o[2], o[3]); *(u32x2*)(qrow + n * 256 + 16 * mt + 4 * kg) = w; }
        }
    }
#ifdef DBG_TIME_ATT
    if (tid == 0) { const unsigned tn_ = (unsigned)__builtin_amdgcn_s_memrealtime(); ((LAS unsigned*)(lds + LDS_MISC))[20] += tn_ - tk0; tk0 = tn_; }
#endif
}
__device__ __forceinline__ void ln_finish(f32x4 (&v)[4], const float* gam, const float* bet, float* orow, bf16_t* brow, int lane) {
    float s = 0.f;
#pragma unroll
    for (int j = 0; j < 4; ++j) s += (v[j][0] + v[j][1]) + (v[j][2] + v[j][3]);
    const float mean = wave_sum(s) * (1.0f / 1024.0f); float s2 = 0.f;
#pragma unroll
    for (int j = 0; j < 4; ++j) { v[j] = v[j] - mean; s2 += (v[j][0] * v[j][0] + v[j][1] * v[j][1]) + (v[j][2] * v[j][2] + v[j][3] * v[j][3]); }
    const float rstd = 1.0f / __builtin_sqrtf(wave_sum(s2) * (1.0f / 1024.0f) + LN_EPS);
#pragma unroll
    for (int j = 0; j < 4; ++j) { const f32x4 g = *(const f32x4*)(gam + 256 * j + 4 * lane), bb = *(const f32x4*)(bet + 256 * j + 4 * lane);
        v[j] = v[j] * rstd * g + bb;
        if (orow != nullptr) *(f32x4*)(orow + 256 * j + 4 * lane) = v[j];
        u32x2 w; w.x = pk2(v[j][0], v[j][1]); w.y = pk2(v[j][2], v[j][3]); *(u32x2*)(brow + 256 * j + 4 * lane) = w; }
}
struct RouteP { int* r_e; int* r_pos; int* r_slot; float* r_g; unsigned* gcnt; };

__device__ __forceinline__ void ln1_route_block(LAS unsigned char* lds, int blk, float* xo, bf16_t* xb, const float* gam, const float* bet, const float* rbias, const RouteP& R, int tid) {
    const int wave = __builtin_amdgcn_readfirstlane(tid >> 6), lane = tid & 63;
    const LAS float* WR = (const LAS float*)lds; LAS int* lcnt = (LAS int*)(lds + 65536); LAS int* basee = (LAS int*)(lds + 65600); LAS int* tok = (LAS int*)(lds + 65664);
    __syncthreads();
    if (tid < 16) lcnt[tid] = 0;
    __syncthreads();
    u32x2 wn[4];
#pragma unroll
    for (int j = 0; j < 4; ++j) wn[j] = *(const u32x2*)(xb + ((size_t)blk * 128 + wave * 16) * 1024 + 256 * j + 4 * lane);
    float rb[16];
#pragma unroll
    for (int e = 0; e < 16; ++e) rb[e] = rbias[e];
    for (int rr = 0; rr < 16; ++rr) {
        const int rl = wave * 16 + rr; const size_t row = (size_t)blk * 128 + rl;
        f32x4 v[4];
#pragma unroll
        for (int j = 0; j < 4; ++j) { const u32x2 w = wn[j]; v[j] = (f32x4){bf_lo(w.x), bf_hi(w.x), bf_lo(w.y), bf_hi(w.y)}; }
        { const size_t rn = row + (rr + 1 < 16 ? 1 : 0);
#pragma unroll
          for (int j = 0; j < 4; ++j) wn[j] = *(const u32x2*)(xb + rn * 1024 + 256 * j + 4 * lane); }
        ln_finish(v, gam, bet, nullptr, xb + row * 1024, lane);
        float aff[16], sel[16];
#pragma unroll
        for (int e = 0; e < 16; ++e) { float p = 0.f;
#pragma unroll
            for (int j = 0; j < 4; ++j) { const f32x4 w = *(const LAS f32x4*)(WR + e * 1024 + 256 * j + 4 * lane); p += (v[j][0] * w[0] + v[j][1] * w[1]) + (v[j][2] * w[2] + v[j][3] * w[3]); }
            const float lg = wave_sum(p); aff[e] = sigmoidf_(lg); sel[e] = aff[e] + rb[e]; }
        float gbv = -3.0e38f; int gb = 0;
#pragma unroll
        for (int g = 0; g < 4; ++g) { float m1 = -3.0e38f, m2 = -3.0e38f;
#pragma unroll
            for (int i = 0; i < 4; ++i) { const float x = sel[4 * g + i]; if (x > m1) { m2 = m1; m1 = x; } else if (x > m2) m2 = x; }
            const float gs_ = m1 + m2; if (gs_ > gbv) { gbv = gs_; gb = g; } }
        float s0 = -3.0e38f, a0 = 0.f; int e0 = 0;
#pragma unroll
        for (int e = 0; e < 16; ++e) { const bool in = (e >> 2) == gb; if (in && sel[e] > s0) { s0 = sel[e]; a0 = aff[e]; e0 = e; } }
        float s1 = -3.0e38f, a1 = 0.f; int e1 = 0;
#pragma unroll
        for (int e = 0; e < 16; ++e) { const bool in = ((e >> 2) == gb) && (e != e0); if (in && sel[e] > s1) { s1 = sel[e]; a1 = aff[e]; e1 = e; } }
        if (lane == 0) {
            const float inv = 1.0f / (a0 + a1);
            const int p0 = __hip_atomic_fetch_add(lcnt + e0, 1, __ATOMIC_RELAXED, __HIP_MEMORY_SCOPE_WORKGROUP);
            const int p1 = __hip_atomic_fetch_add(lcnt + e1, 1, __ATOMIC_RELAXED, __HIP_MEMORY_SCOPE_WORKGROUP);
            tok[rl * 4 + 0] = e0; tok[rl * 4 + 1] = p0; tok[rl * 4 + 2] = e1; tok[rl * 4 + 3] = p1;
            *(f32x2*)(R.r_g + row * 2) = (f32x2){a0 * inv, a1 * inv};
        }
    }
    __syncthreads();
    if (tid < 16) basee[tid] = (int)__hip_atomic_fetch_add(R.gcnt + tid * 64, (unsigned)lcnt[tid], __ATOMIC_RELAXED, __HIP_MEMORY_SCOPE_AGENT);
    __syncthreads();
    if (tid < 256) { const int rl = tid >> 1, k = tid & 1; const int e = tok[rl * 4 + 2 * k], p = tok[rl * 4 + 2 * k + 1]; const size_t o = ((size_t)blk * 128 + rl) * 2 + k; R.r_e[o] = e; R.r_pos[o] = basee[e] + p; }
}
__device__ __forceinline__ void moe_offsets(LAS int* offp, const unsigned* gcnt, int tid) {
    __syncthreads();
    if (tid == 0) { int o = 0;
        for (int e = 0; e < 16; ++e) { offp[e] = o; const int c = (int)__hip_atomic_load(gcnt + e * 64, __ATOMIC_RELAXED, __HIP_MEMORY_SCOPE_AGENT); o += (c + 255) & ~255; }
        offp[16] = o; }
    __syncthreads();
}
#ifndef MK_PER_PHASE
#define MK_PER_PHASE 0
#endif
#ifndef EN_MASK
#define EN_MASK 0xFFF
#endif
#ifndef EN_M1
#define EN_M1 1
#endif
#ifndef EN_M2
#define EN_M2 1
#endif
#ifndef DBG_REP_P0A
#define DBG_REP_P0A 1
#endif
#ifndef EN_2A
#define EN_2A 1
#endif
#ifndef EN_2R
#define EN_2R 1
#endif
#define EN_A ((EN_MASK >> 0) & 1)
#define EN_B ((EN_MASK >> 1) & 1)
#define EN_0 ((EN_MASK >> 2) & 1)
#define EN_1 ((EN_MASK >> 3) & 1)
#define EN_2 ((EN_MASK >> 4) & 1)
#define EN_3 ((EN_MASK >> 5) & 1)
#define EN_4 ((EN_MASK >> 6) & 1)
#define EN_5 ((EN_MASK >> 7) & 1)
#define EN_6 ((EN_MASK >> 8) & 1)
#define EN_7 ((EN_MASK >> 9) & 1)
#define EN_8 ((EN_MASK >> 10) & 1)
#define EN_9 ((EN_MASK >> 11) & 1)
constexpr int NPH_L = 10, NPH = 2 + NL * NPH_L;
__device__ __forceinline__ const float* karg_in(int k) {
    typedef __attribute__((address_space(4))) const unsigned long long cu64_t;
    cu64_t* kp = (cu64_t*)__builtin_amdgcn_kernarg_segment_ptr();
    asm volatile("" : "+s"(kp));
    return (const float*)kp[k];
}
struct Args { const float* in[25]; float* out; unsigned char* ws; int ph_lo, ph_hi; };

__global__ void __launch_bounds__(NTHR, 2) fwd(Args a) {
    extern __shared__ __attribute__((aligned(16))) unsigned char lds_raw[];
    LAS unsigned char* lds = (LAS unsigned char*)lds_raw;
    const int G = gridDim.x, bx = blockIdx.x, vcu = (G % 8 == 0) ? (bx % 8) * (G / 8) + bx / 8 : bx;
    const int NGW = G * NWAVES;
#define PH_LOCALS int tid = wave_s * 64 + lane_id(); asm volatile("" : "+v"(tid)); const int lane = tid & 63, wave = wave_s, gw = vcu * NWAVES + wave; (void)lane; (void)gw;
    volatile LAS unsigned* MISC = (volatile LAS unsigned*)(lds + LDS_MISC);
    const int wave_s = __builtin_amdgcn_readfirstlane((int)threadIdx.x >> 6);
    if (threadIdx.x < 64) MISC[threadIdx.x] = 0u;
    __syncthreads();
    unsigned char* ws = a.ws;
    unsigned* ctl = (unsigned*)(ws + WS_CTL);
    const int lo = a.ph_lo, hi = a.ph_hi;
    XcdBarrier bar; bar.bar = ctl + CW_BAR; bar.x = 0; bar.st = MISC + 8;
    if (hi - lo > 1) bar = xcd_barrier_post(ctl + CW_BAR, MISC + 8);
#define IN(k) (lo <= (k) && (k) < hi)
#ifdef DBG_TIME
    if (blockIdx.x == 0 && threadIdx.x == 0) ctl[12288 + 63] = (unsigned)__builtin_amdgcn_s_memrealtime();
#define SEAM(k) do { if (IN(k) && IN((k) + 1)) { xcd_barrier(bar, wave_s == 0 && lane_id() == 0); if (bx == 0 && wave_s == 0 && lane_id() == 0) ctl[12288 + (k)] = (unsigned)__builtin_amdgcn_s_memrealtime(); } } while (0)
#else
#define SEAM(k) do { if (IN(k) && IN((k) + 1)) xcd_barrier(bar, wave_s == 0 && lane_id() == 0); } while (0)
#endif
    float* xo = a.out;
    bf16_t* xb = (bf16_t*)(ws + WS_XB);
    unsigned char* R = ws + WS_R;

    for (int rep_ = 0; rep_ < (DBG_REP_P0A); ++rep_)
    if (EN_A && IN(0)) { PH_LOCALS
        LAS float* scr = (LAS float*)(lds + wave * 8448);
        constexpr int PER_L = 4160;
        const float *in1 = karg_in(1), *in4 = karg_in(4), *in6 = karg_in(6), *in12 = karg_in(12), *in13 = karg_in(13), *in14 = karg_in(14);
        for (int it = gw; it < NL * PER_L; it += NGW) {
            const int l = it / PER_L; int r = it - l * PER_L;
            const float* win = in1 + (size_t)l * 1024 * DIN;
            unsigned char* wm = ws + WS_WMIX + (size_t)l * WMIX_STRIDE;
            if (r < 1024) { tr_item(win, DIN, 0, 2048, (bf16_t*)(wm + OFF_WIN), 1024, 0, r, 64, scr, lane); continue; } r -= 1024;
            if (r < 512) { tr_item(win, DIN, 3072, 840, (bf16_t*)(wm + OFF_WIN) + (size_t)4096 * 1024, 1024, 0, r, 32, scr, lane); continue; } r -= 512;
            if (r < 1024) { tr_item(win, DIN, 3912, 2048, (bf16_t*)(wm + OFF_WG), 1024, 0, r, 64, scr, lane); continue; } r -= 1024;
            if (r < 512) { tr_item(in12 + (size_t)l * 1048576, 1024, 0, 1024, (bf16_t*)(wm + OFF_WPR), 1024, 0, r, 32, scr, lane); continue; } r -= 512;
            if (r < 512) { tr_item(in14 + (size_t)l * 1048576, 1024, 0, 1024, (bf16_t*)(wm + OFF_WO), 1024, 0, r, 32, scr, lane); continue; } r -= 512;
            if (r < 512) { tr_item(in13 + (size_t)l * 1048576, 1024, 0, 1024, (bf16_t*)(R + R_PT + (size_t)l * 2 * MiB), 1024, 0, r, 32, scr, lane); continue; } r -= 512;
            { const int m = r >> 5, g = (r >> 1) & 15, nb = r & 1;
              const float* src = (m ? in6 : in4) + (size_t)(l * 16 + g) * 4096;
              bf16_t* dst = (bf16_t*)(ws + WS_WSM + (size_t)l * 262144 + (size_t)m * 131072) + g * 4096;
              tr_item(src, 64, 0, 64, dst, 64, 0, nb, 2, scr, lane); }
        }
        const size_t gt = (size_t)vcu * NTHR + tid, GT = (size_t)G * NTHR;
        for (size_t i = gt; i < (size_t)NL * 1024 * 128; i += 4 * GT) {
            f32x4 va[4], vb[4];
#pragma unroll
            for (int q = 0; q < 4; ++q) { const size_t iq = i + q * GT < (size_t)NL * 1024 * 128 ? i + q * GT : i; const int l = (int)(iq >> 17), k = (int)(iq >> 7) & 1023, j8 = (int)iq & 127;
                const float* s = in1 + ((size_t)l * 1024 + k) * DIN + 2048 + 8 * j8; va[q] = *(const f32x4*)s; vb[q] = *(const f32x4*)(s + 4); }
#pragma unroll
            for (int q = 0; q < 4; ++q) { const size_t iq = i + q * GT; const int l = (int)(iq >> 17), k = (int)(iq >> 7) & 1023, j8 = (int)iq & 127;
                if (iq < (size_t)NL * 1024 * 128) *(u32x4*)((bf16_t*)(R + R_WQ + (size_t)l * 2 * MiB) + (size_t)k * 1024 + 8 * j8) = pack8(va[q], vb[q]); }
        }
        const float *in10 = karg_in(10), *in11 = karg_in(11), *in0 = karg_in(0);
        for (size_t i = gt; i < (size_t)2 * NL * 8 * 256 * 32; i += GT) { const int which = (int)(i >> 18); const int r = (int)(i & 262143); const int lh = r >> 13, c = (r >> 5) & 255, d8 = r & 31; const int h = lh & 7;
            u32x4 o = (u32x4){0u, 0u, 0u, 0u};
            if ((d8 >> 4) == (h & 1)) { const float* s = (which ? in11 : in10) + ((size_t)lh * 256 + c) * 128 + 8 * (d8 & 15); o = pack8(*(const f32x4*)s, *(const f32x4*)(s + 4)); }
            *(u32x4*)((bf16_t*)(R + (which ? R_UVP : R_UKP)) + ((size_t)lh * 256 + c) * 1024 + 8 * d8) = o; }
        for (size_t i = gt; i < (size_t)T * 128; i += 4 * GT) {
            f32x4 va[4], vb[4];
#pragma unroll
            for (int k = 0; k < 4; ++k) { const size_t ik = i + k * GT < (size_t)T * 128 ? i + k * GT : i; const float* s = in0 + ik * 8; va[k] = *(const f32x4*)s; vb[k] = *(const f32x4*)(s + 4); }
#pragma unroll
            for (int k = 0; k < 4; ++k) { const size_t ik = i + k * GT; if (ik < (size_t)T * 128) *(u32x4*)(xb + ik * 8) = pack8(va[k], vb[k]); }
        }
    }
    SEAM(0);
    if (EN_B && IN(1)) {
        SchedPro S{R, G, vcu}; EpiPro E{ws + WS_WMIX};
        gs::gemm_stream<true>(lds, S, E, wave_s);
    }
    SEAM(1);

    for (int l = 0; l < NL; ++l) {
        const int pb = 2 + l * NPH_L;
        unsigned char* wm = ws + WS_WMIX + (size_t)l * WMIX_STRIDE;
        bf16_t* xrnn = (bf16_t*)(R + R_XRNN); bf16_t* grnn = (bf16_t*)(R + R_GRNN); bf16_t* qlat = (bf16_t*)(R + R_QLAT); bf16_t* ckv = (bf16_t*)(R + R_CKV);
        bf16_t* qidx = (bf16_t*)(R + R_QIDX); bf16_t* kidx = (bf16_t*)(R + R_KIDX); float* widx = (float*)(R + R_WIDX);
        if (EN_0 && IN(pb + 0)) {
            SchedDense S{(const char*)xb, (const char*)(wm + OFF_WIN), 2048u, 2048u, 16, T / 256, 20, G, vcu};
            EpiInproj E{xrnn, grnn, qlat, ckv, qidx, kidx, widx};
            gs::gemm_stream<true>(lds, S, E, wave_s);
#ifdef DBG_REP_INPROJ
            gs::gemm_stream<true>(lds, S, E, wave_s);
#endif
        }
        SEAM(pb + 0);
#define RNN_PARAMS RnnP RP{xrnn, grnn, (float*)(R + R_TOT), (const bf16_t*)(ws + WS_WSM + (size_t)l * 262144), (const bf16_t*)(ws + WS_WSM + (size_t)l * 262144 + 131072), \
                karg_in(2) + (size_t)l * 4096, karg_in(3) + (size_t)l * 1024, karg_in(5) + (size_t)l * 1024, karg_in(7) + (size_t)l * 1024, karg_in(8) + (size_t)l * 1024}
        if (EN_1 && IN(pb + 1)) { PH_LOCALS
#ifdef DBG_TIME
            if (tid == 0) MISC[24] = (unsigned)__builtin_amdgcn_s_memrealtime();
#endif
            { RNN_PARAMS;
            for (int it = gw; it < 2048; it += NGW) rnn_item<1>(RP, it, lds + wave * 8448, lane); }
#ifdef DBG_TIME
            if (tid == 0) MISC[25] = (unsigned)__builtin_amdgcn_s_memrealtime();
#endif
#ifdef DBG_REP_RNN
            { RNN_PARAMS; for (int it = gw; it < 2048; it += NGW) rnn_item<1>(RP, it, lds + wave * 8448, lane); }
#endif
            const float* in9 = karg_in(9) + (size_t)l * 256;
            for (int row = gw; row < T; row += 4 * NGW) ckv_norm_rows4(ckv, row, NGW, T, in9, lane);
#ifdef DBG_TIME
            if (tid == 0) MISC[26] = (unsigned)__builtin_amdgcn_s_memrealtime();
#endif
            const float *in19 = karg_in(19), *in20 = karg_in(20), *in21 = karg_in(21);
            LAS float* scr = (LAS float*)(lds + wave * 8448);
            for (int it = gw; it < 16 * 768; it += NGW) { const int e = it / 768; int r = it - e * 768; const size_t le = (size_t)l * 16 + e;
                bf16_t* gu = (bf16_t*)(ws + WS_WEXP) + (size_t)e * 1048576; bf16_t* dn = (bf16_t*)(ws + WS_WEXP + OFF_DN) + (size_t)e * 524288;
                if (r < 256) { tr_item(in19 + le * 524288, 512, 0, 512, gu, 1024, 1, r, 16, scr, lane); continue; } r -= 256;
                if (r < 256) { tr_item(in20 + le * 524288, 512, 0, 512, gu + 4 * 1024, 1024, 1, r, 16, scr, lane); continue; } r -= 256;
                tr_item(in21 + le * 524288, 1024, 0, 1024, dn, 512, 0, r, 32, scr, lane); }
#ifdef DBG_TIME
            if (l == 1 && bx == 0 && tid == 0) { const unsigned tq3 = (unsigned)__builtin_amdgcn_s_memrealtime();
                ctl[12288 + 48] = MISC[25] - MISC[24]; ctl[12288 + 49] = MISC[26] - MISC[25]; ctl[12288 + 50] = tq3 - MISC[26]; ctl[12288 + 51] = tq3 - MISC[24]; }
#endif
        }
        SEAM(pb + 1);
        if (EN_2 && IN(pb + 2)) { PH_LOCALS
            __syncthreads();
            if (tid < 256) ((LAS float*)(lds + AT_BIAS))[tid] = karg_in(24)[tid];
            if (tid < 128) { const int d = tid; int bk = d; if (d >= 16) { bk = 16 + (int)(logf((float)d / 16.0f) / 2.0794415416798357f * 16.0f); bk = bk > 31 ? 31 : bk; } ((LAS int*)(lds + AT_BKT))[d] = bk; }
            __syncthreads();
            for (int i = tid; i < 1024; i += NTHR) ((LAS float*)(lds + AT_BIAS2))[i] = ((const LAS float*)(lds + AT_BIAS))[((const LAS int*)(lds + AT_BKT))[i >> 3] * 8 + (i & 7)];
            AttnP AP{qidx, kidx, ckv, widx, qlat, (unsigned long long*)(R + R_MSCR + (size_t)bx * 393216)};
#ifdef DBG_TIME
            unsigned tph0 = (unsigned)__builtin_amdgcn_s_memrealtime();
#endif
#ifdef DBG_STATIC_UNITS
            if (EN_2A) for (int p = vcu; p < 512; p += G) { const int b = p >> 8, uu = p & 255;
#pragma unroll 1
                for (int k2 = 0; k2 < 2; ++k2) { attn_unit(lds, AP, b, k2 ? uu : 511 - uu, tid);
#ifdef DBG_TIME
                    if (tid == 0) MISC[21] = MISC[21] + 1u;
#endif
                } }
#else
            if (EN_2A) for (;;) {
                __syncthreads();
                if (tid == 0) MISC[4] = __hip_atomic_fetch_add(ctl + CW_QUEUE + l * 64, 1u, __ATOMIC_RELAXED, __HIP_MEMORY_SCOPE_AGENT);
                __syncthreads();
                const unsigned tk = MISC[4];
                if (tk >= 1024u) break;
                attn_unit(lds, AP, (int)(tk & 1u), 511 - (int)(tk >> 1), tid);
#ifdef DBG_TIME
                if (tid == 0) MISC[21] = MISC[21] + 1u;
#endif
            }
            __syncthreads();
#endif
#ifdef DBG_TIME
            if (l == 1 && bx == 0 && tid == 0) { for (int i_ = 0; i_ < 6; ++i_) ctl[12288 + 40 + i_] = ((LAS unsigned*)(lds + LDS_MISC))[16 + i_]; ctl[12288 + 46] = ((LAS unsigned*)(lds + LDS_MISC))[16]; }
            if (l == 0 && tid == 0) { for (int i_ = 0; i_ < 6; ++i_) ((LAS unsigned*)(lds + LDS_MISC))[16 + i_] = 0u; }
            __syncthreads();
            unsigned tph1 = (unsigned)__builtin_amdgcn_s_memrealtime();
            if (l == 1 && bx == 0 && tid == 0) ctl[12288 + 47] = tph1 - tph0;
            if (l == 1 && tid == 0) { __hip_atomic_fetch_max(ctl + 12288 + 59, tph1 - tph0, __ATOMIC_RELAXED, __HIP_MEMORY_SCOPE_AGENT); __hip_atomic_fetch_max(ctl + 12288 + 58, 0x40000000u - (tph1 - tph0), __ATOMIC_RELAXED, __HIP_MEMORY_SCOPE_AGENT); }
#endif
            if (EN_2R) { RNN_PARAMS; for (int it = gw; it < 2048; it += NGW) rnn_item<2>(RP, it, lds + wave * 8448, lane); }
#ifdef DBG_TIME
            { __syncthreads(); const unsigned tph2 = (unsigned)__builtin_amdgcn_s_memrealtime();
              if (l == 1 && tid == 0) __hip_atomic_fetch_max(ctl + 12288 + 57, tph2 - tph1, __ATOMIC_RELAXED, __HIP_MEMORY_SCOPE_AGENT); }
#endif
        }
        SEAM(pb + 2);
        if (EN_3 && IN(pb + 3)) {
            if (EN_M1) { SchedMerge1 S{(const char*)xb, (const char*)grnn, (const char*)(wm + OFF_WG), (const char*)(wm + OFF_WPR), G, vcu};
              EpiMerge1 E{R + R_MSCR + (size_t)bx * 131072, R + R_MSCR2, (bf16_t*)(R + R_MERGED)};
              gs::gemm_stream<true>(lds, S, E, wave_s); }
            if (EN_M2) { SchedDense S{(const char*)qlat, (const char*)(wm + OFF_WVO), 4096u, 4096u, 32, T / 256, 4, G, vcu};
              EpiMerge2 E{R + R_MSCR2, (bf16_t*)(R + R_MERGED)};
              gs::gemm_stream<true>(lds, S, E, wave_s); }
        }
        SEAM(pb + 3);
        if (EN_4 && IN(pb + 4)) {
            SchedDense S{(const char*)(R + R_MERGED), (const char*)(wm + OFF_WO), 2048u, 2048u, 16, T / 256, 4, G, vcu};
            EpiOut E{xb};
            gs::gemm_stream<true>(lds, S, E, wave_s);
        }
        SEAM(pb + 4);
        RouteP RT{(int*)(R + R_ROUTE), (int*)(R + R_ROUTE + 262144), (int*)(R + R_ROUTE + 524288), (float*)(R + R_ROUTE + 786432), ctl + CW_CNT + l * 16 * 64};
        LAS int* offp = (LAS int*)(lds + LDS_MISC - 128);
        if (EN_5 && IN(pb + 5)) { PH_LOCALS
            __syncthreads();
            { const float* in17 = karg_in(17); float wv[32];
#pragma unroll
              for (int j = 0; j < 32; ++j) wv[j] = in17[tid + j * NTHR];
#pragma unroll
              for (int j = 0; j < 32; ++j) { const int i = tid + j * NTHR; ((LAS float*)lds)[(i & 15) * 1024 + (i >> 4)] = wv[j]; } }
            const float *in15 = karg_in(15) + (size_t)l * 1024, *in16 = karg_in(16) + (size_t)l * 1024, *in18 = karg_in(18);
            for (int blk = vcu; blk < T / 128; blk += G) ln1_route_block(lds, blk, xo, xb, in15, in16, in18, RT, tid);
        }
        SEAM(pb + 5);
        int* tokof = (int*)(R + R_ROUTE + 1048576);
        if (EN_6 && IN(pb + 6)) { PH_LOCALS
            moe_offsets(offp, RT.gcnt, tid);
            for (int p = vcu * NTHR + tid; p < 2 * T; p += G * NTHR) { const int e = RT.r_e[p], slot = offp[e] + RT.r_pos[p]; RT.r_slot[p] = slot; tokof[slot] = p >> 1; }
            if (vcu == 0 && tid < 256) {
                for (int e = 0; e < 16; ++e) { const int cnt = (int)__hip_atomic_load(RT.gcnt + e * 64, __ATOMIC_RELAXED, __HIP_MEMORY_SCOPE_AGENT); const int s0 = offp[e] + cnt;
                    if (s0 + tid < offp[e + 1]) tokof[s0 + tid] = 0; } }
        }
        SEAM(pb + 6);
        if (EN_7 && IN(pb + 7)) { PH_LOCALS
            moe_offsets(offp, RT.gcnt, tid);
            SchedMoEG S{(const char*)xb, (const char*)(ws + WS_WEXP), 2048u, 2048u, (size_t)2097152, 16, 4, G, vcu, offp, tokof};
            EpiGU E{(bf16_t*)(R + R_HE)};
            gs::gemm_stream<true, SchedMoEG, EpiGU, true>(lds, S, E, wave_s);
        }
        SEAM(pb + 7);
        if (EN_8 && IN(pb + 8)) { PH_LOCALS
            moe_offsets(offp, RT.gcnt, tid);
            SchedMoE S{(const char*)(R + R_HE), (const char*)(ws + WS_WEXP + OFF_DN), 1024u, 1024u, (size_t)1048576, 8, 4, G, vcu, offp};
            EpiBf16 E{(bf16_t*)(R + R_XG), 1024};
            gs::gemm_stream<true>(lds, S, E, wave_s);
        }
        SEAM(pb + 8);
        if (EN_9 && IN(pb + 9)) { PH_LOCALS
            const bf16_t* Y = (const bf16_t*)(R + R_XG);
            const float *in22 = karg_in(22) + (size_t)l * 1024, *in23 = karg_in(23) + (size_t)l * 1024;
#define LN2_ROWS(X, Y0, Y1, A0, A1, RR) do { _Pragma("unroll") for (int j = 0; j < 4; ++j) { X[j] = *(const u32x2*)(xb + (size_t)(RR) * 1024 + 256 * j + 4 * lane); \
                Y0[j] = *(const u32x2*)(Y + (size_t)(A0) * 1024 + 256 * j + 4 * lane); Y1[j] = *(const u32x2*)(Y + (size_t)(A1) * 1024 + 256 * j + 4 * lane); } } while (0)
#define LN2_CL(r_) ((r_) < T ? (r_) : T - 1)
            u32x2 xwa[4], y0a[4], y1a[4], xwb[4], y0b[4], y1b[4]; int s0n, s1n; f32x2 gga, ggb, ggn;
            { const int r0 = LN2_CL(gw), r1 = LN2_CL(gw + NGW), r2 = LN2_CL(gw + 2 * NGW);
              const int a0 = RT.r_slot[2 * r0], a1 = RT.r_slot[2 * r0 + 1], c0 = RT.r_slot[2 * r1], c1 = RT.r_slot[2 * r1 + 1];
              gga = *(const f32x2*)(RT.r_g + 2 * (size_t)r0); ggb = *(const f32x2*)(RT.r_g + 2 * (size_t)r1);
              LN2_ROWS(xwa, y0a, y1a, a0, a1, r0); LN2_ROWS(xwb, y0b, y1b, c0, c1, r1);
              s0n = RT.r_slot[2 * r2]; s1n = RT.r_slot[2 * r2 + 1]; ggn = *(const f32x2*)(RT.r_g + 2 * (size_t)r2); }
            for (int row = gw; row < T; row += NGW) {
                const f32x2 gg = gga;
                u32x2 xwc[4], y0c[4], y1c[4];
#pragma unroll
                for (int j = 0; j < 4; ++j) { xwc[j] = xwa[j]; y0c[j] = y0a[j]; y1c[j] = y1a[j]; xwa[j] = xwb[j]; y0a[j] = y0b[j]; y1a[j] = y1b[j]; }
                gga = ggb;
                { const int r2 = LN2_CL(row + 2 * NGW), r3 = LN2_CL(row + 3 * NGW);
                  const int a0 = s0n, a1 = s1n; ggb = ggn;
                  LN2_ROWS(xwb, y0b, y1b, a0, a1, r2);
                  s0n = RT.r_slot[2 * r3]; s1n = RT.r_slot[2 * r3 + 1]; ggn = *(const f32x2*)(RT.r_g + 2 * (size_t)r3); }
                f32x4 v[4];
#pragma unroll
                for (int j = 0; j < 4; ++j) { const u32x2 xw = xwc[j]; const f32x4 x1 = {bf_lo(xw.x), bf_hi(xw.x), bf_lo(xw.y), bf_hi(xw.y)};
                    const u32x2 y0 = y0c[j], y1 = y1c[j];
                    v[j][0] = ALPHA * x1[0] + gg.x * bf_lo(y0.x) + gg.y * bf_lo(y1.x); v[j][1] = ALPHA * x1[1] + gg.x * bf_hi(y0.x) + gg.y * bf_hi(y1.x);
                    v[j][2] = ALPHA * x1[2] + gg.x * bf_lo(y0.y) + gg.y * bf_lo(y1.y); v[j][3] = ALPHA * x1[3] + gg.x * bf_hi(y0.y) + gg.y * bf_hi(y1.y); }
                ln_finish(v, in22, in23, l == NL - 1 ? xo + (size_t)row * 1024 : nullptr, xb + (size_t)row * 1024, lane);
#ifdef DBG_TIME
                if (l == NL - 1) {
                    const unsigned ta = __hip_atomic_load(ctl + 12288 + (DBG_TA), __ATOMIC_RELAXED, __HIP_MEMORY_SCOPE_AGENT), tb = __hip_atomic_load(ctl + 12288 + (DBG_TB), __ATOMIC_RELAXED, __HIP_MEMORY_SCOPE_AGENT);
                    unsigned k_ = (DBG_Q) == 0 ? (40u * ta + tb / 2u) / (tb ? tb : 1u) : ((DBG_TA) == 58 ? (0x40000000u - ta) : (ta - tb)) / (unsigned)((DBG_Q) ? (DBG_Q) : 1); k_ = k_ > 45u ? 45u : k_;
                    const float sc_ = 1.0f - 0.02f * (float)k_;
#pragma unroll
                    for (int j = 0; j < 4; ++j) *(f32x4*)(xo + (size_t)row * 1024 + 256 * j + 4 * lane) = v[j] * sc_; }
#endif
            }
        }
#undef LN2_ROWS
#undef LN2_CL
        SEAM(pb + 9);
    }
#undef IN
#undef SEAM
}

#ifdef DUMP_OFF
__global__ void dump_k(const bf16_t* src, float* dst, size_t ld, size_t col0) { for (size_t i = (size_t)blockIdx.x * blockDim.x + threadIdx.x; i < (size_t)T * 1024; i += (size_t)gridDim.x * blockDim.x) dst[i] = bf2f(src[(i >> 10) * ld + col0 + (i & 1023)]); }
#endif
extern "C" void kernel_launch(void* const* d_in, const int* in_sizes, int n_in, void* d_out, int out_size, void* d_ws, size_t ws_size, hipStream_t stream) {
    static int grid = 0;
    if (grid == 0) {
        if (n_in != 25 || out_size != T * D || ws_size < WS_END) { fprintf(stderr, "kernel_launch: unexpected shapes (n_in %d, out %d, ws %zu < %zu)\n", n_in, out_size, ws_size, (size_t)WS_END); grid = -1; return; }
        int dev = 0, cus = 0, per_cu = 0;
        if (hipGetDevice(&dev) != hipSuccess || hipDeviceGetAttribute(&cus, hipDeviceAttributeMultiprocessorCount, dev) != hipSuccess) { grid = -1; return; }
        if (hipFuncSetAttribute((const void*)fwd, hipFuncAttributeMaxDynamicSharedMemorySize, LDS_BYTES) != hipSuccess) { fprintf(stderr, "kernel_launch: hipFuncSetAttribute failed\n"); grid = -1; return; }
        if (hipOccupancyMaxActiveBlocksPerMultiprocessor(&per_cu, (const void*)fwd, NTHR, LDS_BYTES) != hipSuccess || per_cu < 1) fprintf(stderr, "kernel_launch: occupancy query says %d\n", per_cu);
        (void)hipGetLastError();
        grid = cus < 256 ? cus : 256;
    }
    if (grid < 0) return;
    (void)hipMemsetAsync((char*)d_ws + WS_CTL, 0, CTL_BYTES, stream);
    Args a{};
    for (int i = 0; i < 25; ++i) a.in[i] = (const float*)d_in[i];
    a.out = (float*)d_out; a.ws = (unsigned char*)d_ws;
#if MK_PER_PHASE
#ifndef PH_LIMIT
#define PH_LIMIT NPH
#endif
    for (int ph = 0; ph < PH_LIMIT; ++ph) { a.ph_lo = ph; a.ph_hi = ph + 1; hipLaunchKernelGGL(fwd, dim3(grid), dim3(NTHR), LDS_BYTES, stream, a); }
#else
    a.ph_lo = 0; a.ph_hi = NPH; hipLaunchKernelGGL(fwd, dim3(grid), dim3(NTHR), LDS_BYTES, stream, a);
#endif
#ifdef DUMP_OFF
    hipLaunchKernelGGL(dump_k, dim3(2048), dim3(256), 0, stream, (const bf16_t*)((const char*)d_ws + (DUMP_OFF)), (float*)d_out, (size_t)(DUMP_LD), (size_t)(DUMP_COL));
#endif
}
```
